# Optimizing an MI355X kernel written in HIP

```python
import math
import jax, jax.numpy as jnp
from jax import lax
import numpy as np

D_MODEL = 1024
BATCH = 2
SEQ = 8192
DEPTH = 1

GRID_W = 64
HEAD_DIM = 128
HALF_ROT = HEAD_DIM // 2
RET_HEADS = 4
RET_DIM = RET_HEADS * HEAD_DIM
ATT_HEADS = 4
ATT_KV_HEADS = 2
ATT_DIM = ATT_HEADS * HEAD_DIM
ATT_KV_DIM = ATT_KV_HEADS * HEAD_DIM
CHUNK = 128
Q_BLOCK = 128
ROPE_THETA = 10000.0
N_EXPERTS = 16
EXPERT_FF = 2816
CAPACITY_FACTOR = 2
EPS = 1e-6
IN_WIDTH = 4 * RET_DIM + ATT_DIM + 2 * ATT_KV_DIM + 2 * D_MODEL
SPLIT_POINTS = (RET_DIM, 2 * RET_DIM, 3 * RET_DIM, 4 * RET_DIM,
                4 * RET_DIM + ATT_DIM,
                4 * RET_DIM + ATT_DIM + ATT_KV_DIM,
                4 * RET_DIM + ATT_DIM + 2 * ATT_KV_DIM,
                4 * RET_DIM + ATT_DIM + 2 * ATT_KV_DIM + D_MODEL)

kernel_name = "hybrid_retention_axialgqa_ecmoe_encoder"


def rmsnorm(x, g):
    xf = x.astype(jnp.float32)
    y = xf * lax.rsqrt(jnp.mean(xf * xf, axis=-1, keepdims=True) + EPS)
    return (y * g.astype(jnp.float32)).astype(x.dtype)


def axial_rope_tables(seq):
    rows = seq // GRID_W
    row = jnp.repeat(jnp.arange(rows, dtype=jnp.float32), GRID_W)
    col = jnp.tile(jnp.arange(GRID_W, dtype=jnp.float32), rows)
    n_freq = HALF_ROT // 2
    freqs = ROPE_THETA ** (-jnp.arange(n_freq, dtype=jnp.float32) / n_freq)
    ang = jnp.concatenate([row[:, None] * freqs, col[:, None] * freqs], axis=-1)
    return jnp.cos(ang), jnp.sin(ang)


def apply_rope(x, cos, sin):
    c = cos[None, :, None, :]
    s = sin[None, :, None, :]
    x1 = x[..., :HALF_ROT].astype(jnp.float32)
    x2 = x[..., HALF_ROT:].astype(jnp.float32)
    return jnp.concatenate([x1 * c - x2 * s, x1 * s + x2 * c], axis=-1).astype(x.dtype)


def retention_chunkwise(q, k, v, log_gamma, strict):
    B, H, S, dk = q.shape
    dv = v.shape[-1]
    n = S // CHUNK
    q = q.reshape(B, H, n, CHUNK, dk)
    k = k.reshape(B, H, n, CHUNK, dk)
    v = v.reshape(B, H, n, CHUNK, dv)
    idx = jnp.arange(CHUNK, dtype=jnp.float32)
    lg = log_gamma.astype(jnp.float32)
    diff = idx[:, None] - idx[None, :]
    mask = (diff > 0) if strict else (diff >= 0)
    decay = jnp.where(mask[None], jnp.exp(lg[:, None, None] * jnp.maximum(diff, 0.0)[None]), 0.0)
    scores = jnp.einsum('bhncd,bhnmd->bhncm', q, k) * decay[None, :, None]
    intra = jnp.einsum('bhncm,bhnme->bhnce', scores, v)
    k_dec = k * jnp.exp(lg[:, None] * (CHUNK - 1.0 - idx)[None])[None, :, None, :, None]
    kv = jnp.einsum('bhncd,bhnce->nbhde', k_dec, v)
    chunk_decay = jnp.exp(lg * CHUNK)[None, :, None, None]

    def step(state, kv_c):
        return state * chunk_decay + kv_c, state

    _, prev = lax.scan(step, jnp.zeros((B, H, dk, dv), jnp.float32), kv)
    q_dec = q * jnp.exp(lg[:, None] * (idx + 1.0)[None])[None, :, None, :, None]
    inter = jnp.einsum('bhncd,nbhde->bhnce', q_dec, prev)
    return (intra + inter).reshape(B, H, S, dv)


def bidirectional_retention(q, k, v, p_fwd, p_bwd):
    lg_f = jnp.log1p(-jnp.exp(p_fwd.astype(jnp.float32)))
    lg_b = jnp.log1p(-jnp.exp(p_bwd.astype(jnp.float32)))
    qt = q.astype(jnp.float32).transpose(0, 2, 1, 3)
    kt = k.astype(jnp.float32).transpose(0, 2, 1, 3)
    vt = v.astype(jnp.float32).transpose(0, 2, 1, 3)
    fwd = retention_chunkwise(qt, kt, vt, lg_f, strict=False)
    bwd = retention_chunkwise(qt[:, :, ::-1], kt[:, :, ::-1], vt[:, :, ::-1], lg_b, strict=True)[:, :, ::-1]
    return (fwd + bwd).transpose(0, 2, 1, 3)


def group_norm_heads(y, gain):
    mu = jnp.mean(y, axis=-1, keepdims=True)
    var = jnp.mean(jnp.square(y - mu), axis=-1, keepdims=True)
    yn = (y - mu) * lax.rsqrt(var + EPS)
    B, S = y.shape[:2]
    return yn.reshape(B, S, RET_DIM) * gain.astype(jnp.float32)


def gqa_block_attention(q, k, v):
    B, S = q.shape[:2]
    nblk = S // Q_BLOCK
    R = ATT_HEADS // ATT_KV_HEADS
    scale = HEAD_DIM ** -0.5
    qb = q.reshape(B, nblk, Q_BLOCK, ATT_KV_HEADS, R, HEAD_DIM).transpose(1, 0, 3, 4, 2, 5)
    kt = k.transpose(0, 2, 1, 3)
    vt = v.transpose(0, 2, 1, 3)

    def one_block(qblk):
        s = jnp.einsum('bgrqd,bgkd->bgrqk', qblk, kt).astype(jnp.float32) * scale
        p = jax.nn.softmax(s, axis=-1).astype(vt.dtype)
        return jnp.einsum('bgrqk,bgkd->bgrqd', p, vt)

    o = lax.map(one_block, qb)
    return o.transpose(1, 0, 4, 2, 3, 5).reshape(B, S, ATT_DIM)


def expert_choice_ffn(h, w_router, w_gate, w_up, w_down):
    B, S, D = h.shape
    cap = CAPACITY_FACTOR * S // N_EXPERTS
    logits = jnp.einsum('bsd,de->bse', h, w_router)
    aff = jax.nn.softmax(logits.astype(jnp.float32), axis=-1)
    gates, idx = lax.top_k(aff.transpose(0, 2, 1), cap)
    xe = jax.vmap(lambda hb, ib: hb[ib])(h, idx)
    a = jnp.einsum('becd,edf->becf', xe, w_gate)
    u = jnp.einsum('becd,edf->becf', xe, w_up)
    y = jnp.einsum('becf,efd->becd', jax.nn.silu(a) * u, w_down)
    y = y * gates[..., None].astype(y.dtype)
    flat = (idx + (jnp.arange(B, dtype=jnp.int32) * S)[:, None, None]).reshape(-1)
    out = jnp.zeros((B * S, D), y.dtype).at[flat].add(y.reshape(-1, D))
    return out.reshape(B, S, D)


def setup_inputs(seed: int = 0) -> dict:
    key = jax.random.key(seed)
    ks = jax.random.split(key, 20)

    def nrm(k, shape, scale):
        return jax.random.normal(k, shape, jnp.float32) * scale

    base_p = -(5.0 + jnp.arange(RET_HEADS, dtype=jnp.float32)) * math.log(2.0)
    return {
        "x": nrm(ks[0], (BATCH, SEQ, D_MODEL), 1.0),
        "norm_mix": 1.0 + nrm(ks[1], (DEPTH, D_MODEL), 0.02),
        "w_in": nrm(ks[2], (DEPTH, D_MODEL, IN_WIDTH), D_MODEL ** -0.5),
        "ret_decay_fwd": base_p[None] + nrm(ks[3], (DEPTH, RET_HEADS), 0.1),
        "ret_decay_bwd": base_p[None] + nrm(ks[4], (DEPTH, RET_HEADS), 0.1),
        "ret_gn_gain": 1.0 + nrm(ks[5], (DEPTH, RET_DIM), 0.02),
        "w_ret_branch": nrm(ks[6], (DEPTH, RET_DIM, D_MODEL), RET_DIM ** -0.5),
        "q_norm": 1.0 + nrm(ks[7], (DEPTH, HEAD_DIM), 0.02),
        "k_norm": 1.0 + nrm(ks[8], (DEPTH, HEAD_DIM), 0.02),
        "w_att_branch": nrm(ks[9], (DEPTH, ATT_DIM, D_MODEL), ATT_DIM ** -0.5),
        "w_o": nrm(ks[10], (DEPTH, D_MODEL, D_MODEL), D_MODEL ** -0.5),
        "norm_ffn": 1.0 + nrm(ks[11], (DEPTH, D_MODEL), 0.02),
        "w_router": nrm(ks[12], (DEPTH, D_MODEL, N_EXPERTS), D_MODEL ** -0.5),
        "w_expert_gate": nrm(ks[13], (DEPTH, N_EXPERTS, D_MODEL, EXPERT_FF), D_MODEL ** -0.5),
        "w_expert_up": nrm(ks[14], (DEPTH, N_EXPERTS, D_MODEL, EXPERT_FF), D_MODEL ** -0.5),
        "w_expert_down": nrm(ks[15], (DEPTH, N_EXPERTS, EXPERT_FF, D_MODEL), EXPERT_FF ** -0.5),
        "norm_final": 1.0 + nrm(ks[16], (D_MODEL,), 0.02),
    }


def reference(x, norm_mix, w_in, ret_decay_fwd, ret_decay_bwd, ret_gn_gain, w_ret_branch,
              q_norm, k_norm, w_att_branch, w_o, norm_ffn, w_router, w_expert_gate,
              w_expert_up, w_expert_down, norm_final):
    B, S, _ = x.shape
    cos, sin = axial_rope_tables(S)
    for l in range(DEPTH):
        h = rmsnorm(x, norm_mix[l])
        proj = jnp.einsum('bsd,dk->bsk', h, w_in[l])
        rq, rk, rv, rg, aq, ak, av, gr, ga = jnp.split(proj, SPLIT_POINTS, axis=-1)

        rq = apply_rope(rq.reshape(B, S, RET_HEADS, HEAD_DIM), cos, sin)
        rk = apply_rope(rk.reshape(B, S, RET_HEADS, HEAD_DIM), cos, sin) * (HEAD_DIM ** -0.5)
        rv = rv.reshape(B, S, RET_HEADS, HEAD_DIM)
        y_ret = bidirectional_retention(rq, rk, rv, ret_decay_fwd[l], ret_decay_bwd[l])
        y_ret = group_norm_heads(y_ret, ret_gn_gain[l]).astype(x.dtype)
        y_ret = jnp.einsum('bsk,kd->bsd', jax.nn.silu(rg) * y_ret, w_ret_branch[l])

        aq = apply_rope(rmsnorm(aq.reshape(B, S, ATT_HEADS, HEAD_DIM), q_norm[l]), cos, sin)
        ak = apply_rope(rmsnorm(ak.reshape(B, S, ATT_KV_HEADS, HEAD_DIM), k_norm[l]), cos, sin)
        av = av.reshape(B, S, ATT_KV_HEADS, HEAD_DIM)
        y_att = gqa_block_attention(aq, ak, av)
        y_att = jnp.einsum('bsk,kd->bsd', y_att, w_att_branch[l])

        mixed = jax.nn.sigmoid(gr) * y_ret + jax.nn.sigmoid(ga) * y_att
        x = x + jnp.einsum('bsd,de->bse', mixed, w_o[l])

        h2 = rmsnorm(x, norm_ffn[l])
        x = x + expert_choice_ffn(h2, w_router[l], w_expert_gate[l], w_expert_up[l], w_expert_down[l])
    return rmsnorm(x, norm_final)
```

```cpp
#include <hip/hip_runtime.h>
#include <cstdio>
#include <cstdint>

constexpr int D_MODEL = 1024, BATCH = 2, SEQ = 8192, T = BATCH * SEQ;
constexpr int HD = 128, CHUNK = 128, NCHUNK = SEQ / CHUNK;
constexpr int NE = 16, FF = 2816, CAP = 1024;
constexpr int INW = 5120;
constexpr int O_RQ = 0, O_RK = 512, O_RV = 1024, O_RG = 1536, O_AQ = 2048, O_AK = 2560, O_AV = 2816, O_GR = 3072, O_GA = 4096;
constexpr float EPS = 1e-6f;

__device__ __forceinline__ float wave_sum(float v) {
#pragma unroll
  for (int o = 32; o > 0; o >>= 1) v += __shfl_xor(v, o);
  return v;
}
__device__ __forceinline__ float sigmoidf_(float x) { return 1.0f / (1.0f + expf(-x)); }
__device__ __forceinline__ float siluf_(float x) { return x / (1.0f + expf(-x)); }

__global__ __launch_bounds__(256) void k_rmsnorm(const float* __restrict__ x, const float* __restrict__ g, float* __restrict__ out) {
  const int row = blockIdx.x * 4 + (threadIdx.x >> 6), lane = threadIdx.x & 63;
  const float4* xr = (const float4*)(x + (size_t)row * D_MODEL);
  float4 v[4]; float s = 0.f;
#pragma unroll
  for (int j = 0; j < 4; ++j) { v[j] = xr[lane + 64 * j]; s += v[j].x * v[j].x + v[j].y * v[j].y + v[j].z * v[j].z + v[j].w * v[j].w; }
  s = wave_sum(s);
  const float r = 1.0f / sqrtf(s * (1.0f / D_MODEL) + EPS);
  const float4* gr = (const float4*)g; float4* o = (float4*)(out + (size_t)row * D_MODEL);
#pragma unroll
  for (int j = 0; j < 4; ++j) { const float4 gg = gr[lane + 64 * j]; o[lane + 64 * j] = make_float4(v[j].x * r * gg.x, v[j].y * r * gg.y, v[j].z * r * gg.z, v[j].w * r * gg.w); }
}

struct GemmArgs {
  const float* A; const int* ridx; long lda; long a_bs_hi; long a_bs_z; long zdiv;
  long ridx_bs; const float* B; long ldb; long b_bs; long K;
};
template <class Epi>
__global__ __launch_bounds__(256) void k_sgemm(GemmArgs g, Epi epi) {
  __shared__ float As[16][68]; __shared__ float Bs[16][68];
  const int z = blockIdx.z, tid = threadIdx.x, ty = tid >> 4, tx = tid & 15; const int zdiv = (int)g.zdiv, K = (int)g.K;
  const int m0 = blockIdx.y * 64, n0 = blockIdx.x * 64;
  const float* A = g.A + (long)(z / zdiv) * g.a_bs_hi + (long)z * g.a_bs_z;
  const float* B = g.B + (long)(z % zdiv) * g.b_bs;
  const int ar = tid >> 2, ak = (tid & 3) * 4, bk = tid >> 4, bc = (tid & 15) * 4;
  const long arow = g.ridx ? (long)g.ridx[(long)z * g.ridx_bs + m0 + ar] : (long)(m0 + ar);
  const float* ap = A + arow * g.lda + ak;
  const float* bp = B + (long)bk * g.ldb + n0 + bc;
  float acc[4][4];
#pragma unroll
  for (int i = 0; i < 4; ++i)
#pragma unroll
    for (int j = 0; j < 4; ++j) acc[i][j] = 0.f;
  for (int k0 = 0; k0 < K; k0 += 16) {
    const float4 av = *(const float4*)(ap + k0);
    const float4 bv = *(const float4*)(bp + (long)k0 * g.ldb);
    As[ak + 0][ar] = av.x; As[ak + 1][ar] = av.y; As[ak + 2][ar] = av.z; As[ak + 3][ar] = av.w;
    *(float4*)&Bs[bk][bc] = bv;
    __syncthreads();
#pragma unroll
    for (int kk = 0; kk < 16; ++kk) {
      const float4 a4 = *(const float4*)&As[kk][ty * 4]; const float4 b4 = *(const float4*)&Bs[kk][tx * 4];
      const float a[4] = {a4.x, a4.y, a4.z, a4.w}, b[4] = {b4.x, b4.y, b4.z, b4.w};
#pragma unroll
      for (int i = 0; i < 4; ++i)
#pragma unroll
        for (int j = 0; j < 4; ++j) acc[i][j] += a[i] * b[j];
    }
    __syncthreads();
  }
#pragma unroll
  for (int i = 0; i < 4; ++i)
#pragma unroll
    for (int j = 0; j < 4; ++j) epi(z, m0 + ty * 4 + i, n0 + tx * 4 + j, acc[i][j]);
}
struct EpiStore { float* C; long ldc; long c_bs; __device__ void operator()(int z, int r, int c, float v) const { C[(long)z * c_bs + (long)r * ldc + c] = v; } };
struct EpiGate1 { float* mixed; const float* proj; __device__ void operator()(int, int r, int c, float v) const { mixed[(long)r * D_MODEL + c] = sigmoidf_(proj[(long)r * INW + O_GR + c]) * v; } };
struct EpiGate2 { float* mixed; const float* proj; __device__ void operator()(int, int r, int c, float v) const { mixed[(long)r * D_MODEL + c] += sigmoidf_(proj[(long)r * INW + O_GA + c]) * v; } };
struct EpiResid { float* x1; const float* x; __device__ void operator()(int, int r, int c, float v) const { x1[(long)r * D_MODEL + c] = x[(long)r * D_MODEL + c] + v; } };
struct EpiSwiglu { float* act; __device__ void operator()(int z, int r, int c, float v) const { float* p = act + ((long)z * CAP + r) * FF + c; *p = siluf_(*p) * v; } };
struct EpiDown { float* y; const float* gate; __device__ void operator()(int z, int r, int c, float v) const { y[((long)z * CAP + r) * D_MODEL + c] = v * gate[z * CAP + r]; } };

__global__ __launch_bounds__(256) void k_rope_norm(float* __restrict__ proj, const float* __restrict__ qn, const float* __restrict__ kn) {
  const long w = (long)blockIdx.x * 4 + (threadIdx.x >> 6); const int lane = threadIdx.x & 63;
  const long t = w / 14; const int s = (int)(w % 14);
  int base; const float* nrm = nullptr; float scale = 1.f;
  if (s < 4) base = O_RQ + s * HD;
  else if (s < 8) { base = O_RK + (s - 4) * HD; scale = 0.08838834764831845f; }
  else if (s < 12) { base = O_AQ + (s - 8) * HD; nrm = qn; }
  else { base = O_AK + (s - 12) * HD; nrm = kn; }
  float* p = proj + t * INW + base;
  float x1 = p[lane], x2 = p[lane + 64];
  if (nrm) { const float ss = wave_sum(x1 * x1 + x2 * x2); const float r = 1.0f / sqrtf(ss * (1.0f / HD) + EPS); x1 = x1 * r * nrm[lane]; x2 = x2 * r * nrm[lane + 64]; }
  const int pos = (int)(t % SEQ), prow = pos / 64, pcol = pos % 64;
  const float freq = powf(10000.0f, -(float)(lane & 31) / 32.0f);
  const float ang = (float)(lane < 32 ? prow : pcol) * freq;
  const float c = cosf(ang), sn = sinf(ang);
  p[lane] = (x1 * c - x2 * sn) * scale; p[lane + 64] = (x1 * sn + x2 * c) * scale;
}

__device__ __forceinline__ float lg_of(const float* p, int h) { return log1pf(-expf(p[h])); }
__global__ __launch_bounds__(256) void k_ret_kv(const float* __restrict__ proj, const float* __restrict__ pf, const float* __restrict__ pb, float* __restrict__ kv) {
  const int c = blockIdx.x, bh = blockIdx.y, dir = blockIdx.z, b = bh >> 2, h = bh & 3, tid = threadIdx.x;
  const float lg = lg_of(dir ? pb : pf, h);
  const float* base = proj + ((long)b * SEQ + (long)c * CHUNK) * INW + h * HD;
  float* out = kv + (((long)dir * 8 + bh) * NCHUNK + c) * (HD * HD);
  const int e = tid & 127;
  for (int d = tid >> 7; d < HD; d += 2) {
    float acc = 0.f;
    for (int j = 0; j < CHUNK; ++j) {
      const float w = expf(lg * (dir ? (float)j : (float)(CHUNK - 1 - j)));
      acc += w * base[(long)j * INW + O_RK + d] * base[(long)j * INW + O_RV + e];
    }
    out[d * HD + e] = acc;
  }
}
__global__ __launch_bounds__(256) void k_ret_scan(const float* __restrict__ pf, const float* __restrict__ pb, float* __restrict__ kv) {
  const long gid = (long)blockIdx.x * 256 + threadIdx.x;
  const int el = (int)(gid & 16383), bh = (int)((gid >> 14) & 7), dir = (int)(gid >> 17), h = bh & 3;
  const float g = expf(lg_of(dir ? pb : pf, h) * (float)CHUNK);
  float* p = kv + (((long)dir * 8 + bh) * NCHUNK) * (HD * HD) + el;
  float S = 0.f;
  if (dir == 0) { for (int c = 0; c < NCHUNK; ++c) { const float v = p[(long)c * HD * HD]; p[(long)c * HD * HD] = S; S = S * g + v; } }
  else { for (int c = NCHUNK - 1; c >= 0; --c) { const float v = p[(long)c * HD * HD]; p[(long)c * HD * HD] = S; S = S * g + v; } }
}
__global__ __launch_bounds__(256) void k_ret_P(const float* __restrict__ proj, const float* __restrict__ pf, const float* __restrict__ pb, float* __restrict__ P) {
  const int c = blockIdx.x, bh = blockIdx.y, b = bh >> 2, h = bh & 3, tid = threadIdx.x;
  const float lgf = lg_of(pf, h), lgb = lg_of(pb, h);
  const float* base = proj + ((long)b * SEQ + (long)c * CHUNK) * INW + h * HD;
  float* out = P + ((long)bh * NCHUNK + c) * (CHUNK * CHUNK);
  const int j = tid & 127;
  for (int i = tid >> 7; i < CHUNK; i += 2) {
    const float4* q = (const float4*)(base + (long)i * INW + O_RQ); const float4* k = (const float4*)(base + (long)j * INW + O_RK);
    float s = 0.f;
    for (int d = 0; d < HD / 4; ++d) { const float4 a = q[d], bb = k[d]; s += a.x * bb.x + a.y * bb.y + a.z * bb.z + a.w * bb.w; }
    const float dec = (j <= i) ? expf(lgf * (float)(i - j)) : expf(lgb * (float)(j - i));
    out[i * CHUNK + j] = s * dec;
  }
}
__global__ __launch_bounds__(256) void k_ret_out(const float* __restrict__ proj, const float* __restrict__ pf, const float* __restrict__ pb, const float* __restrict__ P,
                                                 const float* __restrict__ kv, const float* __restrict__ gain, float* __restrict__ yrin) {
  __shared__ float red[4];
  const int c = blockIdx.y, bh = blockIdx.z, b = bh >> 2, h = bh & 3, tid = threadIdx.x;
  const int i = blockIdx.x * 2 + (tid >> 7), e = tid & 127;
  const float lgf = lg_of(pf, h), lgb = lg_of(pb, h);
  const long tok0 = (long)b * SEQ + (long)c * CHUNK;
  const float* base = proj + tok0 * INW + h * HD;
  const float* Pr = P + ((long)bh * NCHUNK + c) * (CHUNK * CHUNK) + i * CHUNK;
  const float* Sf = kv + (((long)0 * 8 + bh) * NCHUNK + c) * (HD * HD);
  const float* Sb = kv + (((long)1 * 8 + bh) * NCHUNK + c) * (HD * HD);
  float a0 = 0.f, a1 = 0.f, a2 = 0.f;
  for (int j = 0; j < CHUNK; ++j) a0 += Pr[j] * base[(long)j * INW + O_RV + e];
  const float* q = base + (long)i * INW + O_RQ;
  for (int d = 0; d < HD; ++d) { const float qd = q[d]; a1 += qd * Sf[d * HD + e]; a2 += qd * Sb[d * HD + e]; }
  const float y = a0 + expf(lgf * (float)(i + 1)) * a1 + expf(lgb * (float)(CHUNK - i)) * a2;
  const int wv = tid >> 6;
  float s = wave_sum(y); if ((tid & 63) == 0) red[wv] = s; __syncthreads();
  const float mu = (red[wv & 2] + red[(wv & 2) + 1]) * (1.0f / HD); __syncthreads();
  const float dlt = y - mu; float s2 = wave_sum(dlt * dlt); if ((tid & 63) == 0) red[wv] = s2; __syncthreads();
  const float var = (red[wv & 2] + red[(wv & 2) + 1]) * (1.0f / HD);
  const float yn = dlt * (1.0f / sqrtf(var + EPS)) * gain[h * HD + e];
  const float rg = proj[(tok0 + i) * INW + O_RG + h * HD + e];
  yrin[(tok0 + i) * 512 + h * HD + e] = siluf_(rg) * yn;
}

__global__ __launch_bounds__(256) void k_attn(const float* __restrict__ proj, float* __restrict__ att) {
  __shared__ float qs[32][129]; __shared__ float kvs[64][129]; __shared__ float ps[32][65];
  const int qb = blockIdx.x, h = blockIdx.y, b = blockIdx.z, kvh = h >> 1, tid = threadIdx.x, qi = tid >> 3, sub = tid & 7;
  const long tok0 = (long)b * SEQ + (long)qb * 32;
  for (int o = tid; o < 32 * 128; o += 256) { const int r = o >> 7, d = o & 127; qs[r][d] = proj[(tok0 + r) * INW + O_AQ + h * HD + d]; }
  float m = -1e30f, l = 0.f; float oacc[16];
#pragma unroll
  for (int cc = 0; cc < 16; ++cc) oacc[cc] = 0.f;
  const float scale = 0.08838834764831845f;
  for (int kt = 0; kt < SEQ / 64; ++kt) {
    __syncthreads();
    const float* kb = proj + ((long)b * SEQ + (long)kt * 64) * INW + kvh * HD;
    for (int o = tid; o < 64 * 128; o += 256) { const int r = o >> 7, d = o & 127; kvs[r][d] = kb[(long)r * INW + O_AK + d]; }
    __syncthreads();
    float s[8]; float mt = -1e30f;
#pragma unroll
    for (int jj = 0; jj < 8; ++jj) { const int kj = sub + 8 * jj; float dot = 0.f; for (int d = 0; d < HD; ++d) dot += qs[qi][d] * kvs[kj][d]; s[jj] = dot * scale; mt = fmaxf(mt, s[jj]); }
    mt = fmaxf(mt, __shfl_xor(mt, 1)); mt = fmaxf(mt, __shfl_xor(mt, 2)); mt = fmaxf(mt, __shfl_xor(mt, 4));
    const float mn = fmaxf(m, mt), alpha = expf(m - mn); float psum = 0.f;
#pragma unroll
    for (int jj = 0; jj < 8; ++jj) { const float p = expf(s[jj] - mn); ps[qi][sub + 8 * jj] = p; psum += p; }
    psum += __shfl_xor(psum, 1); psum += __shfl_xor(psum, 2); psum += __shfl_xor(psum, 4);
    l = l * alpha + psum; m = mn;
    __syncthreads();
    for (int o = tid; o < 64 * 128; o += 256) { const int r = o >> 7, d = o & 127; kvs[r][d] = kb[(long)r * INW + O_AV + d]; }
    __syncthreads();
#pragma unroll
    for (int cc = 0; cc < 16; ++cc) oacc[cc] *= alpha;
    for (int j = 0; j < 64; ++j) { const float p = ps[qi][j];
#pragma unroll
      for (int cc = 0; cc < 16; ++cc) oacc[cc] += p * kvs[j][sub * 16 + cc]; }
  }
  const float il = 1.0f / l;
#pragma unroll
  for (int cc = 0; cc < 16; ++cc) att[(tok0 + qi) * 512 + h * HD + sub * 16 + cc] = oacc[cc] * il;
}

__global__ __launch_bounds__(256) void k_router(const float* __restrict__ x1, const float* __restrict__ g, const float* __restrict__ wr, float* __restrict__ h2, float* __restrict__ aff) {
  const int row = blockIdx.x * 4 + (threadIdx.x >> 6), lane = threadIdx.x & 63;
  const float* xr = x1 + (size_t)row * D_MODEL;
  float v[16]; float s = 0.f;
#pragma unroll
  for (int j = 0; j < 16; ++j) { v[j] = xr[lane + 64 * j]; s += v[j] * v[j]; }
  s = wave_sum(s);
  const float r = 1.0f / sqrtf(s * (1.0f / D_MODEL) + EPS);
  float lg[NE];
#pragma unroll
  for (int e = 0; e < NE; ++e) lg[e] = 0.f;
#pragma unroll
  for (int j = 0; j < 16; ++j) { const int d = lane + 64 * j; const float hv = v[j] * r * g[d]; h2[(size_t)row * D_MODEL + d] = hv;
    const float4* w4 = (const float4*)(wr + (size_t)d * NE);
#pragma unroll
    for (int q = 0; q < 4; ++q) { const float4 w = w4[q]; lg[4 * q + 0] += hv * w.x; lg[4 * q + 1] += hv * w.y; lg[4 * q + 2] += hv * w.z; lg[4 * q + 3] += hv * w.w; } }
  float mx = -1e30f;
#pragma unroll
  for (int e = 0; e < NE; ++e) { lg[e] = wave_sum(lg[e]); mx = fmaxf(mx, lg[e]); }
  float den = 0.f;
#pragma unroll
  for (int e = 0; e < NE; ++e) { lg[e] = expf(lg[e] - mx); den += lg[e]; }
  if (lane == 0) {
#pragma unroll
    for (int e = 0; e < NE; ++e) aff[(size_t)row * NE + e] = lg[e] / den; }
}

__device__ __forceinline__ int block_excl_scan512(int v, int* sh, int tid) {
  sh[tid] = v; __syncthreads();
  for (int off = 1; off < 512; off <<= 1) { const int t = (tid >= off) ? sh[tid - off] : 0; __syncthreads(); sh[tid] += t; __syncthreads(); }
  const int r = sh[tid] - v; __syncthreads(); return r;
}
__global__ __launch_bounds__(512) void k_topk(const float* __restrict__ aff, int* __restrict__ idx, float* __restrict__ gate, int* __restrict__ sel) {
  __shared__ unsigned keys[SEQ]; __shared__ int hist[256]; __shared__ unsigned s_prefix; __shared__ int s_krem; __shared__ int sc[512];
  const int z = blockIdx.x, b = z / NE, e = z % NE, tid = threadIdx.x;
  for (int i = tid; i < SEQ; i += 512) keys[i] = __float_as_uint(aff[((size_t)b * SEQ + i) * NE + e]);
  if (tid == 0) { s_prefix = 0u; s_krem = CAP; }
  __syncthreads();
  unsigned mask = 0u;
  for (int pass = 3; pass >= 0; --pass) {
    const int shift = pass * 8;
    if (tid < 256) hist[tid] = 0;
    __syncthreads();
    const unsigned prefix = s_prefix;
    for (int i = tid; i < SEQ; i += 512) { const unsigned k = keys[i]; if ((k & mask) == prefix) atomicAdd(&hist[(k >> shift) & 255u], 1); }
    __syncthreads();
    if (tid == 0) { const int krem = s_krem; int cum = 0, d = 255; for (; d > 0; --d) { if (cum + hist[d] >= krem) break; cum += hist[d]; } s_krem = krem - cum; s_prefix = prefix | ((unsigned)d << shift); }
    __syncthreads();
    mask |= 0xFFu << shift;
  }
  const unsigned Tk = s_prefix; const int krem = s_krem;
  int cgt = 0, ceq = 0;
  for (int q = 0; q < 16; ++q) { const unsigned k = keys[tid * 16 + q]; cgt += (k > Tk); ceq += (k == Tk); }
  const int eqbase = block_excl_scan512(ceq, sc, tid);
  int take = krem - eqbase; take = take < 0 ? 0 : (take > ceq ? ceq : take);
  int slot = block_excl_scan512(cgt + take, sc, tid);
  int eqr = eqbase;
  for (int q = 0; q < 16; ++q) { const int i = tid * 16 + q; const unsigned k = keys[i]; bool tk = k > Tk; if (k == Tk) { tk = eqr < krem; ++eqr; }
    if (tk) { idx[z * CAP + slot] = i; gate[z * CAP + slot] = __uint_as_float(k); sel[((size_t)b * SEQ + i) * NE + e] = slot; ++slot; } else sel[((size_t)b * SEQ + i) * NE + e] = -1; }
}

__global__ __launch_bounds__(256) void k_final(const float* __restrict__ x1, const float* __restrict__ y, const int* __restrict__ sel, const float* __restrict__ g, float* __restrict__ out) {
  const int row = blockIdx.x * 4 + (threadIdx.x >> 6), lane = threadIdx.x & 63, b = row / SEQ;
  const float4* xr = (const float4*)(x1 + (size_t)row * D_MODEL);
  float4 v[4];
#pragma unroll
  for (int j = 0; j < 4; ++j) v[j] = xr[lane + 64 * j];
  for (int e = 0; e < NE; ++e) { const int sl = sel[(size_t)row * NE + e]; if (sl >= 0) { const float4* yr = (const float4*)(y + ((size_t)(b * NE + e) * CAP + sl) * D_MODEL);
#pragma unroll
      for (int j = 0; j < 4; ++j) { const float4 t = yr[lane + 64 * j]; v[j].x += t.x; v[j].y += t.y; v[j].z += t.z; v[j].w += t.w; } } }
  float s = 0.f;
#pragma unroll
  for (int j = 0; j < 4; ++j) s += v[j].x * v[j].x + v[j].y * v[j].y + v[j].z * v[j].z + v[j].w * v[j].w;
  s = wave_sum(s);
  const float r = 1.0f / sqrtf(s * (1.0f / D_MODEL) + EPS);
  const float4* gr = (const float4*)g; float4* o = (float4*)(out + (size_t)row * D_MODEL);
#pragma unroll
  for (int j = 0; j < 4; ++j) { const float4 gg = gr[lane + 64 * j]; o[lane + 64 * j] = make_float4(v[j].x * r * gg.x, v[j].y * r * gg.y, v[j].z * r * gg.z, v[j].w * r * gg.w); }
}

extern "C" void kernel_launch(void* const* d_in, const int* in_sizes, int n_in, void* d_out, int out_size, void* d_ws, size_t ws_size, hipStream_t stream) {
  const float* x = (const float*)d_in[0]; const float* norm_mix = (const float*)d_in[1]; const float* w_in = (const float*)d_in[2];
  const float* pf = (const float*)d_in[3]; const float* pb = (const float*)d_in[4]; const float* gn_gain = (const float*)d_in[5];
  const float* w_ret = (const float*)d_in[6]; const float* qn = (const float*)d_in[7]; const float* kn = (const float*)d_in[8];
  const float* w_att = (const float*)d_in[9]; const float* w_o = (const float*)d_in[10]; const float* norm_ffn = (const float*)d_in[11];
  const float* w_router = (const float*)d_in[12]; const float* wg = (const float*)d_in[13]; const float* wu = (const float*)d_in[14];
  const float* wd = (const float*)d_in[15]; const float* norm_final = (const float*)d_in[16];
  float* out = (float*)d_out;
  size_t off = 0; auto take = [&](size_t n) { size_t o = off; off += (n + 63) / 64 * 64; return o; };
  const size_t o_h = take((size_t)T * D_MODEL);
  const size_t o_proj = take((size_t)T * INW);
  const size_t o_kv = take((size_t)2 * 8 * NCHUNK * HD * HD);
  const size_t o_P = take((size_t)8 * NCHUNK * CHUNK * CHUNK);
  const size_t o_yrin = take((size_t)T * 512);
  const size_t o_att = take((size_t)T * 512);
  const size_t o_mixed = take((size_t)T * D_MODEL);
  const size_t o_x1 = take((size_t)T * D_MODEL);
  const size_t o_aff = take((size_t)T * NE);
  const size_t o_idx = take((size_t)32 * CAP);
  const size_t o_gate = take((size_t)32 * CAP);
  const size_t o_sel = take((size_t)T * NE);
  const size_t o_act = o_proj;
  const size_t o_y = o_P;
  if (off * 4 > ws_size || (size_t)32 * CAP * FF > (size_t)T * INW + (size_t)2 * 8 * NCHUNK * HD * HD || n_in != 17 || out_size != T * D_MODEL) {
    fprintf(stderr, "kernel_launch: workspace/shape mismatch need %zu have %zu\n", off * 4, ws_size); return; }
  float* ws = (float*)d_ws;
  float* h = ws + o_h; float* proj = ws + o_proj; float* kv = ws + o_kv; float* P = ws + o_P; float* yrin = ws + o_yrin; float* att = ws + o_att;
  float* mixed = ws + o_mixed; float* x1 = ws + o_x1; float* aff = ws + o_aff; int* idx = (int*)(ws + o_idx); float* gate = ws + o_gate; int* sel = (int*)(ws + o_sel);
  float* act = ws + o_act; float* y = ws + o_y;

  k_rmsnorm<<<T / 4, 256, 0, stream>>>(x, norm_mix, h);
  { GemmArgs g{h, nullptr, D_MODEL, 0, 0, 1, 0, w_in, INW, 0, D_MODEL}; k_sgemm<EpiStore><<<dim3(INW / 64, T / 64, 1), 256, 0, stream>>>(g, EpiStore{proj, INW, 0}); }
  k_rope_norm<<<(unsigned)((size_t)T * 14 / 4), 256, 0, stream>>>(proj, qn, kn);
  k_ret_kv<<<dim3(NCHUNK, 8, 2), 256, 0, stream>>>(proj, pf, pb, kv);
  k_ret_scan<<<2 * 8 * 16384 / 256, 256, 0, stream>>>(pf, pb, kv);
  k_ret_P<<<dim3(NCHUNK, 8), 256, 0, stream>>>(proj, pf, pb, P);
  k_ret_out<<<dim3(CHUNK / 2, NCHUNK, 8), 256, 0, stream>>>(proj, pf, pb, P, kv, gn_gain, yrin);
  k_attn<<<dim3(SEQ / 32, 4, BATCH), 256, 0, stream>>>(proj, att);
  { GemmArgs g{yrin, nullptr, 512, 0, 0, 1, 0, w_ret, D_MODEL, 0, 512}; k_sgemm<EpiGate1><<<dim3(D_MODEL / 64, T / 64, 1), 256, 0, stream>>>(g, EpiGate1{mixed, proj}); }
  { GemmArgs g{att, nullptr, 512, 0, 0, 1, 0, w_att, D_MODEL, 0, 512}; k_sgemm<EpiGate2><<<dim3(D_MODEL / 64, T / 64, 1), 256, 0, stream>>>(g, EpiGate2{mixed, proj}); }
  { GemmArgs g{mixed, nullptr, D_MODEL, 0, 0, 1, 0, w_o, D_MODEL, 0, D_MODEL}; k_sgemm<EpiResid><<<dim3(D_MODEL / 64, T / 64, 1), 256, 0, stream>>>(g, EpiResid{x1, x}); }
  k_router<<<T / 4, 256, 0, stream>>>(x1, norm_ffn, w_router, h, aff);
  k_topk<<<32, 512, 0, stream>>>(aff, idx, gate, sel);
  { GemmArgs g{h, idx, D_MODEL, (long)SEQ * D_MODEL, 0, NE, CAP, wg, FF, (long)D_MODEL * FF, D_MODEL}; k_sgemm<EpiStore><<<dim3(FF / 64, CAP / 64, 32), 256, 0, stream>>>(g, EpiStore{act, FF, (long)CAP * FF}); }
  { GemmArgs g{h, idx, D_MODEL, (long)SEQ * D_MODEL, 0, NE, CAP, wu, FF, (long)D_MODEL * FF, D_MODEL}; k_sgemm<EpiSwiglu><<<dim3(FF / 64, CAP / 64, 32), 256, 0, stream>>>(g, EpiSwiglu{act}); }
  { GemmArgs g{act, nullptr, FF, 0, (long)CAP * FF, NE, 0, wd, D_MODEL, (long)FF * D_MODEL, FF}; k_sgemm<EpiDown><<<dim3(D_MODEL / 64, CAP / 64, 32), 256, 0, stream>>>(g, EpiDown{y, gate}); }
  k_final<<<T / 4, 256, 0, stream>>>(x1, y, sel, norm_final, out);
}
```

```cpp
#include <hip/hip_runtime.h>
#include <hip/hip_bf16.h>
#include <cstdio>
#include <cstdint>
#include <cmath>

constexpr size_t EP_MiB = 1u << 20;
constexpr size_t EP_COS = 2 * EP_MiB, EP_SIN = 4 * EP_MiB, EP_RQ = 382 * EP_MiB, EP_RK = 398 * EP_MiB, EP_RV = 414 * EP_MiB, EP_RGS = 430 * EP_MiB, EP_AQ = 446 * EP_MiB, EP_AK = 462 * EP_MiB, EP_AV = 470 * EP_MiB, EP_GRS = 478 * EP_MiB, EP_GAS = 510 * EP_MiB;
constexpr int D_MODEL = 1024, BATCH = 2, SEQ = 8192, T = BATCH * SEQ;
constexpr int HD = 128, CHUNK = 128, NCHUNK = SEQ / CHUNK;
constexpr int NE = 16, FF = 2816, CAP = 1024, NZ = BATCH * NE;
constexpr int INW = 5120;
constexpr int O_RQ = 0, O_RK = 512, O_RV = 1024, O_RG = 1536, O_AQ = 2048, O_AK = 2560, O_AV = 2816, O_GR = 3072, O_GA = 4096;
constexpr float EPS = 1e-6f;
constexpr float RSQRT_HD = 0.08838834764831845f;

namespace pg8 {
#define PG8_LAS __attribute__((address_space(3)))
typedef unsigned short bf16_t;
typedef short bf16x8 __attribute__((ext_vector_type(8)));
typedef float f32x4 __attribute__((ext_vector_type(4)));
typedef unsigned u32x4 __attribute__((ext_vector_type(4)));
constexpr int BM = 256, BK = 64, HALF = 128, HTB = HALF * BK * 2  , STAGE_BYTES = 8 * HTB, NXCD = 8, WGM = 8;

__host__ __device__ __forceinline__ int lds_byte(int r, int c) { const int st = (r >> 4) * 2 + (c >> 5), rr = r & 15, cc = c & 31, ob = rr * 64 + cc * 2; return st * 1024 + (ob ^ (((ob >> 9) & 1) << 5)); }
__host__ __device__ __forceinline__ void stage_rc(int b, int& R, int& C) { const int st = b / 1024, sb = b % 1024, swz = sb ^ (((sb >> 9) & 1) << 5); R = (st >> 1) * 16 + swz / 64; C = (st & 1) * 32 + (swz % 64) / 2; }
__host__ __device__ __forceinline__ int perm32(int rho) { const int n = rho >> 4, i = rho & 15; return 8 * (i >> 2) + 4 * n + (i & 3); }

struct Unit { int pm, pn, aux; };
struct Gemm { const bf16_t* A; const bf16_t* Bt; int M, N, K; };

struct StaticOrder {
    int nM, nN, nwg, G, c;
    __host__ __device__ void init(int M, int N, int G_, int c_) { nM = M / BM; nN = N / BM; nwg = nM * nN; G = G_; c = c_; }
    __host__ __device__ bool next(int i, Unit& u) const {
        const long L = (long)i * G + c; if (L >= nwg) return false;
        int wgid = (int)L; { const int q = nwg / NXCD, r = nwg % NXCD, xcd = wgid % NXCD, off = wgid / NXCD; wgid = (xcd < r ? xcd * (q + 1) : r * (q + 1) + (xcd - r) * q) + off; }
        const int nig = WGM * nN, gid = wgid / nig, fm = gid * WGM, gsz = (nM - fm) < WGM ? (nM - fm) : WGM;
        u.pm = fm + ((wgid % nig) % gsz); u.pn = (wgid % nig) / gsz; u.aux = 0; return true;
    }
    __device__ __forceinline__ void a_ready(const Unit&) const {}
    __device__ __forceinline__ void done(const Unit&) const {}
    static constexpr bool GATHER = false;
    __device__ __forceinline__ unsigned gather_off(const Unit&, int, int) const { return 0u; }
    __device__ __forceinline__ bool keep_acc(const Unit&) const { return false; }
};


struct PlainSched : StaticOrder {
    const char* A; const char* Bt; size_t tstep;
    __device__ __forceinline__ void bases(const Unit& u, const char*& a, const char*& b) const { a = A + (size_t)u.pm * tstep; b = Bt + (size_t)u.pn * tstep; }
};

typedef float f32x2_t __attribute__((ext_vector_type(2))); typedef __bf16 bf16x2_t __attribute__((ext_vector_type(2)));
__device__ __forceinline__ unsigned cvt_pk_bf16(float lo, float hi) { f32x2_t v = {lo, hi}; bf16x2_t b = __builtin_convertvector(v, bf16x2_t); return __builtin_bit_cast(unsigned, b); }
__device__ __forceinline__ u32x4 pack8(const f32x4 a, const f32x4 b) { u32x4 w; w.x = cvt_pk_bf16(a[0], a[1]); w.y = cvt_pk_bf16(a[2], a[3]); w.z = cvt_pk_bf16(b[0], b[1]); w.w = cvt_pk_bf16(b[2], b[3]); return w; }
__device__ __forceinline__ float fast_sigmoid(float x) { return __builtin_amdgcn_rcpf(1.0f + __builtin_amdgcn_exp2f(-1.4426950408889634f * x)); }
__device__ __forceinline__ f32x4 sigmoid4(const f32x4 v) { return (f32x4){fast_sigmoid(v[0]), fast_sigmoid(v[1]), fast_sigmoid(v[2]), fast_sigmoid(v[3])}; }
__device__ __forceinline__ f32x4 silu4(const f32x4 v) { return v * sigmoid4(v); }

struct EpiProj {
    static constexpr bool PERM = true, AFTER_DRAIN = false;
    unsigned char* wsb;
    const float *qn, *kn;
    PG8_LAS float* xch;
    mutable unsigned epoch;
    template <int ACT>
    __device__ __forceinline__ void plain(const f32x4 (&acc)[2][2][4][2], bf16_t* base, int ld, int col0, int row0) const {
#pragma unroll
        for (int ai = 0; ai < 2; ++ai)
#pragma unroll
            for (int m = 0; m < 4; ++m) { bf16_t* rowp = base + (size_t)(row0 + ai * HALF + m * 16) * ld + col0;
#pragma unroll
                for (int bj = 0; bj < 2; ++bj) { f32x4 v0 = acc[ai][bj][m][0], v1 = acc[ai][bj][m][1];
                    if (ACT == 1) { v0 = silu4(v0); v1 = silu4(v1); } else if (ACT == 2) { v0 = sigmoid4(v0); v1 = sigmoid4(v1); }
                    *(u32x4*)(rowp + bj * HALF) = pack8(v0, v1); } }
    }
    template <bool NORM>
    __device__ __forceinline__ void rope(const f32x4 (&acc)[2][2][4][2], bf16_t* base, int ld, int col0, int row0, float scale, const float* nw, int wr, int wc, int fr, int fq) const {
        const int g = 4 * wc + fq;
        f32x4 nw1 = {1.f, 1.f, 1.f, 1.f}, nw2 = {1.f, 1.f, 1.f, 1.f};
        if (NORM) {
#pragma unroll
            for (int ai = 0; ai < 2; ++ai)
#pragma unroll
                for (int m = 0; m < 4; ++m)
#pragma unroll
                    for (int bj = 0; bj < 2; ++bj) { const f32x4 a = acc[ai][bj][m][0], b = acc[ai][bj][m][1];
                        float s = (a[0] * a[0] + a[1] * a[1]) + (a[2] * a[2] + a[3] * a[3]) + (b[0] * b[0] + b[1] * b[1]) + (b[2] * b[2] + b[3] * b[3]);
                        s += __shfl_xor(s, 16); s += __shfl_xor(s, 32);
                        if (fq == 0) xch[((ai * HALF + wr * 64 + m * 16 + fr) * 2 + bj) * 4 + wc] = s; }
            asm volatile("s_waitcnt lgkmcnt(0)" ::: "memory");
            PG8_LAS unsigned* cnt = (PG8_LAS unsigned*)(xch + 2048) + wr;
            if ((fr | fq) == 0) __hip_atomic_fetch_add(cnt, 1u, __ATOMIC_RELAXED, __HIP_MEMORY_SCOPE_WORKGROUP);
            epoch += 4u;
            while (__hip_atomic_load(cnt, __ATOMIC_RELAXED, __HIP_MEMORY_SCOPE_WORKGROUP) < epoch) __builtin_amdgcn_s_sleep(1);
            asm volatile("s_waitcnt lgkmcnt(0)" ::: "memory");
            nw1 = *(const f32x4*)(nw + 4 * g); nw2 = *(const f32x4*)(nw + 64 + 4 * g);
        }
#pragma unroll
        for (int ai = 0; ai < 2; ++ai)
#pragma unroll
            for (int m = 0; m < 4; ++m) { const int r = row0 + ai * HALF + m * 16; const int pos = r & 8191;
                const f32x4 c4 = *(const f32x4*)((const float*)(wsb + EP_COS) + (size_t)pos * 64 + 4 * g), s4 = *(const f32x4*)((const float*)(wsb + EP_SIN) + (size_t)pos * 64 + 4 * g);
                bf16_t* rowp = base + (size_t)r * ld + col0;
#pragma unroll
                for (int bj = 0; bj < 2; ++bj) { f32x4 x1 = acc[ai][bj][m][0], x2 = acc[ai][bj][m][1];
                    if (NORM) { const f32x4 p = *(const PG8_LAS f32x4*)(xch + ((ai * HALF + wr * 64 + m * 16 + fr) * 2 + bj) * 4);
                        const float rs = __builtin_amdgcn_rsqf(((p[0] + p[1]) + (p[2] + p[3])) * (1.0f / 128.0f) + 1e-6f);
                        x1 = x1 * (nw1 * rs); x2 = x2 * (nw2 * rs); }
                    const f32x4 y1 = (x1 * c4 - x2 * s4) * scale, y2 = (x1 * s4 + x2 * c4) * scale;
                    *(u32x4*)(rowp + bj * HALF) = pack8(y1, y2); }
                asm volatile("" ::: "memory"); }
    }
    __device__ __forceinline__ void operator()(const f32x4 (&acc)[2][2][4][2], const Unit& u, int wr, int wc, int fr, int fq) const {
        const int row0 = u.pm * BM + wr * 64 + fr, cw = wc * 32 + 8 * fq, pn = u.pn;
        if (pn < 2)       rope<false>(acc, (bf16_t*)(wsb + EP_RQ), 512, pn * 256 + cw, row0, 1.0f, nullptr, wr, wc, fr, fq);
        else if (pn < 4)  rope<false>(acc, (bf16_t*)(wsb + EP_RK), 512, (pn - 2) * 256 + cw, row0, 0.08838834764831845f, nullptr, wr, wc, fr, fq);
        else if (pn < 6)  plain<0>(acc, (bf16_t*)(wsb + EP_RV), 512, (pn - 4) * 256 + cw, row0);
        else if (pn < 8)  plain<1>(acc, (bf16_t*)(wsb + EP_RGS), 512, (pn - 6) * 256 + cw, row0);
        else if (pn < 10) rope<true>(acc, (bf16_t*)(wsb + EP_AQ), 512, (pn - 8) * 256 + cw, row0, 1.0f, qn, wr, wc, fr, fq);
        else if (pn < 11) rope<true>(acc, (bf16_t*)(wsb + EP_AK), 256, cw, row0, 1.0f, kn, wr, wc, fr, fq);
        else if (pn < 12) plain<0>(acc, (bf16_t*)(wsb + EP_AV), 256, cw, row0);
        else if (pn < 16) plain<2>(acc, (bf16_t*)(wsb + EP_GRS), 1024, (pn - 12) * 256 + cw, row0);
        else              plain<2>(acc, (bf16_t*)(wsb + EP_GAS), 1024, (pn - 16) * 256 + cw, row0);
    }
};

struct BranchSched : StaticOrder {
    const char *A0, *A1, *B0, *B1; size_t tstep;
    __device__ __forceinline__ bool next(int i, Unit& u) const { if (!StaticOrder::next(i >> 1, u)) return false; u.aux = i & 1; return true; }
    __device__ __forceinline__ void bases(const Unit& u, const char*& a, const char*& b) const { a = (u.aux ? A1 : A0) + (size_t)u.pm * tstep; b = (u.aux ? B1 : B0) + (size_t)u.pn * tstep; }
    __device__ __forceinline__ bool keep_acc(const Unit& nxt) const { return nxt.aux == 1; }
};
__device__ __forceinline__ void unpack8(const u32x4 w, f32x4& a, f32x4& b) {
    a = (f32x4){__uint_as_float(w.x << 16), __uint_as_float(w.x & 0xffff0000u), __uint_as_float(w.y << 16), __uint_as_float(w.y & 0xffff0000u)};
    b = (f32x4){__uint_as_float(w.z << 16), __uint_as_float(w.z & 0xffff0000u), __uint_as_float(w.w << 16), __uint_as_float(w.w & 0xffff0000u)};
}
struct EpiBranch {
    static constexpr bool PERM = true, AFTER_DRAIN = false;
    const bf16_t *grs, *gas; bf16_t* mixed;
    __device__ __forceinline__ void operator()(f32x4 (&acc)[2][2][4][2], const Unit& u, int wr, int wc, int fr, int fq) const {
        const int row0 = u.pm * BM + wr * 64 + fr, col0 = u.pn * BM + wc * 32 + 8 * fq;
#pragma unroll
        for (int ai = 0; ai < 2; ++ai)
#pragma unroll
            for (int m = 0; m < 4; ++m) { const size_t off = (size_t)(row0 + ai * HALF + m * 16) * 1024 + col0;
#pragma unroll
                for (int bj = 0; bj < 2; ++bj) { f32x4 ga0, ga1; unpack8(*(const u32x4*)(gas + off + bj * HALF), ga0, ga1);
                    if (u.aux == 0) { f32x4 gr0, gr1; unpack8(*(const u32x4*)(grs + off + bj * HALF), gr0, gr1);
#pragma unroll
                        for (int k = 0; k < 4; ++k) { acc[ai][bj][m][0][k] *= gr0[k] * __builtin_amdgcn_rcpf(fmaxf(ga0[k], 1e-30f)); acc[ai][bj][m][1][k] *= gr1[k] * __builtin_amdgcn_rcpf(fmaxf(ga1[k], 1e-30f)); } }
                    else *(u32x4*)(mixed + off + bj * HALF) = pack8(acc[ai][bj][m][0] * ga0, acc[ai][bj][m][1] * ga1); }
                asm volatile("" ::: "memory"); }
    }
};
struct EpiResid {
    static constexpr bool PERM = false, AFTER_DRAIN = false;
    const float* x; float* x1;
    __device__ __forceinline__ void operator()(const f32x4 (&acc)[2][2][4][2], const Unit& u, int wr, int wc, int fr, int fq) const {
        const int row0 = u.pm * BM + wr * 64 + fr, col0 = u.pn * BM + wc * 32 + 4 * fq;
#pragma unroll
        for (int ai = 0; ai < 2; ++ai)
#pragma unroll
            for (int m = 0; m < 4; ++m) { const size_t off = (size_t)(row0 + ai * HALF + m * 16) * 1024 + col0;
#pragma unroll
                for (int bj = 0; bj < 2; ++bj)
#pragma unroll
                    for (int n = 0; n < 2; ++n) { const f32x4 xv = *(const f32x4*)(x + off + bj * HALF + n * 16); *(f32x4*)(x1 + off + bj * HALF + n * 16) = xv + acc[ai][bj][m][n]; }
                if (m & 1) asm volatile("" ::: "memory"); }
    }
};
__device__ __forceinline__ int moe_rowbase(int pm) { return ((((pm >> 2) & 1) * 16 + (pm >> 3)) * 1024) + (pm & 3) * 256; }
struct MoeSched : StaticOrder {
    const char *A, *Bt; size_t kb; int nper;
    __device__ __forceinline__ void bases(const Unit& u, const char*& a, const char*& b) const { a = A + (size_t)moe_rowbase(u.pm) * kb; b = Bt + ((size_t)(u.pm >> 3) * nper + (size_t)u.pn * 256) * kb; }
};
struct MoeGatherSched : StaticOrder {
    static constexpr bool GATHER = true;
    const char *A, *Bt; const int* idx;
    __device__ __forceinline__ void bases(const Unit& u, const char*& a, const char*& b) const { a = A; b = Bt + ((size_t)(u.pm >> 3) * 5632 + (size_t)u.pn * 256) * 2048; }
    __device__ __forceinline__ unsigned gather_off(const Unit& u, int r, int c) const { const int tok = ((u.pm >> 2) & 1) * 8192 + idx[moe_rowbase(u.pm) + r]; return (unsigned)((tok * 1024 + c) * 2); }
};
struct EpiSwiglu {
    static constexpr bool PERM = true, AFTER_DRAIN = false;
    bf16_t* act;
    __device__ __forceinline__ void operator()(const f32x4 (&acc)[2][2][4][2], const Unit& u, int wr, int wc, int fr, int fq) const {
        const int row0 = moe_rowbase(u.pm) + wr * 64 + fr, col0 = u.pn * HALF + wc * 32 + 8 * fq;
#pragma unroll
        for (int ai = 0; ai < 2; ++ai)
#pragma unroll
            for (int m = 0; m < 4; ++m)
                *(u32x4*)(act + (size_t)(row0 + ai * HALF + m * 16) * 2816 + col0) = pack8(silu4(acc[ai][0][m][0]) * acc[ai][1][m][0], silu4(acc[ai][0][m][1]) * acc[ai][1][m][1]);
    }
};
struct EpiDown {
    static constexpr bool PERM = true, AFTER_DRAIN = false;
    bf16_t* y; const float* gate;
    __device__ __forceinline__ void operator()(const f32x4 (&acc)[2][2][4][2], const Unit& u, int wr, int wc, int fr, int fq) const {
        const int row0 = moe_rowbase(u.pm) + wr * 64 + fr, col0 = u.pn * BM + wc * 32 + 8 * fq;
#pragma unroll
        for (int ai = 0; ai < 2; ++ai)
#pragma unroll
            for (int m = 0; m < 4; ++m) { const int r = row0 + ai * HALF + m * 16; const float g = gate[r];
#pragma unroll
                for (int bj = 0; bj < 2; ++bj) *(u32x4*)(y + (size_t)r * 1024 + col0 + bj * HALF) = pack8(acc[ai][bj][m][0] * g, acc[ai][bj][m][1] * g); }
    }
};
template <class Epi, class Sched, bool ALIGN_EPI = false, bool SP2 = false>
__device__ __forceinline__ void gemm_phase(PG8_LAS unsigned char* lds, const int K_, const Sched& S, const Epi& E, const int tid) {
    const int wid = __builtin_amdgcn_readfirstlane(tid >> 6), lane = tid & 63, wr = wid >> 2, wc = wid & 3, fr = lane & 15, fq = lane >> 4;
    const int K = K_, nt = K / BK;
    unsigned voffA[2], voffB[2];
#pragma unroll
    for (int i = 0; i < 2; ++i) { int R, C; stage_rc(tid * 16 + i * 8192, R, C); const int Rb = Epi::PERM ? ((R & ~31) + perm32(R & 31)) : R;
        voffA[i] = (unsigned)(R * K + C) * 2u; voffB[i] = (unsigned)(Rb * K + C) * 2u; }
    unsigned va0[2] = {0u, 0u}, va1[2] = {0u, 0u}, vn0[2] = {0u, 0u}, vn1[2] = {0u, 0u};
    int gR[2], gC[2];
#pragma unroll
    for (int i = 0; i < 2; ++i) stage_rc(tid * 16 + i * 8192, gR[i], gC[i]);
    const size_t kstep = (size_t)(BK * 2);
    const size_t hstep = (size_t)HALF * K * 2;
        const unsigned ldsw = (unsigned)wid * 1024u;
    const int aoff = lds_byte(wr * 64 + fr, fq * 8), boff = lds_byte(wc * 32 + fr, fq * 8);
#define PG8_SA(b, h) (((b) * 2 + (h)) * HTB)
#define PG8_SB(b, h) ((4 + (b) * 2 + (h)) * HTB)
#define PG8_STAGE(bufoff, gbase, voff) do { _Pragma("unroll") for (int _i = 0; _i < 2; ++_i) \
        __builtin_amdgcn_global_load_lds((const unsigned*)((const char*)(gbase) + (voff)[_i]), (PG8_LAS unsigned*)(lds + (bufoff) + ldsw + _i * 8192), 16, 0, 0); } while (0)
#define PG8_STAGE_A(bufoff, gbase, h, usenext) do { if constexpr (Sched::GATHER) { unsigned vo_[2]; \
        vo_[0] = (usenext) ? ((h) ? vn1[0] : vn0[0]) : ((h) ? va1[0] : va0[0]); vo_[1] = (usenext) ? ((h) ? vn1[1] : vn0[1]) : ((h) ? va1[1] : va0[1]); PG8_STAGE(bufoff, gbase, vo_); } \
        else { PG8_STAGE(bufoff, (gbase) + ((h) ? hstep : (size_t)0), voffA); } } while (0)
#define PG8_LDA(dst, b, h) do { _Pragma("unroll") for (int m = 0; m < 4; ++m) _Pragma("unroll") for (int k = 0; k < 2; ++k) dst[m][k] = *(const PG8_LAS bf16x8*)(lds + PG8_SA(b, h) + aoff + m * 2048 + k * 1024); } while (0)
#define PG8_LDB(dst, b, h) do { _Pragma("unroll") for (int n = 0; n < 2; ++n) _Pragma("unroll") for (int k = 0; k < 2; ++k) dst[n][k] = *(const PG8_LAS bf16x8*)(lds + PG8_SB(b, h) + boff + n * 2048 + k * 1024); } while (0)
#define PG8_MMA(ai, bj, At, Bt) do { __builtin_amdgcn_s_setprio(1); _Pragma("unroll") for (int m = 0; m < 4; ++m) _Pragma("unroll") for (int n = 0; n < 2; ++n) _Pragma("unroll") for (int k = 0; k < 2; ++k) \
        acc[ai][bj][m][n] = __builtin_amdgcn_mfma_f32_16x16x32_bf16(Bt[n][k], At[m][k], acc[ai][bj][m][n], 0, 0, 0); __builtin_amdgcn_s_setprio(0); } while (0)
#define PG8_WAIT_V(n) asm volatile("s_waitcnt vmcnt(" #n ")" ::: "memory")
#define PG8_WAIT_L(n) asm volatile("s_waitcnt lgkmcnt(" #n ")" ::: "memory")
#define PG8_BAR __builtin_amdgcn_s_barrier()
#define PG8_SCHED __builtin_amdgcn_sched_barrier(0)
    Unit cur, nxt; int ui = 0;
    if (!S.next(0, cur)) return;
    f32x4 acc[2][2][4][2];
#pragma unroll
    for (int a = 0; a < 2; ++a)
#pragma unroll
        for (int b = 0; b < 2; ++b)
#pragma unroll
            for (int m = 0; m < 4; ++m)
#pragma unroll
                for (int n = 0; n < 2; ++n) acc[a][b][m][n] = (f32x4){0.f, 0.f, 0.f, 0.f};
    bf16x8 At[4][2], B0[2][2], B1[2][2];
    const char* cA; const char* cB; S.bases(cur, cA, cB);
    if constexpr (Sched::GATHER) {
#pragma unroll
        for (int i = 0; i < 2; ++i) { va0[i] = S.gather_off(cur, gR[i], gC[i]); va1[i] = S.gather_off(cur, gR[i] + HALF, gC[i]); } }
    S.a_ready(cur);
    if constexpr (SP2) {
        PG8_STAGE(PG8_SB(0, 0), cB, voffB); PG8_STAGE(PG8_SB(0, 1), cB + hstep, voffB); PG8_STAGE_A(PG8_SA(0, 0), cA, 0, false); PG8_STAGE_A(PG8_SA(0, 1), cA, 1, false);
        if (wr == 1) PG8_BAR;
        PG8_WAIT_V(2); PG8_BAR;
        PG8_STAGE(PG8_SB(1, 0), cB + kstep, voffB); PG8_STAGE_A(PG8_SA(1, 0), cA + kstep, 0, false); PG8_STAGE(PG8_SB(1, 1), cB + hstep + kstep, voffB);
        PG8_WAIT_V(6); PG8_BAR;
    } else {
        PG8_STAGE(PG8_SB(0, 0), cB, voffB); PG8_STAGE_A(PG8_SA(0, 0), cA, 0, false); PG8_STAGE(PG8_SB(0, 1), cB + hstep, voffB); PG8_STAGE_A(PG8_SA(0, 1), cA, 1, false);
        if (wr == 1) PG8_BAR;
        PG8_WAIT_V(4); PG8_BAR;
        PG8_STAGE(PG8_SB(1, 0), cB + kstep, voffB); PG8_STAGE_A(PG8_SA(1, 0), cA + kstep, 0, false); PG8_STAGE(PG8_SB(1, 1), cB + hstep + kstep, voffB);
        PG8_WAIT_V(6); PG8_BAR;
    }
    for (;;) {
        const bool has_next = S.next(ui + 1, nxt);
        const char* nA = cA; const char* nB = cB; if (has_next) S.bases(nxt, nA, nB);
        if constexpr (Sched::GATHER) { if (has_next) {
#pragma unroll
            for (int i = 0; i < 2; ++i) { vn0[i] = S.gather_off(nxt, gR[i], gC[i]); vn1[i] = S.gather_off(nxt, gR[i] + HALF, gC[i]); } }
            else {
#pragma unroll
            for (int i = 0; i < 2; ++i) { vn0[i] = va0[i]; vn1[i] = va1[i]; } } }
        for (int t = 0; t < nt; t += 2) {
            const bool last = (t == nt - 2);
            const char* a1 = cA + (size_t)(t + 1) * kstep;
            const char* a2 = last ? nA : cA + (size_t)(t + 2) * kstep; const char* b2 = last ? nB : cB + (size_t)(t + 2) * kstep;
            const char* a3 = a2 + kstep; const char* b3 = b2 + kstep;
            if (last && has_next) S.a_ready(nxt);
            if constexpr (SP2) {
            PG8_LDB(B0, 0, 0); PG8_LDB(B1, 0, 1); PG8_SCHED; PG8_LDA(At, 0, 0); PG8_STAGE_A(PG8_SA(1, 1), a1, 1, false);
            PG8_WAIT_V(8); PG8_WAIT_L(0); PG8_BAR; PG8_MMA(0, 0, At, B0); PG8_MMA(0, 1, At, B1); PG8_BAR; PG8_SCHED;
            PG8_LDA(At, 0, 1); PG8_STAGE(PG8_SB(0, 0), b2, voffB); PG8_STAGE(PG8_SB(0, 1), b2 + hstep, voffB); PG8_STAGE_A(PG8_SA(0, 0), a2, 0, last);
            PG8_WAIT_V(8); PG8_WAIT_L(0); PG8_BAR; PG8_MMA(1, 0, At, B0); PG8_MMA(1, 1, At, B1); PG8_BAR; PG8_SCHED;
            PG8_LDB(B0, 1, 0); PG8_LDB(B1, 1, 1); PG8_SCHED; PG8_LDA(At, 1, 0); PG8_STAGE_A(PG8_SA(0, 1), a2, 1, last);
            PG8_WAIT_V(8); PG8_WAIT_L(0); PG8_BAR; PG8_MMA(0, 0, At, B0); PG8_MMA(0, 1, At, B1); PG8_BAR; PG8_SCHED;
            PG8_LDA(At, 1, 1); PG8_STAGE(PG8_SB(1, 0), b3, voffB); PG8_STAGE(PG8_SB(1, 1), b3 + hstep, voffB); PG8_STAGE_A(PG8_SA(1, 0), a3, 0, last);
            PG8_WAIT_V(8); PG8_WAIT_L(0); PG8_BAR; PG8_MMA(1, 0, At, B0); PG8_MMA(1, 1, At, B1); PG8_BAR; PG8_SCHED;
            } else {
            PG8_LDB(B0, 0, 0); PG8_SCHED; PG8_LDA(At, 0, 0); PG8_STAGE_A(PG8_SA(1, 1), a1, 1, false);
            PG8_WAIT_L(8); PG8_BAR; PG8_WAIT_L(0); PG8_MMA(0, 0, At, B0); PG8_BAR; PG8_SCHED;
            PG8_LDB(B1, 0, 1); PG8_STAGE(PG8_SB(0, 0), b2, voffB);
            PG8_BAR; PG8_WAIT_L(0); PG8_MMA(0, 1, At, B1); PG8_BAR;
            PG8_LDA(At, 0, 1); PG8_STAGE_A(PG8_SA(0, 0), a2, 0, last);
            PG8_BAR; PG8_WAIT_L(0); PG8_MMA(1, 0, At, B0); PG8_BAR; PG8_SCHED;
            PG8_STAGE(PG8_SB(0, 1), b2 + hstep, voffB);
            PG8_WAIT_V(6); PG8_BAR; PG8_MMA(1, 1, At, B1); PG8_BAR;
            PG8_LDB(B0, 1, 0); PG8_SCHED; PG8_LDA(At, 1, 0); PG8_STAGE_A(PG8_SA(0, 1), a2, 1, last);
            PG8_WAIT_L(8); PG8_BAR; PG8_WAIT_L(0); PG8_MMA(0, 0, At, B0); PG8_BAR; PG8_SCHED;
            PG8_LDB(B1, 1, 1); PG8_STAGE(PG8_SB(1, 0), b3, voffB);
            PG8_BAR; PG8_WAIT_L(0); PG8_MMA(0, 1, At, B1); PG8_BAR;
            PG8_LDA(At, 1, 1); PG8_STAGE_A(PG8_SA(1, 0), a3, 0, last);
            PG8_BAR; PG8_WAIT_L(0); PG8_MMA(1, 0, At, B0); PG8_BAR; PG8_SCHED;
            PG8_STAGE(PG8_SB(1, 1), b3 + hstep, voffB);
            PG8_WAIT_V(6); PG8_BAR; PG8_MMA(1, 1, At, B1); PG8_BAR;
            }
        }
        if constexpr (ALIGN_EPI) { if (wr == 0) PG8_BAR; }
        if constexpr (!Epi::AFTER_DRAIN) { E(acc, cur, wr, wc, fr, fq); S.done(cur); }
        if (!has_next) break;
        if (!S.keep_acc(nxt)) {
#pragma unroll
        for (int a = 0; a < 2; ++a)
#pragma unroll
            for (int b = 0; b < 2; ++b)
#pragma unroll
                for (int m = 0; m < 4; ++m)
#pragma unroll
                    for (int n = 0; n < 2; ++n) acc[a][b][m][n] = (f32x4){0.f, 0.f, 0.f, 0.f};
        }
        cur = nxt; cA = nA; cB = nB; ++ui;
        if constexpr (Sched::GATHER) {
#pragma unroll
            for (int i = 0; i < 2; ++i) { va0[i] = vn0[i]; va1[i] = vn1[i]; } }
        if constexpr (ALIGN_EPI) { if (wr == 1) PG8_BAR; }
    }
    PG8_WAIT_V(0);
    if constexpr (!ALIGN_EPI) { if (wr == 0) PG8_BAR; }
    PG8_BAR;
    if constexpr (Epi::AFTER_DRAIN) { E.fused(acc, cur, wr, wc, fr, fq, lds, wid, lane); S.done(cur); }
#undef PG8_SA
#undef PG8_SB
#undef PG8_STAGE
#undef PG8_STAGE_A
#undef PG8_LDA
#undef PG8_LDB
#undef PG8_MMA
#undef PG8_WAIT_V
#undef PG8_WAIT_L
#undef PG8_BAR
#undef PG8_SCHED
}
}


namespace attn {
using bf16 = __hip_bfloat16;
constexpr int   D = 128, NW = 8, QBLK = 32, KVBLK = 64;
constexpr float SCALE = 0.088388347648318440f;
constexpr float THR = 8.f;
constexpr int SDEPTH = 2;
constexpr int LDQ = 512, LDK = 256, LDO = 512;
constexpr size_t SHM_V = KVBLK * D * 2, SHM_K = KVBLK * D * 2, SHM_ATTN = 2 * SHM_V + 2 * SHM_K + NW * 64 * 4;
using bf16x8 = __attribute__((ext_vector_type(8))) short;
using s16x4  = __attribute__((ext_vector_type(4))) short;
using f32x16 = __attribute__((ext_vector_type(16))) float;
using f32x8  = __attribute__((ext_vector_type(8))) float;
using u32x4  = __attribute__((ext_vector_type(4))) unsigned;
#define KSWZ(row, colB) ((row) * 256 + ((colB) ^ (((row) & 7) << 4)))
#define SBAR() __builtin_amdgcn_sched_barrier(0)
__device__ __forceinline__ int crow(int r, int hi) { return (r & 3) + 8 * (r >> 2) + 4 * hi; }
typedef float f32x2_t __attribute__((ext_vector_type(2))); typedef __bf16 bf16x2_t __attribute__((ext_vector_type(2)));
__device__ __forceinline__ unsigned cvtpk(float lo, float hi) { f32x2_t v = {lo, hi}; bf16x2_t b = __builtin_convertvector(v, bf16x2_t); return __builtin_bit_cast(unsigned, b); }
template <typename TIn> struct Stage;
template <> struct Stage<bf16>  { using T = bf16x8;
  __device__ static __forceinline__ T ld8(const bf16* p) { return *reinterpret_cast<const bf16x8*>(p); }
  __device__ static __forceinline__ bf16x8 tobf(T x) { return x; } };
template <> struct Stage<float> { using T = f32x8;
  __device__ static __forceinline__ T ld8(const float* p) { return *reinterpret_cast<const f32x8*>(p); }
  __device__ static __forceinline__ bf16x8 tobf(T x) {
    u32x4 w = {cvtpk(x[0], x[1]), cvtpk(x[2], x[3]), cvtpk(x[4], x[5]), cvtpk(x[6], x[7])}; return *reinterpret_cast<bf16x8*>(&w); } };

__device__ __forceinline__ void partialSM(f32x16& p0, f32x16& p1, float& m_reg, float& mn, float& alpha) {
  constexpr float C = SCALE * 1.4426950408889634f;
  float pmax = p0[0]; for (int r = 1; r < 16; ++r) pmax = fmaxf(pmax, p0[r]); for (int r = 0; r < 16; ++r) pmax = fmaxf(pmax, p1[r]);
  { auto rr = __builtin_amdgcn_permlane32_swap(__float_as_uint(pmax), __float_as_uint(pmax), false, false);
    pmax = fmaxf(__uint_as_float(rr[0]), __uint_as_float(rr[1])); }
  if (__builtin_expect(__all(pmax - m_reg <= THR / SCALE), 1)) { mn = m_reg; alpha = 1.f; }
  else { mn = fmaxf(m_reg, pmax); alpha = __builtin_amdgcn_exp2f((m_reg - mn) * C); m_reg = mn; }
  float mnC = -mn * C;
  for (int r = 0; r < 16; ++r) p0[r] = fmaf(p0[r], C, mnC); for (int r = 0; r < 16; ++r) p1[r] = fmaf(p1[r], C, mnC);
  for (int r = 0; r < 16; ++r) p0[r] = __builtin_amdgcn_exp2f(p0[r]);
}
__device__ __forceinline__ void finishSM(f32x16& p0, f32x16& p1, float alpha, float& l_reg, bf16x8& pa0, bf16x8& pa1, bf16x8& pa2, bf16x8& pa3) {
  for (int r = 0; r < 16; ++r) p1[r] = __builtin_amdgcn_exp2f(p1[r]);
  float ps = 0; for (int r = 0; r < 16; ++r) ps += p0[r]; for (int r = 0; r < 16; ++r) ps += p1[r];
  { auto rr = __builtin_amdgcn_permlane32_swap(__float_as_uint(ps), __float_as_uint(ps), false, false);
    ps = __uint_as_float(rr[0]) + __uint_as_float(rr[1]); }
  l_reg = l_reg * alpha + ps;
#define PK4(P, BASE, OUT) do { unsigned a0 = cvtpk(P[BASE + 0], P[BASE + 1]), a1 = cvtpk(P[BASE + 2], P[BASE + 3]);   \
    unsigned b0 = cvtpk(P[BASE + 4], P[BASE + 5]), b1 = cvtpk(P[BASE + 6], P[BASE + 7]);                              \
    auto r0 = __builtin_amdgcn_permlane32_swap(a0, b0, false, false); auto r1 = __builtin_amdgcn_permlane32_swap(a1, b1, false, false); \
    u32x4 w = {r0[0], r1[0], r0[1], r1[1]}; OUT = *reinterpret_cast<bf16x8*>(&w); } while (0)
  PK4(p0, 0, pa0); PK4(p0, 8, pa1); PK4(p1, 0, pa2); PK4(p1, 8, pa3);
#undef PK4
}
__device__ __forceinline__ void qkt(f32x16& p0, f32x16& p1, const bf16* Ks, const bf16x8* qr, int r32, int hi) {
  p0 = f32x16{}; p1 = f32x16{};
  for (int d0 = 0; d0 < 8; ++d0) { int cb = (d0 * 16 + hi * 8) * 2;
    bf16x8 b0 = *reinterpret_cast<const bf16x8*>((const char*)Ks + KSWZ(r32, cb));
    bf16x8 b1 = *reinterpret_cast<const bf16x8*>((const char*)Ks + KSWZ(32 + r32, cb));
    p0 = __builtin_amdgcn_mfma_f32_32x32x16_bf16(b0, qr[d0], p0, 0, 0, 0);
    p1 = __builtin_amdgcn_mfma_f32_32x32x16_bf16(b1, qr[d0], p1, 0, 0, 0); }
}
__device__ __forceinline__ int v_st(int k, int c) { const int kk = (k & ~0xC) | ((k & 4) << 1) | ((k & 8) >> 1); return ((kk >> 3) * 4 + (c >> 5)) * 512 + ((kk & 7) * 32 + (c & 31)) * 2; }
__device__ __forceinline__ int v_rd_base(int lane) { return ((lane & 3) << 3) | (((lane >> 2) & 3) << 6) | (((lane >> 4) & 1) << 5) | (((lane >> 5) & 1) << 8); }
constexpr int v_rd_off(int d0, int ks, int half) { return d0 * 512 + ks * 4096 + half * 2048; }
template <int OFF> __device__ __forceinline__ s16x4 tr_read(int vb) {
  s16x4 r; asm volatile("ds_read_b64_tr_b16 %0, %1 offset:%2" : "=&v"(r) : "v"(vb), "i"(OFF) : "memory"); return r;
}
template <int D0> __device__ __forceinline__ void pv_one(f32x16& od, int vb, bf16x8 pa0, bf16x8 pa1, bf16x8 pa2, bf16x8 pa3) {
  const s16x4 l0 = tr_read<v_rd_off(D0, 0, 0)>(vb), h0 = tr_read<v_rd_off(D0, 0, 1)>(vb), l1 = tr_read<v_rd_off(D0, 1, 0)>(vb), h1 = tr_read<v_rd_off(D0, 1, 1)>(vb);
  const s16x4 l2 = tr_read<v_rd_off(D0, 2, 0)>(vb), h2 = tr_read<v_rd_off(D0, 2, 1)>(vb), l3 = tr_read<v_rd_off(D0, 3, 0)>(vb), h3 = tr_read<v_rd_off(D0, 3, 1)>(vb);
  asm volatile("s_waitcnt lgkmcnt(0)" ::: "memory"); SBAR();
#define PK(L, H) (bf16x8){L[0], L[1], L[2], L[3], H[0], H[1], H[2], H[3]}
  od = __builtin_amdgcn_mfma_f32_32x32x16_bf16(pa0, PK(l0, h0), od, 0, 0, 0);
  od = __builtin_amdgcn_mfma_f32_32x32x16_bf16(pa1, PK(l1, h1), od, 0, 0, 0);
  od = __builtin_amdgcn_mfma_f32_32x32x16_bf16(pa2, PK(l2, h2), od, 0, 0, 0);
  od = __builtin_amdgcn_mfma_f32_32x32x16_bf16(pa3, PK(l3, h3), od, 0, 0, 0);
#undef PK
}
__device__ __forceinline__ void pv_d0(f32x16* o, int vb, bf16x8 pa0, bf16x8 pa1, bf16x8 pa2, bf16x8 pa3) {
  pv_one<0>(o[0], vb, pa0, pa1, pa2, pa3); pv_one<1>(o[1], vb, pa0, pa1, pa2, pa3); pv_one<2>(o[2], vb, pa0, pa1, pa2, pa3); pv_one<3>(o[3], vb, pa0, pa1, pa2, pa3);
}

template <typename TQ>
__device__ __forceinline__ void attn_dense_body(const TQ* __restrict__ Qb, const bf16* __restrict__ Kh, const bf16* __restrict__ Vh,
                                                bf16* __restrict__ Ob, int seq, char* lds, const int tid) {
  using St = Stage<bf16>; using SQ = Stage<TQ>;
  const int wid = tid >> 6, lane = tid & 63, r32 = lane & 31, hi = lane >> 5;
  bf16* V_lds = (bf16*)lds; bf16* K_lds = (bf16*)(lds + 2 * SHM_V);
  float* ws = (float*)(lds + 2 * SHM_V + 2 * SHM_K) + wid * 64; float* li_l = ws; float* al_l = ws + 32;
  float m_reg = -1e30f, l_reg = 0; f32x16 o[4] = {}; bf16x8 qr[8];
  const TQ* Qw = Qb + (long)(wid * QBLK + r32) * LDQ + hi * 8;
#pragma unroll
  for (int d0 = 0; d0 < 8; ++d0) qr[d0] = SQ::tobf(SQ::ld8(Qw + d0 * 16));
  const int sr = tid >> 4, sc = (tid & 15) * 8, vst0 = v_st(sr, sc), vst1 = v_st(32 + sr, sc);
  const int vb0 = (int)(uintptr_t)V_lds + v_rd_base(lane);
  struct { typename St::T vs0, vs1, ks0, ks1; } sr_[SDEPTH];
#define SLOAD(i, k0) do { sr_[i].vs0 = St::ld8(&Vh[(long)((k0) + sr) * LDK + sc]); sr_[i].vs1 = St::ld8(&Vh[(long)((k0) + 32 + sr) * LDK + sc]); \
    sr_[i].ks0 = St::ld8(&Kh[(long)((k0) + sr) * LDK + sc]); sr_[i].ks1 = St::ld8(&Kh[(long)((k0) + 32 + sr) * LDK + sc]); } while (0)
#define SWRITE(b, i) do { *(bf16x8*)((char*)V_lds + (b) * SHM_V + vst0) = St::tobf(sr_[i].vs0);          \
    *(bf16x8*)((char*)V_lds + (b) * SHM_V + vst1) = St::tobf(sr_[i].vs1); int kc = sc * 2;               \
    *(bf16x8*)((char*)K_lds + (b) * SHM_K + KSWZ(sr, kc)) = St::tobf(sr_[i].ks0);                       \
    *(bf16x8*)((char*)K_lds + (b) * SHM_K + KSWZ(32 + sr, kc)) = St::tobf(sr_[i].ks1); } while (0)
#define SWAIT() do { if constexpr (SDEPTH == 2) asm volatile("s_waitcnt vmcnt(4)" ::: "memory"); else asm volatile("s_waitcnt vmcnt(0)" ::: "memory"); } while (0)
#define RESC(a) do { if (__any((a) < 1.f)) { if (hi == 0) al_l[r32] = (a); asm volatile("s_waitcnt lgkmcnt(0)" ::: "memory"); \
    for (int d = 0; d < 4; ++d) for (int r = 0; r < 16; ++r) o[d][r] *= al_l[crow(r, hi)]; } } while (0)
  f32x16 pA0, pA1, pB0, pB1; float mnA, mnB, alA, alB; bf16x8 pa0, pa1, pa2, pa3; const int NT = seq / KVBLK;
  constexpr int SE = 0, SO = SDEPTH - 1;
  SLOAD(SE, 0); asm volatile("s_waitcnt vmcnt(0)" ::: "memory"); SWRITE(0, SE); __syncthreads();
  qkt(pA0, pA1, K_lds, qr, r32, hi); partialSM(pA0, pA1, m_reg, mnA, alA);
  SLOAD(SO, KVBLK); if constexpr (SDEPTH == 2) { if (2 < NT) SLOAD(SE, 2 * KVBLK); }
  SWAIT(); SWRITE(1, SO); __syncthreads();
  for (int j = 1; j + 1 < NT; j += 2) {
    SBAR(); qkt(pB0, pB1, (bf16*)((char*)K_lds + SHM_K), qr, r32, hi);
    finishSM(pA0, pA1, alA, l_reg, pa0, pa1, pa2, pa3); SBAR();
    SLOAD(SO, (j + SDEPTH) * KVBLK); SBAR();
    pv_d0(o, vb0, pa0, pa1, pa2, pa3); partialSM(pB0, pB1, m_reg, mnB, alB);
    __syncthreads(); SWAIT(); SWRITE(0, SE);
    RESC(alB); __syncthreads();
    SBAR(); qkt(pA0, pA1, K_lds, qr, r32, hi);
    finishSM(pB0, pB1, alB, l_reg, pa0, pa1, pa2, pa3); SBAR();
    if (SDEPTH == 1 || j + 3 < NT) SLOAD(SE, (j + 1 + SDEPTH) * KVBLK); SBAR();
    pv_d0(o, vb0 + (int)SHM_V, pa0, pa1, pa2, pa3); partialSM(pA0, pA1, m_reg, mnA, alA);
    __syncthreads(); SWAIT(); SWRITE(1, SO);
    RESC(alA); __syncthreads();
  }
  SBAR(); qkt(pB0, pB1, (bf16*)((char*)K_lds + SHM_K), qr, r32, hi);
  finishSM(pA0, pA1, alA, l_reg, pa0, pa1, pa2, pa3); SBAR();
  pv_d0(o, vb0, pa0, pa1, pa2, pa3); partialSM(pB0, pB1, m_reg, mnB, alB);
  __syncthreads(); RESC(alB);
  finishSM(pB0, pB1, alB, l_reg, pa0, pa1, pa2, pa3); SBAR();
  pv_d0(o, vb0 + (int)SHM_V, pa0, pa1, pa2, pa3);
  if (hi == 0) li_l[r32] = l_reg; asm volatile("s_waitcnt lgkmcnt(0)" ::: "memory");
  float rli[16];
#pragma unroll
  for (int r = 0; r < 16; ++r) rli[r] = __builtin_amdgcn_rcpf(li_l[crow(r, hi)]);
  bf16* Ow = Ob + (long)(wid * QBLK) * LDO;
#pragma unroll
  for (int r = 0; r < 16; ++r) { int orow = crow(r, hi);
    for (int d0 = 0; d0 < 4; ++d0) Ow[(long)orow * LDO + d0 * 32 + r32] = __float2bfloat16(o[d0][r] * rli[r]); }
#undef SLOAD
#undef SWRITE
#undef SWAIT
#undef RESC
}

#undef KSWZ
#undef SBAR
}
#define GAS __attribute__((address_space(1)))
#define LAS __attribute__((address_space(3)))
typedef unsigned short bf16;
typedef unsigned v4u __attribute__((ext_vector_type(4)));
typedef float f32x4 __attribute__((ext_vector_type(4)));
typedef short bf16x8 __attribute__((ext_vector_type(8)));
typedef GAS unsigned gu32;
typedef GAS unsigned long long gu64;
#define RLX_AGENT __ATOMIC_RELAXED, __HIP_MEMORY_SCOPE_AGENT
#define LDS_WAIT() asm volatile("s_waitcnt lgkmcnt(0)" ::: "memory")
#define VM_WAIT() asm volatile("s_waitcnt vmcnt(0)" ::: "memory")
__device__ __forceinline__ unsigned long long rt() { return __builtin_amdgcn_s_memrealtime(); }
__device__ __forceinline__ unsigned f2bf(float f) { unsigned u = __builtin_bit_cast(unsigned, f); return (u + 0x7fffu + ((u >> 16) & 1u)) >> 16; }
__device__ __forceinline__ unsigned pk2(float lo, float hi) { return f2bf(lo) | (f2bf(hi) << 16); }

#define XB_TMO      128
#define XB_XCNT(j)  (256  + 64 * (j))
#define XB_XSUB(j)  (1280 + 64 * (j))
#define XB_XGEN(j)  (2304 + 64 * (j))
#define XB_TOP      3328
#define XB_TOPGEN   3392
#define XCD_BAR_WORDS 3456
#define XB_SPIN_CAP (1u << 18)

__device__ __forceinline__ unsigned xb_ld(unsigned* p)              { return __hip_atomic_load(p, __ATOMIC_RELAXED, __HIP_MEMORY_SCOPE_AGENT); }
__device__ __forceinline__ unsigned xb_add(unsigned* p, unsigned v) { return __hip_atomic_fetch_add(p, v, __ATOMIC_RELAXED, __HIP_MEMORY_SCOPE_AGENT); }
__device__ __forceinline__ unsigned xb_xcc_id() { return (unsigned)__builtin_amdgcn_s_getreg((3 << 11) | 20) & 0xFu; }
#define XB_SPIN(cond, bar) do { unsigned _sp = 0; while (cond) { __builtin_amdgcn_s_sleep(1); \
    if ((++_sp & 255u) == 0u) { if (xb_ld(&(bar)[XB_TMO])) break; if (_sp > XB_SPIN_CAP) { atomicAdd(&(bar)[XB_TMO], 1u); break; } } } } while (0)

struct XcdBarrier {
    unsigned* bar; unsigned x;
    volatile LAS unsigned* st;
};

__device__ __forceinline__ XcdBarrier xcd_barrier_post(unsigned* bar, volatile LAS unsigned* st) {
    XcdBarrier b; b.bar = bar; b.x = xb_xcc_id(); b.st = st;
    if (threadIdx.x == 0) (void)xb_add(&bar[XB_XCNT(b.x)], 1u);
    return b;
}
__device__ __forceinline__ void xcd_barrier_complete(unsigned* bar, unsigned x, unsigned& nloc, unsigned& nx) {
    const unsigned G = gridDim.x * gridDim.y * gridDim.z;
    unsigned sum, cnt, mine, sp = 0u;
    for (;;) {
        sum = 0u; cnt = 0u; mine = 0u;
#pragma unroll
        for (unsigned j = 0; j < 16; ++j) { const unsigned c = xb_ld(&bar[XB_XCNT(j)]); sum += c; cnt += (c > 0u) ? 1u : 0u; mine = (j == x) ? c : mine; }
        if (sum == G) break;
        __builtin_amdgcn_s_sleep(1);
        if ((++sp & 255u) == 0u) { if (xb_ld(&bar[XB_TMO])) break; if (sp > XB_SPIN_CAP) { atomicAdd(&bar[XB_TMO], 1u); break; } }
    }
    nloc = mine > 0u ? mine : 1u; nx = cnt > 0u ? cnt : 1u;
}

__device__ __forceinline__ void xcd_barrier(const XcdBarrier& b, const int tid_) {
    asm volatile("s_waitcnt vmcnt(0)" ::: "memory");
    __syncthreads();
    if (tid_ == 0) {
        unsigned* bar = b.bar;
        __builtin_amdgcn_s_waitcnt(0);
        unsigned nloc = b.st[0], nx = b.st[1];
        if (nloc == 0u) { xcd_barrier_complete(bar, b.x, nloc, nx); b.st[0] = nloc; b.st[1] = nx; }
        const unsigned old = xb_add(&bar[XB_XSUB(b.x)], 1u);
        const unsigned gen = old / nloc;
        if (old + 1u == (gen + 1u) * nloc) {
            __builtin_amdgcn_fence(__ATOMIC_RELEASE, "agent");
            asm volatile("s_waitcnt vmcnt(0)" ::: "memory");
            const unsigned og = xb_add(&bar[XB_TOP], 1u);
            const unsigned tg = og / nx;
            if (og + 1u == (tg + 1u) * nx) xb_add(&bar[XB_TOPGEN], 1u);
            else XB_SPIN(xb_ld(&bar[XB_TOPGEN]) == tg, bar);
            __builtin_amdgcn_fence(__ATOMIC_ACQUIRE, "agent");
            xb_add(&bar[XB_XGEN(b.x)], 1u);
            asm volatile("s_waitcnt vmcnt(0)" ::: "memory");
        } else {
            XB_SPIN(xb_ld(&bar[XB_XGEN(b.x)]) == gen, bar);
            __builtin_amdgcn_fence(__ATOMIC_ACQUIRE, "agent");
            asm volatile("s_waitcnt vmcnt(0)" ::: "memory");
        }
    }
    __syncthreads();
}


constexpr size_t MiB = 1u << 20;
constexpr size_t WS_CTL = 0, CTL_ZERO_BYTES = 64 * 1024;
constexpr size_t WS_AFF = 1 * MiB;
constexpr size_t WS_COS = 2 * MiB, WS_SIN = 4 * MiB;
constexpr size_t WS_IDX = 6 * MiB, WS_GATE = 6 * MiB + 256 * 1024, WS_SEL = 7 * MiB;
constexpr size_t WS_WIN = 8 * MiB;
constexpr size_t WS_WR = 18 * MiB, WS_WA = 19 * MiB, WS_WO = 20 * MiB;
constexpr size_t WS_W1C = 22 * MiB;
constexpr size_t WS_WD = 198 * MiB;
constexpr size_t WS_X1 = 286 * MiB;
constexpr size_t WS_H = 350 * MiB;
constexpr size_t WS_RQ = 382 * MiB, WS_RK = 398 * MiB, WS_RV = 414 * MiB, WS_RGS = 430 * MiB;
constexpr size_t WS_AQ = 446 * MiB, WS_AK = 462 * MiB, WS_AV = 470 * MiB;
constexpr size_t WS_GRS = 478 * MiB, WS_GAS = 510 * MiB;
constexpr size_t WS_KV = 542 * MiB;
constexpr size_t WS_S = 606 * MiB;
constexpr size_t WS_YRIN = 638 * MiB, WS_ATT = 654 * MiB;
constexpr size_t WS_MIXED = 670 * MiB;
constexpr size_t WS_XE = 382 * MiB, WS_ACT = 446 * MiB, WS_Y = 622 * MiB;
constexpr size_t WS_END = 704 * MiB;
static_assert(EP_COS == WS_COS && EP_SIN == WS_SIN && EP_RQ == WS_RQ && EP_RK == WS_RK && EP_RV == WS_RV && EP_RGS == WS_RGS && EP_AQ == WS_AQ && EP_AK == WS_AK && EP_AV == WS_AV && EP_GRS == WS_GRS && EP_GAS == WS_GAS, "epilogue offsets vs d_ws map");
constexpr int CW_BAR = 4096;

constexpr int RING_OFF = 0, RING_BYTES = 131072;
constexpr int LDSCTL_OFF = RING_BYTES, MISC_OFF = LDSCTL_OFF + 320;
constexpr int XCH_OFF = RING_BYTES + 1024;
constexpr int LDS_BYTES = 147456;
constexpr int NWAVES = 8;

__device__ __forceinline__ float wave_sum(float v) {
#pragma unroll
    for (int o = 1; o < 64; o <<= 1) v += __shfl_xor(v, o);
    return v;
}
__device__ __forceinline__ float bf2f(bf16 v) { return __uint_as_float((unsigned)v << 16); }

template <class CM>
__device__ __forceinline__ void transpose_item(const float* W, int K, int N, bf16* WT, const CM cm, LAS float* scr, int kb, int nb, int lane) {
    const int k0 = 64 * kb, n0 = 32 * nb;
    const int srccol = cm(n0 + (lane & 31));
    float tv[32];
#pragma unroll
    for (int i = 0; i < 32; ++i) tv[i] = W[(size_t)(k0 + 2 * i + (lane >> 5)) * N + srccol];
#pragma unroll
    for (int i = 0; i < 32; ++i) scr[(2 * i + (lane >> 5)) * 33 + (lane & 31)] = tv[i];
    LDS_WAIT(); asm volatile("" ::: "memory");
    const int c = lane & 7;
#pragma unroll
    for (int j = 0; j < 4; ++j) { const int n = (lane >> 3) + 8 * j; const LAS float* s = scr + (8 * c) * 33 + n;
        v4u o; o.x = pk2(s[0 * 33], s[1 * 33]); o.y = pk2(s[2 * 33], s[3 * 33]); o.z = pk2(s[4 * 33], s[5 * 33]); o.w = pk2(s[6 * 33], s[7 * 33]);
        *(GAS v4u*)(WT + (size_t)(n0 + n) * K + k0 + 8 * c) = o; }
    LDS_WAIT(); asm volatile("" ::: "memory");
}
struct CmId { __device__ __forceinline__ int operator()(int n) const { return n; } };
struct CmWin {
    __device__ __forceinline__ int operator()(int n) const {
        const bool rope = (n < 1024) || (n >= 2048 && n < 2816);
        const int L = n & 127, g = L >> 3, i = L & 7, o = (i < 4) ? (4 * g + i) : (64 + 4 * g + (i - 4));
        return rope ? ((n & ~127) + o) : n; }
};
struct CmW1 { __device__ __forceinline__ int operator()(int n) const { return 128 * (n >> 8) + (n & 127); } };

__device__ __forceinline__ void rms_row_to_bf16(const float* xrow, const float* gain, bf16* orow, int lane) {
    const GAS f32x4* xr = (const GAS f32x4*)xrow + lane; const GAS f32x4* gr = (const GAS f32x4*)gain + lane;
    f32x4 v[4]; float s = 0.f;
#pragma unroll
    for (int j = 0; j < 4; ++j) { v[j] = xr[64 * j]; s += (v[j].x * v[j].x + v[j].y * v[j].y) + (v[j].z * v[j].z + v[j].w * v[j].w); }
    const float rstd = 1.f / sqrtf(wave_sum(s) * (1.f / D_MODEL) + EPS);
    GAS unsigned long long* o8 = (GAS unsigned long long*)orow + lane;
#pragma unroll
    for (int j = 0; j < 4; ++j) { const f32x4 g4 = gr[64 * j]; o8[64 * j] = (unsigned long long)pk2(v[j].x * rstd * g4.x, v[j].y * rstd * g4.y) | ((unsigned long long)pk2(v[j].z * rstd * g4.z, v[j].w * rstd * g4.w) << 32); }
}


namespace ret {
typedef short bf16x8 __attribute__((ext_vector_type(8)));
typedef short v4i16 __attribute__((ext_vector_type(4)));
constexpr int PITCH = 272;
constexpr int TILE_B = 128 * PITCH;
constexpr int STRIP_B = 16 * PITCH;
__device__ __forceinline__ float lg2_of(const float* p, int h) { return log1pf(-expf(p[h])) * 1.4426950408889634f; }
__device__ __forceinline__ unsigned cvt2(float lo, float hi) { typedef float f2 __attribute__((ext_vector_type(2))); typedef __bf16 b2 __attribute__((ext_vector_type(2))); f2 v = {lo, hi}; b2 b = __builtin_convertvector(v, b2); return __builtin_bit_cast(unsigned, b); }
__device__ __forceinline__ bf16x8 frag_tr(LAS const unsigned char* tile, int k0, int n0, int lane) {
    const int g = lane >> 4, q = (lane >> 2) & 3, p = lane & 3;
    LAS const unsigned char* a = tile + (k0 + 8 * g + q) * PITCH + (n0 + 4 * p) * 2;
    const v4i16 lo = __builtin_amdgcn_ds_read_tr16_b64_v4i16((LAS v4i16*)a);
    const v4i16 hi = __builtin_amdgcn_ds_read_tr16_b64_v4i16((LAS v4i16*)(a + 4 * PITCH));
    return (bf16x8){lo[0], lo[1], lo[2], lo[3], hi[0], hi[1], hi[2], hi[3]};
}
__device__ __forceinline__ bf16x8 frag_row(LAS const unsigned char* tile, int r0, int k0, int lane) { return *(LAS const bf16x8*)(tile + (r0 + (lane & 15)) * PITCH + (k0 + 8 * (lane >> 4)) * 2); }
__device__ __forceinline__ void stage_tile(LAS unsigned char* tile, const bf16* src, long tok0, int h, int tid) {
#pragma unroll
    for (int i = 0; i < 4; ++i) { const int q = tid + 512 * i, row = q >> 4, ch = q & 15;
        const v4u v = *(const GAS v4u*)(src + (tok0 + row) * 512 + h * HD + ch * 8); *(LAS v4u*)(tile + row * PITCH + ch * 16) = v; }
}
__device__ __forceinline__ void kv_item(int item, LAS unsigned char* lds, const bf16* rk, const bf16* rv, const float* pf, const float* pb, float* kv, int tid) {
    asm volatile("" : "+v"(tid));
    const int c = item & 63, bh = item >> 6, b = bh >> 2, h = bh & 3, lane = tid & 63, w = tid >> 6, g = lane >> 4;
    const long tok0 = (long)b * SEQ + (long)c * CHUNK;
    LAS unsigned char* Kl = lds; LAS unsigned char* Vl = lds + TILE_B;
    stage_tile(Kl, rk, tok0, h, tid); stage_tile(Vl, rv, tok0, h, tid);
    __syncthreads();
    const float lf = lg2_of(pf, h), lb = lg2_of(pb, h);
    f32x4 accf[8], accb[8];
#pragma unroll
    for (int n = 0; n < 8; ++n) { accf[n] = (f32x4){0.f, 0.f, 0.f, 0.f}; accb[n] = (f32x4){0.f, 0.f, 0.f, 0.f}; }
#pragma unroll
    for (int kk = 0; kk < 4; ++kk) {
        const bf16x8 a = frag_tr(Vl, 32 * kk, 16 * w, lane);
        bf16x8 af, ab;
        { unsigned pf_[4], pb_[4];
#pragma unroll
          for (int t = 0; t < 8; t += 2) { const int j = 32 * kk + 8 * g + t;
              const float v0 = __uint_as_float((unsigned)(unsigned short)a[t] << 16), v1 = __uint_as_float((unsigned)(unsigned short)a[t + 1] << 16);
              pf_[t >> 1] = cvt2(v0 * __builtin_amdgcn_exp2f(lf * (float)(127 - j)), v1 * __builtin_amdgcn_exp2f(lf * (float)(126 - j)));
              pb_[t >> 1] = cvt2(v0 * __builtin_amdgcn_exp2f(lb * (float)j), v1 * __builtin_amdgcn_exp2f(lb * (float)(j + 1))); }
          const v4u wf_ = {pf_[0], pf_[1], pf_[2], pf_[3]}, wb_ = {pb_[0], pb_[1], pb_[2], pb_[3]};
          af = __builtin_bit_cast(bf16x8, wf_); ab = __builtin_bit_cast(bf16x8, wb_); }
#pragma unroll
        for (int n = 0; n < 8; ++n) { const bf16x8 bk = frag_tr(Kl, 32 * kk, 16 * n, lane);
            accf[n] = __builtin_amdgcn_mfma_f32_16x16x32_bf16(af, bk, accf[n], 0, 0, 0); accb[n] = __builtin_amdgcn_mfma_f32_16x16x32_bf16(ab, bk, accb[n], 0, 0, 0); }
    }
    float* of = kv + (((long)0 * 8 + bh) * NCHUNK + c) * (HD * HD); float* ob = kv + (((long)1 * 8 + bh) * NCHUNK + c) * (HD * HD);
#pragma unroll
    for (int n = 0; n < 8; ++n)
#pragma unroll
        for (int r = 0; r < 4; ++r) { const int o = (16 * w + 4 * g + r) * HD + 16 * n + (lane & 15); of[o] = accf[n][r]; ob[o] = accb[n][r]; }
    __syncthreads();
}
__device__ __forceinline__ void scan_thread(long gid, const float* pf, const float* pb, const float* kv, bf16* S) {
    const int el = (int)(gid & 16383), bh = (int)((gid >> 14) & 7), dir = (int)(gid >> 17), h = bh & 3;
    const float gC = __builtin_amdgcn_exp2f(lg2_of(dir ? pb : pf, h) * (float)CHUNK);
    const float* p = kv + (((long)dir * 8 + bh) * NCHUNK) * (HD * HD) + el; bf16* o = S + (((long)dir * 8 + bh) * NCHUNK) * (HD * HD) + el;
    float st = 0.f;
    if (dir == 0) {
#pragma unroll 8
        for (int c = 0; c < NCHUNK; ++c) { const float v = p[(long)c * HD * HD]; o[(long)c * HD * HD] = (bf16)f2bf(st); st = st * gC + v; } }
    else {
#pragma unroll 8
        for (int c = NCHUNK - 1; c >= 0; --c) { const float v = p[(long)c * HD * HD]; o[(long)c * HD * HD] = (bf16)f2bf(st); st = st * gC + v; } }
}
__device__ __forceinline__ void out_item(int item, LAS unsigned char* lds, const bf16* rq, const bf16* rk, const bf16* rv, const bf16* rgs, const float* pf, const float* pb,
                                         const bf16* S, const float* gain, bf16* yrin, int tid) {
    asm volatile("" : "+v"(tid));
    const int c = item & 63, bh = item >> 6, b = bh >> 2, h = bh & 3, lane = tid & 63, w = tid >> 6, g = lane >> 4, lc = lane & 15;
    const long tok0 = (long)b * SEQ + (long)c * CHUNK;
    LAS unsigned char* Kl = lds; LAS unsigned char* Vl = lds + TILE_B; LAS unsigned char* strip = lds + 2 * TILE_B + w * STRIP_B;
    stage_tile(Kl, rk, tok0, h, tid); stage_tile(Vl, rv, tok0, h, tid);
    bf16x8 qa[4];
#pragma unroll
    for (int kk = 0; kk < 4; ++kk) qa[kk] = *(const GAS bf16x8*)(rq + (tok0 + 16 * w + lc) * 512 + h * HD + 32 * kk + 8 * g);
    __syncthreads();
    const float lf = lg2_of(pf, h), lb = lg2_of(pb, h);
    {
        f32x4 sc[8];
#pragma unroll
        for (int n = 0; n < 8; ++n) { sc[n] = (f32x4){0.f, 0.f, 0.f, 0.f};
#pragma unroll
            for (int kk = 0; kk < 4; ++kk) sc[n] = __builtin_amdgcn_mfma_f32_16x16x32_bf16(qa[kk], frag_row(Kl, 16 * n, 32 * kk, lane), sc[n], 0, 0, 0); }
#pragma unroll
        for (int n = 0; n < 8; ++n)
#pragma unroll
            for (int r = 0; r < 4; ++r) { const int i = 16 * w + 4 * g + r, j = 16 * n + lc; const int df = i - j;
                const float dec = __builtin_amdgcn_exp2f(df >= 0 ? lf * (float)df : lb * (float)(-df));
                *(LAS unsigned short*)(strip + (4 * g + r) * PITCH + j * 2) = (unsigned short)f2bf(sc[n][r] * dec); }
    }
    asm volatile("s_waitcnt lgkmcnt(0)" ::: "memory");
    bf16x8 qf[4], qb[4];
    { const int ia = 16 * w + lc; const float cf = __builtin_amdgcn_exp2f(lf * (float)(ia + 1)), cb = __builtin_amdgcn_exp2f(lb * (float)(CHUNK - ia));
#pragma unroll
      for (int kk = 0; kk < 4; ++kk) { unsigned pf_[4], pb_[4];
#pragma unroll
          for (int t = 0; t < 8; t += 2) { const float v0 = __uint_as_float((unsigned)(unsigned short)qa[kk][t] << 16), v1 = __uint_as_float((unsigned)(unsigned short)qa[kk][t + 1] << 16);
              pf_[t >> 1] = cvt2(v0 * cf, v1 * cf); pb_[t >> 1] = cvt2(v0 * cb, v1 * cb); }
          const v4u wf_ = {pf_[0], pf_[1], pf_[2], pf_[3]}, wb_ = {pb_[0], pb_[1], pb_[2], pb_[3]};
          qf[kk] = __builtin_bit_cast(bf16x8, wf_); qb[kk] = __builtin_bit_cast(bf16x8, wb_); } }
    f32x4 o[8];
#pragma unroll
    for (int n = 0; n < 8; ++n) o[n] = (f32x4){0.f, 0.f, 0.f, 0.f};
    const bf16* Sf = S + (((long)0 * 8 + bh) * NCHUNK + c) * (HD * HD); const bf16* Sb = S + (((long)1 * 8 + bh) * NCHUNK + c) * (HD * HD);
#pragma unroll
    for (int kh = 0; kh < 2; ++kh) {
        bf16x8 bfv[2][8], bbv[2][8];
#pragma unroll
        for (int k2 = 0; k2 < 2; ++k2)
#pragma unroll
            for (int n = 0; n < 8; ++n) { const int kk = 2 * kh + k2; bfv[k2][n] = *(const GAS bf16x8*)(Sf + (16 * n + lc) * HD + 32 * kk + 8 * g); bbv[k2][n] = *(const GAS bf16x8*)(Sb + (16 * n + lc) * HD + 32 * kk + 8 * g); }
#pragma unroll
        for (int k2 = 0; k2 < 2; ++k2) { const int kk = 2 * kh + k2;
            const bf16x8 sa = frag_row(strip, 0, 32 * kk, lane);
#pragma unroll
            for (int n = 0; n < 8; ++n) {
                o[n] = __builtin_amdgcn_mfma_f32_16x16x32_bf16(sa, frag_tr(Vl, 32 * kk, 16 * n, lane), o[n], 0, 0, 0);
                o[n] = __builtin_amdgcn_mfma_f32_16x16x32_bf16(qf[kk], bfv[k2][n], o[n], 0, 0, 0); o[n] = __builtin_amdgcn_mfma_f32_16x16x32_bf16(qb[kk], bbv[k2][n], o[n], 0, 0, 0); } }
        asm volatile("" ::: "memory");
    }
    asm volatile("s_waitcnt lgkmcnt(0)" ::: "memory");
#pragma unroll
    for (int r = 0; r < 4; ++r) {
        float y[8]; float s = 0.f;
#pragma unroll
        for (int n = 0; n < 8; ++n) { y[n] = o[n][r]; s += y[n]; }
        s += __shfl_xor(s, 1); s += __shfl_xor(s, 2); s += __shfl_xor(s, 4); s += __shfl_xor(s, 8);
        const float mu = s * (1.0f / HD); float s2 = 0.f;
#pragma unroll
        for (int n = 0; n < 8; ++n) { y[n] -= mu; s2 += y[n] * y[n]; }
        s2 += __shfl_xor(s2, 1); s2 += __shfl_xor(s2, 2); s2 += __shfl_xor(s2, 4); s2 += __shfl_xor(s2, 8);
        const float rstd = 1.0f / sqrtf(s2 * (1.0f / HD) + EPS);
#pragma unroll
        for (int n = 0; n < 8; ++n) *(LAS unsigned short*)(strip + (4 * g + r) * PITCH + (16 * n + lc) * 2) = (unsigned short)f2bf(y[n] * rstd); }
    asm volatile("s_waitcnt lgkmcnt(0)" ::: "memory");
    { const int row = lane >> 2, qc = lane & 3; const long ro = (tok0 + 16 * w + row) * 512 + h * HD;
#pragma unroll
      for (int t = 0; t < 4; ++t) { const int e0 = 32 * qc + 8 * t;
          const v4u yv = *(LAS const v4u*)(strip + row * PITCH + e0 * 2);
          const f32x4 y0 = {__uint_as_float(yv.x << 16), __uint_as_float(yv.x & 0xffff0000u), __uint_as_float(yv.y << 16), __uint_as_float(yv.y & 0xffff0000u)};
          const f32x4 y1 = {__uint_as_float(yv.z << 16), __uint_as_float(yv.z & 0xffff0000u), __uint_as_float(yv.w << 16), __uint_as_float(yv.w & 0xffff0000u)};
          const f32x4 g0 = *(const GAS f32x4*)(gain + h * HD + e0), g1 = *(const GAS f32x4*)(gain + h * HD + e0 + 4);
          const v4u rg = *(const GAS v4u*)(rgs + ro + e0);
          const f32x4 r0 = {__uint_as_float(rg.x << 16), __uint_as_float(rg.x & 0xffff0000u), __uint_as_float(rg.y << 16), __uint_as_float(rg.y & 0xffff0000u)};
          const f32x4 r1 = {__uint_as_float(rg.z << 16), __uint_as_float(rg.z & 0xffff0000u), __uint_as_float(rg.w << 16), __uint_as_float(rg.w & 0xffff0000u)};
          const f32x4 a0 = y0 * g0 * r0, a1 = y1 * g1 * r1;
          v4u ov; ov.x = cvt2(a0[0], a0[1]); ov.y = cvt2(a0[2], a0[3]); ov.z = cvt2(a1[0], a1[1]); ov.w = cvt2(a1[2], a1[3]);
          *(GAS v4u*)(yrin + ro + e0) = ov; } }
    __syncthreads();
}
}

struct Args { const float* in[17]; float* out; unsigned char* ws; int ph_lo, ph_hi; };
constexpr int PH_PROLOGUE = 0, PH_PROJ = 1, PH_RETKV = 2, PH_ATTN = 3, PH_RETOUT = 4, PH_BRANCH = 5, PH_WO = 6, PH_ROUTER = 7, PH_TOPK = 8, PH_GATHER = 9, PH_MOE1 = 10, PH_MOE2 = 11, PH_FINAL = 12, PH_END = 13;
#ifndef MK_EXPERT_CVT
#define MK_EXPERT_CVT 1
#endif

__global__ void __launch_bounds__(NWAVES * 64, 2) mega(Args args) {
    extern __shared__ __attribute__((aligned(16))) unsigned char lds_raw[];
    LAS unsigned char* lds = (LAS unsigned char*)lds_raw;
    volatile LAS unsigned* MISC = (volatile LAS unsigned*)(lds + MISC_OFF);
    const int wave = __builtin_amdgcn_readfirstlane((int)threadIdx.x >> 6);
#define PHASE_IDS int lane; asm volatile("v_mbcnt_lo_u32_b32 %0, -1, 0\n\tv_mbcnt_hi_u32_b32 %0, -1, %0" : "=v"(lane)); const int tid = wave * 64 + lane; (void)tid;
    const int G = gridDim.x; const int bx = blockIdx.x; const int vcu = (G % 8 == 0) ? (bx % 8) * (G / 8) + bx / 8 : bx;
    unsigned char* ws = args.ws;
    gu32* ctl = (gu32*)(ws + WS_CTL);
    for (int u = threadIdx.x; u < (LDS_BYTES - LDSCTL_OFF) / 4; u += NWAVES * 64) ((LAS unsigned*)(lds + LDSCTL_OFF))[u] = 0u;
    __syncthreads();
    const bool one_launch = (args.ph_hi - args.ph_lo) > 1;
    XcdBarrier bar; bar.bar = (unsigned*)(ctl + CW_BAR); bar.x = 0; bar.st = nullptr;
    if (one_launch) bar = xcd_barrier_post((unsigned*)(ctl + CW_BAR), MISC + 8);
    const int lo = args.ph_lo, hi = args.ph_hi;
#define IN(k) (lo <= (k) && (k) < hi)
#define SEAM(k) do { if (IN(k) && IN((k) + 1)) { PHASE_IDS xcd_barrier(bar, tid); } } while (0)
    const int gw = vcu * NWAVES + wave, NGW = G * NWAVES;

    if (IN(PH_PROLOGUE)) { PHASE_IDS
        LAS float* scr = (LAS float*)(lds + RING_OFF + wave * 16384);
        const float* w_in = args.in[2]; const float* w_ret = args.in[6]; const float* w_att = args.in[9]; const float* w_o = args.in[10];
        const float* wg = args.in[13]; const float* wu = args.in[14];
        constexpr int I_IN = 16 * 160, I_R = 8 * 32, I_A = 8 * 32, I_O = 16 * 32, I_1 = 16 * 176;
        constexpr int NSMALL = I_IN + I_R + I_A + I_O;
        const int NITEMS = NSMALL + NE * I_1;
        for (int it = gw; it < NITEMS; it += NGW) {
            int r = it;
            if (r < I_IN) { transpose_item(w_in, 1024, INW, (bf16*)(ws + WS_WIN), CmWin(), scr, r / 160, r % 160, lane); continue; } r -= I_IN;
            if (r < I_R) { transpose_item(w_ret, 512, D_MODEL, (bf16*)(ws + WS_WR), CmId(), scr, r / 32, r % 32, lane); continue; } r -= I_R;
            if (r < I_A) { transpose_item(w_att, 512, D_MODEL, (bf16*)(ws + WS_WA), CmId(), scr, r / 32, r % 32, lane); continue; } r -= I_A;
            if (r < I_O) { transpose_item(w_o, 1024, D_MODEL, (bf16*)(ws + WS_WO), CmId(), scr, r / 32, r % 32, lane); continue; } r -= I_O;
            { const int e = r / I_1, q = r % I_1, kb = q / 176, nb = q % 176; const bool up = (nb >> 2) & 1;
                transpose_item((up ? wu : wg) + (size_t)e * D_MODEL * FF, 1024, FF, (bf16*)(ws + WS_W1C) + (size_t)e * 5632 * 1024, CmW1(), scr, kb, nb, lane); }
        }
        for (int m = gw; m < T; m += NGW) rms_row_to_bf16(args.in[0] + (size_t)m * D_MODEL, args.in[1], (bf16*)(ws + WS_H) + (size_t)m * D_MODEL, lane);
        { float* ct = (float*)(ws + WS_COS); float* st = (float*)(ws + WS_SIN);
          for (int e = (vcu * NWAVES * 64) + tid; e < SEQ * 64; e += G * NWAVES * 64) { const int pos = e >> 6, j = e & 63;
              const float freq = powf(10000.0f, -(float)(j & 31) / 32.0f); const float ang = (float)(j < 32 ? (pos >> 6) : (pos & 63)) * freq;
              ct[e] = cosf(ang); st[e] = sinf(ang); } }
    }
    SEAM(PH_PROLOGUE);

    if (IN(PH_PROJ)) { PHASE_IDS
        pg8::PlainSched S; S.init(T, INW, G, bx); S.A = (const char*)(ws + WS_H); S.Bt = (const char*)(ws + WS_WIN); S.tstep = (size_t)256 * 1024 * 2;
        pg8::EpiProj E; E.wsb = ws; E.qn = args.in[7]; E.kn = args.in[8]; E.xch = (LAS float*)(lds + XCH_OFF); E.epoch = 0u;
        pg8::gemm_phase<pg8::EpiProj, pg8::PlainSched, true, true>(lds + RING_OFF, 1024, S, E, tid);
    }
    SEAM(PH_PROJ);

    if (IN(PH_RETKV)) { PHASE_IDS
        for (int item = vcu; item < 8 * NCHUNK; item += G)
            ret::kv_item(item, lds + RING_OFF, (const bf16*)(ws + WS_RK), (const bf16*)(ws + WS_RV), args.in[3], args.in[4], (float*)(ws + WS_KV), tid);
    }
    SEAM(PH_RETKV);

    if (IN(PH_ATTN)) { PHASE_IDS
        for (long gid = (long)vcu * 512 + tid; gid < 2 * 8 * 16384; gid += (long)G * 512) ret::scan_thread(gid, args.in[3], args.in[4], (const float*)(ws + WS_KV), (bf16*)(ws + WS_S));
    }

    if (IN(PH_ATTN)) { PHASE_IDS
        for (int u = vcu; u < BATCH * 4 * (SEQ / 256); u += G) {
            const int bh = u >> 5, qb = u & 31, b = bh >> 2, h = bh & 3, kvh = h >> 1;
            const size_t q0 = ((size_t)b * SEQ + (size_t)qb * 256) * 512 + (size_t)h * 128, k0 = (size_t)b * SEQ * 256 + (size_t)kvh * 128;
            attn::attn_dense_body<attn::bf16>((const attn::bf16*)(ws + WS_AQ) + q0, (const attn::bf16*)(ws + WS_AK) + k0, (const attn::bf16*)(ws + WS_AV) + k0,
                                              (attn::bf16*)(ws + WS_ATT) + q0, SEQ, (char*)lds_raw, tid);
            __syncthreads();
        }
    }
    SEAM(PH_ATTN);

    if (IN(PH_RETOUT)) { PHASE_IDS
        for (int item = vcu; item < 8 * NCHUNK; item += G)
            ret::out_item(item, lds + RING_OFF, (const bf16*)(ws + WS_RQ), (const bf16*)(ws + WS_RK), (const bf16*)(ws + WS_RV), (const bf16*)(ws + WS_RGS), args.in[3], args.in[4],
                          (const bf16*)(ws + WS_S), args.in[5], (bf16*)(ws + WS_YRIN), tid);
    }
    SEAM(PH_RETOUT);

    if (IN(PH_BRANCH)) { PHASE_IDS
        pg8::BranchSched S; S.init(T, D_MODEL, G, bx); S.A0 = (const char*)(ws + WS_YRIN); S.A1 = (const char*)(ws + WS_ATT); S.B0 = (const char*)(ws + WS_WR); S.B1 = (const char*)(ws + WS_WA); S.tstep = (size_t)256 * 512 * 2;
        pg8::EpiBranch E; E.grs = (const bf16*)(ws + WS_GRS); E.gas = (const bf16*)(ws + WS_GAS); E.mixed = (bf16*)(ws + WS_MIXED);
        pg8::gemm_phase<pg8::EpiBranch, pg8::BranchSched, true, true>(lds + RING_OFF, 512, S, E, tid);
    }
    SEAM(PH_BRANCH);

    if (IN(PH_WO)) { PHASE_IDS
        pg8::PlainSched S; S.init(T, D_MODEL, G, bx); S.A = (const char*)(ws + WS_MIXED); S.Bt = (const char*)(ws + WS_WO); S.tstep = (size_t)256 * 1024 * 2;
        pg8::EpiResid E; E.x = args.in[0]; E.x1 = (float*)(ws + WS_X1);
        pg8::gemm_phase<pg8::EpiResid, pg8::PlainSched, true, true>(lds + RING_OFF, 1024, S, E, tid);
    }
    SEAM(PH_WO);

    if (IN(PH_ROUTER)) { PHASE_IDS
        LAS float* wl = (LAS float*)(lds + RING_OFF);
        { const GAS float* src = (const GAS float*)args.in[12]; for (int i = tid; i < 1024 * 16; i += NWAVES * 64) wl[(i & 15) * 1024 + (i >> 4)] = src[i]; }
        __syncthreads();
        const float* x1 = (const float*)(ws + WS_X1); const float* gain = args.in[11]; bf16* h2 = (bf16*)(ws + WS_H); float* aff = (float*)(ws + WS_AFF);
        const GAS f32x4* gr = (const GAS f32x4*)gain + lane;
        f32x4 v[4];
        if (gw < T) { const GAS f32x4* xr = (const GAS f32x4*)(x1 + (size_t)gw * D_MODEL) + lane;
#pragma unroll
            for (int j = 0; j < 4; ++j) v[j] = xr[64 * j]; }
        for (int m = gw; m < T; m += NGW) {
            f32x4 nv[4];
            { const int mn = (m + NGW < T) ? m + NGW : m; const GAS f32x4* xn = (const GAS f32x4*)(x1 + (size_t)mn * D_MODEL) + lane;
#pragma unroll
              for (int j = 0; j < 4; ++j) nv[j] = xn[64 * j]; }
            float s = 0.f;
#pragma unroll
            for (int j = 0; j < 4; ++j) s += (v[j].x * v[j].x + v[j].y * v[j].y) + (v[j].z * v[j].z + v[j].w * v[j].w);
            const float rstd = 1.f / sqrtf(wave_sum(s) * (1.f / D_MODEL) + EPS);
            float lg[NE];
#pragma unroll
            for (int e = 0; e < NE; ++e) lg[e] = 0.f;
            GAS unsigned long long* o8 = (GAS unsigned long long*)(h2 + (size_t)m * D_MODEL) + lane;
#pragma unroll
            for (int j = 0; j < 4; ++j) { const f32x4 g4 = gr[64 * j]; const f32x4 hv = v[j] * g4 * rstd;
                o8[64 * j] = (unsigned long long)pk2(hv.x, hv.y) | ((unsigned long long)pk2(hv.z, hv.w) << 32);
#pragma unroll
                for (int e = 0; e < NE; ++e) { const f32x4 w = *(const LAS f32x4*)(wl + e * 1024 + 4 * lane + 256 * j); lg[e] += (hv.x * w.x + hv.y * w.y) + (hv.z * w.z + hv.w * w.w); if ((e & 3) == 3) asm volatile("" ::: "memory"); }
                asm volatile("" ::: "memory"); }
            float r8[8], r4[4], r2[2], r1;
            { const bool b = (lane & 32) != 0;
#pragma unroll
              for (int e = 0; e < 8; ++e) { const float keep = b ? lg[e + 8] : lg[e], send = b ? lg[e] : lg[e + 8]; r8[e] = keep + __shfl_xor(send, 32); } }
            { const bool b = (lane & 16) != 0;
#pragma unroll
              for (int e = 0; e < 4; ++e) { const float keep = b ? r8[e + 4] : r8[e], send = b ? r8[e] : r8[e + 4]; r4[e] = keep + __shfl_xor(send, 16); } }
            { const bool b = (lane & 8) != 0;
#pragma unroll
              for (int e = 0; e < 2; ++e) { const float keep = b ? r4[e + 2] : r4[e], send = b ? r4[e] : r4[e + 2]; r2[e] = keep + __shfl_xor(send, 8); } }
            { const bool b = (lane & 4) != 0; const float keep = b ? r2[1] : r2[0], send = b ? r2[0] : r2[1]; r1 = keep + __shfl_xor(send, 4); }
            r1 += __shfl_xor(r1, 2); r1 += __shfl_xor(r1, 1);
            float mx = r1; mx = fmaxf(mx, __shfl_xor(mx, 4)); mx = fmaxf(mx, __shfl_xor(mx, 8)); mx = fmaxf(mx, __shfl_xor(mx, 16)); mx = fmaxf(mx, __shfl_xor(mx, 32));
            const float pe = expf(r1 - mx); float den = pe; den += __shfl_xor(den, 4); den += __shfl_xor(den, 8); den += __shfl_xor(den, 16); den += __shfl_xor(den, 32);
            if ((lane & 3) == 0) aff[(size_t)m * NE + (((lane >> 5) & 1) * 8 + ((lane >> 4) & 1) * 4 + ((lane >> 3) & 1) * 2 + ((lane >> 2) & 1))] = pe / den;
#pragma unroll
            for (int j = 0; j < 4; ++j) v[j] = nv[j];
        }
        __syncthreads();
    }
    SEAM(PH_ROUTER);

    if (IN(PH_TOPK)) { PHASE_IDS
        if (vcu >= NZ) {
            const int lane_c = lane;
            LAS float* scr = (LAS float*)(lds + RING_OFF + wave * 16384); const float* wd = args.in[15]; constexpr int I_D = 44 * 32;
            for (int it = (vcu - NZ) * NWAVES + wave; it < NE * I_D; it += (G - NZ) * NWAVES) { const int e = it / I_D, q = it % I_D;
                transpose_item(wd + (size_t)e * FF * D_MODEL, FF, D_MODEL, (bf16*)(ws + WS_WD) + (size_t)e * 1024 * FF, CmId(), scr, q / 32, q % 32, lane_c); }
        }
        LAS unsigned* keys = (LAS unsigned*)(lds + RING_OFF); LAS int* hist = (LAS int*)(lds + RING_OFF + 32768); LAS int* sc = (LAS int*)(lds + RING_OFF + 34816); volatile LAS unsigned* sv = (volatile LAS unsigned*)(lds + RING_OFF + 36864);
        const float* aff = (const float*)(ws + WS_AFF); int* idx = (int*)(ws + WS_IDX); float* gate = (float*)(ws + WS_GATE); int* sel = (int*)(ws + WS_SEL);
        for (int z = vcu; z < NZ; z += G) {
            const int b = z / NE, e = z % NE;
            for (int i = tid; i < SEQ; i += 512) keys[i] = __float_as_uint(aff[((size_t)b * SEQ + i) * NE + e]);
            if (tid == 0) { sv[0] = 0u; sv[1] = (unsigned)CAP; }
            __syncthreads();
            unsigned mask = 0u;
            for (int pass = 3; pass >= 0; --pass) {
                const int shift = pass * 8;
                if (tid < 256) hist[tid] = 0;
                __syncthreads();
                const unsigned prefix = sv[0];
                for (int i = tid; i < SEQ; i += 512) { const unsigned k = keys[i]; if ((k & mask) == prefix) atomicAdd((int*)&hist[(k >> shift) & 255u], 1); }
                __syncthreads();
                if (tid < 64) {
                    const int krem = (int)sv[1]; const int h0 = hist[4 * tid], h1 = hist[4 * tid + 1], h2 = hist[4 * tid + 2], h3 = hist[4 * tid + 3];
                    int suf = h0 + h1 + h2 + h3;
#pragma unroll
                    for (int o = 1; o < 64; o <<= 1) { const int t = __shfl_down(suf, o); if (tid + o < 64) suf += t; }
                    int cum = suf - (h0 + h1 + h2 + h3);
                    int dsel = -1, cumsel = 0;
                    if (cum < krem && cum + h3 >= krem) { dsel = 3; cumsel = cum; } cum += h3;
                    if (dsel < 0 && cum < krem && cum + h2 >= krem) { dsel = 2; cumsel = cum; } cum += h2;
                    if (dsel < 0 && cum < krem && cum + h1 >= krem) { dsel = 1; cumsel = cum; } cum += h1;
                    if (dsel < 0 && cum < krem && cum + h0 >= krem) { dsel = 0; cumsel = cum; }
                    if (dsel >= 0) { sv[1] = (unsigned)(krem - cumsel); sv[0] = prefix | ((unsigned)(4 * tid + dsel) << shift); }
                }
                __syncthreads();
                mask |= 0xFFu << shift;
            }
            const unsigned Tk = sv[0]; const int krem = (int)sv[1];
            int cgt = 0, ceq = 0;
            for (int q = 0; q < 16; ++q) { const unsigned k = keys[tid * 16 + q]; cgt += (k > Tk); ceq += (k == Tk); }
            int eqbase, slot;
            { sc[tid] = ceq; __syncthreads(); for (int off = 1; off < 512; off <<= 1) { const int t = (tid >= off) ? sc[tid - off] : 0; __syncthreads(); sc[tid] += t; __syncthreads(); } eqbase = sc[tid] - ceq; __syncthreads(); }
            int take = krem - eqbase; take = take < 0 ? 0 : (take > ceq ? ceq : take);
            { const int v = cgt + take; sc[tid] = v; __syncthreads(); for (int off = 1; off < 512; off <<= 1) { const int t = (tid >= off) ? sc[tid - off] : 0; __syncthreads(); sc[tid] += t; __syncthreads(); } slot = sc[tid] - v; __syncthreads(); }
            int eqr = eqbase;
            for (int q = 0; q < 16; ++q) { const int i = tid * 16 + q; const unsigned k = keys[i]; bool tk = k > Tk; if (k == Tk) { tk = eqr < krem; ++eqr; }
                if (tk) { idx[z * CAP + slot] = i; gate[z * CAP + slot] = __uint_as_float(k); sel[((size_t)b * SEQ + i) * NE + e] = slot; ++slot; } else sel[((size_t)b * SEQ + i) * NE + e] = -1; }
            __syncthreads();
        }
    }
    SEAM(PH_TOPK);


    if (IN(PH_MOE1)) { PHASE_IDS
        pg8::MoeGatherSched S; S.init(NZ * CAP, 5632, G, bx); S.A = (const char*)(ws + WS_H); S.Bt = (const char*)(ws + WS_W1C); S.idx = (const int*)(ws + WS_IDX);
        pg8::EpiSwiglu E; E.act = (bf16*)(ws + WS_ACT);
        pg8::gemm_phase<pg8::EpiSwiglu, pg8::MoeGatherSched, true, true>(lds + RING_OFF, 1024, S, E, tid);
    }
    SEAM(PH_MOE1);

    if (IN(PH_MOE2)) { PHASE_IDS
        pg8::MoeSched S; S.init(NZ * CAP, D_MODEL, G, bx); S.A = (const char*)(ws + WS_ACT); S.Bt = (const char*)(ws + WS_WD); S.kb = (size_t)FF * 2; S.nper = 1024;
        pg8::EpiDown E; E.y = (bf16*)(ws + WS_Y); E.gate = (const float*)(ws + WS_GATE);
        pg8::gemm_phase<pg8::EpiDown, pg8::MoeSched, true, true>(lds + RING_OFF, FF, S, E, tid);
    }
    SEAM(PH_MOE2);

    if (IN(PH_FINAL)) { PHASE_IDS
        const float* x1 = (const float*)(ws + WS_X1); const int* sel = (const int*)(ws + WS_SEL); const bf16* y = (const bf16*)(ws + WS_Y); const float* gain = args.in[16];
        for (int m = gw; m < T; m += NGW) {
            const int b = m / SEQ;
            const GAS f32x4* xr = (const GAS f32x4*)(x1 + (size_t)m * D_MODEL) + lane; const GAS f32x4* gr = (const GAS f32x4*)gain + lane;
            f32x4 v[4];
#pragma unroll
            for (int j = 0; j < 4; ++j) v[j] = xr[64 * j];
            const int mysel = (lane < NE) ? sel[(size_t)m * NE + lane] : -1;
            for (int e = 0; e < NE; ++e) { const int sl = __builtin_amdgcn_readlane(mysel, e);
                if (sl >= 0) { const GAS unsigned long long* yr = (const GAS unsigned long long*)(y + ((size_t)(b * NE + e) * CAP + sl) * D_MODEL) + lane;
#pragma unroll
                    for (int j = 0; j < 4; ++j) { const unsigned long long w = yr[64 * j]; const unsigned lo = (unsigned)w, hi = (unsigned)(w >> 32);
                        v[j].x += __uint_as_float(lo << 16); v[j].y += __uint_as_float(lo & 0xffff0000u); v[j].z += __uint_as_float(hi << 16); v[j].w += __uint_as_float(hi & 0xffff0000u); } } }
            float s = 0.f;
#pragma unroll
            for (int j = 0; j < 4; ++j) s += (v[j].x * v[j].x + v[j].y * v[j].y) + (v[j].z * v[j].z + v[j].w * v[j].w);
            const float rstd = 1.f / sqrtf(wave_sum(s) * (1.f / D_MODEL) + EPS);
            GAS f32x4* o = (GAS f32x4*)(args.out + (size_t)m * D_MODEL) + lane;
#pragma unroll
            for (int j = 0; j < 4; ++j) { const f32x4 g4 = gr[64 * j]; o[64 * j] = v[j] * g4 * rstd; }
        }
    }
#undef IN
#undef SEAM
}

#ifndef MK_DUP
#define MK_DUP (-1)
#endif
#ifndef MK_ONE_LAUNCH
#define MK_ONE_LAUNCH 1
#endif
extern "C" void kernel_launch(void* const* d_in, const int* in_sizes, int n_in, void* d_out, int out_size, void* d_ws, size_t ws_size, hipStream_t stream) {
    static int grid = 0;
    if (grid == 0) {
        if (n_in != 17 || in_sizes[0] != T * D_MODEL || out_size != T * D_MODEL || ws_size < WS_END) { fprintf(stderr, "kernel_launch: shape/workspace mismatch (ws %zu need %zu)\n", ws_size, (size_t)WS_END); grid = -1; return; }
        int dev = 0, cus = 0, per_cu = 0;
        if (hipGetDevice(&dev) != hipSuccess || hipDeviceGetAttribute(&cus, hipDeviceAttributeMultiprocessorCount, dev) != hipSuccess) { grid = -1; return; }
        if (hipFuncSetAttribute((const void*)mega, hipFuncAttributeMaxDynamicSharedMemorySize, LDS_BYTES) != hipSuccess) { fprintf(stderr, "kernel_launch: hipFuncSetAttribute failed\n"); grid = -1; return; }
        if (hipOccupancyMaxActiveBlocksPerMultiprocessor(&per_cu, (const void*)mega, NWAVES * 64, LDS_BYTES) != hipSuccess || per_cu < 1) { fprintf(stderr, "kernel_launch: occupancy query says %d blocks per CU\n", per_cu); (void)hipGetLastError(); grid = -1; return; }
        grid = cus;
    }
    if (grid < 0) return;
    unsigned char* ws = (unsigned char*)d_ws;
    (void)hipMemsetAsync(ws + WS_CTL, 0, CTL_ZERO_BYTES, stream);
    Args a{};
    for (int i = 0; i < 17; ++i) a.in[i] = (const float*)d_in[i];
    a.out = (float*)d_out; a.ws = ws;
#if MK_ONE_LAUNCH
    a.ph_lo = 0; a.ph_hi = PH_END; hipLaunchKernelGGL(mega, dim3(grid), dim3(NWAVES * 64), LDS_BYTES, stream, a);
#if MK_DUP >= 0
    a.ph_lo = MK_DUP; a.ph_hi = MK_DUP + 1; hipLaunchKernelGGL(mega, dim3(grid), dim3(NWAVES * 64), LDS_BYTES, stream, a);
#endif
#else
    for (int ph = 0; ph < PH_END; ++ph) { a.ph_lo = ph; a.ph_hi = ph + 1; hipLaunchKernelGGL(mega, dim3(grid), dim3(NWAVES * 64), LDS_BYTES, stream, a); }
#endif
}
```

```cpp
#include <hip/hip_runtime.h>
#include <hip/hip_bf16.h>
#include <cstdio>
#include <cstdint>
#include <cmath>

constexpr size_t EP_MiB = 1u << 20;
constexpr size_t EP_COS = 2 * EP_MiB, EP_SIN = 4 * EP_MiB, EP_RQ = 382 * EP_MiB, EP_RK = 398 * EP_MiB, EP_RV = 414 * EP_MiB, EP_RGS = 430 * EP_MiB, EP_AQ = 446 * EP_MiB, EP_AK = 462 * EP_MiB, EP_AV = 470 * EP_MiB, EP_GRS = 478 * EP_MiB, EP_GAS = 510 * EP_MiB;
constexpr int D_MODEL = 1024, BATCH = 2, SEQ = 8192, T = BATCH * SEQ;
constexpr int HD = 128, CHUNK = 128, NCHUNK = SEQ / CHUNK;
constexpr int NE = 16, FF = 2816, CAP = 1024, NZ = BATCH * NE;
constexpr int INW = 5120;
constexpr int O_RQ = 0, O_RK = 512, O_RV = 1024, O_RG = 1536, O_AQ = 2048, O_AK = 2560, O_AV = 2816, O_GR = 3072, O_GA = 4096;
constexpr float EPS = 1e-6f;
constexpr float RSQRT_HD = 0.08838834764831845f;

namespace pg8 {
#define PG8_LAS __attribute__((address_space(3)))
typedef unsigned short bf16_t;
typedef short bf16x8 __attribute__((ext_vector_type(8)));
typedef float f32x4 __attribute__((ext_vector_type(4)));
typedef unsigned u32x4 __attribute__((ext_vector_type(4)));
constexpr int BM = 256, BK = 64, HALF = 128, HTB = HALF * BK * 2  , STAGE_BYTES = 8 * HTB, NXCD = 8, WGM = 8;

__host__ __device__ __forceinline__ int lds_byte(int r, int c) { const int st = (r >> 4) * 2 + (c >> 5), rr = r & 15, cc = c & 31, ob = rr * 64 + cc * 2; return st * 1024 + (ob ^ (((ob >> 9) & 1) << 5)); }
__host__ __device__ __forceinline__ void stage_rc(int b, int& R, int& C) { const int st = b / 1024, sb = b % 1024, swz = sb ^ (((sb >> 9) & 1) << 5); R = (st >> 1) * 16 + swz / 64; C = (st & 1) * 32 + (swz % 64) / 2; }
__host__ __device__ __forceinline__ int perm32(int rho) { const int n = rho >> 4, i = rho & 15; return 8 * (i >> 2) + 4 * n + (i & 3); }

struct Unit { int pm, pn, aux; };
struct Gemm { const bf16_t* A; const bf16_t* Bt; int M, N, K; };

struct StaticOrder {
    int nM, nN, nwg, G, c;
    __host__ __device__ void init(int M, int N, int G_, int c_) { nM = M / BM; nN = N / BM; nwg = nM * nN; G = G_; c = c_; }
    __host__ __device__ bool next(int i, Unit& u) const {
        const long L = (long)i * G + c; if (L >= nwg) return false;
        int wgid = (int)L; { const int q = nwg / NXCD, r = nwg % NXCD, xcd = wgid % NXCD, off = wgid / NXCD; wgid = (xcd < r ? xcd * (q + 1) : r * (q + 1) + (xcd - r) * q) + off; }
        const int nig = WGM * nN, gid = wgid / nig, fm = gid * WGM, gsz = (nM - fm) < WGM ? (nM - fm) : WGM;
        u.pm = fm + ((wgid % nig) % gsz); u.pn = (wgid % nig) / gsz; u.aux = 0; return true;
    }
    __device__ __forceinline__ void a_ready(const Unit&) const {}
    __device__ __forceinline__ void done(const Unit&) const {}
    static constexpr bool GATHER = false;
    __device__ __forceinline__ unsigned gather_off(const Unit&, int, int) const { return 0u; }
    __device__ __forceinline__ bool keep_acc(const Unit&) const { return false; }
};


struct PlainSched : StaticOrder {
    const char* A; const char* Bt; size_t tstep;
    __device__ __forceinline__ void bases(const Unit& u, const char*& a, const char*& b) const { a = A + (size_t)u.pm * tstep; b = Bt + (size_t)u.pn * tstep; }
};

typedef float f32x2_t __attribute__((ext_vector_type(2))); typedef __bf16 bf16x2_t __attribute__((ext_vector_type(2)));
__device__ __forceinline__ unsigned cvt_pk_bf16(float lo, float hi) { f32x2_t v = {lo, hi}; bf16x2_t b = __builtin_convertvector(v, bf16x2_t); return __builtin_bit_cast(unsigned, b); }
__device__ __forceinline__ u32x4 pack8(const f32x4 a, const f32x4 b) { u32x4 w; w.x = cvt_pk_bf16(a[0], a[1]); w.y = cvt_pk_bf16(a[2], a[3]); w.z = cvt_pk_bf16(b[0], b[1]); w.w = cvt_pk_bf16(b[2], b[3]); return w; }
__device__ __forceinline__ float fast_sigmoid(float x) { return __builtin_amdgcn_rcpf(1.0f + __builtin_amdgcn_exp2f(-1.4426950408889634f * x)); }
__device__ __forceinline__ f32x4 sigmoid4(const f32x4 v) { return (f32x4){fast_sigmoid(v[0]), fast_sigmoid(v[1]), fast_sigmoid(v[2]), fast_sigmoid(v[3])}; }
__device__ __forceinline__ f32x4 silu4(const f32x4 v) { return v * sigmoid4(v); }

struct EpiProj {
    static constexpr bool PERM = true, AFTER_DRAIN = false;
    unsigned char* wsb;
    const float *qn, *kn;
    PG8_LAS float* xch;
    mutable unsigned epoch;
    template <int ACT>
    __device__ __forceinline__ void plain(const f32x4 (&acc)[2][2][4][2], bf16_t* base, int ld, int col0, int row0) const {
#pragma unroll
        for (int ai = 0; ai < 2; ++ai)
#pragma unroll
            for (int m = 0; m < 4; ++m) { bf16_t* rowp = base + (size_t)(row0 + ai * HALF + m * 16) * ld + col0;
#pragma unroll
                for (int bj = 0; bj < 2; ++bj) { f32x4 v0 = acc[ai][bj][m][0], v1 = acc[ai][bj][m][1];
                    if (ACT == 1) { v0 = silu4(v0); v1 = silu4(v1); } else if (ACT == 2) { v0 = sigmoid4(v0); v1 = sigmoid4(v1); }
                    *(u32x4*)(rowp + bj * HALF) = pack8(v0, v1); } }
    }
    template <bool NORM>
    __device__ __forceinline__ void rope(const f32x4 (&acc)[2][2][4][2], bf16_t* base, int ld, int col0, int row0, float scale, const float* nw, int wr, int wc, int fr, int fq) const {
        const int g = 4 * wc + fq;
        f32x4 nw1 = {1.f, 1.f, 1.f, 1.f}, nw2 = {1.f, 1.f, 1.f, 1.f};
        if (NORM) {
#pragma unroll
            for (int ai = 0; ai < 2; ++ai)
#pragma unroll
                for (int m = 0; m < 4; ++m)
#pragma unroll
                    for (int bj = 0; bj < 2; ++bj) { const f32x4 a = acc[ai][bj][m][0], b = acc[ai][bj][m][1];
                        float s = (a[0] * a[0] + a[1] * a[1]) + (a[2] * a[2] + a[3] * a[3]) + (b[0] * b[0] + b[1] * b[1]) + (b[2] * b[2] + b[3] * b[3]);
                        s += __shfl_xor(s, 16); s += __shfl_xor(s, 32);
                        if (fq == 0) xch[((ai * HALF + wr * 64 + m * 16 + fr) * 2 + bj) * 4 + wc] = s; }
            asm volatile("s_waitcnt lgkmcnt(0)" ::: "memory");
            PG8_LAS unsigned* cnt = (PG8_LAS unsigned*)(xch + 2048) + wr;
            if ((fr | fq) == 0) __hip_atomic_fetch_add(cnt, 1u, __ATOMIC_RELAXED, __HIP_MEMORY_SCOPE_WORKGROUP);
            epoch += 4u;
            while (__hip_atomic_load(cnt, __ATOMIC_RELAXED, __HIP_MEMORY_SCOPE_WORKGROUP) < epoch) __builtin_amdgcn_s_sleep(1);
            asm volatile("s_waitcnt lgkmcnt(0)" ::: "memory");
            nw1 = *(const f32x4*)(nw + 4 * g); nw2 = *(const f32x4*)(nw + 64 + 4 * g);
        }
#pragma unroll
        for (int ai = 0; ai < 2; ++ai)
#pragma unroll
            for (int m = 0; m < 4; ++m) { const int r = row0 + ai * HALF + m * 16; const int pos = r & 8191;
                const f32x4 c4 = *(const f32x4*)((const float*)(wsb + EP_COS) + (size_t)pos * 64 + 4 * g), s4 = *(const f32x4*)((const float*)(wsb + EP_SIN) + (size_t)pos * 64 + 4 * g);
                bf16_t* rowp = base + (size_t)r * ld + col0;
#pragma unroll
                for (int bj = 0; bj < 2; ++bj) { f32x4 x1 = acc[ai][bj][m][0], x2 = acc[ai][bj][m][1];
                    if (NORM) { const f32x4 p = *(const PG8_LAS f32x4*)(xch + ((ai * HALF + wr * 64 + m * 16 + fr) * 2 + bj) * 4);
                        const float rs = __builtin_amdgcn_rsqf(((p[0] + p[1]) + (p[2] + p[3])) * (1.0f / 128.0f) + 1e-6f);
                        x1 = x1 * (nw1 * rs); x2 = x2 * (nw2 * rs); }
                    const f32x4 y1 = (x1 * c4 - x2 * s4) * scale, y2 = (x1 * s4 + x2 * c4) * scale;
                    *(u32x4*)(rowp + bj * HALF) = pack8(y1, y2); }
                asm volatile("" ::: "memory"); }
    }
    __device__ __forceinline__ void operator()(const f32x4 (&acc)[2][2][4][2], const Unit& u, int wr, int wc, int fr, int fq) const {
        const int row0 = u.pm * BM + wr * 64 + fr, cw = wc * 32 + 8 * fq, pn = u.pn;
        if (pn < 2)       rope<false>(acc, (bf16_t*)(wsb + EP_RQ), 512, pn * 256 + cw, row0, 1.0f, nullptr, wr, wc, fr, fq);
        else if (pn < 4)  rope<false>(acc, (bf16_t*)(wsb + EP_RK), 512, (pn - 2) * 256 + cw, row0, 0.08838834764831845f, nullptr, wr, wc, fr, fq);
        else if (pn < 6)  plain<0>(acc, (bf16_t*)(wsb + EP_RV), 512, (pn - 4) * 256 + cw, row0);
        else if (pn < 8)  plain<1>(acc, (bf16_t*)(wsb + EP_RGS), 512, (pn - 6) * 256 + cw, row0);
        else if (pn < 10) rope<true>(acc, (bf16_t*)(wsb + EP_AQ), 512, (pn - 8) * 256 + cw, row0, 1.0f, qn, wr, wc, fr, fq);
        else if (pn < 11) rope<true>(acc, (bf16_t*)(wsb + EP_AK), 256, cw, row0, 1.0f, kn, wr, wc, fr, fq);
        else if (pn < 12) plain<0>(acc, (bf16_t*)(wsb + EP_AV), 256, cw, row0);
        else if (pn < 16) plain<2>(acc, (bf16_t*)(wsb + EP_GRS), 1024, (pn - 12) * 256 + cw, row0);
        else              plain<2>(acc, (bf16_t*)(wsb + EP_GAS), 1024, (pn - 16) * 256 + cw, row0);
    }
};

struct BranchSched : StaticOrder {
    const char *A0, *A1, *B0, *B1; size_t tstep;
    __device__ __forceinline__ bool next(int i, Unit& u) const { if (!StaticOrder::next(i >> 1, u)) return false; u.aux = i & 1; return true; }
    __device__ __forceinline__ void bases(const Unit& u, const char*& a, const char*& b) const { a = (u.aux ? A1 : A0) + (size_t)u.pm * tstep; b = (u.aux ? B1 : B0) + (size_t)u.pn * tstep; }
    __device__ __forceinline__ bool keep_acc(const Unit& nxt) const { return nxt.aux == 1; }
};
__device__ __forceinline__ void unpack8(const u32x4 w, f32x4& a, f32x4& b) {
    a = (f32x4){__uint_as_float(w.x << 16), __uint_as_float(w.x & 0xffff0000u), __uint_as_float(w.y << 16), __uint_as_float(w.y & 0xffff0000u)};
    b = (f32x4){__uint_as_float(w.z << 16), __uint_as_float(w.z & 0xffff0000u), __uint_as_float(w.w << 16), __uint_as_float(w.w & 0xffff0000u)};
}
struct EpiBranch {
    static constexpr bool PERM = true, AFTER_DRAIN = false;
    const bf16_t *grs, *gas; bf16_t* mixed;
    __device__ __forceinline__ void operator()(f32x4 (&acc)[2][2][4][2], const Unit& u, int wr, int wc, int fr, int fq) const {
        const int row0 = u.pm * BM + wr * 64 + fr, col0 = u.pn * BM + wc * 32 + 8 * fq;
#pragma unroll
        for (int ai = 0; ai < 2; ++ai)
#pragma unroll
            for (int m = 0; m < 4; ++m) { const size_t off = (size_t)(row0 + ai * HALF + m * 16) * 1024 + col0;
#pragma unroll
                for (int bj = 0; bj < 2; ++bj) { f32x4 ga0, ga1; unpack8(*(const u32x4*)(gas + off + bj * HALF), ga0, ga1);
                    if (u.aux == 0) { f32x4 gr0, gr1; unpack8(*(const u32x4*)(grs + off + bj * HALF), gr0, gr1);
#pragma unroll
                        for (int k = 0; k < 4; ++k) { acc[ai][bj][m][0][k] *= gr0[k] * __builtin_amdgcn_rcpf(fmaxf(ga0[k], 1e-30f)); acc[ai][bj][m][1][k] *= gr1[k] * __builtin_amdgcn_rcpf(fmaxf(ga1[k], 1e-30f)); } }
                    else *(u32x4*)(mixed + off + bj * HALF) = pack8(acc[ai][bj][m][0] * ga0, acc[ai][bj][m][1] * ga1); }
                asm volatile("" ::: "memory"); }
    }
};
struct EpiResid {
    static constexpr bool PERM = false, AFTER_DRAIN = false;
    const float* x; float* x1;
    __device__ __forceinline__ void operator()(const f32x4 (&acc)[2][2][4][2], const Unit& u, int wr, int wc, int fr, int fq) const {
        const int row0 = u.pm * BM + wr * 64 + fr, col0 = u.pn * BM + wc * 32 + 4 * fq;
#pragma unroll
        for (int ai = 0; ai < 2; ++ai)
#pragma unroll
            for (int m = 0; m < 4; ++m) { const size_t off = (size_t)(row0 + ai * HALF + m * 16) * 1024 + col0;
#pragma unroll
                for (int bj = 0; bj < 2; ++bj)
#pragma unroll
                    for (int n = 0; n < 2; ++n) { const f32x4 xv = *(const f32x4*)(x + off + bj * HALF + n * 16); *(f32x4*)(x1 + off + bj * HALF + n * 16) = xv + acc[ai][bj][m][n]; }
                if (m & 1) asm volatile("" ::: "memory"); }
    }
};
__device__ __forceinline__ int moe_rowbase(int pm) { return ((((pm >> 2) & 1) * 16 + (pm >> 3)) * 1024) + (pm & 3) * 256; }
struct MoeSched : StaticOrder {
    const char *A, *Bt; size_t kb; int nper;
    __device__ __forceinline__ void bases(const Unit& u, const char*& a, const char*& b) const { a = A + (size_t)moe_rowbase(u.pm) * kb; b = Bt + ((size_t)(u.pm >> 3) * nper + (size_t)u.pn * 256) * kb; }
};
struct MoeGatherSched : StaticOrder {
    static constexpr bool GATHER = true;
    const char *A, *Bt; const int* idx;
    __device__ __forceinline__ void bases(const Unit& u, const char*& a, const char*& b) const { a = A; b = Bt + ((size_t)(u.pm >> 3) * 5632 + (size_t)u.pn * 256) * 2048; }
    __device__ __forceinline__ unsigned gather_off(const Unit& u, int r, int c) const { const int tok = ((u.pm >> 2) & 1) * 8192 + idx[moe_rowbase(u.pm) + r]; return (unsigned)((tok * 1024 + c) * 2); }
};
struct EpiSwiglu {
    static constexpr bool PERM = true, AFTER_DRAIN = false;
    bf16_t* act;
    __device__ __forceinline__ void operator()(const f32x4 (&acc)[2][2][4][2], const Unit& u, int wr, int wc, int fr, int fq) const {
        const int row0 = moe_rowbase(u.pm) + wr * 64 + fr, col0 = u.pn * HALF + wc * 32 + 8 * fq;
#pragma unroll
        for (int ai = 0; ai < 2; ++ai)
#pragma unroll
            for (int m = 0; m < 4; ++m)
                *(u32x4*)(act + (size_t)(row0 + ai * HALF + m * 16) * 2816 + col0) = pack8(silu4(acc[ai][0][m][0]) * acc[ai][1][m][0], silu4(acc[ai][0][m][1]) * acc[ai][1][m][1]);
    }
};
struct EpiDown {
    static constexpr bool PERM = true, AFTER_DRAIN = false;
    bf16_t* y; const float* gate;
    __device__ __forceinline__ void operator()(const f32x4 (&acc)[2][2][4][2], const Unit& u, int wr, int wc, int fr, int fq) const {
        const int row0 = moe_rowbase(u.pm) + wr * 64 + fr, col0 = u.pn * BM + wc * 32 + 8 * fq;
#pragma unroll
        for (int ai = 0; ai < 2; ++ai)
#pragma unroll
            for (int m = 0; m < 4; ++m) { const int r = row0 + ai * HALF + m * 16; const float g = gate[r];
#pragma unroll
                for (int bj = 0; bj < 2; ++bj) *(u32x4*)(y + (size_t)r * 1024 + col0 + bj * HALF) = pack8(acc[ai][bj][m][0] * g, acc[ai][bj][m][1] * g); }
    }
};
template <class Epi, class Sched, bool ALIGN_EPI = false, bool SP2 = false>
__device__ __forceinline__ void gemm_phase(PG8_LAS unsigned char* lds, const int K_, const Sched& S, const Epi& E, const int tid) {
    const int wid = __builtin_amdgcn_readfirstlane(tid >> 6), lane = tid & 63, wr = wid >> 2, wc = wid & 3, fr = lane & 15, fq = lane >> 4;
    const int K = K_, nt = K / BK;
    unsigned voffA[2], voffB[2];
#pragma unroll
    for (int i = 0; i < 2; ++i) { int R, C; stage_rc(tid * 16 + i * 8192, R, C); const int Rb = Epi::PERM ? ((R & ~31) + perm32(R & 31)) : R;
        voffA[i] = (unsigned)(R * K + C) * 2u; voffB[i] = (unsigned)(Rb * K + C) * 2u; }
    unsigned va0[2] = {0u, 0u}, va1[2] = {0u, 0u}, vn0[2] = {0u, 0u}, vn1[2] = {0u, 0u};
    int gR[2], gC[2];
#pragma unroll
    for (int i = 0; i < 2; ++i) stage_rc(tid * 16 + i * 8192, gR[i], gC[i]);
    const size_t kstep = (size_t)(BK * 2);
    const size_t hstep = (size_t)HALF * K * 2;
        const unsigned ldsw = (unsigned)wid * 1024u;
    const int aoff = lds_byte(wr * 64 + fr, fq * 8), boff = lds_byte(wc * 32 + fr, fq * 8);
#define PG8_SA(b, h) (((b) * 2 + (h)) * HTB)
#define PG8_SB(b, h) ((4 + (b) * 2 + (h)) * HTB)
#define PG8_STAGE(bufoff, gbase, voff) do { _Pragma("unroll") for (int _i = 0; _i < 2; ++_i) \
        __builtin_amdgcn_global_load_lds((const unsigned*)((const char*)(gbase) + (voff)[_i]), (PG8_LAS unsigned*)(lds + (bufoff) + ldsw + _i * 8192), 16, 0, 0); } while (0)
#define PG8_STAGE_A(bufoff, gbase, h, usenext) do { if constexpr (Sched::GATHER) { unsigned vo_[2]; \
        vo_[0] = (usenext) ? ((h) ? vn1[0] : vn0[0]) : ((h) ? va1[0] : va0[0]); vo_[1] = (usenext) ? ((h) ? vn1[1] : vn0[1]) : ((h) ? va1[1] : va0[1]); PG8_STAGE(bufoff, gbase, vo_); } \
        else { PG8_STAGE(bufoff, (gbase) + ((h) ? hstep : (size_t)0), voffA); } } while (0)
#define PG8_LDA(dst, b, h) do { _Pragma("unroll") for (int m = 0; m < 4; ++m) _Pragma("unroll") for (int k = 0; k < 2; ++k) dst[m][k] = *(const PG8_LAS bf16x8*)(lds + PG8_SA(b, h) + aoff + m * 2048 + k * 1024); } while (0)
#define PG8_LDB(dst, b, h) do { _Pragma("unroll") for (int n = 0; n < 2; ++n) _Pragma("unroll") for (int k = 0; k < 2; ++k) dst[n][k] = *(const PG8_LAS bf16x8*)(lds + PG8_SB(b, h) + boff + n * 2048 + k * 1024); } while (0)
#define PG8_MMA(ai, bj, At, Bt) do { __builtin_amdgcn_s_setprio(1); _Pragma("unroll") for (int m = 0; m < 4; ++m) _Pragma("unroll") for (int n = 0; n < 2; ++n) _Pragma("unroll") for (int k = 0; k < 2; ++k) \
        acc[ai][bj][m][n] = __builtin_amdgcn_mfma_f32_16x16x32_bf16(Bt[n][k], At[m][k], acc[ai][bj][m][n], 0, 0, 0); __builtin_amdgcn_s_setprio(0); } while (0)
#define PG8_WAIT_V(n) asm volatile("s_waitcnt vmcnt(" #n ")" ::: "memory")
#define PG8_WAIT_L(n) asm volatile("s_waitcnt lgkmcnt(" #n ")" ::: "memory")
#define PG8_BAR __builtin_amdgcn_s_barrier()
#define PG8_SCHED __builtin_amdgcn_sched_barrier(0)
    Unit cur, nxt; int ui = 0;
    if (!S.next(0, cur)) return;
    f32x4 acc[2][2][4][2];
#pragma unroll
    for (int a = 0; a < 2; ++a)
#pragma unroll
        for (int b = 0; b < 2; ++b)
#pragma unroll
            for (int m = 0; m < 4; ++m)
#pragma unroll
                for (int n = 0; n < 2; ++n) acc[a][b][m][n] = (f32x4){0.f, 0.f, 0.f, 0.f};
    bf16x8 At[4][2], B0[2][2], B1[2][2];
    const char* cA; const char* cB; S.bases(cur, cA, cB);
    if constexpr (Sched::GATHER) {
#pragma unroll
        for (int i = 0; i < 2; ++i) { va0[i] = S.gather_off(cur, gR[i], gC[i]); va1[i] = S.gather_off(cur, gR[i] + HALF, gC[i]); } }
    S.a_ready(cur);
    if constexpr (SP2) {
        PG8_STAGE(PG8_SB(0, 0), cB, voffB); PG8_STAGE(PG8_SB(0, 1), cB + hstep, voffB); PG8_STAGE_A(PG8_SA(0, 0), cA, 0, false); PG8_STAGE_A(PG8_SA(0, 1), cA, 1, false);
        if (wr == 1) PG8_BAR;
        PG8_WAIT_V(2); PG8_BAR;
        PG8_STAGE(PG8_SB(1, 0), cB + kstep, voffB); PG8_STAGE_A(PG8_SA(1, 0), cA + kstep, 0, false); PG8_STAGE(PG8_SB(1, 1), cB + hstep + kstep, voffB);
        PG8_WAIT_V(6); PG8_BAR;
    } else {
        PG8_STAGE(PG8_SB(0, 0), cB, voffB); PG8_STAGE_A(PG8_SA(0, 0), cA, 0, false); PG8_STAGE(PG8_SB(0, 1), cB + hstep, voffB); PG8_STAGE_A(PG8_SA(0, 1), cA, 1, false);
        if (wr == 1) PG8_BAR;
        PG8_WAIT_V(4); PG8_BAR;
        PG8_STAGE(PG8_SB(1, 0), cB + kstep, voffB); PG8_STAGE_A(PG8_SA(1, 0), cA + kstep, 0, false); PG8_STAGE(PG8_SB(1, 1), cB + hstep + kstep, voffB);
        PG8_WAIT_V(6); PG8_BAR;
    }
    for (;;) {
        const bool has_next = S.next(ui + 1, nxt);
        const char* nA = cA; const char* nB = cB; if (has_next) S.bases(nxt, nA, nB);
        if constexpr (Sched::GATHER) { if (has_next) {
#pragma unroll
            for (int i = 0; i < 2; ++i) { vn0[i] = S.gather_off(nxt, gR[i], gC[i]); vn1[i] = S.gather_off(nxt, gR[i] + HALF, gC[i]); } }
            else {
#pragma unroll
            for (int i = 0; i < 2; ++i) { vn0[i] = va0[i]; vn1[i] = va1[i]; } } }
        for (int t = 0; t < nt; t += 2) {
            const bool last = (t == nt - 2);
            const char* a1 = cA + (size_t)(t + 1) * kstep;
            const char* a2 = last ? nA : cA + (size_t)(t + 2) * kstep; const char* b2 = last ? nB : cB + (size_t)(t + 2) * kstep;
            const char* a3 = a2 + kstep; const char* b3 = b2 + kstep;
            if (last && has_next) S.a_ready(nxt);
            if constexpr (SP2) {
            PG8_LDB(B0, 0, 0); PG8_LDB(B1, 0, 1); PG8_SCHED; PG8_LDA(At, 0, 0); PG8_STAGE_A(PG8_SA(1, 1), a1, 1, false);
            PG8_WAIT_V(8); PG8_WAIT_L(0); PG8_BAR; PG8_MMA(0, 0, At, B0); PG8_MMA(0, 1, At, B1); PG8_BAR; PG8_SCHED;
            PG8_LDA(At, 0, 1); PG8_STAGE(PG8_SB(0, 0), b2, voffB); PG8_STAGE(PG8_SB(0, 1), b2 + hstep, voffB); PG8_STAGE_A(PG8_SA(0, 0), a2, 0, last);
            PG8_WAIT_V(8); PG8_WAIT_L(0); PG8_BAR; PG8_MMA(1, 0, At, B0); PG8_MMA(1, 1, At, B1); PG8_BAR; PG8_SCHED;
            PG8_LDB(B0, 1, 0); PG8_LDB(B1, 1, 1); PG8_SCHED; PG8_LDA(At, 1, 0); PG8_STAGE_A(PG8_SA(0, 1), a2, 1, last);
            PG8_WAIT_V(8); PG8_WAIT_L(0); PG8_BAR; PG8_MMA(0, 0, At, B0); PG8_MMA(0, 1, At, B1); PG8_BAR; PG8_SCHED;
            PG8_LDA(At, 1, 1); PG8_STAGE(PG8_SB(1, 0), b3, voffB); PG8_STAGE(PG8_SB(1, 1), b3 + hstep, voffB); PG8_STAGE_A(PG8_SA(1, 0), a3, 0, last);
            PG8_WAIT_V(8); PG8_WAIT_L(0); PG8_BAR; PG8_MMA(1, 0, At, B0); PG8_MMA(1, 1, At, B1); PG8_BAR; PG8_SCHED;
            } else {
            PG8_LDB(B0, 0, 0); PG8_SCHED; PG8_LDA(At, 0, 0); PG8_STAGE_A(PG8_SA(1, 1), a1, 1, false);
            PG8_WAIT_L(8); PG8_BAR; PG8_WAIT_L(0); PG8_MMA(0, 0, At, B0); PG8_BAR; PG8_SCHED;
            PG8_LDB(B1, 0, 1); PG8_STAGE(PG8_SB(0, 0), b2, voffB);
            PG8_BAR; PG8_WAIT_L(0); PG8_MMA(0, 1, At, B1); PG8_BAR;
            PG8_LDA(At, 0, 1); PG8_STAGE_A(PG8_SA(0, 0), a2, 0, last);
            PG8_BAR; PG8_WAIT_L(0); PG8_MMA(1, 0, At, B0); PG8_BAR; PG8_SCHED;
            PG8_STAGE(PG8_SB(0, 1), b2 + hstep, voffB);
            PG8_WAIT_V(6); PG8_BAR; PG8_MMA(1, 1, At, B1); PG8_BAR;
            PG8_LDB(B0, 1, 0); PG8_SCHED; PG8_LDA(At, 1, 0); PG8_STAGE_A(PG8_SA(0, 1), a2, 1, last);
            PG8_WAIT_L(8); PG8_BAR; PG8_WAIT_L(0); PG8_MMA(0, 0, At, B0); PG8_BAR; PG8_SCHED;
            PG8_LDB(B1, 1, 1); PG8_STAGE(PG8_SB(1, 0), b3, voffB);
            PG8_BAR; PG8_WAIT_L(0); PG8_MMA(0, 1, At, B1); PG8_BAR;
            PG8_LDA(At, 1, 1); PG8_STAGE_A(PG8_SA(1, 0), a3, 0, last);
            PG8_BAR; PG8_WAIT_L(0); PG8_MMA(1, 0, At, B0); PG8_BAR; PG8_SCHED;
            PG8_STAGE(PG8_SB(1, 1), b3 + hstep, voffB);
            PG8_WAIT_V(6); PG8_BAR; PG8_MMA(1, 1, At, B1); PG8_BAR;
            }
        }
        if constexpr (ALIGN_EPI) { if (wr == 0) PG8_BAR; }
        if constexpr (!Epi::AFTER_DRAIN) { E(acc, cur, wr, wc, fr, fq); S.done(cur); }
        if (!has_next) break;
        if (!S.keep_acc(nxt)) {
#pragma unroll
        for (int a = 0; a < 2; ++a)
#pragma unroll
            for (int b = 0; b < 2; ++b)
#pragma unroll
                for (int m = 0; m < 4; ++m)
#pragma unroll
                    for (int n = 0; n < 2; ++n) acc[a][b][m][n] = (f32x4){0.f, 0.f, 0.f, 0.f};
        }
        cur = nxt; cA = nA; cB = nB; ++ui;
        if constexpr (Sched::GATHER) {
#pragma unroll
            for (int i = 0; i < 2; ++i) { va0[i] = vn0[i]; va1[i] = vn1[i]; } }
        if constexpr (ALIGN_EPI) { if (wr == 1) PG8_BAR; }
    }
    PG8_WAIT_V(0);
    if constexpr (!ALIGN_EPI) { if (wr == 0) PG8_BAR; }
    PG8_BAR;
    if constexpr (Epi::AFTER_DRAIN) { E.fused(acc, cur, wr, wc, fr, fq, lds, wid, lane); S.done(cur); }
#undef PG8_SA
#undef PG8_SB
#undef PG8_STAGE
#undef PG8_STAGE_A
#undef PG8_LDA
#undef PG8_LDB
#undef PG8_MMA
#undef PG8_WAIT_V
#undef PG8_WAIT_L
#undef PG8_BAR
#undef PG8_SCHED
}
}


namespace attn {
using bf16 = __hip_bfloat16;
constexpr int   D = 128, NW = 8, QBLK = 32, KVBLK = 64;
constexpr float SCALE = 0.088388347648318440f;
constexpr float THR = 8.f;
constexpr int SDEPTH = 2;
constexpr int LDQ = 512, LDK = 256, LDO = 512;
constexpr size_t SHM_V = KVBLK * D * 2, SHM_K = KVBLK * D * 2, SHM_ATTN = 2 * SHM_V + 2 * SHM_K + NW * 64 * 4;
using bf16x8 = __attribute__((ext_vector_type(8))) short;
using s16x4  = __attribute__((ext_vector_type(4))) short;
using f32x16 = __attribute__((ext_vector_type(16))) float;
using f32x8  = __attribute__((ext_vector_type(8))) float;
using u32x4  = __attribute__((ext_vector_type(4))) unsigned;
#define KSWZ(row, colB) ((row) * 256 + ((colB) ^ (((row) & 7) << 4)))
#define SBAR() __builtin_amdgcn_sched_barrier(0)
__device__ __forceinline__ int crow(int r, int hi) { return (r & 3) + 8 * (r >> 2) + 4 * hi; }
typedef float f32x2_t __attribute__((ext_vector_type(2))); typedef __bf16 bf16x2_t __attribute__((ext_vector_type(2)));
__device__ __forceinline__ unsigned cvtpk(float lo, float hi) { f32x2_t v = {lo, hi}; bf16x2_t b = __builtin_convertvector(v, bf16x2_t); return __builtin_bit_cast(unsigned, b); }
template <typename TIn> struct Stage;
template <> struct Stage<bf16>  { using T = bf16x8;
  __device__ static __forceinline__ T ld8(const bf16* p) { return *reinterpret_cast<const bf16x8*>(p); }
  __device__ static __forceinline__ bf16x8 tobf(T x) { return x; } };
template <> struct Stage<float> { using T = f32x8;
  __device__ static __forceinline__ T ld8(const float* p) { return *reinterpret_cast<const f32x8*>(p); }
  __device__ static __forceinline__ bf16x8 tobf(T x) {
    u32x4 w = {cvtpk(x[0], x[1]), cvtpk(x[2], x[3]), cvtpk(x[4], x[5]), cvtpk(x[6], x[7])}; return *reinterpret_cast<bf16x8*>(&w); } };

__device__ __forceinline__ void partialSM(f32x16& p0, f32x16& p1, float& m_reg, float& mn, float& alpha) {
  constexpr float C = SCALE * 1.4426950408889634f;
  float pmax = p0[0]; for (int r = 1; r < 16; ++r) pmax = fmaxf(pmax, p0[r]); for (int r = 0; r < 16; ++r) pmax = fmaxf(pmax, p1[r]);
  { auto rr = __builtin_amdgcn_permlane32_swap(__float_as_uint(pmax), __float_as_uint(pmax), false, false);
    pmax = fmaxf(__uint_as_float(rr[0]), __uint_as_float(rr[1])); }
  if (__builtin_expect(__all(pmax - m_reg <= THR / SCALE), 1)) { mn = m_reg; alpha = 1.f; }
  else { mn = fmaxf(m_reg, pmax); alpha = __builtin_amdgcn_exp2f((m_reg - mn) * C); m_reg = mn; }
  float mnC = -mn * C;
  for (int r = 0; r < 16; ++r) p0[r] = fmaf(p0[r], C, mnC); for (int r = 0; r < 16; ++r) p1[r] = fmaf(p1[r], C, mnC);
  for (int r = 0; r < 16; ++r) p0[r] = __builtin_amdgcn_exp2f(p0[r]);
}
__device__ __forceinline__ void finishSM(f32x16& p0, f32x16& p1, float alpha, float& l_reg, bf16x8& pa0, bf16x8& pa1, bf16x8& pa2, bf16x8& pa3) {
  for (int r = 0; r < 16; ++r) p1[r] = __builtin_amdgcn_exp2f(p1[r]);
  float ps = 0; for (int r = 0; r < 16; ++r) ps += p0[r]; for (int r = 0; r < 16; ++r) ps += p1[r];
  { auto rr = __builtin_amdgcn_permlane32_swap(__float_as_uint(ps), __float_as_uint(ps), false, false);
    ps = __uint_as_float(rr[0]) + __uint_as_float(rr[1]); }
  l_reg = l_reg * alpha + ps;
#define PK4(P, BASE, OUT) do { unsigned a0 = cvtpk(P[BASE + 0], P[BASE + 1]), a1 = cvtpk(P[BASE + 2], P[BASE + 3]);   \
    unsigned b0 = cvtpk(P[BASE + 4], P[BASE + 5]), b1 = cvtpk(P[BASE + 6], P[BASE + 7]);                              \
    auto r0 = __builtin_amdgcn_permlane32_swap(a0, b0, false, false); auto r1 = __builtin_amdgcn_permlane32_swap(a1, b1, false, false); \
    u32x4 w = {r0[0], r1[0], r0[1], r1[1]}; OUT = *reinterpret_cast<bf16x8*>(&w); } while (0)
  PK4(p0, 0, pa0); PK4(p0, 8, pa1); PK4(p1, 0, pa2); PK4(p1, 8, pa3);
#undef PK4
}
__device__ __forceinline__ void qkt(f32x16& p0, f32x16& p1, const bf16* Ks, const bf16x8* qr, int r32, int hi) {
  p0 = f32x16{}; p1 = f32x16{};
  for (int d0 = 0; d0 < 8; ++d0) { int cb = (d0 * 16 + hi * 8) * 2;
    bf16x8 b0 = *reinterpret_cast<const bf16x8*>((const char*)Ks + KSWZ(r32, cb));
    bf16x8 b1 = *reinterpret_cast<const bf16x8*>((const char*)Ks + KSWZ(32 + r32, cb));
    p0 = __builtin_amdgcn_mfma_f32_32x32x16_bf16(b0, qr[d0], p0, 0, 0, 0);
    p1 = __builtin_amdgcn_mfma_f32_32x32x16_bf16(b1, qr[d0], p1, 0, 0, 0); }
}
__device__ __forceinline__ int v_st(int k, int c) { const int kk = (k & ~0xC) | ((k & 4) << 1) | ((k & 8) >> 1); return ((kk >> 3) * 4 + (c >> 5)) * 512 + ((kk & 7) * 32 + (c & 31)) * 2; }
__device__ __forceinline__ int v_rd_base(int lane) { return ((lane & 3) << 3) | (((lane >> 2) & 3) << 6) | (((lane >> 4) & 1) << 5) | (((lane >> 5) & 1) << 8); }
constexpr int v_rd_off(int d0, int ks, int half) { return d0 * 512 + ks * 4096 + half * 2048; }
template <int OFF> __device__ __forceinline__ s16x4 tr_read(int vb) {
  s16x4 r; asm volatile("ds_read_b64_tr_b16 %0, %1 offset:%2" : "=&v"(r) : "v"(vb), "i"(OFF) : "memory"); return r;
}
template <int D0> __device__ __forceinline__ void pv_one(f32x16& od, int vb, bf16x8 pa0, bf16x8 pa1, bf16x8 pa2, bf16x8 pa3) {
  const s16x4 l0 = tr_read<v_rd_off(D0, 0, 0)>(vb), h0 = tr_read<v_rd_off(D0, 0, 1)>(vb), l1 = tr_read<v_rd_off(D0, 1, 0)>(vb), h1 = tr_read<v_rd_off(D0, 1, 1)>(vb);
  const s16x4 l2 = tr_read<v_rd_off(D0, 2, 0)>(vb), h2 = tr_read<v_rd_off(D0, 2, 1)>(vb), l3 = tr_read<v_rd_off(D0, 3, 0)>(vb), h3 = tr_read<v_rd_off(D0, 3, 1)>(vb);
  asm volatile("s_waitcnt lgkmcnt(0)" ::: "memory"); SBAR();
#define PK(L, H) (bf16x8){L[0], L[1], L[2], L[3], H[0], H[1], H[2], H[3]}
  od = __builtin_amdgcn_mfma_f32_32x32x16_bf16(pa0, PK(l0, h0), od, 0, 0, 0);
  od = __builtin_amdgcn_mfma_f32_32x32x16_bf16(pa1, PK(l1, h1), od, 0, 0, 0);
  od = __builtin_amdgcn_mfma_f32_32x32x16_bf16(pa2, PK(l2, h2), od, 0, 0, 0);
  od = __builtin_amdgcn_mfma_f32_32x32x16_bf16(pa3, PK(l3, h3), od, 0, 0, 0);
#undef PK
}
__device__ __forceinline__ void pv_d0(f32x16* o, int vb, bf16x8 pa0, bf16x8 pa1, bf16x8 pa2, bf16x8 pa3) {
  pv_one<0>(o[0], vb, pa0, pa1, pa2, pa3); pv_one<1>(o[1], vb, pa0, pa1, pa2, pa3); pv_one<2>(o[2], vb, pa0, pa1, pa2, pa3); pv_one<3>(o[3], vb, pa0, pa1, pa2, pa3);
}

template <typename TQ>
__device__ __forceinline__ void attn_dense_body(const TQ* __restrict__ Qb, const bf16* __restrict__ Kh, const bf16* __restrict__ Vh,
                                                bf16* __restrict__ Ob, int seq, char* lds, const int tid) {
  using St = Stage<bf16>; using SQ = Stage<TQ>;
  const int wid = tid >> 6, lane = tid & 63, r32 = lane & 31, hi = lane >> 5;
  bf16* V_lds = (bf16*)lds; bf16* K_lds = (bf16*)(lds + 2 * SHM_V);
  float* ws = (float*)(lds + 2 * SHM_V + 2 * SHM_K) + wid * 64; float* li_l = ws; float* al_l = ws + 32;
  float m_reg = -1e30f, l_reg = 0; f32x16 o[4] = {}; bf16x8 qr[8];
  const TQ* Qw = Qb + (long)(wid * QBLK + r32) * LDQ + hi * 8;
#pragma unroll
  for (int d0 = 0; d0 < 8; ++d0) qr[d0] = SQ::tobf(SQ::ld8(Qw + d0 * 16));
  const int sr = tid >> 4, sc = (tid & 15) * 8, vst0 = v_st(sr, sc), vst1 = v_st(32 + sr, sc);
  const int vb0 = (int)(uintptr_t)V_lds + v_rd_base(lane);
  struct { typename St::T vs0, vs1, ks0, ks1; } sr_[SDEPTH];
#define SLOAD(i, k0) do { sr_[i].vs0 = St::ld8(&Vh[(long)((k0) + sr) * LDK + sc]); sr_[i].vs1 = St::ld8(&Vh[(long)((k0) + 32 + sr) * LDK + sc]); \
    sr_[i].ks0 = St::ld8(&Kh[(long)((k0) + sr) * LDK + sc]); sr_[i].ks1 = St::ld8(&Kh[(long)((k0) + 32 + sr) * LDK + sc]); } while (0)
#define SWRITE(b, i) do { *(bf16x8*)((char*)V_lds + (b) * SHM_V + vst0) = St::tobf(sr_[i].vs0);          \
    *(bf16x8*)((char*)V_lds + (b) * SHM_V + vst1) = St::tobf(sr_[i].vs1); int kc = sc * 2;               \
    *(bf16x8*)((char*)K_lds + (b) * SHM_K + KSWZ(sr, kc)) = St::tobf(sr_[i].ks0);                       \
    *(bf16x8*)((char*)K_lds + (b) * SHM_K + KSWZ(32 + sr, kc)) = St::tobf(sr_[i].ks1); } while (0)
#define SWAIT() do { if constexpr (SDEPTH == 2) asm volatile("s_waitcnt vmcnt(4)" ::: "memory"); else asm volatile("s_waitcnt vmcnt(0)" ::: "memory"); } while (0)
#define RESC(a) do { if (__any((a) < 1.f)) { if (hi == 0) al_l[r32] = (a); asm volatile("s_waitcnt lgkmcnt(0)" ::: "memory"); \
    for (int d = 0; d < 4; ++d) for (int r = 0; r < 16; ++r) o[d][r] *= al_l[crow(r, hi)]; } } while (0)
  f32x16 pA0, pA1, pB0, pB1; float mnA, mnB, alA, alB; bf16x8 pa0, pa1, pa2, pa3; const int NT = seq / KVBLK;
  constexpr int SE = 0, SO = SDEPTH - 1;
  SLOAD(SE, 0); asm volatile("s_waitcnt vmcnt(0)" ::: "memory"); SWRITE(0, SE); __syncthreads();
  qkt(pA0, pA1, K_lds, qr, r32, hi); partialSM(pA0, pA1, m_reg, mnA, alA);
  SLOAD(SO, KVBLK); if constexpr (SDEPTH == 2) { if (2 < NT) SLOAD(SE, 2 * KVBLK); }
  SWAIT(); SWRITE(1, SO); __syncthreads();
  for (int j = 1; j + 1 < NT; j += 2) {
    SBAR(); qkt(pB0, pB1, (bf16*)((char*)K_lds + SHM_K), qr, r32, hi);
    finishSM(pA0, pA1, alA, l_reg, pa0, pa1, pa2, pa3); SBAR();
    SLOAD(SO, (j + SDEPTH) * KVBLK); SBAR();
    pv_d0(o, vb0, pa0, pa1, pa2, pa3); partialSM(pB0, pB1, m_reg, mnB, alB);
    __syncthreads(); SWAIT(); SWRITE(0, SE);
    RESC(alB); __syncthreads();
    SBAR(); qkt(pA0, pA1, K_lds, qr, r32, hi);
    finishSM(pB0, pB1, alB, l_reg, pa0, pa1, pa2, pa3); SBAR();
    if (SDEPTH == 1 || j + 3 < NT) SLOAD(SE, (j + 1 + SDEPTH) * KVBLK); SBAR();
    pv_d0(o, vb0 + (int)SHM_V, pa0, pa1, pa2, pa3); partialSM(pA0, pA1, m_reg, mnA, alA);
    __syncthreads(); SWAIT(); SWRITE(1, SO);
    RESC(alA); __syncthreads();
  }
  SBAR(); qkt(pB0, pB1, (bf16*)((char*)K_lds + SHM_K), qr, r32, hi);
  finishSM(pA0, pA1, alA, l_reg, pa0, pa1, pa2, pa3); SBAR();
  pv_d0(o, vb0, pa0, pa1, pa2, pa3); partialSM(pB0, pB1, m_reg, mnB, alB);
  __syncthreads(); RESC(alB);
  finishSM(pB0, pB1, alB, l_reg, pa0, pa1, pa2, pa3); SBAR();
  pv_d0(o, vb0 + (int)SHM_V, pa0, pa1, pa2, pa3);
  if (hi == 0) li_l[r32] = l_reg; asm volatile("s_waitcnt lgkmcnt(0)" ::: "memory");
  float rli[16];
#pragma unroll
  for (int r = 0; r < 16; ++r) rli[r] = __builtin_amdgcn_rcpf(li_l[crow(r, hi)]);
  bf16* Ow = Ob + (long)(wid * QBLK) * LDO;
#pragma unroll
  for (int r = 0; r < 16; ++r) { int orow = crow(r, hi);
    for (int d0 = 0; d0 < 4; ++d0) Ow[(long)orow * LDO + d0 * 32 + r32] = __float2bfloat16(o[d0][r] * rli[r]); }
#undef SLOAD
#undef SWRITE
#undef SWAIT
#undef RESC
}

#undef KSWZ
#undef SBAR
}
#define GAS __attribute__((address_space(1)))
#define LAS __attribute__((address_space(3)))
typedef unsigned short bf16;
typedef unsigned v4u __attribute__((ext_vector_type(4)));
typedef float f32x4 __attribute__((ext_vector_type(4)));
typedef short bf16x8 __attribute__((ext_vector_type(8)));
typedef GAS unsigned gu32;
typedef GAS unsigned long long gu64;
#define RLX_AGENT __ATOMIC_RELAXED, __HIP_MEMORY_SCOPE_AGENT
#define LDS_WAIT() asm volatile("s_waitcnt lgkmcnt(0)" ::: "memory")
#define VM_WAIT() asm volatile("s_waitcnt vmcnt(0)" ::: "memory")
__device__ __forceinline__ unsigned long long rt() { return __builtin_amdgcn_s_memrealtime(); }
__device__ __forceinline__ unsigned f2bf(float f) { unsigned u = __builtin_bit_cast(unsigned, f); return (u + 0x7fffu + ((u >> 16) & 1u)) >> 16; }
__device__ __forceinline__ unsigned pk2(float lo, float hi) { return f2bf(lo) | (f2bf(hi) << 16); }

#define XB_TMO      128
#define XB_XCNT(j)  (256  + 64 * (j))
#define XB_XSUB(j)  (1280 + 64 * (j))
#define XB_XGEN(j)  (2304 + 64 * (j))
#define XB_TOP      3328
#define XB_TOPGEN   3392
#define XCD_BAR_WORDS 3456
#define XB_SPIN_CAP (1u << 18)

__device__ __forceinline__ unsigned xb_ld(unsigned* p)              { return __hip_atomic_load(p, __ATOMIC_RELAXED, __HIP_MEMORY_SCOPE_AGENT); }
__device__ __forceinline__ unsigned xb_add(unsigned* p, unsigned v) { return __hip_atomic_fetch_add(p, v, __ATOMIC_RELAXED, __HIP_MEMORY_SCOPE_AGENT); }
__device__ __forceinline__ unsigned xb_xcc_id() { return (unsigned)__builtin_amdgcn_s_getreg((3 << 11) | 20) & 0xFu; }
#define XB_SPIN(cond, bar) do { unsigned _sp = 0; while (cond) { __builtin_amdgcn_s_sleep(1); \
    if ((++_sp & 255u) == 0u) { if (xb_ld(&(bar)[XB_TMO])) break; if (_sp > XB_SPIN_CAP) { atomicAdd(&(bar)[XB_TMO], 1u); break; } } } } while (0)

struct XcdBarrier {
    unsigned* bar; unsigned x;
    volatile LAS unsigned* st;
};

__device__ __forceinline__ XcdBarrier xcd_barrier_post(unsigned* bar, volatile LAS unsigned* st) {
    XcdBarrier b; b.bar = bar; b.x = xb_xcc_id(); b.st = st;
    if (threadIdx.x == 0) (void)xb_add(&bar[XB_XCNT(b.x)], 1u);
    return b;
}
__device__ __forceinline__ void xcd_barrier_complete(unsigned* bar, unsigned x, unsigned& nloc, unsigned& nx) {
    const unsigned G = gridDim.x * gridDim.y * gridDim.z;
    unsigned sum, cnt, mine, sp = 0u;
    for (;;) {
        sum = 0u; cnt = 0u; mine = 0u;
#pragma unroll
        for (unsigned j = 0; j < 16; ++j) { const unsigned c = xb_ld(&bar[XB_XCNT(j)]); sum += c; cnt += (c > 0u) ? 1u : 0u; mine = (j == x) ? c : mine; }
        if (sum == G) break;
        __builtin_amdgcn_s_sleep(1);
        if ((++sp & 255u) == 0u) { if (xb_ld(&bar[XB_TMO])) break; if (sp > XB_SPIN_CAP) { atomicAdd(&bar[XB_TMO], 1u); break; } }
    }
    nloc = mine > 0u ? mine : 1u; nx = cnt > 0u ? cnt : 1u;
}

__device__ __forceinline__ void xcd_barrier(const XcdBarrier& b, const int tid_) {
    asm volatile("s_waitcnt vmcnt(0)" ::: "memory");
    __syncthreads();
    if (tid_ == 0) {
        unsigned* bar = b.bar;
        __builtin_amdgcn_s_waitcnt(0);
        unsigned nloc = b.st[0], nx = b.st[1];
        if (nloc == 0u) { xcd_barrier_complete(bar, b.x, nloc, nx); b.st[0] = nloc; b.st[1] = nx; }
        const unsigned old = xb_add(&bar[XB_XSUB(b.x)], 1u);
        const unsigned gen = old / nloc;
        if (old + 1u == (gen + 1u) * nloc) {
            __builtin_amdgcn_fence(__ATOMIC_RELEASE, "agent");
            asm volatile("s_waitcnt vmcnt(0)" ::: "memory");
            const unsigned og = xb_add(&bar[XB_TOP], 1u);
            const unsigned tg = og / nx;
            if (og + 1u == (tg + 1u) * nx) xb_add(&bar[XB_TOPGEN], 1u);
            else XB_SPIN(xb_ld(&bar[XB_TOPGEN]) == tg, bar);
            __builtin_amdgcn_fence(__ATOMIC_ACQUIRE, "agent");
            xb_add(&bar[XB_XGEN(b.x)], 1u);
            asm volatile("s_waitcnt vmcnt(0)" ::: "memory");
        } else {
            XB_SPIN(xb_ld(&bar[XB_XGEN(b.x)]) == gen, bar);
            __builtin_amdgcn_fence(__ATOMIC_ACQUIRE, "agent");
            asm volatile("s_waitcnt vmcnt(0)" ::: "memory");
        }
    }
    __syncthreads();
}


constexpr size_t MiB = 1u << 20;
constexpr size_t WS_CTL = 0, CTL_ZERO_BYTES = 64 * 1024;
constexpr size_t WS_AFF = 1 * MiB;
constexpr size_t WS_COS = 2 * MiB, WS_SIN = 4 * MiB;
constexpr size_t WS_IDX = 6 * MiB, WS_GATE = 6 * MiB + 256 * 1024, WS_SEL = 7 * MiB;
constexpr size_t WS_WIN = 8 * MiB;
constexpr size_t WS_WR = 18 * MiB, WS_WA = 19 * MiB, WS_WO = 20 * MiB;
constexpr size_t WS_W1C = 22 * MiB;
constexpr size_t WS_WD = 198 * MiB;
constexpr size_t WS_X1 = 286 * MiB;
constexpr size_t WS_H = 350 * MiB;
constexpr size_t WS_RQ = 382 * MiB, WS_RK = 398 * MiB, WS_RV = 414 * MiB, WS_RGS = 430 * MiB;
constexpr size_t WS_AQ = 446 * MiB, WS_AK = 462 * MiB, WS_AV = 470 * MiB;
constexpr size_t WS_GRS = 478 * MiB, WS_GAS = 510 * MiB;
constexpr size_t WS_KV = 542 * MiB;
constexpr size_t WS_S = 606 * MiB;
constexpr size_t WS_YRIN = 638 * MiB, WS_ATT = 654 * MiB;
constexpr size_t WS_MIXED = 670 * MiB;
constexpr size_t WS_XE = 382 * MiB, WS_ACT = 446 * MiB, WS_Y = 622 * MiB;
constexpr size_t WS_END = 704 * MiB;
static_assert(EP_COS == WS_COS && EP_SIN == WS_SIN && EP_RQ == WS_RQ && EP_RK == WS_RK && EP_RV == WS_RV && EP_RGS == WS_RGS && EP_AQ == WS_AQ && EP_AK == WS_AK && EP_AV == WS_AV && EP_GRS == WS_GRS && EP_GAS == WS_GAS, "epilogue offsets vs d_ws map");
constexpr int CW_BAR = 4096;

constexpr int RING_OFF = 0, RING_BYTES = 131072;
constexpr int LDSCTL_OFF = RING_BYTES, MISC_OFF = LDSCTL_OFF + 320;
constexpr int XCH_OFF = RING_BYTES + 1024;
constexpr int LDS_BYTES = 147456;
constexpr int NWAVES = 8;

__device__ __forceinline__ float wave_sum(float v) {
#pragma unroll
    for (int o = 1; o < 64; o <<= 1) v += __shfl_xor(v, o);
    return v;
}
__device__ __forceinline__ float bf2f(bf16 v) { return __uint_as_float((unsigned)v << 16); }

template <class CM>
__device__ __forceinline__ void transpose_item(const float* W, int K, int N, bf16* WT, const CM cm, LAS float* scr, int kb, int nb, int lane) {
    const int k0 = 64 * kb, n0 = 32 * nb;
    const int srccol = cm(n0 + (lane & 31));
    float tv[32];
#pragma unroll
    for (int i = 0; i < 32; ++i) tv[i] = __builtin_nontemporal_load(W + (size_t)(k0 + 2 * i + (lane >> 5)) * N + srccol);
#pragma unroll
    for (int i = 0; i < 32; ++i) scr[(2 * i + (lane >> 5)) * 33 + (lane & 31)] = tv[i];
    LDS_WAIT(); asm volatile("" ::: "memory");
    const int c = lane & 7;
#pragma unroll
    for (int j = 0; j < 4; ++j) { const int n = (lane >> 3) + 8 * j; const LAS float* s = scr + (8 * c) * 33 + n;
        v4u o; o.x = pk2(s[0 * 33], s[1 * 33]); o.y = pk2(s[2 * 33], s[3 * 33]); o.z = pk2(s[4 * 33], s[5 * 33]); o.w = pk2(s[6 * 33], s[7 * 33]);
        __builtin_nontemporal_store(o, (GAS v4u*)(WT + (size_t)(n0 + n) * K + k0 + 8 * c)); }
    LDS_WAIT(); asm volatile("" ::: "memory");
}
struct CmId { __device__ __forceinline__ int operator()(int n) const { return n; } };
struct CmWin {
    __device__ __forceinline__ int operator()(int n) const {
        const bool rope = (n < 1024) || (n >= 2048 && n < 2816);
        const int L = n & 127, g = L >> 3, i = L & 7, o = (i < 4) ? (4 * g + i) : (64 + 4 * g + (i - 4));
        return rope ? ((n & ~127) + o) : n; }
};
struct CmW1 { __device__ __forceinline__ int operator()(int n) const { return 128 * (n >> 8) + (n & 127); } };

__device__ __forceinline__ void rms_row_to_bf16(const float* xrow, const float* gain, bf16* orow, int lane) {
    const GAS f32x4* xr = (const GAS f32x4*)xrow + lane; const GAS f32x4* gr = (const GAS f32x4*)gain + lane;
    f32x4 v[4]; float s = 0.f;
#pragma unroll
    for (int j = 0; j < 4; ++j) { v[j] = xr[64 * j]; s += (v[j].x * v[j].x + v[j].y * v[j].y) + (v[j].z * v[j].z + v[j].w * v[j].w); }
    const float rstd = 1.f / sqrtf(wave_sum(s) * (1.f / D_MODEL) + EPS);
    GAS unsigned long long* o8 = (GAS unsigned long long*)orow + lane;
#pragma unroll
    for (int j = 0; j < 4; ++j) { const f32x4 g4 = gr[64 * j]; o8[64 * j] = (unsigned long long)pk2(v[j].x * rstd * g4.x, v[j].y * rstd * g4.y) | ((unsigned long long)pk2(v[j].z * rstd * g4.z, v[j].w * rstd * g4.w) << 32); }
}


namespace ret {
typedef short bf16x8 __attribute__((ext_vector_type(8)));
typedef short v4i16 __attribute__((ext_vector_type(4)));
constexpr int PITCH = 272;
constexpr int TILE_B = 128 * PITCH;
constexpr int STRIP_B = 16 * PITCH;
__device__ __forceinline__ float lg2_of(const float* p, int h) { return log1pf(-expf(p[h])) * 1.4426950408889634f; }
__device__ __forceinline__ unsigned cvt2(float lo, float hi) { typedef float f2 __attribute__((ext_vector_type(2))); typedef __bf16 b2 __attribute__((ext_vector_type(2))); f2 v = {lo, hi}; b2 b = __builtin_convertvector(v, b2); return __builtin_bit_cast(unsigned, b); }
__device__ __forceinline__ bf16x8 frag_tr(LAS const unsigned char* tile, int k0, int n0, int lane) {
    const int g = lane >> 4, q = (lane >> 2) & 3, p = lane & 3;
    LAS const unsigned char* a = tile + (k0 + 8 * g + q) * PITCH + (n0 + 4 * p) * 2;
    const v4i16 lo = __builtin_amdgcn_ds_read_tr16_b64_v4i16((LAS v4i16*)a);
    const v4i16 hi = __builtin_amdgcn_ds_read_tr16_b64_v4i16((LAS v4i16*)(a + 4 * PITCH));
    return (bf16x8){lo[0], lo[1], lo[2], lo[3], hi[0], hi[1], hi[2], hi[3]};
}
__device__ __forceinline__ bf16x8 frag_row(LAS const unsigned char* tile, int r0, int k0, int lane) { return *(LAS const bf16x8*)(tile + (r0 + (lane & 15)) * PITCH + (k0 + 8 * (lane >> 4)) * 2); }
__device__ __forceinline__ void stage_tile(LAS unsigned char* tile, const bf16* src, long tok0, int h, int tid) {
#pragma unroll
    for (int i = 0; i < 4; ++i) { const int q = tid + 512 * i, row = q >> 4, ch = q & 15;
        const v4u v = *(const GAS v4u*)(src + (tok0 + row) * 512 + h * HD + ch * 8); *(LAS v4u*)(tile + row * PITCH + ch * 16) = v; }
}
__device__ __forceinline__ void kv_item(int item, LAS unsigned char* lds, const bf16* rk, const bf16* rv, const float* pf, const float* pb, float* kv, int tid) {
    asm volatile("" : "+v"(tid));
    const int c = item & 63, bh = item >> 6, b = bh >> 2, h = bh & 3, lane = tid & 63, w = tid >> 6, g = lane >> 4;
    const long tok0 = (long)b * SEQ + (long)c * CHUNK;
    LAS unsigned char* Kl = lds; LAS unsigned char* Vl = lds + TILE_B;
    stage_tile(Kl, rk, tok0, h, tid); stage_tile(Vl, rv, tok0, h, tid);
    __syncthreads();
    const float lf = lg2_of(pf, h), lb = lg2_of(pb, h);
    f32x4 accf[8], accb[8];
#pragma unroll
    for (int n = 0; n < 8; ++n) { accf[n] = (f32x4){0.f, 0.f, 0.f, 0.f}; accb[n] = (f32x4){0.f, 0.f, 0.f, 0.f}; }
#pragma unroll
    for (int kk = 0; kk < 4; ++kk) {
        const bf16x8 a = frag_tr(Vl, 32 * kk, 16 * w, lane);
        bf16x8 af, ab;
        { unsigned pf_[4], pb_[4];
#pragma unroll
          for (int t = 0; t < 8; t += 2) { const int j = 32 * kk + 8 * g + t;
              const float v0 = __uint_as_float((unsigned)(unsigned short)a[t] << 16), v1 = __uint_as_float((unsigned)(unsigned short)a[t + 1] << 16);
              pf_[t >> 1] = cvt2(v0 * __builtin_amdgcn_exp2f(lf * (float)(127 - j)), v1 * __builtin_amdgcn_exp2f(lf * (float)(126 - j)));
              pb_[t >> 1] = cvt2(v0 * __builtin_amdgcn_exp2f(lb * (float)j), v1 * __builtin_amdgcn_exp2f(lb * (float)(j + 1))); }
          const v4u wf_ = {pf_[0], pf_[1], pf_[2], pf_[3]}, wb_ = {pb_[0], pb_[1], pb_[2], pb_[3]};
          af = __builtin_bit_cast(bf16x8, wf_); ab = __builtin_bit_cast(bf16x8, wb_); }
#pragma unroll
        for (int n = 0; n < 8; ++n) { const bf16x8 bk = frag_tr(Kl, 32 * kk, 16 * n, lane);
            accf[n] = __builtin_amdgcn_mfma_f32_16x16x32_bf16(af, bk, accf[n], 0, 0, 0); accb[n] = __builtin_amdgcn_mfma_f32_16x16x32_bf16(ab, bk, accb[n], 0, 0, 0); }
    }
    float* of = kv + (((long)0 * 8 + bh) * NCHUNK + c) * (HD * HD); float* ob = kv + (((long)1 * 8 + bh) * NCHUNK + c) * (HD * HD);
#pragma unroll
    for (int n = 0; n < 8; ++n)
#pragma unroll
        for (int r = 0; r < 4; ++r) { const int o = (16 * w + 4 * g + r) * HD + 16 * n + (lane & 15); of[o] = accf[n][r]; ob[o] = accb[n][r]; }
    __syncthreads();
}
__device__ __forceinline__ void scan_thread(long gid, const float* pf, const float* pb, const float* kv, bf16* S) {
    const int el = (int)(gid & 16383), bh = (int)((gid >> 14) & 7), dir = (int)(gid >> 17), h = bh & 3;
    const float gC = __builtin_amdgcn_exp2f(lg2_of(dir ? pb : pf, h) * (float)CHUNK);
    const float* p = kv + (((long)dir * 8 + bh) * NCHUNK) * (HD * HD) + el; bf16* o = S + (((long)dir * 8 + bh) * NCHUNK) * (HD * HD) + el;
    float st = 0.f;
    if (dir == 0) {
#pragma unroll 8
        for (int c = 0; c < NCHUNK; ++c) { const float v = p[(long)c * HD * HD]; o[(long)c * HD * HD] = (bf16)f2bf(st); st = st * gC + v; } }
    else {
#pragma unroll 8
        for (int c = NCHUNK - 1; c >= 0; --c) { const float v = p[(long)c * HD * HD]; o[(long)c * HD * HD] = (bf16)f2bf(st); st = st * gC + v; } }
}
__device__ __forceinline__ void out_item(int item, LAS unsigned char* lds, const bf16* rq, const bf16* rk, const bf16* rv, const bf16* rgs, const float* pf, const float* pb,
                                         const bf16* S, const float* gain, bf16* yrin, int tid) {
    asm volatile("" : "+v"(tid));
    const int c = item & 63, bh = item >> 6, b = bh >> 2, h = bh & 3, lane = tid & 63, w = tid >> 6, g = lane >> 4, lc = lane & 15;
    const long tok0 = (long)b * SEQ + (long)c * CHUNK;
    LAS unsigned char* Kl = lds; LAS unsigned char* Vl = lds + TILE_B; LAS unsigned char* strip = lds + 2 * TILE_B + w * STRIP_B;
    stage_tile(Kl, rk, tok0, h, tid); stage_tile(Vl, rv, tok0, h, tid);
    bf16x8 qa[4];
#pragma unroll
    for (int kk = 0; kk < 4; ++kk) qa[kk] = *(const GAS bf16x8*)(rq + (tok0 + 16 * w + lc) * 512 + h * HD + 32 * kk + 8 * g);
    __syncthreads();
    const float lf = lg2_of(pf, h), lb = lg2_of(pb, h);
    {
        f32x4 sc[8];
#pragma unroll
        for (int n = 0; n < 8; ++n) { sc[n] = (f32x4){0.f, 0.f, 0.f, 0.f};
#pragma unroll
            for (int kk = 0; kk < 4; ++kk) sc[n] = __builtin_amdgcn_mfma_f32_16x16x32_bf16(qa[kk], frag_row(Kl, 16 * n, 32 * kk, lane), sc[n], 0, 0, 0); }
#pragma unroll
        for (int n = 0; n < 8; ++n)
#pragma unroll
            for (int r = 0; r < 4; ++r) { const int i = 16 * w + 4 * g + r, j = 16 * n + lc; const int df = i - j;
                const float dec = __builtin_amdgcn_exp2f(df >= 0 ? lf * (float)df : lb * (float)(-df));
                *(LAS unsigned short*)(strip + (4 * g + r) * PITCH + j * 2) = (unsigned short)f2bf(sc[n][r] * dec); }
    }
    asm volatile("s_waitcnt lgkmcnt(0)" ::: "memory");
    bf16x8 qf[4], qb[4];
    { const int ia = 16 * w + lc; const float cf = __builtin_amdgcn_exp2f(lf * (float)(ia + 1)), cb = __builtin_amdgcn_exp2f(lb * (float)(CHUNK - ia));
#pragma unroll
      for (int kk = 0; kk < 4; ++kk) { unsigned pf_[4], pb_[4];
#pragma unroll
          for (int t = 0; t < 8; t += 2) { const float v0 = __uint_as_float((unsigned)(unsigned short)qa[kk][t] << 16), v1 = __uint_as_float((unsigned)(unsigned short)qa[kk][t + 1] << 16);
              pf_[t >> 1] = cvt2(v0 * cf, v1 * cf); pb_[t >> 1] = cvt2(v0 * cb, v1 * cb); }
          const v4u wf_ = {pf_[0], pf_[1], pf_[2], pf_[3]}, wb_ = {pb_[0], pb_[1], pb_[2], pb_[3]};
          qf[kk] = __builtin_bit_cast(bf16x8, wf_); qb[kk] = __builtin_bit_cast(bf16x8, wb_); } }
    f32x4 o[8];
#pragma unroll
    for (int n = 0; n < 8; ++n) o[n] = (f32x4){0.f, 0.f, 0.f, 0.f};
    const bf16* Sf = S + (((long)0 * 8 + bh) * NCHUNK + c) * (HD * HD); const bf16* Sb = S + (((long)1 * 8 + bh) * NCHUNK + c) * (HD * HD);
#pragma unroll
    for (int kh = 0; kh < 2; ++kh) {
        bf16x8 bfv[2][8], bbv[2][8];
#pragma unroll
        for (int k2 = 0; k2 < 2; ++k2)
#pragma unroll
            for (int n = 0; n < 8; ++n) { const int kk = 2 * kh + k2; bfv[k2][n] = *(const GAS bf16x8*)(Sf + (16 * n + lc) * HD + 32 * kk + 8 * g); bbv[k2][n] = *(const GAS bf16x8*)(Sb + (16 * n + lc) * HD + 32 * kk + 8 * g); }
#pragma unroll
        for (int k2 = 0; k2 < 2; ++k2) { const int kk = 2 * kh + k2;
            const bf16x8 sa = frag_row(strip, 0, 32 * kk, lane);
#pragma unroll
            for (int n = 0; n < 8; ++n) {
                o[n] = __builtin_amdgcn_mfma_f32_16x16x32_bf16(sa, frag_tr(Vl, 32 * kk, 16 * n, lane), o[n], 0, 0, 0);
                o[n] = __builtin_amdgcn_mfma_f32_16x16x32_bf16(qf[kk], bfv[k2][n], o[n], 0, 0, 0); o[n] = __builtin_amdgcn_mfma_f32_16x16x32_bf16(qb[kk], bbv[k2][n], o[n], 0, 0, 0); } }
        asm volatile("" ::: "memory");
    }
    asm volatile("s_waitcnt lgkmcnt(0)" ::: "memory");
#pragma unroll
    for (int r = 0; r < 4; ++r) {
        float y[8]; float s = 0.f;
#pragma unroll
        for (int n = 0; n < 8; ++n) { y[n] = o[n][r]; s += y[n]; }
        s += __shfl_xor(s, 1); s += __shfl_xor(s, 2); s += __shfl_xor(s, 4); s += __shfl_xor(s, 8);
        const float mu = s * (1.0f / HD); float s2 = 0.f;
#pragma unroll
        for (int n = 0; n < 8; ++n) { y[n] -= mu; s2 += y[n] * y[n]; }
        s2 += __shfl_xor(s2, 1); s2 += __shfl_xor(s2, 2); s2 += __shfl_xor(s2, 4); s2 += __shfl_xor(s2, 8);
        const float rstd = 1.0f / sqrtf(s2 * (1.0f / HD) + EPS);
#pragma unroll
        for (int n = 0; n < 8; ++n) *(LAS unsigned short*)(strip + (4 * g + r) * PITCH + (16 * n + lc) * 2) = (unsigned short)f2bf(y[n] * rstd); }
    asm volatile("s_waitcnt lgkmcnt(0)" ::: "memory");
    { const int row = lane >> 2, qc = lane & 3; const long ro = (tok0 + 16 * w + row) * 512 + h * HD;
#pragma unroll
      for (int t = 0; t < 4; ++t) { const int e0 = 32 * qc + 8 * t;
          const v4u yv = *(LAS const v4u*)(strip + row * PITCH + e0 * 2);
          const f32x4 y0 = {__uint_as_float(yv.x << 16), __uint_as_float(yv.x & 0xffff0000u), __uint_as_float(yv.y << 16), __uint_as_float(yv.y & 0xffff0000u)};
          const f32x4 y1 = {__uint_as_float(yv.z << 16), __uint_as_float(yv.z & 0xffff0000u), __uint_as_float(yv.w << 16), __uint_as_float(yv.w & 0xffff0000u)};
          const f32x4 g0 = *(const GAS f32x4*)(gain + h * HD + e0), g1 = *(const GAS f32x4*)(gain + h * HD + e0 + 4);
          const v4u rg = *(const GAS v4u*)(rgs + ro + e0);
          const f32x4 r0 = {__uint_as_float(rg.x << 16), __uint_as_float(rg.x & 0xffff0000u), __uint_as_float(rg.y << 16), __uint_as_float(rg.y & 0xffff0000u)};
          const f32x4 r1 = {__uint_as_float(rg.z << 16), __uint_as_float(rg.z & 0xffff0000u), __uint_as_float(rg.w << 16), __uint_as_float(rg.w & 0xffff0000u)};
          const f32x4 a0 = y0 * g0 * r0, a1 = y1 * g1 * r1;
          v4u ov; ov.x = cvt2(a0[0], a0[1]); ov.y = cvt2(a0[2], a0[3]); ov.z = cvt2(a1[0], a1[1]); ov.w = cvt2(a1[2], a1[3]);
          *(GAS v4u*)(yrin + ro + e0) = ov; } }
    __syncthreads();
}
}

struct Args { const float* in[17]; float* out; unsigned char* ws; int ph_lo, ph_hi; };
constexpr int PH_PROLOGUE = 0, PH_PROJ = 1, PH_RETKV = 2, PH_ATTN = 3, PH_RETOUT = 4, PH_BRANCH = 5, PH_WO = 6, PH_ROUTER = 7, PH_TOPK = 8, PH_GATHER = 9, PH_MOE1 = 10, PH_MOE2 = 11, PH_FINAL = 12, PH_END = 13;
#ifndef MK_EXPERT_CVT
#define MK_EXPERT_CVT 1
#endif

__global__ void __launch_bounds__(NWAVES * 64, 2) mega(Args args) {
    extern __shared__ __attribute__((aligned(16))) unsigned char lds_raw[];
    LAS unsigned char* lds = (LAS unsigned char*)lds_raw;
    volatile LAS unsigned* MISC = (volatile LAS unsigned*)(lds + MISC_OFF);
    const int wave = __builtin_amdgcn_readfirstlane((int)threadIdx.x >> 6);
#define PHASE_IDS int lane; asm volatile("v_mbcnt_lo_u32_b32 %0, -1, 0\n\tv_mbcnt_hi_u32_b32 %0, -1, %0" : "=v"(lane)); const int tid = wave * 64 + lane; (void)tid;
    const int G = gridDim.x; const int bx = blockIdx.x; const int vcu = (G % 8 == 0) ? (bx % 8) * (G / 8) + bx / 8 : bx;
    unsigned char* ws = args.ws;
    gu32* ctl = (gu32*)(ws + WS_CTL);
    for (int u = threadIdx.x; u < (LDS_BYTES - LDSCTL_OFF) / 4; u += NWAVES * 64) ((LAS unsigned*)(lds + LDSCTL_OFF))[u] = 0u;
    __syncthreads();
    const bool one_launch = (args.ph_hi - args.ph_lo) > 1;
    XcdBarrier bar; bar.bar = (unsigned*)(ctl + CW_BAR); bar.x = 0; bar.st = nullptr;
    if (one_launch) bar = xcd_barrier_post((unsigned*)(ctl + CW_BAR), MISC + 8);
    const int lo = args.ph_lo, hi = args.ph_hi;
#define IN(k) (lo <= (k) && (k) < hi)
#define SEAM(k) do { if (IN(k) && IN((k) + 1)) { PHASE_IDS xcd_barrier(bar, tid); } } while (0)
    const int gw = vcu * NWAVES + wave, NGW = G * NWAVES;

    if (IN(PH_PROLOGUE)) { PHASE_IDS
        LAS float* scr = (LAS float*)(lds + RING_OFF + wave * 16384);
        const float* w_in = args.in[2]; const float* w_ret = args.in[6]; const float* w_att = args.in[9]; const float* w_o = args.in[10];
        const float* wg = args.in[13]; const float* wu = args.in[14];
        constexpr int I_IN = 16 * 160, I_R = 8 * 32, I_A = 8 * 32, I_O = 16 * 32, I_1 = 16 * 176;
        constexpr int NSMALL = I_IN + I_R + I_A + I_O;
        const int NITEMS = NSMALL + NE * I_1;
        for (int it = gw; it < NITEMS; it += NGW) {
            int r = it;
            if (r < I_IN) { transpose_item(w_in, 1024, INW, (bf16*)(ws + WS_WIN), CmWin(), scr, r / 160, r % 160, lane); continue; } r -= I_IN;
            if (r < I_R) { transpose_item(w_ret, 512, D_MODEL, (bf16*)(ws + WS_WR), CmId(), scr, r / 32, r % 32, lane); continue; } r -= I_R;
            if (r < I_A) { transpose_item(w_att, 512, D_MODEL, (bf16*)(ws + WS_WA), CmId(), scr, r / 32, r % 32, lane); continue; } r -= I_A;
            if (r < I_O) { transpose_item(w_o, 1024, D_MODEL, (bf16*)(ws + WS_WO), CmId(), scr, r / 32, r % 32, lane); continue; } r -= I_O;
            { const int e = r / I_1, q = r % I_1, kb = q / 176, nb = q % 176; const bool up = (nb >> 2) & 1;
                transpose_item((up ? wu : wg) + (size_t)e * D_MODEL * FF, 1024, FF, (bf16*)(ws + WS_W1C) + (size_t)e * 5632 * 1024, CmW1(), scr, kb, nb, lane); }
        }
        for (int m = gw; m < T; m += NGW) rms_row_to_bf16(args.in[0] + (size_t)m * D_MODEL, args.in[1], (bf16*)(ws + WS_H) + (size_t)m * D_MODEL, lane);
        { float* ct = (float*)(ws + WS_COS); float* st = (float*)(ws + WS_SIN);
          for (int e = (vcu * NWAVES * 64) + tid; e < SEQ * 64; e += G * NWAVES * 64) { const int pos = e >> 6, j = e & 63;
              const float freq = powf(10000.0f, -(float)(j & 31) / 32.0f); const float ang = (float)(j < 32 ? (pos >> 6) : (pos & 63)) * freq;
              ct[e] = cosf(ang); st[e] = sinf(ang); } }
    }
    SEAM(PH_PROLOGUE);

    if (IN(PH_PROJ)) { PHASE_IDS
        pg8::PlainSched S; S.init(T, INW, G, bx); S.A = (const char*)(ws + WS_H); S.Bt = (const char*)(ws + WS_WIN); S.tstep = (size_t)256 * 1024 * 2;
        pg8::EpiProj E; E.wsb = ws; E.qn = args.in[7]; E.kn = args.in[8]; E.xch = (LAS float*)(lds + XCH_OFF); E.epoch = 0u;
        pg8::gemm_phase<pg8::EpiProj, pg8::PlainSched, true, true>(lds + RING_OFF, 1024, S, E, tid);
    }
    SEAM(PH_PROJ);

    if (IN(PH_RETKV)) { PHASE_IDS
        for (int item = vcu; item < 8 * NCHUNK; item += G)
            ret::kv_item(item, lds + RING_OFF, (const bf16*)(ws + WS_RK), (const bf16*)(ws + WS_RV), args.in[3], args.in[4], (float*)(ws + WS_KV), tid);
    }
    SEAM(PH_RETKV);

    if (IN(PH_ATTN)) { PHASE_IDS
        for (long gid = (long)vcu * 512 + tid; gid < 2 * 8 * 16384; gid += (long)G * 512) ret::scan_thread(gid, args.in[3], args.in[4], (const float*)(ws + WS_KV), (bf16*)(ws + WS_S));
    }

    if (IN(PH_ATTN)) { PHASE_IDS
        for (int u = vcu; u < BATCH * 4 * (SEQ / 256); u += G) {
            const int bh = u >> 5, qb = u & 31, b = bh >> 2, h = bh & 3, kvh = h >> 1;
            const size_t q0 = ((size_t)b * SEQ + (size_t)qb * 256) * 512 + (size_t)h * 128, k0 = (size_t)b * SEQ * 256 + (size_t)kvh * 128;
            attn::attn_dense_body<attn::bf16>((const attn::bf16*)(ws + WS_AQ) + q0, (const attn::bf16*)(ws + WS_AK) + k0, (const attn::bf16*)(ws + WS_AV) + k0,
                                              (attn::bf16*)(ws + WS_ATT) + q0, SEQ, (char*)lds_raw, tid);
            __syncthreads();
        }
    }
    SEAM(PH_ATTN);

    if (IN(PH_RETOUT)) { PHASE_IDS
        for (int item = vcu; item < 8 * NCHUNK; item += G)
            ret::out_item(item, lds + RING_OFF, (const bf16*)(ws + WS_RQ), (const bf16*)(ws + WS_RK), (const bf16*)(ws + WS_RV), (const bf16*)(ws + WS_RGS), args.in[3], args.in[4],
                          (const bf16*)(ws + WS_S), args.in[5], (bf16*)(ws + WS_YRIN), tid);
    }
    SEAM(PH_RETOUT);

    if (IN(PH_BRANCH)) { PHASE_IDS
        pg8::BranchSched S; S.init(T, D_MODEL, G, bx); S.A0 = (const char*)(ws + WS_YRIN); S.A1 = (const char*)(ws + WS_ATT); S.B0 = (const char*)(ws + WS_WR); S.B1 = (const char*)(ws + WS_WA); S.tstep = (size_t)256 * 512 * 2;
        pg8::EpiBranch E; E.grs = (const bf16*)(ws + WS_GRS); E.gas = (const bf16*)(ws + WS_GAS); E.mixed = (bf16*)(ws + WS_MIXED);
        pg8::gemm_phase<pg8::EpiBranch, pg8::BranchSched, true, true>(lds + RING_OFF, 512, S, E, tid);
    }
    SEAM(PH_BRANCH);

    if (IN(PH_WO)) { PHASE_IDS
        pg8::PlainSched S; S.init(T, D_MODEL, G, bx); S.A = (const char*)(ws + WS_MIXED); S.Bt = (const char*)(ws + WS_WO); S.tstep = (size_t)256 * 1024 * 2;
        pg8::EpiResid E; E.x = args.in[0]; E.x1 = (float*)(ws + WS_X1);
        pg8::gemm_phase<pg8::EpiResid, pg8::PlainSched, true, true>(lds + RING_OFF, 1024, S, E, tid);
    }
    SEAM(PH_WO);

    if (IN(PH_ROUTER)) { PHASE_IDS
        LAS float* wl = (LAS float*)(lds + RING_OFF);
        { const GAS float* src = (const GAS float*)args.in[12]; for (int i = tid; i < 1024 * 16; i += NWAVES * 64) wl[(i & 15) * 1024 + (i >> 4)] = src[i]; }
        __syncthreads();
        const float* x1 = (const float*)(ws + WS_X1); const float* gain = args.in[11]; bf16* h2 = (bf16*)(ws + WS_H); float* aff = (float*)(ws + WS_AFF);
        const GAS f32x4* gr = (const GAS f32x4*)gain + lane;
        f32x4 v[4];
        if (gw < T) { const GAS f32x4* xr = (const GAS f32x4*)(x1 + (size_t)gw * D_MODEL) + lane;
#pragma unroll
            for (int j = 0; j < 4; ++j) v[j] = xr[64 * j]; }
        for (int m = gw; m < T; m += NGW) {
            f32x4 nv[4];
            { const int mn = (m + NGW < T) ? m + NGW : m; const GAS f32x4* xn = (const GAS f32x4*)(x1 + (size_t)mn * D_MODEL) + lane;
#pragma unroll
              for (int j = 0; j < 4; ++j) nv[j] = xn[64 * j]; }
            float s = 0.f;
#pragma unroll
            for (int j = 0; j < 4; ++j) s += (v[j].x * v[j].x + v[j].y * v[j].y) + (v[j].z * v[j].z + v[j].w * v[j].w);
            const float rstd = 1.f / sqrtf(wave_sum(s) * (1.f / D_MODEL) + EPS);
            float lg[NE];
#pragma unroll
            for (int e = 0; e < NE; ++e) lg[e] = 0.f;
            GAS unsigned long long* o8 = (GAS unsigned long long*)(h2 + (size_t)m * D_MODEL) + lane;
#pragma unroll
            for (int j = 0; j < 4; ++j) { const f32x4 g4 = gr[64 * j]; const f32x4 hv = v[j] * g4 * rstd;
                o8[64 * j] = (unsigned long long)pk2(hv.x, hv.y) | ((unsigned long long)pk2(hv.z, hv.w) << 32);
#pragma unroll
                for (int e = 0; e < NE; ++e) { const f32x4 w = *(const LAS f32x4*)(wl + e * 1024 + 4 * lane + 256 * j); lg[e] += (hv.x * w.x + hv.y * w.y) + (hv.z * w.z + hv.w * w.w); if ((e & 3) == 3) asm volatile("" ::: "memory"); }
                asm volatile("" ::: "memory"); }
            float r8[8], r4[4], r2[2], r1;
            { const bool b = (lane & 32) != 0;
#pragma unroll
              for (int e = 0; e < 8; ++e) { const float keep = b ? lg[e + 8] : lg[e], send = b ? lg[e] : lg[e + 8]; r8[e] = keep + __shfl_xor(send, 32); } }
            { const bool b = (lane & 16) != 0;
#pragma unroll
              for (int e = 0; e < 4; ++e) { const float keep = b ? r8[e + 4] : r8[e], send = b ? r8[e] : r8[e + 4]; r4[e] = keep + __shfl_xor(send, 16); } }
            { const bool b = (lane & 8) != 0;
#pragma unroll
              for (int e = 0; e < 2; ++e) { const float keep = b ? r4[e + 2] : r4[e], send = b ? r4[e] : r4[e + 2]; r2[e] = keep + __shfl_xor(send, 8); } }
            { const bool b = (lane & 4) != 0; const float keep = b ? r2[1] : r2[0], send = b ? r2[0] : r2[1]; r1 = keep + __shfl_xor(send, 4); }
            r1 += __shfl_xor(r1, 2); r1 += __shfl_xor(r1, 1);
            float mx = r1; mx = fmaxf(mx, __shfl_xor(mx, 4)); mx = fmaxf(mx, __shfl_xor(mx, 8)); mx = fmaxf(mx, __shfl_xor(mx, 16)); mx = fmaxf(mx, __shfl_xor(mx, 32));
            const float pe = expf(r1 - mx); float den = pe; den += __shfl_xor(den, 4); den += __shfl_xor(den, 8); den += __shfl_xor(den, 16); den += __shfl_xor(den, 32);
            if ((lane & 3) == 0) aff[(size_t)m * NE + (((lane >> 5) & 1) * 8 + ((lane >> 4) & 1) * 4 + ((lane >> 3) & 1) * 2 + ((lane >> 2) & 1))] = pe / den;
#pragma unroll
            for (int j = 0; j < 4; ++j) v[j] = nv[j];
        }
        __syncthreads();
    }
    SEAM(PH_ROUTER);

    if (IN(PH_TOPK)) { PHASE_IDS
        if (vcu >= NZ) {
            const int lane_c = lane;
            LAS float* scr = (LAS float*)(lds + RING_OFF + wave * 16384); const float* wd = args.in[15]; constexpr int I_D = 44 * 32;
            for (int it = (vcu - NZ) * NWAVES + wave; it < NE * I_D; it += (G - NZ) * NWAVES) { const int e = it / I_D, q = it % I_D;
                transpose_item(wd + (size_t)e * FF * D_MODEL, FF, D_MODEL, (bf16*)(ws + WS_WD) + (size_t)e * 1024 * FF, CmId(), scr, q / 32, q % 32, lane_c); }
        }
        LAS unsigned* keys = (LAS unsigned*)(lds + RING_OFF); LAS int* hist = (LAS int*)(lds + RING_OFF + 32768); LAS int* sc = (LAS int*)(lds + RING_OFF + 34816); volatile LAS unsigned* sv = (volatile LAS unsigned*)(lds + RING_OFF + 36864);
        const float* aff = (const float*)(ws + WS_AFF); int* idx = (int*)(ws + WS_IDX); float* gate = (float*)(ws + WS_GATE); int* sel = (int*)(ws + WS_SEL);
        for (int z = vcu; z < NZ; z += G) {
            const int b = z / NE, e = z % NE;
            for (int i = tid; i < SEQ; i += 512) keys[i] = __float_as_uint(aff[((size_t)b * SEQ + i) * NE + e]);
            if (tid == 0) { sv[0] = 0u; sv[1] = (unsigned)CAP; }
            __syncthreads();
            unsigned mask = 0u;
            for (int pass = 3; pass >= 0; --pass) {
                const int shift = pass * 8;
                if (tid < 256) hist[tid] = 0;
                __syncthreads();
                const unsigned prefix = sv[0];
                for (int i = tid; i < SEQ; i += 512) { const unsigned k = keys[i]; if ((k & mask) == prefix) atomicAdd((int*)&hist[(k >> shift) & 255u], 1); }
                __syncthreads();
                if (tid < 64) {
                    const int krem = (int)sv[1]; const int h0 = hist[4 * tid], h1 = hist[4 * tid + 1], h2 = hist[4 * tid + 2], h3 = hist[4 * tid + 3];
                    int suf = h0 + h1 + h2 + h3;
#pragma unroll
                    for (int o = 1; o < 64; o <<= 1) { const int t = __shfl_down(suf, o); if (tid + o < 64) suf += t; }
                    int cum = suf - (h0 + h1 + h2 + h3);
                    int dsel = -1, cumsel = 0;
                    if (cum < krem && cum + h3 >= krem) { dsel = 3; cumsel = cum; } cum += h3;
                    if (dsel < 0 && cum < krem && cum + h2 >= krem) { dsel = 2; cumsel = cum; } cum += h2;
                    if (dsel < 0 && cum < krem && cum + h1 >= krem) { dsel = 1; cumsel = cum; } cum += h1;
                    if (dsel < 0 && cum < krem && cum + h0 >= krem) { dsel = 0; cumsel = cum; }
                    if (dsel >= 0) { sv[1] = (unsigned)(krem - cumsel); sv[0] = prefix | ((unsigned)(4 * tid + dsel) << shift); }
                }
                __syncthreads();
                mask |= 0xFFu << shift;
            }
            const unsigned Tk = sv[0]; const int krem = (int)sv[1];
            int cgt = 0, ceq = 0;
            for (int q = 0; q < 16; ++q) { const unsigned k = keys[tid * 16 + q]; cgt += (k > Tk); ceq += (k == Tk); }
            int eqbase, slot;
            { sc[tid] = ceq; __syncthreads(); for (int off = 1; off < 512; off <<= 1) { const int t = (tid >= off) ? sc[tid - off] : 0; __syncthreads(); sc[tid] += t; __syncthreads(); } eqbase = sc[tid] - ceq; __syncthreads(); }
            int take = krem - eqbase; take = take < 0 ? 0 : (take > ceq ? ceq : take);
            { const int v = cgt + take; sc[tid] = v; __syncthreads(); for (int off = 1; off < 512; off <<= 1) { const int t = (tid >= off) ? sc[tid - off] : 0; __syncthreads(); sc[tid] += t; __syncthreads(); } slot = sc[tid] - v; __syncthreads(); }
            int eqr = eqbase;
            for (int q = 0; q < 16; ++q) { const int i = tid * 16 + q; const unsigned k = keys[i]; bool tk = k > Tk; if (k == Tk) { tk = eqr < krem; ++eqr; }
                if (tk) { idx[z * CAP + slot] = i; gate[z * CAP + slot] = __uint_as_float(k); sel[((size_t)b * SEQ + i) * NE + e] = slot; ++slot; } else sel[((size_t)b * SEQ + i) * NE + e] = -1; }
            __syncthreads();
        }
    }
    SEAM(PH_TOPK);


    if (IN(PH_MOE1)) { PHASE_IDS
        pg8::MoeGatherSched S; S.init(NZ * CAP, 5632, G, bx); S.A = (const char*)(ws + WS_H); S.Bt = (const char*)(ws + WS_W1C); S.idx = (const int*)(ws + WS_IDX);
        pg8::EpiSwiglu E; E.act = (bf16*)(ws + WS_ACT);
        pg8::gemm_phase<pg8::EpiSwiglu, pg8::MoeGatherSched, true, true>(lds + RING_OFF, 1024, S, E, tid);
    }
    SEAM(PH_MOE1);

    if (IN(PH_MOE2)) { PHASE_IDS
        pg8::MoeSched S; S.init(NZ * CAP, D_MODEL, G, bx); S.A = (const char*)(ws + WS_ACT); S.Bt = (const char*)(ws + WS_WD); S.kb = (size_t)FF * 2; S.nper = 1024;
        pg8::EpiDown E; E.y = (bf16*)(ws + WS_Y); E.gate = (const float*)(ws + WS_GATE);
        pg8::gemm_phase<pg8::EpiDown, pg8::MoeSched, true, true>(lds + RING_OFF, FF, S, E, tid);
    }
    SEAM(PH_MOE2);

    if (IN(PH_FINAL)) { PHASE_IDS
        const float* x1 = (const float*)(ws + WS_X1); const int* sel = (const int*)(ws + WS_SEL); const bf16* y = (const bf16*)(ws + WS_Y); const float* gain = args.in[16];
        for (int m = gw; m < T; m += NGW) {
            const int b = m / SEQ;
            const GAS f32x4* xr = (const GAS f32x4*)(x1 + (size_t)m * D_MODEL) + lane; const GAS f32x4* gr = (const GAS f32x4*)gain + lane;
            f32x4 v[4];
#pragma unroll
            for (int j = 0; j < 4; ++j) v[j] = xr[64 * j];
            const int mysel = (lane < NE) ? sel[(size_t)m * NE + lane] : -1;
            for (int e = 0; e < NE; ++e) { const int sl = __builtin_amdgcn_readlane(mysel, e);
                if (sl >= 0) { const GAS unsigned long long* yr = (const GAS unsigned long long*)(y + ((size_t)(b * NE + e) * CAP + sl) * D_MODEL) + lane;
#pragma unroll
                    for (int j = 0; j < 4; ++j) { const unsigned long long w = yr[64 * j]; const unsigned lo = (unsigned)w, hi = (unsigned)(w >> 32);
                        v[j].x += __uint_as_float(lo << 16); v[j].y += __uint_as_float(lo & 0xffff0000u); v[j].z += __uint_as_float(hi << 16); v[j].w += __uint_as_float(hi & 0xffff0000u); } } }
            float s = 0.f;
#pragma unroll
            for (int j = 0; j < 4; ++j) s += (v[j].x * v[j].x + v[j].y * v[j].y) + (v[j].z * v[j].z + v[j].w * v[j].w);
            const float rstd = 1.f / sqrtf(wave_sum(s) * (1.f / D_MODEL) + EPS);
            GAS f32x4* o = (GAS f32x4*)(args.out + (size_t)m * D_MODEL) + lane;
#pragma unroll
            for (int j = 0; j < 4; ++j) { const f32x4 g4 = gr[64 * j]; o[64 * j] = v[j] * g4 * rstd; }
        }
    }
#undef IN
#undef SEAM
}

#ifndef MK_DUP
#define MK_DUP (-1)
#endif
#ifndef MK_ONE_LAUNCH
#define MK_ONE_LAUNCH 1
#endif
extern "C" void kernel_launch(void* const* d_in, const int* in_sizes, int n_in, void* d_out, int out_size, void* d_ws, size_t ws_size, hipStream_t stream) {
    static int grid = 0;
    if (grid == 0) {
        if (n_in != 17 || in_sizes[0] != T * D_MODEL || out_size != T * D_MODEL || ws_size < WS_END) { fprintf(stderr, "kernel_launch: shape/workspace mismatch (ws %zu need %zu)\n", ws_size, (size_t)WS_END); grid = -1; return; }
        int dev = 0, cus = 0, per_cu = 0;
        if (hipGetDevice(&dev) != hipSuccess || hipDeviceGetAttribute(&cus, hipDeviceAttributeMultiprocessorCount, dev) != hipSuccess) { grid = -1; return; }
        if (hipFuncSetAttribute((const void*)mega, hipFuncAttributeMaxDynamicSharedMemorySize, LDS_BYTES) != hipSuccess) { fprintf(stderr, "kernel_launch: hipFuncSetAttribute failed\n"); grid = -1; return; }
        if (hipOccupancyMaxActiveBlocksPerMultiprocessor(&per_cu, (const void*)mega, NWAVES * 64, LDS_BYTES) != hipSuccess || per_cu < 1) { fprintf(stderr, "kernel_launch: occupancy query says %d blocks per CU\n", per_cu); (void)hipGetLastError(); grid = -1; return; }
        grid = cus;
    }
    if (grid < 0) return;
    unsigned char* ws = (unsigned char*)d_ws;
    (void)hipMemsetAsync(ws + WS_CTL, 0, CTL_ZERO_BYTES, stream);
    Args a{};
    for (int i = 0; i < 17; ++i) a.in[i] = (const float*)d_in[i];
    a.out = (float*)d_out; a.ws = ws;
#if MK_ONE_LAUNCH
    a.ph_lo = 0; a.ph_hi = PH_END; hipLaunchKernelGGL(mega, dim3(grid), dim3(NWAVES * 64), LDS_BYTES, stream, a);
#if MK_DUP >= 0
    a.ph_lo = MK_DUP; a.ph_hi = MK_DUP + 1; hipLaunchKernelGGL(mega, dim3(grid), dim3(NWAVES * 64), LDS_BYTES, stream, a);
#endif
#else
    for (int ph = 0; ph < PH_END; ++ph) { a.ph_lo = ph; a.ph_hi = ph + 1; hipLaunchKernelGGL(mega, dim3(grid), dim3(NWAVES * 64), LDS_BYTES, stream, a); }
#endif
}
```

```cpp
#include <hip/hip_runtime.h>
#include <hip/hip_bf16.h>
#include <cstdio>
#include <cstdint>
#include <cmath>

constexpr size_t EP_MiB = 1u << 20;
constexpr size_t EP_COS = 2 * EP_MiB, EP_SIN = 4 * EP_MiB, EP_RQ = 382 * EP_MiB, EP_RK = 398 * EP_MiB, EP_RV = 414 * EP_MiB, EP_RGS = 430 * EP_MiB, EP_AQ = 446 * EP_MiB, EP_AK = 462 * EP_MiB, EP_AV = 470 * EP_MiB, EP_GRS = 478 * EP_MiB, EP_GAS = 510 * EP_MiB;
constexpr int D_MODEL = 1024, BATCH = 2, SEQ = 8192, T = BATCH * SEQ;
constexpr int HD = 128, CHUNK = 128, NCHUNK = SEQ / CHUNK;
constexpr int NE = 16, FF = 2816, CAP = 1024, NZ = BATCH * NE;
constexpr int INW = 5120;
constexpr int O_RQ = 0, O_RK = 512, O_RV = 1024, O_RG = 1536, O_AQ = 2048, O_AK = 2560, O_AV = 2816, O_GR = 3072, O_GA = 4096;
constexpr float EPS = 1e-6f;
constexpr float RSQRT_HD = 0.08838834764831845f;
constexpr float W1_SCALE = 32.0f, WD_SCALE = 64.0f, ACT_SCALE = 4.0f;

namespace pg8 {
#define PG8_LAS __attribute__((address_space(3)))
typedef unsigned short bf16_t;
typedef short bf16x8 __attribute__((ext_vector_type(8)));
typedef float f32x4 __attribute__((ext_vector_type(4)));
typedef unsigned u32x4 __attribute__((ext_vector_type(4)));
constexpr int BM = 256, BK = 64, HALF = 128, HTB = HALF * BK * 2  , STAGE_BYTES = 8 * HTB, NXCD = 8, WGM = 8;

__host__ __device__ __forceinline__ int lds_byte(int r, int c) { const int st = (r >> 4) * 2 + (c >> 5), rr = r & 15, cc = c & 31, ob = rr * 64 + cc * 2; return st * 1024 + (ob ^ (((ob >> 9) & 1) << 5)); }
__host__ __device__ __forceinline__ void stage_rc(int b, int& R, int& C) { const int st = b / 1024, sb = b % 1024, swz = sb ^ (((sb >> 9) & 1) << 5); R = (st >> 1) * 16 + swz / 64; C = (st & 1) * 32 + (swz % 64) / 2; }
__host__ __device__ __forceinline__ int perm32(int rho) { const int n = rho >> 4, i = rho & 15; return 8 * (i >> 2) + 4 * n + (i & 3); }

struct Unit { int pm, pn, aux; };
struct Gemm { const bf16_t* A; const bf16_t* Bt; int M, N, K; };

struct StaticOrder {
    int nM, nN, nwg, G, c;
    __host__ __device__ void init(int M, int N, int G_, int c_) { nM = M / BM; nN = N / BM; nwg = nM * nN; G = G_; c = c_; }
    __host__ __device__ bool next(int i, Unit& u) const {
        const long L = (long)i * G + c; if (L >= nwg) return false;
        int wgid = (int)L; { const int q = nwg / NXCD, r = nwg % NXCD, xcd = wgid % NXCD, off = wgid / NXCD; wgid = (xcd < r ? xcd * (q + 1) : r * (q + 1) + (xcd - r) * q) + off; }
        const int nig = WGM * nN, gid = wgid / nig, fm = gid * WGM, gsz = (nM - fm) < WGM ? (nM - fm) : WGM;
        u.pm = fm + ((wgid % nig) % gsz); u.pn = (wgid % nig) / gsz; u.aux = 0; return true;
    }
    __device__ __forceinline__ void a_ready(const Unit&) const {}
    __device__ __forceinline__ void done(const Unit&) const {}
    static constexpr bool GATHER = false;
    __device__ __forceinline__ unsigned gather_off(const Unit&, int, int) const { return 0u; }
    __device__ __forceinline__ bool keep_acc(const Unit&) const { return false; }
};


struct PlainSched : StaticOrder {
    const char* A; const char* Bt; size_t tstep;
    __device__ __forceinline__ void bases(const Unit& u, const char*& a, const char*& b) const { a = A + (size_t)u.pm * tstep; b = Bt + (size_t)u.pn * tstep; }
};

typedef float f32x2_t __attribute__((ext_vector_type(2))); typedef __bf16 bf16x2_t __attribute__((ext_vector_type(2)));
__device__ __forceinline__ unsigned cvt_pk_bf16(float lo, float hi) { f32x2_t v = {lo, hi}; bf16x2_t b = __builtin_convertvector(v, bf16x2_t); return __builtin_bit_cast(unsigned, b); }
__device__ __forceinline__ u32x4 pack8(const f32x4 a, const f32x4 b) { u32x4 w; w.x = cvt_pk_bf16(a[0], a[1]); w.y = cvt_pk_bf16(a[2], a[3]); w.z = cvt_pk_bf16(b[0], b[1]); w.w = cvt_pk_bf16(b[2], b[3]); return w; }
__device__ __forceinline__ float fast_sigmoid(float x) { return __builtin_amdgcn_rcpf(1.0f + __builtin_amdgcn_exp2f(-1.4426950408889634f * x)); }
__device__ __forceinline__ f32x4 sigmoid4(const f32x4 v) { return (f32x4){fast_sigmoid(v[0]), fast_sigmoid(v[1]), fast_sigmoid(v[2]), fast_sigmoid(v[3])}; }
__device__ __forceinline__ f32x4 silu4(const f32x4 v) { return v * sigmoid4(v); }

struct EpiProj {
    static constexpr bool PERM = true, AFTER_DRAIN = false;
    unsigned char* wsb;
    const float *qn, *kn;
    PG8_LAS float* xch;
    mutable unsigned epoch;
    template <int ACT>
    __device__ __forceinline__ void plain(const f32x4 (&acc)[2][2][4][2], bf16_t* base, int ld, int col0, int row0) const {
#pragma unroll
        for (int ai = 0; ai < 2; ++ai)
#pragma unroll
            for (int m = 0; m < 4; ++m) { bf16_t* rowp = base + (size_t)(row0 + ai * HALF + m * 16) * ld + col0;
#pragma unroll
                for (int bj = 0; bj < 2; ++bj) { f32x4 v0 = acc[ai][bj][m][0], v1 = acc[ai][bj][m][1];
                    if (ACT == 1) { v0 = silu4(v0); v1 = silu4(v1); } else if (ACT == 2) { v0 = sigmoid4(v0); v1 = sigmoid4(v1); }
                    *(u32x4*)(rowp + bj * HALF) = pack8(v0, v1); } }
    }
    template <bool NORM>
    __device__ __forceinline__ void rope(const f32x4 (&acc)[2][2][4][2], bf16_t* base, int ld, int col0, int row0, float scale, const float* nw, int wr, int wc, int fr, int fq) const {
        const int g = 4 * wc + fq;
        f32x4 nw1 = {1.f, 1.f, 1.f, 1.f}, nw2 = {1.f, 1.f, 1.f, 1.f};
        if (NORM) {
#pragma unroll
            for (int ai = 0; ai < 2; ++ai)
#pragma unroll
                for (int m = 0; m < 4; ++m)
#pragma unroll
                    for (int bj = 0; bj < 2; ++bj) { const f32x4 a = acc[ai][bj][m][0], b = acc[ai][bj][m][1];
                        float s = (a[0] * a[0] + a[1] * a[1]) + (a[2] * a[2] + a[3] * a[3]) + (b[0] * b[0] + b[1] * b[1]) + (b[2] * b[2] + b[3] * b[3]);
                        s += __shfl_xor(s, 16); s += __shfl_xor(s, 32);
                        if (fq == 0) xch[((ai * HALF + wr * 64 + m * 16 + fr) * 2 + bj) * 4 + wc] = s; }
            asm volatile("s_waitcnt lgkmcnt(0)" ::: "memory");
            PG8_LAS unsigned* cnt = (PG8_LAS unsigned*)(xch + 2048) + wr;
            if ((fr | fq) == 0) __hip_atomic_fetch_add(cnt, 1u, __ATOMIC_RELAXED, __HIP_MEMORY_SCOPE_WORKGROUP);
            epoch += 4u;
            while (__hip_atomic_load(cnt, __ATOMIC_RELAXED, __HIP_MEMORY_SCOPE_WORKGROUP) < epoch) __builtin_amdgcn_s_sleep(1);
            asm volatile("s_waitcnt lgkmcnt(0)" ::: "memory");
            nw1 = *(const f32x4*)(nw + 4 * g); nw2 = *(const f32x4*)(nw + 64 + 4 * g);
        }
#pragma unroll
        for (int ai = 0; ai < 2; ++ai)
#pragma unroll
            for (int m = 0; m < 4; ++m) { const int r = row0 + ai * HALF + m * 16; const int pos = r & 8191;
                const f32x4 c4 = *(const f32x4*)((const float*)(wsb + EP_COS) + (size_t)pos * 64 + 4 * g), s4 = *(const f32x4*)((const float*)(wsb + EP_SIN) + (size_t)pos * 64 + 4 * g);
                bf16_t* rowp = base + (size_t)r * ld + col0;
#pragma unroll
                for (int bj = 0; bj < 2; ++bj) { f32x4 x1 = acc[ai][bj][m][0], x2 = acc[ai][bj][m][1];
                    if (NORM) { const f32x4 p = *(const PG8_LAS f32x4*)(xch + ((ai * HALF + wr * 64 + m * 16 + fr) * 2 + bj) * 4);
                        const float rs = __builtin_amdgcn_rsqf(((p[0] + p[1]) + (p[2] + p[3])) * (1.0f / 128.0f) + 1e-6f);
                        x1 = x1 * (nw1 * rs); x2 = x2 * (nw2 * rs); }
                    const f32x4 y1 = (x1 * c4 - x2 * s4) * scale, y2 = (x1 * s4 + x2 * c4) * scale;
                    *(u32x4*)(rowp + bj * HALF) = pack8(y1, y2); }
                asm volatile("" ::: "memory"); }
    }
    __device__ __forceinline__ void operator()(const f32x4 (&acc)[2][2][4][2], const Unit& u, int wr, int wc, int fr, int fq) const {
        const int row0 = u.pm * BM + wr * 64 + fr, cw = wc * 32 + 8 * fq, pn = u.pn;
        if (pn < 2)       rope<false>(acc, (bf16_t*)(wsb + EP_RQ), 512, pn * 256 + cw, row0, 1.0f, nullptr, wr, wc, fr, fq);
        else if (pn < 4)  rope<false>(acc, (bf16_t*)(wsb + EP_RK), 512, (pn - 2) * 256 + cw, row0, 0.08838834764831845f, nullptr, wr, wc, fr, fq);
        else if (pn < 6)  plain<0>(acc, (bf16_t*)(wsb + EP_RV), 512, (pn - 4) * 256 + cw, row0);
        else if (pn < 8)  plain<1>(acc, (bf16_t*)(wsb + EP_RGS), 512, (pn - 6) * 256 + cw, row0);
        else if (pn < 10) rope<true>(acc, (bf16_t*)(wsb + EP_AQ), 512, (pn - 8) * 256 + cw, row0, 1.0f, qn, wr, wc, fr, fq);
        else if (pn < 11) rope<true>(acc, (bf16_t*)(wsb + EP_AK), 256, cw, row0, 1.0f, kn, wr, wc, fr, fq);
        else if (pn < 12) plain<0>(acc, (bf16_t*)(wsb + EP_AV), 256, cw, row0);
        else if (pn < 16) plain<2>(acc, (bf16_t*)(wsb + EP_GRS), 1024, (pn - 12) * 256 + cw, row0);
        else              plain<2>(acc, (bf16_t*)(wsb + EP_GAS), 1024, (pn - 16) * 256 + cw, row0);
    }
};

struct BranchSched : StaticOrder {
    const char *A0, *A1, *B0, *B1; size_t tstep;
    __device__ __forceinline__ bool next(int i, Unit& u) const { if (!StaticOrder::next(i >> 1, u)) return false; u.aux = i & 1; return true; }
    __device__ __forceinline__ void bases(const Unit& u, const char*& a, const char*& b) const { a = (u.aux ? A1 : A0) + (size_t)u.pm * tstep; b = (u.aux ? B1 : B0) + (size_t)u.pn * tstep; }
    __device__ __forceinline__ bool keep_acc(const Unit& nxt) const { return nxt.aux == 1; }
};
__device__ __forceinline__ void unpack8(const u32x4 w, f32x4& a, f32x4& b) {
    a = (f32x4){__uint_as_float(w.x << 16), __uint_as_float(w.x & 0xffff0000u), __uint_as_float(w.y << 16), __uint_as_float(w.y & 0xffff0000u)};
    b = (f32x4){__uint_as_float(w.z << 16), __uint_as_float(w.z & 0xffff0000u), __uint_as_float(w.w << 16), __uint_as_float(w.w & 0xffff0000u)};
}
struct EpiBranch {
    static constexpr bool PERM = true, AFTER_DRAIN = false;
    const bf16_t *grs, *gas; bf16_t* mixed;
    __device__ __forceinline__ void operator()(f32x4 (&acc)[2][2][4][2], const Unit& u, int wr, int wc, int fr, int fq) const {
        const int row0 = u.pm * BM + wr * 64 + fr, col0 = u.pn * BM + wc * 32 + 8 * fq;
#pragma unroll
        for (int ai = 0; ai < 2; ++ai)
#pragma unroll
            for (int m = 0; m < 4; ++m) { const size_t off = (size_t)(row0 + ai * HALF + m * 16) * 1024 + col0;
#pragma unroll
                for (int bj = 0; bj < 2; ++bj) { f32x4 ga0, ga1; unpack8(*(const u32x4*)(gas + off + bj * HALF), ga0, ga1);
                    if (u.aux == 0) { f32x4 gr0, gr1; unpack8(*(const u32x4*)(grs + off + bj * HALF), gr0, gr1);
#pragma unroll
                        for (int k = 0; k < 4; ++k) { acc[ai][bj][m][0][k] *= gr0[k] * __builtin_amdgcn_rcpf(fmaxf(ga0[k], 1e-30f)); acc[ai][bj][m][1][k] *= gr1[k] * __builtin_amdgcn_rcpf(fmaxf(ga1[k], 1e-30f)); } }
                    else *(u32x4*)(mixed + off + bj * HALF) = pack8(acc[ai][bj][m][0] * ga0, acc[ai][bj][m][1] * ga1); }
                asm volatile("" ::: "memory"); }
    }
};
struct EpiResid {
    static constexpr bool PERM = false, AFTER_DRAIN = false;
    const float* x; float* x1;
    __device__ __forceinline__ void operator()(const f32x4 (&acc)[2][2][4][2], const Unit& u, int wr, int wc, int fr, int fq) const {
        const int row0 = u.pm * BM + wr * 64 + fr, col0 = u.pn * BM + wc * 32 + 4 * fq;
#pragma unroll
        for (int ai = 0; ai < 2; ++ai)
#pragma unroll
            for (int m = 0; m < 4; ++m) { const size_t off = (size_t)(row0 + ai * HALF + m * 16) * 1024 + col0;
#pragma unroll
                for (int bj = 0; bj < 2; ++bj)
#pragma unroll
                    for (int n = 0; n < 2; ++n) { const f32x4 xv = *(const f32x4*)(x + off + bj * HALF + n * 16); *(f32x4*)(x1 + off + bj * HALF + n * 16) = xv + acc[ai][bj][m][n]; }
                if (m & 1) asm volatile("" ::: "memory"); }
    }
};
__device__ __forceinline__ int moe_rowbase(int pm) { return ((((pm >> 2) & 1) * 16 + (pm >> 3)) * 1024) + (pm & 3) * 256; }
struct MoeSched : StaticOrder {
    const char *A, *Bt; size_t kb; int nper;
    __device__ __forceinline__ void bases(const Unit& u, const char*& a, const char*& b) const { a = A + (size_t)moe_rowbase(u.pm) * kb; b = Bt + ((size_t)(u.pm >> 3) * nper + (size_t)u.pn * 256) * kb; }
};
struct MoeGatherSched : StaticOrder {
    static constexpr bool GATHER = true;
    const char *A, *Bt; const int* idx;
    __device__ __forceinline__ void bases(const Unit& u, const char*& a, const char*& b) const { a = A; b = Bt + ((size_t)(u.pm >> 3) * 5632 + (size_t)u.pn * 256) * 1024; }
    __device__ __forceinline__ unsigned gather_off(const Unit& u, int r, int c) const { const int tok = ((u.pm >> 2) & 1) * 8192 + idx[moe_rowbase(u.pm) + r]; return (unsigned)(tok * 1024 + c * 2); }
};
struct EpiSwiglu {
    static constexpr bool PERM = true, AFTER_DRAIN = false;
    unsigned char* act; float in_scale, act_scale;
    __device__ __forceinline__ void operator()(const f32x4 (&acc)[2][2][4][2], const Unit& u, int wr, int wc, int fr, int fq) const {
        const int row0 = moe_rowbase(u.pm) + wr * 64 + fr, col0 = u.pn * HALF + wc * 32 + 8 * fq;
#pragma unroll
        for (int ai = 0; ai < 2; ++ai)
#pragma unroll
            for (int m = 0; m < 4; ++m) { const f32x4 v0 = silu4(acc[ai][0][m][0] * in_scale) * (acc[ai][1][m][0] * (in_scale * act_scale)), v1 = silu4(acc[ai][0][m][1] * in_scale) * (acc[ai][1][m][1] * (in_scale * act_scale));
                const unsigned lo = (unsigned)__builtin_amdgcn_cvt_pk_fp8_f32(v0[2], v0[3], __builtin_amdgcn_cvt_pk_fp8_f32(v0[0], v0[1], 0, false), true), hi = (unsigned)__builtin_amdgcn_cvt_pk_fp8_f32(v1[2], v1[3], __builtin_amdgcn_cvt_pk_fp8_f32(v1[0], v1[1], 0, false), true);
                *(unsigned long long*)(act + (size_t)(row0 + ai * HALF + m * 16) * 2816 + col0) = (unsigned long long)lo | ((unsigned long long)hi << 32); }
    }
};
struct EpiDown {
    static constexpr bool PERM = true, AFTER_DRAIN = false;
    bf16_t* y; const float* gate; float out_scale;
    __device__ __forceinline__ void operator()(const f32x4 (&acc)[2][2][4][2], const Unit& u, int wr, int wc, int fr, int fq) const {
        const int row0 = moe_rowbase(u.pm) + wr * 64 + fr, col0 = u.pn * BM + wc * 32 + 8 * fq;
#pragma unroll
        for (int ai = 0; ai < 2; ++ai)
#pragma unroll
            for (int m = 0; m < 4; ++m) { const int r = row0 + ai * HALF + m * 16; const float g = gate[r] * out_scale;
#pragma unroll
                for (int bj = 0; bj < 2; ++bj) *(u32x4*)(y + (size_t)r * 1024 + col0 + bj * HALF) = pack8(acc[ai][bj][m][0] * g, acc[ai][bj][m][1] * g); }
    }
};
typedef int v4i32 __attribute__((ext_vector_type(4)));
typedef int v8i32 __attribute__((ext_vector_type(8)));
__device__ __forceinline__ v8i32 cat8(const bf16x8 lo, const bf16x8 hi) { const v4i32 l = __builtin_bit_cast(v4i32, lo), h = __builtin_bit_cast(v4i32, hi); return __builtin_shufflevector(l, h, 0, 1, 2, 3, 4, 5, 6, 7); }
__device__ __forceinline__ void mfma_f8_inplace(f32x4& acc, const v8i32 b8, const v8i32 a8, const int sc) {
    asm volatile("v_mfma_scale_f32_16x16x128_f8f6f4 %0, %1, %2, %0, %3, %3 op_sel_hi:[0,0,0]" : "+v"(acc) : "v"(b8), "v"(a8), "v"(sc)); }
template <class Epi, class Sched, bool ALIGN_EPI = false, bool SP2 = false, bool FP8 = false>
__device__ __forceinline__ void gemm_phase(PG8_LAS unsigned char* lds, const int K_, const Sched& S, const Epi& E, const int tid) {
    const int wid = __builtin_amdgcn_readfirstlane(tid >> 6), lane = tid & 63, wr = wid >> 2, wc = wid & 3, fr = lane & 15, fq = lane >> 4;
    const int K = K_, nt = K / BK;
    unsigned voffA[2], voffB[2];
#pragma unroll
    for (int i = 0; i < 2; ++i) { int R, C; stage_rc(tid * 16 + i * 8192, R, C); const int Rb = Epi::PERM ? ((R & ~31) + perm32(R & 31)) : R;
        voffA[i] = (unsigned)(R * K + C) * 2u; voffB[i] = (unsigned)(Rb * K + C) * 2u; }
    unsigned va0[2] = {0u, 0u}, va1[2] = {0u, 0u}, vn0[2] = {0u, 0u}, vn1[2] = {0u, 0u};
    int gR[2], gC[2];
#pragma unroll
    for (int i = 0; i < 2; ++i) stage_rc(tid * 16 + i * 8192, gR[i], gC[i]);
    const size_t kstep = (size_t)(BK * 2);
    const size_t hstep = (size_t)HALF * K * 2;
        const unsigned ldsw = (unsigned)wid * 1024u;
    const int aoff = lds_byte(wr * 64 + fr, fq * 8), boff = lds_byte(wc * 32 + fr, fq * 8);
#define PG8_SA(b, h) (((b) * 2 + (h)) * HTB)
#define PG8_SB(b, h) ((4 + (b) * 2 + (h)) * HTB)
#define PG8_STAGE(bufoff, gbase, voff) do { _Pragma("unroll") for (int _i = 0; _i < 2; ++_i) \
        __builtin_amdgcn_global_load_lds((const unsigned*)((const char*)(gbase) + (voff)[_i]), (PG8_LAS unsigned*)(lds + (bufoff) + ldsw + _i * 8192), 16, 0, 0); } while (0)
#define PG8_STAGE_A(bufoff, gbase, h, usenext) do { if constexpr (Sched::GATHER) { unsigned vo_[2]; \
        vo_[0] = (usenext) ? ((h) ? vn1[0] : vn0[0]) : ((h) ? va1[0] : va0[0]); vo_[1] = (usenext) ? ((h) ? vn1[1] : vn0[1]) : ((h) ? va1[1] : va0[1]); PG8_STAGE(bufoff, gbase, vo_); } \
        else { PG8_STAGE(bufoff, (gbase) + ((h) ? hstep : (size_t)0), voffA); } } while (0)
#define PG8_LDA(dst, b, h) do { if constexpr (FP8) { _Pragma("unroll") for (int m = 0; m < 4; ++m) dst##8[m] = cat8(*(const PG8_LAS bf16x8*)(lds + PG8_SA(b, h) + aoff + m * 2048), *(const PG8_LAS bf16x8*)(lds + PG8_SA(b, h) + aoff + m * 2048 + 1024)); } else { \
        _Pragma("unroll") for (int m = 0; m < 4; ++m) _Pragma("unroll") for (int k = 0; k < 2; ++k) dst[m][k] = *(const PG8_LAS bf16x8*)(lds + PG8_SA(b, h) + aoff + m * 2048 + k * 1024); } } while (0)
#define PG8_LDB(dst, b, h) do { if constexpr (FP8) { _Pragma("unroll") for (int n = 0; n < 2; ++n) dst##8[n] = cat8(*(const PG8_LAS bf16x8*)(lds + PG8_SB(b, h) + boff + n * 2048), *(const PG8_LAS bf16x8*)(lds + PG8_SB(b, h) + boff + n * 2048 + 1024)); } else { \
        _Pragma("unroll") for (int n = 0; n < 2; ++n) _Pragma("unroll") for (int k = 0; k < 2; ++k) dst[n][k] = *(const PG8_LAS bf16x8*)(lds + PG8_SB(b, h) + boff + n * 2048 + k * 1024); } } while (0)
#define PG8_MMA(ai, bj, At, Bt) do { __builtin_amdgcn_s_setprio(1); if constexpr (FP8) { _Pragma("unroll") for (int m = 0; m < 4; ++m) _Pragma("unroll") for (int n = 0; n < 2; ++n) \
        mfma_f8_inplace(acc[ai][bj][m][n], Bt##8[n], At##8[m], 0x7f7f7f7f); } else { \
        _Pragma("unroll") for (int m = 0; m < 4; ++m) _Pragma("unroll") for (int n = 0; n < 2; ++n) _Pragma("unroll") for (int k = 0; k < 2; ++k) \
        acc[ai][bj][m][n] = __builtin_amdgcn_mfma_f32_16x16x32_bf16(Bt[n][k], At[m][k], acc[ai][bj][m][n], 0, 0, 0); } __builtin_amdgcn_s_setprio(0); } while (0)
#define PG8_WAIT_V(n) asm volatile("s_waitcnt vmcnt(" #n ")" ::: "memory")
#define PG8_WAIT_L(n) asm volatile("s_waitcnt lgkmcnt(" #n ")" ::: "memory")
#define PG8_BAR __builtin_amdgcn_s_barrier()
#define PG8_SCHED __builtin_amdgcn_sched_barrier(0)
    Unit cur, nxt; int ui = 0;
    if (!S.next(0, cur)) return;
    f32x4 acc[2][2][4][2];
#pragma unroll
    for (int a = 0; a < 2; ++a)
#pragma unroll
        for (int b = 0; b < 2; ++b)
#pragma unroll
            for (int m = 0; m < 4; ++m)
#pragma unroll
                for (int n = 0; n < 2; ++n) acc[a][b][m][n] = (f32x4){0.f, 0.f, 0.f, 0.f};
    bf16x8 At[4][2], B0[2][2], B1[2][2]; v8i32 At8[4], B08[2], B18[2];
    const char* cA; const char* cB; S.bases(cur, cA, cB);
    if constexpr (Sched::GATHER) {
#pragma unroll
        for (int i = 0; i < 2; ++i) { va0[i] = S.gather_off(cur, gR[i], gC[i]); va1[i] = S.gather_off(cur, gR[i] + HALF, gC[i]); } }
    S.a_ready(cur);
    if constexpr (SP2) {
        PG8_STAGE(PG8_SB(0, 0), cB, voffB); PG8_STAGE(PG8_SB(0, 1), cB + hstep, voffB); PG8_STAGE_A(PG8_SA(0, 0), cA, 0, false); PG8_STAGE_A(PG8_SA(0, 1), cA, 1, false);
        if (wr == 1) PG8_BAR;
        PG8_WAIT_V(2); PG8_BAR;
        PG8_STAGE(PG8_SB(1, 0), cB + kstep, voffB); PG8_STAGE_A(PG8_SA(1, 0), cA + kstep, 0, false); PG8_STAGE(PG8_SB(1, 1), cB + hstep + kstep, voffB);
        PG8_WAIT_V(6); PG8_BAR;
    } else {
        PG8_STAGE(PG8_SB(0, 0), cB, voffB); PG8_STAGE_A(PG8_SA(0, 0), cA, 0, false); PG8_STAGE(PG8_SB(0, 1), cB + hstep, voffB); PG8_STAGE_A(PG8_SA(0, 1), cA, 1, false);
        if (wr == 1) PG8_BAR;
        PG8_WAIT_V(4); PG8_BAR;
        PG8_STAGE(PG8_SB(1, 0), cB + kstep, voffB); PG8_STAGE_A(PG8_SA(1, 0), cA + kstep, 0, false); PG8_STAGE(PG8_SB(1, 1), cB + hstep + kstep, voffB);
        PG8_WAIT_V(6); PG8_BAR;
    }
    for (;;) {
        const bool has_next = S.next(ui + 1, nxt);
        const char* nA = cA; const char* nB = cB; if (has_next) S.bases(nxt, nA, nB);
        if constexpr (Sched::GATHER) { if (has_next) {
#pragma unroll
            for (int i = 0; i < 2; ++i) { vn0[i] = S.gather_off(nxt, gR[i], gC[i]); vn1[i] = S.gather_off(nxt, gR[i] + HALF, gC[i]); } }
            else {
#pragma unroll
            for (int i = 0; i < 2; ++i) { vn0[i] = va0[i]; vn1[i] = va1[i]; } } }
#pragma unroll 1
        for (int t = 0; t < nt; t += 2) {
            const bool last = (t == nt - 2);
            const char* a1 = cA + (size_t)(t + 1) * kstep;
            const char* a2 = last ? nA : cA + (size_t)(t + 2) * kstep; const char* b2 = last ? nB : cB + (size_t)(t + 2) * kstep;
            const char* a3 = a2 + kstep; const char* b3 = b2 + kstep;
            if (last && has_next) S.a_ready(nxt);
            if constexpr (SP2) {
            PG8_LDB(B0, 0, 0); PG8_LDB(B1, 0, 1); PG8_SCHED; PG8_LDA(At, 0, 0); PG8_STAGE_A(PG8_SA(1, 1), a1, 1, false);
            PG8_WAIT_V(8); PG8_WAIT_L(0); PG8_BAR; PG8_MMA(0, 0, At, B0); PG8_MMA(0, 1, At, B1); PG8_BAR; PG8_SCHED;
            PG8_LDA(At, 0, 1); PG8_STAGE(PG8_SB(0, 0), b2, voffB); PG8_STAGE(PG8_SB(0, 1), b2 + hstep, voffB); PG8_STAGE_A(PG8_SA(0, 0), a2, 0, last);
            PG8_WAIT_V(8); PG8_WAIT_L(0); PG8_BAR; PG8_MMA(1, 0, At, B0); PG8_MMA(1, 1, At, B1); PG8_BAR; PG8_SCHED;
            PG8_LDB(B0, 1, 0); PG8_LDB(B1, 1, 1); PG8_SCHED; PG8_LDA(At, 1, 0); PG8_STAGE_A(PG8_SA(0, 1), a2, 1, last);
            PG8_WAIT_V(8); PG8_WAIT_L(0); PG8_BAR; PG8_MMA(0, 0, At, B0); PG8_MMA(0, 1, At, B1); PG8_BAR; PG8_SCHED;
            PG8_LDA(At, 1, 1); PG8_STAGE(PG8_SB(1, 0), b3, voffB); PG8_STAGE(PG8_SB(1, 1), b3 + hstep, voffB); PG8_STAGE_A(PG8_SA(1, 0), a3, 0, last);
            PG8_WAIT_V(8); PG8_WAIT_L(0); PG8_BAR; PG8_MMA(1, 0, At, B0); PG8_MMA(1, 1, At, B1); PG8_BAR; PG8_SCHED;
            } else {
            PG8_LDB(B0, 0, 0); PG8_SCHED; PG8_LDA(At, 0, 0); PG8_STAGE_A(PG8_SA(1, 1), a1, 1, false);
            PG8_WAIT_L(8); PG8_BAR; PG8_WAIT_L(0); PG8_MMA(0, 0, At, B0); PG8_BAR; PG8_SCHED;
            PG8_LDB(B1, 0, 1); PG8_STAGE(PG8_SB(0, 0), b2, voffB);
            PG8_BAR; PG8_WAIT_L(0); PG8_MMA(0, 1, At, B1); PG8_BAR;
            PG8_LDA(At, 0, 1); PG8_STAGE_A(PG8_SA(0, 0), a2, 0, last);
            PG8_BAR; PG8_WAIT_L(0); PG8_MMA(1, 0, At, B0); PG8_BAR; PG8_SCHED;
            PG8_STAGE(PG8_SB(0, 1), b2 + hstep, voffB);
            PG8_WAIT_V(6); PG8_BAR; PG8_MMA(1, 1, At, B1); PG8_BAR;
            PG8_LDB(B0, 1, 0); PG8_SCHED; PG8_LDA(At, 1, 0); PG8_STAGE_A(PG8_SA(0, 1), a2, 1, last);
            PG8_WAIT_L(8); PG8_BAR; PG8_WAIT_L(0); PG8_MMA(0, 0, At, B0); PG8_BAR; PG8_SCHED;
            PG8_LDB(B1, 1, 1); PG8_STAGE(PG8_SB(1, 0), b3, voffB);
            PG8_BAR; PG8_WAIT_L(0); PG8_MMA(0, 1, At, B1); PG8_BAR;
            PG8_LDA(At, 1, 1); PG8_STAGE_A(PG8_SA(1, 0), a3, 0, last);
            PG8_BAR; PG8_WAIT_L(0); PG8_MMA(1, 0, At, B0); PG8_BAR; PG8_SCHED;
            PG8_STAGE(PG8_SB(1, 1), b3 + hstep, voffB);
            PG8_WAIT_V(6); PG8_BAR; PG8_MMA(1, 1, At, B1); PG8_BAR;
            }
        }
        if constexpr (FP8) asm volatile("s_nop 15\n\ts_nop 15" ::: "memory");
        if constexpr (ALIGN_EPI) { if (wr == 0) PG8_BAR; }
        if constexpr (!Epi::AFTER_DRAIN) { int le_; asm volatile("v_mbcnt_lo_u32_b32 %0, -1, 0\n\tv_mbcnt_hi_u32_b32 %0, -1, %0" : "=v"(le_));
            E(acc, cur, wr, wc, le_ & 15, le_ >> 4); S.done(cur); }
        if (!has_next) break;
        if (!S.keep_acc(nxt)) {
#pragma unroll
        for (int a = 0; a < 2; ++a)
#pragma unroll
            for (int b = 0; b < 2; ++b)
#pragma unroll
                for (int m = 0; m < 4; ++m)
#pragma unroll
                    for (int n = 0; n < 2; ++n) acc[a][b][m][n] = (f32x4){0.f, 0.f, 0.f, 0.f};
        }
        cur = nxt; cA = nA; cB = nB; ++ui;
        if constexpr (Sched::GATHER) {
#pragma unroll
            for (int i = 0; i < 2; ++i) { va0[i] = vn0[i]; va1[i] = vn1[i]; } }
        if constexpr (ALIGN_EPI) { if (wr == 1) PG8_BAR; }
    }
    PG8_WAIT_V(0);
    if constexpr (!ALIGN_EPI) { if (wr == 0) PG8_BAR; }
    PG8_BAR;
    if constexpr (Epi::AFTER_DRAIN) { E.fused(acc, cur, wr, wc, fr, fq, lds, wid, lane); S.done(cur); }
#undef PG8_SA
#undef PG8_SB
#undef PG8_STAGE
#undef PG8_STAGE_A
#undef PG8_LDA
#undef PG8_LDB
#undef PG8_MMA
#undef PG8_WAIT_V
#undef PG8_WAIT_L
#undef PG8_BAR
#undef PG8_SCHED
}
}


namespace attn {
using bf16 = __hip_bfloat16;
constexpr int   D = 128, NW = 8, QBLK = 32, KVBLK = 64;
constexpr float SCALE = 0.088388347648318440f;
constexpr float THR = 8.f;
constexpr int SDEPTH = 2;
constexpr int LDQ = 512, LDK = 256, LDO = 512;
constexpr size_t SHM_V = KVBLK * D * 2, SHM_K = KVBLK * D * 2, SHM_ATTN = 2 * SHM_V + 2 * SHM_K + NW * 64 * 4;
using bf16x8 = __attribute__((ext_vector_type(8))) short;
using s16x4  = __attribute__((ext_vector_type(4))) short;
using f32x16 = __attribute__((ext_vector_type(16))) float;
using f32x8  = __attribute__((ext_vector_type(8))) float;
using u32x4  = __attribute__((ext_vector_type(4))) unsigned;
#define KSWZ(row, colB) ((row) * 256 + ((colB) ^ (((row) & 7) << 4)))
#define SBAR() __builtin_amdgcn_sched_barrier(0)
__device__ __forceinline__ int crow(int r, int hi) { return (r & 3) + 8 * (r >> 2) + 4 * hi; }
typedef float f32x2_t __attribute__((ext_vector_type(2))); typedef __bf16 bf16x2_t __attribute__((ext_vector_type(2)));
__device__ __forceinline__ unsigned cvtpk(float lo, float hi) { f32x2_t v = {lo, hi}; bf16x2_t b = __builtin_convertvector(v, bf16x2_t); return __builtin_bit_cast(unsigned, b); }
template <typename TIn> struct Stage;
template <> struct Stage<bf16>  { using T = bf16x8;
  __device__ static __forceinline__ T ld8(const bf16* p) { return *reinterpret_cast<const bf16x8*>(p); }
  __device__ static __forceinline__ bf16x8 tobf(T x) { return x; } };
template <> struct Stage<float> { using T = f32x8;
  __device__ static __forceinline__ T ld8(const float* p) { return *reinterpret_cast<const f32x8*>(p); }
  __device__ static __forceinline__ bf16x8 tobf(T x) {
    u32x4 w = {cvtpk(x[0], x[1]), cvtpk(x[2], x[3]), cvtpk(x[4], x[5]), cvtpk(x[6], x[7])}; return *reinterpret_cast<bf16x8*>(&w); } };

__device__ __forceinline__ void partialSM(f32x16& p0, f32x16& p1, float& m_reg, float& mn, float& alpha) {
  constexpr float C = SCALE * 1.4426950408889634f;
  float pmax = p0[0]; for (int r = 1; r < 16; ++r) pmax = fmaxf(pmax, p0[r]); for (int r = 0; r < 16; ++r) pmax = fmaxf(pmax, p1[r]);
  { auto rr = __builtin_amdgcn_permlane32_swap(__float_as_uint(pmax), __float_as_uint(pmax), false, false);
    pmax = fmaxf(__uint_as_float(rr[0]), __uint_as_float(rr[1])); }
  if (__builtin_expect(__all(pmax - m_reg <= THR / SCALE), 1)) { mn = m_reg; alpha = 1.f; }
  else { mn = fmaxf(m_reg, pmax); alpha = __builtin_amdgcn_exp2f((m_reg - mn) * C); m_reg = mn; }
  float mnC = -mn * C;
  for (int r = 0; r < 16; ++r) p0[r] = fmaf(p0[r], C, mnC); for (int r = 0; r < 16; ++r) p1[r] = fmaf(p1[r], C, mnC);
  for (int r = 0; r < 16; ++r) p0[r] = __builtin_amdgcn_exp2f(p0[r]);
}
__device__ __forceinline__ void finishSM(f32x16& p0, f32x16& p1, float alpha, float& l_reg, bf16x8& pa0, bf16x8& pa1, bf16x8& pa2, bf16x8& pa3) {
  for (int r = 0; r < 16; ++r) p1[r] = __builtin_amdgcn_exp2f(p1[r]);
  float ps = 0; for (int r = 0; r < 16; ++r) ps += p0[r]; for (int r = 0; r < 16; ++r) ps += p1[r];
  { auto rr = __builtin_amdgcn_permlane32_swap(__float_as_uint(ps), __float_as_uint(ps), false, false);
    ps = __uint_as_float(rr[0]) + __uint_as_float(rr[1]); }
  l_reg = l_reg * alpha + ps;
#define PK4(P, BASE, OUT) do { unsigned a0 = cvtpk(P[BASE + 0], P[BASE + 1]), a1 = cvtpk(P[BASE + 2], P[BASE + 3]);   \
    unsigned b0 = cvtpk(P[BASE + 4], P[BASE + 5]), b1 = cvtpk(P[BASE + 6], P[BASE + 7]);                              \
    auto r0 = __builtin_amdgcn_permlane32_swap(a0, b0, false, false); auto r1 = __builtin_amdgcn_permlane32_swap(a1, b1, false, false); \
    u32x4 w = {r0[0], r1[0], r0[1], r1[1]}; OUT = *reinterpret_cast<bf16x8*>(&w); } while (0)
  PK4(p0, 0, pa0); PK4(p0, 8, pa1); PK4(p1, 0, pa2); PK4(p1, 8, pa3);
#undef PK4
}
__device__ __forceinline__ void qkt(f32x16& p0, f32x16& p1, const bf16* Ks, const bf16x8* qr, int r32, int hi) {
  p0 = f32x16{}; p1 = f32x16{};
  for (int d0 = 0; d0 < 8; ++d0) { int cb = (d0 * 16 + hi * 8) * 2;
    bf16x8 b0 = *reinterpret_cast<const bf16x8*>((const char*)Ks + KSWZ(r32, cb));
    bf16x8 b1 = *reinterpret_cast<const bf16x8*>((const char*)Ks + KSWZ(32 + r32, cb));
    p0 = __builtin_amdgcn_mfma_f32_32x32x16_bf16(b0, qr[d0], p0, 0, 0, 0);
    p1 = __builtin_amdgcn_mfma_f32_32x32x16_bf16(b1, qr[d0], p1, 0, 0, 0); }
}
__device__ __forceinline__ int v_st(int k, int c) { const int kk = (k & ~0xC) | ((k & 4) << 1) | ((k & 8) >> 1); return ((kk >> 3) * 4 + (c >> 5)) * 512 + ((kk & 7) * 32 + (c & 31)) * 2; }
__device__ __forceinline__ int v_rd_base(int lane) { return ((lane & 3) << 3) | (((lane >> 2) & 3) << 6) | (((lane >> 4) & 1) << 5) | (((lane >> 5) & 1) << 8); }
constexpr int v_rd_off(int d0, int ks, int half) { return d0 * 512 + ks * 4096 + half * 2048; }
template <int OFF> __device__ __forceinline__ s16x4 tr_read(int vb) {
  s16x4 r; asm volatile("ds_read_b64_tr_b16 %0, %1 offset:%2" : "=&v"(r) : "v"(vb), "i"(OFF) : "memory"); return r;
}
template <int D0> __device__ __forceinline__ void pv_one(f32x16& od, int vb, bf16x8 pa0, bf16x8 pa1, bf16x8 pa2, bf16x8 pa3) {
  const s16x4 l0 = tr_read<v_rd_off(D0, 0, 0)>(vb), h0 = tr_read<v_rd_off(D0, 0, 1)>(vb), l1 = tr_read<v_rd_off(D0, 1, 0)>(vb), h1 = tr_read<v_rd_off(D0, 1, 1)>(vb);
  const s16x4 l2 = tr_read<v_rd_off(D0, 2, 0)>(vb), h2 = tr_read<v_rd_off(D0, 2, 1)>(vb), l3 = tr_read<v_rd_off(D0, 3, 0)>(vb), h3 = tr_read<v_rd_off(D0, 3, 1)>(vb);
  asm volatile("s_waitcnt lgkmcnt(0)" ::: "memory"); SBAR();
#define PK(L, H) (bf16x8){L[0], L[1], L[2], L[3], H[0], H[1], H[2], H[3]}
  od = __builtin_amdgcn_mfma_f32_32x32x16_bf16(pa0, PK(l0, h0), od, 0, 0, 0);
  od = __builtin_amdgcn_mfma_f32_32x32x16_bf16(pa1, PK(l1, h1), od, 0, 0, 0);
  od = __builtin_amdgcn_mfma_f32_32x32x16_bf16(pa2, PK(l2, h2), od, 0, 0, 0);
  od = __builtin_amdgcn_mfma_f32_32x32x16_bf16(pa3, PK(l3, h3), od, 0, 0, 0);
#undef PK
}
__device__ __forceinline__ void pv_d0(f32x16* o, int vb, bf16x8 pa0, bf16x8 pa1, bf16x8 pa2, bf16x8 pa3) {
  pv_one<0>(o[0], vb, pa0, pa1, pa2, pa3); pv_one<1>(o[1], vb, pa0, pa1, pa2, pa3); pv_one<2>(o[2], vb, pa0, pa1, pa2, pa3); pv_one<3>(o[3], vb, pa0, pa1, pa2, pa3);
}

template <typename TQ>
__device__ __forceinline__ void attn_dense_body(const TQ* __restrict__ Qb, const bf16* __restrict__ Kh, const bf16* __restrict__ Vh,
                                                bf16* __restrict__ Ob, int seq, char* lds, const int tid) {
  using St = Stage<bf16>; using SQ = Stage<TQ>;
  const int wid = tid >> 6, lane = tid & 63, r32 = lane & 31, hi = lane >> 5;
  bf16* V_lds = (bf16*)lds; bf16* K_lds = (bf16*)(lds + 2 * SHM_V);
  float* ws = (float*)(lds + 2 * SHM_V + 2 * SHM_K) + wid * 64; float* li_l = ws; float* al_l = ws + 32;
  float m_reg = -1e30f, l_reg = 0; f32x16 o[4] = {}; bf16x8 qr[8];
  const TQ* Qw = Qb + (long)(wid * QBLK + r32) * LDQ + hi * 8;
#pragma unroll
  for (int d0 = 0; d0 < 8; ++d0) qr[d0] = SQ::tobf(SQ::ld8(Qw + d0 * 16));
  const int sr = tid >> 4, sc = (tid & 15) * 8, vst0 = v_st(sr, sc), vst1 = v_st(32 + sr, sc);
  const int vb0 = (int)(uintptr_t)V_lds + v_rd_base(lane);
  struct { typename St::T vs0, vs1, ks0, ks1; } sr_[SDEPTH];
#define SLOAD(i, k0) do { sr_[i].vs0 = St::ld8(&Vh[(long)((k0) + sr) * LDK + sc]); sr_[i].vs1 = St::ld8(&Vh[(long)((k0) + 32 + sr) * LDK + sc]); \
    sr_[i].ks0 = St::ld8(&Kh[(long)((k0) + sr) * LDK + sc]); sr_[i].ks1 = St::ld8(&Kh[(long)((k0) + 32 + sr) * LDK + sc]); } while (0)
#define SWRITE(b, i) do { *(bf16x8*)((char*)V_lds + (b) * SHM_V + vst0) = St::tobf(sr_[i].vs0);          \
    *(bf16x8*)((char*)V_lds + (b) * SHM_V + vst1) = St::tobf(sr_[i].vs1); int kc = sc * 2;               \
    *(bf16x8*)((char*)K_lds + (b) * SHM_K + KSWZ(sr, kc)) = St::tobf(sr_[i].ks0);                       \
    *(bf16x8*)((char*)K_lds + (b) * SHM_K + KSWZ(32 + sr, kc)) = St::tobf(sr_[i].ks1); } while (0)
#define SWAIT() do { if constexpr (SDEPTH == 2) asm volatile("s_waitcnt vmcnt(4)" ::: "memory"); else asm volatile("s_waitcnt vmcnt(0)" ::: "memory"); } while (0)
#define RESC(a) do { if (__any((a) < 1.f)) { if (hi == 0) al_l[r32] = (a); asm volatile("s_waitcnt lgkmcnt(0)" ::: "memory"); \
    for (int d = 0; d < 4; ++d) for (int r = 0; r < 16; ++r) o[d][r] *= al_l[crow(r, hi)]; } } while (0)
  f32x16 pA0, pA1, pB0, pB1; float mnA, mnB, alA, alB; bf16x8 pa0, pa1, pa2, pa3; const int NT = seq / KVBLK;
  constexpr int SE = 0, SO = SDEPTH - 1;
  SLOAD(SE, 0); asm volatile("s_waitcnt vmcnt(0)" ::: "memory"); SWRITE(0, SE); __syncthreads();
  qkt(pA0, pA1, K_lds, qr, r32, hi); partialSM(pA0, pA1, m_reg, mnA, alA);
  SLOAD(SO, KVBLK); if constexpr (SDEPTH == 2) { if (2 < NT) SLOAD(SE, 2 * KVBLK); }
  SWAIT(); SWRITE(1, SO); __syncthreads();
  for (int j = 1; j + 1 < NT; j += 2) {
    SBAR(); qkt(pB0, pB1, (bf16*)((char*)K_lds + SHM_K), qr, r32, hi);
    finishSM(pA0, pA1, alA, l_reg, pa0, pa1, pa2, pa3); SBAR();
    SLOAD(SO, (j + SDEPTH) * KVBLK); SBAR();
    pv_d0(o, vb0, pa0, pa1, pa2, pa3); partialSM(pB0, pB1, m_reg, mnB, alB);
    __syncthreads(); SWAIT(); SWRITE(0, SE);
    RESC(alB); __syncthreads();
    SBAR(); qkt(pA0, pA1, K_lds, qr, r32, hi);
    finishSM(pB0, pB1, alB, l_reg, pa0, pa1, pa2, pa3); SBAR();
    if (SDEPTH == 1 || j + 3 < NT) SLOAD(SE, (j + 1 + SDEPTH) * KVBLK); SBAR();
    pv_d0(o, vb0 + (int)SHM_V, pa0, pa1, pa2, pa3); partialSM(pA0, pA1, m_reg, mnA, alA);
    __syncthreads(); SWAIT(); SWRITE(1, SO);
    RESC(alA); __syncthreads();
  }
  SBAR(); qkt(pB0, pB1, (bf16*)((char*)K_lds + SHM_K), qr, r32, hi);
  finishSM(pA0, pA1, alA, l_reg, pa0, pa1, pa2, pa3); SBAR();
  pv_d0(o, vb0, pa0, pa1, pa2, pa3); partialSM(pB0, pB1, m_reg, mnB, alB);
  __syncthreads(); RESC(alB);
  finishSM(pB0, pB1, alB, l_reg, pa0, pa1, pa2, pa3); SBAR();
  pv_d0(o, vb0 + (int)SHM_V, pa0, pa1, pa2, pa3);
  if (hi == 0) li_l[r32] = l_reg; asm volatile("s_waitcnt lgkmcnt(0)" ::: "memory");
  float rli[16];
#pragma unroll
  for (int r = 0; r < 16; ++r) rli[r] = __builtin_amdgcn_rcpf(li_l[crow(r, hi)]);
  bf16* Ow = Ob + (long)(wid * QBLK) * LDO;
#pragma unroll
  for (int r = 0; r < 16; ++r) { int orow = crow(r, hi);
    for (int d0 = 0; d0 < 4; ++d0) Ow[(long)orow * LDO + d0 * 32 + r32] = __float2bfloat16(o[d0][r] * rli[r]); }
#undef SLOAD
#undef SWRITE
#undef SWAIT
#undef RESC
}

#undef KSWZ
#undef SBAR
}
#define GAS __attribute__((address_space(1)))
#define LAS __attribute__((address_space(3)))
typedef unsigned short bf16;
typedef unsigned v4u __attribute__((ext_vector_type(4)));
typedef float f32x4 __attribute__((ext_vector_type(4)));
typedef short bf16x8 __attribute__((ext_vector_type(8)));
typedef GAS unsigned gu32;
typedef GAS unsigned long long gu64;
#define RLX_AGENT __ATOMIC_RELAXED, __HIP_MEMORY_SCOPE_AGENT
#define LDS_WAIT() asm volatile("s_waitcnt lgkmcnt(0)" ::: "memory")
#define VM_WAIT() asm volatile("s_waitcnt vmcnt(0)" ::: "memory")
__device__ __forceinline__ unsigned long long rt() { return __builtin_amdgcn_s_memrealtime(); }
__device__ __forceinline__ unsigned f2bf(float f) { unsigned u = __builtin_bit_cast(unsigned, f); return (u + 0x7fffu + ((u >> 16) & 1u)) >> 16; }
__device__ __forceinline__ unsigned pk2(float lo, float hi) { return f2bf(lo) | (f2bf(hi) << 16); }

#define XB_TMO      128
#define XB_XCNT(j)  (256  + 64 * (j))
#define XB_XSUB(j)  (1280 + 64 * (j))
#define XB_XGEN(j)  (2304 + 64 * (j))
#define XB_TOP      3328
#define XB_TOPGEN   3392
#define XCD_BAR_WORDS 3456
#define XB_SPIN_CAP (1u << 18)

__device__ __forceinline__ unsigned xb_ld(unsigned* p)              { return __hip_atomic_load(p, __ATOMIC_RELAXED, __HIP_MEMORY_SCOPE_AGENT); }
__device__ __forceinline__ unsigned xb_add(unsigned* p, unsigned v) { return __hip_atomic_fetch_add(p, v, __ATOMIC_RELAXED, __HIP_MEMORY_SCOPE_AGENT); }
__device__ __forceinline__ unsigned xb_xcc_id() { return (unsigned)__builtin_amdgcn_s_getreg((3 << 11) | 20) & 0xFu; }
#define XB_SPIN(cond, bar) do { unsigned _sp = 0; while (cond) { __builtin_amdgcn_s_sleep(1); \
    if ((++_sp & 255u) == 0u) { if (xb_ld(&(bar)[XB_TMO])) break; if (_sp > XB_SPIN_CAP) { atomicAdd(&(bar)[XB_TMO], 1u); break; } } } } while (0)

struct XcdBarrier {
    unsigned* bar; unsigned x;
    volatile LAS unsigned* st;
};

__device__ __forceinline__ XcdBarrier xcd_barrier_post(unsigned* bar, volatile LAS unsigned* st) {
    XcdBarrier b; b.bar = bar; b.x = xb_xcc_id(); b.st = st;
    if (threadIdx.x == 0) (void)xb_add(&bar[XB_XCNT(b.x)], 1u);
    return b;
}
__device__ __forceinline__ void xcd_barrier_complete(unsigned* bar, unsigned x, unsigned& nloc, unsigned& nx) {
    const unsigned G = gridDim.x * gridDim.y * gridDim.z;
    unsigned sum, cnt, mine, sp = 0u;
    for (;;) {
        sum = 0u; cnt = 0u; mine = 0u;
#pragma unroll
        for (unsigned j = 0; j < 16; ++j) { const unsigned c = xb_ld(&bar[XB_XCNT(j)]); sum += c; cnt += (c > 0u) ? 1u : 0u; mine = (j == x) ? c : mine; }
        if (sum == G) break;
        __builtin_amdgcn_s_sleep(1);
        if ((++sp & 255u) == 0u) { if (xb_ld(&bar[XB_TMO])) break; if (sp > XB_SPIN_CAP) { atomicAdd(&bar[XB_TMO], 1u); break; } }
    }
    nloc = mine > 0u ? mine : 1u; nx = cnt > 0u ? cnt : 1u;
}

__device__ __forceinline__ void xcd_barrier(const XcdBarrier& b, const int tid_) {
    asm volatile("s_waitcnt vmcnt(0)" ::: "memory");
    __syncthreads();
    if (tid_ == 0) {
        unsigned* bar = b.bar;
        __builtin_amdgcn_s_waitcnt(0);
        unsigned nloc = b.st[0], nx = b.st[1];
        if (nloc == 0u) { xcd_barrier_complete(bar, b.x, nloc, nx); b.st[0] = nloc; b.st[1] = nx; }
        const unsigned old = xb_add(&bar[XB_XSUB(b.x)], 1u);
        const unsigned gen = old / nloc;
        if (old + 1u == (gen + 1u) * nloc) {
            __builtin_amdgcn_fence(__ATOMIC_RELEASE, "agent");
            asm volatile("s_waitcnt vmcnt(0)" ::: "memory");
            const unsigned og = xb_add(&bar[XB_TOP], 1u);
            const unsigned tg = og / nx;
            if (og + 1u == (tg + 1u) * nx) xb_add(&bar[XB_TOPGEN], 1u);
            else XB_SPIN(xb_ld(&bar[XB_TOPGEN]) == tg, bar);
            __builtin_amdgcn_fence(__ATOMIC_ACQUIRE, "agent");
            xb_add(&bar[XB_XGEN(b.x)], 1u);
            asm volatile("s_waitcnt vmcnt(0)" ::: "memory");
        } else {
            XB_SPIN(xb_ld(&bar[XB_XGEN(b.x)]) == gen, bar);
            __builtin_amdgcn_fence(__ATOMIC_ACQUIRE, "agent");
            asm volatile("s_waitcnt vmcnt(0)" ::: "memory");
        }
    }
    __syncthreads();
}


constexpr size_t MiB = 1u << 20;
constexpr size_t WS_CTL = 0, CTL_ZERO_BYTES = 64 * 1024;
constexpr size_t WS_AFF = 1 * MiB;
constexpr size_t WS_COS = 2 * MiB, WS_SIN = 4 * MiB;
constexpr size_t WS_IDX = 6 * MiB, WS_GATE = 6 * MiB + 256 * 1024, WS_SEL = 7 * MiB;
constexpr size_t WS_WIN = 8 * MiB;
constexpr size_t WS_WR = 18 * MiB, WS_WA = 19 * MiB, WS_WO = 20 * MiB;
constexpr size_t WS_W1C = 22 * MiB;
constexpr size_t WS_WD = 198 * MiB;
constexpr size_t WS_X1 = 286 * MiB;
constexpr size_t WS_H = 350 * MiB;
constexpr size_t WS_RQ = 382 * MiB, WS_RK = 398 * MiB, WS_RV = 414 * MiB, WS_RGS = 430 * MiB;
constexpr size_t WS_AQ = 446 * MiB, WS_AK = 462 * MiB, WS_AV = 470 * MiB;
constexpr size_t WS_GRS = 478 * MiB, WS_GAS = 510 * MiB;
constexpr size_t WS_KV = 542 * MiB;
constexpr size_t WS_S = 606 * MiB;
constexpr size_t WS_YRIN = 638 * MiB, WS_ATT = 654 * MiB;
constexpr size_t WS_MIXED = 670 * MiB;
constexpr size_t WS_XE = 382 * MiB, WS_ACT = 446 * MiB, WS_Y = 622 * MiB;
constexpr size_t WS_END = 704 * MiB;
static_assert(EP_COS == WS_COS && EP_SIN == WS_SIN && EP_RQ == WS_RQ && EP_RK == WS_RK && EP_RV == WS_RV && EP_RGS == WS_RGS && EP_AQ == WS_AQ && EP_AK == WS_AK && EP_AV == WS_AV && EP_GRS == WS_GRS && EP_GAS == WS_GAS, "epilogue offsets vs d_ws map");
constexpr int CW_BAR = 4096;

constexpr int RING_OFF = 0, RING_BYTES = 131072;
constexpr int LDSCTL_OFF = RING_BYTES, MISC_OFF = LDSCTL_OFF + 320;
constexpr int XCH_OFF = RING_BYTES + 1024;
constexpr int LDS_BYTES = 147456;
constexpr int NWAVES = 8;

__device__ __forceinline__ float wave_sum(float v) {
#pragma unroll
    for (int o = 1; o < 64; o <<= 1) v += __shfl_xor(v, o);
    return v;
}
__device__ __forceinline__ float bf2f(bf16 v) { return __uint_as_float((unsigned)v << 16); }

template <class CM>
__device__ __forceinline__ void transpose_item(const float* W, int K, int N, bf16* WT, const CM cm, LAS float* scr, int kb, int nb, int lane) {
    const int k0 = 64 * kb, n0 = 32 * nb;
    const int srccol = cm(n0 + (lane & 31));
    float tv[32];
#pragma unroll
    for (int i = 0; i < 32; ++i) tv[i] = __builtin_nontemporal_load(W + (size_t)(k0 + 2 * i + (lane >> 5)) * N + srccol);
#pragma unroll
    for (int i = 0; i < 32; ++i) scr[(2 * i + (lane >> 5)) * 33 + (lane & 31)] = tv[i];
    LDS_WAIT(); asm volatile("" ::: "memory");
    const int c = lane & 7;
#pragma unroll
    for (int j = 0; j < 4; ++j) { const int n = (lane >> 3) + 8 * j; const LAS float* s = scr + (8 * c) * 33 + n;
        v4u o; o.x = pk2(s[0 * 33], s[1 * 33]); o.y = pk2(s[2 * 33], s[3 * 33]); o.z = pk2(s[4 * 33], s[5 * 33]); o.w = pk2(s[6 * 33], s[7 * 33]);
        __builtin_nontemporal_store(o, (GAS v4u*)(WT + (size_t)(n0 + n) * K + k0 + 8 * c)); }
    LDS_WAIT(); asm volatile("" ::: "memory");
}
__device__ __forceinline__ unsigned pk4_fp8(float a, float b, float c, float d) { int w = 0; w = __builtin_amdgcn_cvt_pk_fp8_f32(a, b, w, false); w = __builtin_amdgcn_cvt_pk_fp8_f32(c, d, w, true); return (unsigned)w; }
template <class CM>
__device__ __forceinline__ void transpose_item_f8(const float* W, int K, int N, unsigned char* WT, const CM cm, LAS float* scr, int kb, int nb, int lane, float scale) {
    const int k0 = 64 * kb, n0 = 32 * nb;
    const int srccol = cm(n0 + (lane & 31));
    float tv[32];
#pragma unroll
    for (int i = 0; i < 32; ++i) tv[i] = __builtin_nontemporal_load(W + (size_t)(k0 + 2 * i + (lane >> 5)) * N + srccol);
#pragma unroll
    for (int i = 0; i < 32; ++i) scr[(2 * i + (lane >> 5)) * 33 + (lane & 31)] = tv[i];
    LDS_WAIT(); asm volatile("" ::: "memory");
    const int c = lane & 7;
#pragma unroll
    for (int j = 0; j < 4; ++j) { const int n = (lane >> 3) + 8 * j; const LAS float* sp = scr + (8 * c) * 33 + n;
        const unsigned lo = pk4_fp8(sp[0 * 33] * scale, sp[1 * 33] * scale, sp[2 * 33] * scale, sp[3 * 33] * scale), hi = pk4_fp8(sp[4 * 33] * scale, sp[5 * 33] * scale, sp[6 * 33] * scale, sp[7 * 33] * scale);
        __builtin_nontemporal_store((unsigned long long)lo | ((unsigned long long)hi << 32), (GAS unsigned long long*)(WT + (size_t)(n0 + n) * K + k0 + 8 * c)); }
    LDS_WAIT(); asm volatile("" ::: "memory");
}
struct CmId { __device__ __forceinline__ int operator()(int n) const { return n; } };
struct CmWin {
    __device__ __forceinline__ int operator()(int n) const {
        const bool rope = (n < 1024) || (n >= 2048 && n < 2816);
        const int L = n & 127, g = L >> 3, i = L & 7, o = (i < 4) ? (4 * g + i) : (64 + 4 * g + (i - 4));
        return rope ? ((n & ~127) + o) : n; }
};
struct CmW1 { __device__ __forceinline__ int operator()(int n) const { return 128 * (n >> 8) + (n & 127); } };

__device__ __forceinline__ void rms_row_to_bf16(const float* xrow, const float* gain, bf16* orow, int lane) {
    const GAS f32x4* xr = (const GAS f32x4*)xrow + lane; const GAS f32x4* gr = (const GAS f32x4*)gain + lane;
    f32x4 v[4]; float s = 0.f;
#pragma unroll
    for (int j = 0; j < 4; ++j) { v[j] = xr[64 * j]; s += (v[j].x * v[j].x + v[j].y * v[j].y) + (v[j].z * v[j].z + v[j].w * v[j].w); }
    const float rstd = 1.f / sqrtf(wave_sum(s) * (1.f / D_MODEL) + EPS);
    GAS unsigned long long* o8 = (GAS unsigned long long*)orow + lane;
#pragma unroll
    for (int j = 0; j < 4; ++j) { const f32x4 g4 = gr[64 * j]; o8[64 * j] = (unsigned long long)pk2(v[j].x * rstd * g4.x, v[j].y * rstd * g4.y) | ((unsigned long long)pk2(v[j].z * rstd * g4.z, v[j].w * rstd * g4.w) << 32); }
}


namespace ret {
typedef short bf16x8 __attribute__((ext_vector_type(8)));
typedef short v4i16 __attribute__((ext_vector_type(4)));
constexpr int PITCH = 272;
constexpr int TILE_B = 128 * PITCH;
constexpr int STRIP_B = 16 * PITCH;
__device__ __forceinline__ float lg2_of(const float* p, int h) { return log1pf(-expf(p[h])) * 1.4426950408889634f; }
__device__ __forceinline__ unsigned cvt2(float lo, float hi) { typedef float f2 __attribute__((ext_vector_type(2))); typedef __bf16 b2 __attribute__((ext_vector_type(2))); f2 v = {lo, hi}; b2 b = __builtin_convertvector(v, b2); return __builtin_bit_cast(unsigned, b); }
__device__ __forceinline__ bf16x8 frag_tr(LAS const unsigned char* tile, int k0, int n0, int lane) {
    const int g = lane >> 4, q = (lane >> 2) & 3, p = lane & 3;
    LAS const unsigned char* a = tile + (k0 + 8 * g + q) * PITCH + (n0 + 4 * p) * 2;
    const v4i16 lo = __builtin_amdgcn_ds_read_tr16_b64_v4i16((LAS v4i16*)a);
    const v4i16 hi = __builtin_amdgcn_ds_read_tr16_b64_v4i16((LAS v4i16*)(a + 4 * PITCH));
    return (bf16x8){lo[0], lo[1], lo[2], lo[3], hi[0], hi[1], hi[2], hi[3]};
}
__device__ __forceinline__ bf16x8 frag_row(LAS const unsigned char* tile, int r0, int k0, int lane) { return *(LAS const bf16x8*)(tile + (r0 + (lane & 15)) * PITCH + (k0 + 8 * (lane >> 4)) * 2); }
__device__ __forceinline__ void stage_tile(LAS unsigned char* tile, const bf16* src, long tok0, int h, int tid) {
#pragma unroll
    for (int i = 0; i < 4; ++i) { const int q = tid + 512 * i, row = q >> 4, ch = q & 15;
        const v4u v = *(const GAS v4u*)(src + (tok0 + row) * 512 + h * HD + ch * 8); *(LAS v4u*)(tile + row * PITCH + ch * 16) = v; }
}
__device__ __forceinline__ void kv_item(int item, LAS unsigned char* lds, const bf16* rk, const bf16* rv, const float* pf, const float* pb, float* kv, int tid) {
    asm volatile("" : "+v"(tid));
    const int c = item & 63, bh = item >> 6, b = bh >> 2, h = bh & 3, lane = tid & 63, w = tid >> 6, g = lane >> 4;
    const long tok0 = (long)b * SEQ + (long)c * CHUNK;
    LAS unsigned char* Kl = lds; LAS unsigned char* Vl = lds + TILE_B;
    stage_tile(Kl, rk, tok0, h, tid); stage_tile(Vl, rv, tok0, h, tid);
    __syncthreads();
    const float lf = lg2_of(pf, h), lb = lg2_of(pb, h);
    f32x4 accf[8], accb[8];
#pragma unroll
    for (int n = 0; n < 8; ++n) { accf[n] = (f32x4){0.f, 0.f, 0.f, 0.f}; accb[n] = (f32x4){0.f, 0.f, 0.f, 0.f}; }
#pragma unroll
    for (int kk = 0; kk < 4; ++kk) {
        const bf16x8 a = frag_tr(Vl, 32 * kk, 16 * w, lane);
        bf16x8 af, ab;
        { unsigned pf_[4], pb_[4];
#pragma unroll
          for (int t = 0; t < 8; t += 2) { const int j = 32 * kk + 8 * g + t;
              const float v0 = __uint_as_float((unsigned)(unsigned short)a[t] << 16), v1 = __uint_as_float((unsigned)(unsigned short)a[t + 1] << 16);
              pf_[t >> 1] = cvt2(v0 * __builtin_amdgcn_exp2f(lf * (float)(127 - j)), v1 * __builtin_amdgcn_exp2f(lf * (float)(126 - j)));
              pb_[t >> 1] = cvt2(v0 * __builtin_amdgcn_exp2f(lb * (float)j), v1 * __builtin_amdgcn_exp2f(lb * (float)(j + 1))); }
          const v4u wf_ = {pf_[0], pf_[1], pf_[2], pf_[3]}, wb_ = {pb_[0], pb_[1], pb_[2], pb_[3]};
          af = __builtin_bit_cast(bf16x8, wf_); ab = __builtin_bit_cast(bf16x8, wb_); }
#pragma unroll
        for (int n = 0; n < 8; ++n) { const bf16x8 bk = frag_tr(Kl, 32 * kk, 16 * n, lane);
            accf[n] = __builtin_amdgcn_mfma_f32_16x16x32_bf16(af, bk, accf[n], 0, 0, 0); accb[n] = __builtin_amdgcn_mfma_f32_16x16x32_bf16(ab, bk, accb[n], 0, 0, 0); }
    }
    float* of = kv + (((long)0 * 8 + bh) * NCHUNK + c) * (HD * HD); float* ob = kv + (((long)1 * 8 + bh) * NCHUNK + c) * (HD * HD);
#pragma unroll
    for (int n = 0; n < 8; ++n)
#pragma unroll
        for (int r = 0; r < 4; ++r) { const int o = (16 * w + 4 * g + r) * HD + 16 * n + (lane & 15); of[o] = accf[n][r]; ob[o] = accb[n][r]; }
    __syncthreads();
}
__device__ __forceinline__ void scan_thread(long gid, const float* pf, const float* pb, const float* kv, bf16* S) {
    const int el = (int)(gid & 16383), bh = (int)((gid >> 14) & 7), dir = (int)(gid >> 17), h = bh & 3;
    const float gC = __builtin_amdgcn_exp2f(lg2_of(dir ? pb : pf, h) * (float)CHUNK);
    const float* p = kv + (((long)dir * 8 + bh) * NCHUNK) * (HD * HD) + el; bf16* o = S + (((long)dir * 8 + bh) * NCHUNK) * (HD * HD) + el;
    float st = 0.f;
    if (dir == 0) {
#pragma unroll 8
        for (int c = 0; c < NCHUNK; ++c) { const float v = p[(long)c * HD * HD]; o[(long)c * HD * HD] = (bf16)f2bf(st); st = st * gC + v; } }
    else {
#pragma unroll 8
        for (int c = NCHUNK - 1; c >= 0; --c) { const float v = p[(long)c * HD * HD]; o[(long)c * HD * HD] = (bf16)f2bf(st); st = st * gC + v; } }
}
__device__ __forceinline__ void out_item(int item, LAS unsigned char* lds, const bf16* rq, const bf16* rk, const bf16* rv, const bf16* rgs, const float* pf, const float* pb,
                                         const bf16* S, const float* gain, bf16* yrin, int tid) {
    asm volatile("" : "+v"(tid));
    const int c = item & 63, bh = item >> 6, b = bh >> 2, h = bh & 3, lane = tid & 63, w = tid >> 6, g = lane >> 4, lc = lane & 15;
    const long tok0 = (long)b * SEQ + (long)c * CHUNK;
    LAS unsigned char* Kl = lds; LAS unsigned char* Vl = lds + TILE_B; LAS unsigned char* strip = lds + 2 * TILE_B + w * STRIP_B;
    stage_tile(Kl, rk, tok0, h, tid); stage_tile(Vl, rv, tok0, h, tid);
    bf16x8 qa[4];
#pragma unroll
    for (int kk = 0; kk < 4; ++kk) qa[kk] = *(const GAS bf16x8*)(rq + (tok0 + 16 * w + lc) * 512 + h * HD + 32 * kk + 8 * g);
    __syncthreads();
    const float lf = lg2_of(pf, h), lb = lg2_of(pb, h);
    {
        f32x4 sc[8];
#pragma unroll
        for (int n = 0; n < 8; ++n) { sc[n] = (f32x4){0.f, 0.f, 0.f, 0.f};
#pragma unroll
            for (int kk = 0; kk < 4; ++kk) sc[n] = __builtin_amdgcn_mfma_f32_16x16x32_bf16(qa[kk], frag_row(Kl, 16 * n, 32 * kk, lane), sc[n], 0, 0, 0); }
#pragma unroll
        for (int n = 0; n < 8; ++n)
#pragma unroll
            for (int r = 0; r < 4; ++r) { const int i = 16 * w + 4 * g + r, j = 16 * n + lc; const int df = i - j;
                const float dec = __builtin_amdgcn_exp2f(df >= 0 ? lf * (float)df : lb * (float)(-df));
                *(LAS unsigned short*)(strip + (4 * g + r) * PITCH + j * 2) = (unsigned short)f2bf(sc[n][r] * dec); }
    }
    asm volatile("s_waitcnt lgkmcnt(0)" ::: "memory");
    bf16x8 qf[4], qb[4];
    { const int ia = 16 * w + lc; const float cf = __builtin_amdgcn_exp2f(lf * (float)(ia + 1)), cb = __builtin_amdgcn_exp2f(lb * (float)(CHUNK - ia));
#pragma unroll
      for (int kk = 0; kk < 4; ++kk) { unsigned pf_[4], pb_[4];
#pragma unroll
          for (int t = 0; t < 8; t += 2) { const float v0 = __uint_as_float((unsigned)(unsigned short)qa[kk][t] << 16), v1 = __uint_as_float((unsigned)(unsigned short)qa[kk][t + 1] << 16);
              pf_[t >> 1] = cvt2(v0 * cf, v1 * cf); pb_[t >> 1] = cvt2(v0 * cb, v1 * cb); }
          const v4u wf_ = {pf_[0], pf_[1], pf_[2], pf_[3]}, wb_ = {pb_[0], pb_[1], pb_[2], pb_[3]};
          qf[kk] = __builtin_bit_cast(bf16x8, wf_); qb[kk] = __builtin_bit_cast(bf16x8, wb_); } }
    f32x4 o[8];
#pragma unroll
    for (int n = 0; n < 8; ++n) o[n] = (f32x4){0.f, 0.f, 0.f, 0.f};
    const bf16* Sf = S + (((long)0 * 8 + bh) * NCHUNK + c) * (HD * HD); const bf16* Sb = S + (((long)1 * 8 + bh) * NCHUNK + c) * (HD * HD);
#pragma unroll
    for (int kh = 0; kh < 2; ++kh) {
        bf16x8 bfv[2][8], bbv[2][8];
#pragma unroll
        for (int k2 = 0; k2 < 2; ++k2)
#pragma unroll
            for (int n = 0; n < 8; ++n) { const int kk = 2 * kh + k2; bfv[k2][n] = *(const GAS bf16x8*)(Sf + (16 * n + lc) * HD + 32 * kk + 8 * g); bbv[k2][n] = *(const GAS bf16x8*)(Sb + (16 * n + lc) * HD + 32 * kk + 8 * g); }
#pragma unroll
        for (int k2 = 0; k2 < 2; ++k2) { const int kk = 2 * kh + k2;
            const bf16x8 sa = frag_row(strip, 0, 32 * kk, lane);
#pragma unroll
            for (int n = 0; n < 8; ++n) {
                o[n] = __builtin_amdgcn_mfma_f32_16x16x32_bf16(sa, frag_tr(Vl, 32 * kk, 16 * n, lane), o[n], 0, 0, 0);
                o[n] = __builtin_amdgcn_mfma_f32_16x16x32_bf16(qf[kk], bfv[k2][n], o[n], 0, 0, 0); o[n] = __builtin_amdgcn_mfma_f32_16x16x32_bf16(qb[kk], bbv[k2][n], o[n], 0, 0, 0); } }
        asm volatile("" ::: "memory");
    }
    asm volatile("s_waitcnt lgkmcnt(0)" ::: "memory");
#pragma unroll
    for (int r = 0; r < 4; ++r) {
        float y[8]; float s = 0.f;
#pragma unroll
        for (int n = 0; n < 8; ++n) { y[n] = o[n][r]; s += y[n]; }
        s += __shfl_xor(s, 1); s += __shfl_xor(s, 2); s += __shfl_xor(s, 4); s += __shfl_xor(s, 8);
        const float mu = s * (1.0f / HD); float s2 = 0.f;
#pragma unroll
        for (int n = 0; n < 8; ++n) { y[n] -= mu; s2 += y[n] * y[n]; }
        s2 += __shfl_xor(s2, 1); s2 += __shfl_xor(s2, 2); s2 += __shfl_xor(s2, 4); s2 += __shfl_xor(s2, 8);
        const float rstd = 1.0f / sqrtf(s2 * (1.0f / HD) + EPS);
#pragma unroll
        for (int n = 0; n < 8; ++n) *(LAS unsigned short*)(strip + (4 * g + r) * PITCH + (16 * n + lc) * 2) = (unsigned short)f2bf(y[n] * rstd); }
    asm volatile("s_waitcnt lgkmcnt(0)" ::: "memory");
    { const int row = lane >> 2, qc = lane & 3; const long ro = (tok0 + 16 * w + row) * 512 + h * HD;
#pragma unroll
      for (int t = 0; t < 4; ++t) { const int e0 = 32 * qc + 8 * t;
          const v4u yv = *(LAS const v4u*)(strip + row * PITCH + e0 * 2);
          const f32x4 y0 = {__uint_as_float(yv.x << 16), __uint_as_float(yv.x & 0xffff0000u), __uint_as_float(yv.y << 16), __uint_as_float(yv.y & 0xffff0000u)};
          const f32x4 y1 = {__uint_as_float(yv.z << 16), __uint_as_float(yv.z & 0xffff0000u), __uint_as_float(yv.w << 16), __uint_as_float(yv.w & 0xffff0000u)};
          const f32x4 g0 = *(const GAS f32x4*)(gain + h * HD + e0), g1 = *(const GAS f32x4*)(gain + h * HD + e0 + 4);
          const v4u rg = *(const GAS v4u*)(rgs + ro + e0);
          const f32x4 r0 = {__uint_as_float(rg.x << 16), __uint_as_float(rg.x & 0xffff0000u), __uint_as_float(rg.y << 16), __uint_as_float(rg.y & 0xffff0000u)};
          const f32x4 r1 = {__uint_as_float(rg.z << 16), __uint_as_float(rg.z & 0xffff0000u), __uint_as_float(rg.w << 16), __uint_as_float(rg.w & 0xffff0000u)};
          const f32x4 a0 = y0 * g0 * r0, a1 = y1 * g1 * r1;
          v4u ov; ov.x = cvt2(a0[0], a0[1]); ov.y = cvt2(a0[2], a0[3]); ov.z = cvt2(a1[0], a1[1]); ov.w = cvt2(a1[2], a1[3]);
          *(GAS v4u*)(yrin + ro + e0) = ov; } }
    __syncthreads();
}
}

struct Args { const float* in[17]; float* out; unsigned char* ws; int ph_lo, ph_hi; };
constexpr int PH_PROLOGUE = 0, PH_PROJ = 1, PH_RETKV = 2, PH_ATTN = 3, PH_RETOUT = 4, PH_BRANCH = 5, PH_WO = 6, PH_ROUTER = 7, PH_TOPK = 8, PH_GATHER = 9, PH_MOE1 = 10, PH_MOE2 = 11, PH_FINAL = 12, PH_END = 13;
#ifndef MK_EXPERT_CVT
#define MK_EXPERT_CVT 1
#endif

__global__ void __launch_bounds__(NWAVES * 64, 2) mega(Args args) {
    extern __shared__ __attribute__((aligned(16))) unsigned char lds_raw[];
    LAS unsigned char* lds = (LAS unsigned char*)lds_raw;
    volatile LAS unsigned* MISC = (volatile LAS unsigned*)(lds + MISC_OFF);
    const int wave = __builtin_amdgcn_readfirstlane((int)threadIdx.x >> 6);
#define PHASE_IDS int lane; asm volatile("v_mbcnt_lo_u32_b32 %0, -1, 0\n\tv_mbcnt_hi_u32_b32 %0, -1, %0" : "=v"(lane)); const int tid = wave * 64 + lane; (void)tid;
    const int G = gridDim.x; const int bx = blockIdx.x; const int vcu = (G % 8 == 0) ? (bx % 8) * (G / 8) + bx / 8 : bx;
    unsigned char* ws = args.ws;
    gu32* ctl = (gu32*)(ws + WS_CTL);
    for (int u = threadIdx.x; u < (LDS_BYTES - LDSCTL_OFF) / 4; u += NWAVES * 64) ((LAS unsigned*)(lds + LDSCTL_OFF))[u] = 0u;
    __syncthreads();
    const bool one_launch = (args.ph_hi - args.ph_lo) > 1;
    XcdBarrier bar; bar.bar = (unsigned*)(ctl + CW_BAR); bar.x = 0; bar.st = nullptr;
    if (one_launch) bar = xcd_barrier_post((unsigned*)(ctl + CW_BAR), MISC + 8);
    const int lo = args.ph_lo, hi = args.ph_hi;
#define IN(k) (lo <= (k) && (k) < hi)
#define SEAM(k) do { if (IN(k) && IN((k) + 1)) { PHASE_IDS xcd_barrier(bar, tid); } } while (0)
    const int gw = vcu * NWAVES + wave, NGW = G * NWAVES;

    if (IN(PH_PROLOGUE)) { PHASE_IDS
        LAS float* scr = (LAS float*)(lds + RING_OFF + wave * 16384);
        const float* w_in = args.in[2]; const float* w_ret = args.in[6]; const float* w_att = args.in[9]; const float* w_o = args.in[10];
        const float* wg = args.in[13]; const float* wu = args.in[14];
        constexpr int I_IN = 16 * 160, I_R = 8 * 32, I_A = 8 * 32, I_O = 16 * 32, I_1 = 16 * 176;
        constexpr int NSMALL = I_IN + I_R + I_A + I_O;
        const int NITEMS = NSMALL + NE * I_1;
        for (int it = gw; it < NITEMS; it += NGW) {
            int r = it;
            if (r < I_IN) { transpose_item(w_in, 1024, INW, (bf16*)(ws + WS_WIN), CmWin(), scr, r / 160, r % 160, lane); continue; } r -= I_IN;
            if (r < I_R) { transpose_item(w_ret, 512, D_MODEL, (bf16*)(ws + WS_WR), CmId(), scr, r / 32, r % 32, lane); continue; } r -= I_R;
            if (r < I_A) { transpose_item(w_att, 512, D_MODEL, (bf16*)(ws + WS_WA), CmId(), scr, r / 32, r % 32, lane); continue; } r -= I_A;
            if (r < I_O) { transpose_item(w_o, 1024, D_MODEL, (bf16*)(ws + WS_WO), CmId(), scr, r / 32, r % 32, lane); continue; } r -= I_O;
            { const int e = r / I_1, q = r % I_1, kb = q / 176, nb = q % 176; const bool up = (nb >> 2) & 1;
                transpose_item_f8((up ? wu : wg) + (size_t)e * D_MODEL * FF, 1024, FF, (unsigned char*)(ws + WS_W1C) + (size_t)e * 5632 * 1024, CmW1(), scr, kb, nb, lane, W1_SCALE); }
        }
        for (int m = gw; m < T; m += NGW) rms_row_to_bf16(args.in[0] + (size_t)m * D_MODEL, args.in[1], (bf16*)(ws + WS_H) + (size_t)m * D_MODEL, lane);
        { float* ct = (float*)(ws + WS_COS); float* st = (float*)(ws + WS_SIN);
          for (int e = (vcu * NWAVES * 64) + tid; e < SEQ * 64; e += G * NWAVES * 64) { const int pos = e >> 6, j = e & 63;
              const float freq = powf(10000.0f, -(float)(j & 31) / 32.0f); const float ang = (float)(j < 32 ? (pos >> 6) : (pos & 63)) * freq;
              ct[e] = cosf(ang); st[e] = sinf(ang); } }
    }
    SEAM(PH_PROLOGUE);

    if (IN(PH_PROJ)) { PHASE_IDS
        pg8::PlainSched S; S.init(T, INW, G, bx); S.A = (const char*)(ws + WS_H); S.Bt = (const char*)(ws + WS_WIN); S.tstep = (size_t)256 * 1024 * 2;
        pg8::EpiProj E; E.wsb = ws; E.qn = args.in[7]; E.kn = args.in[8]; E.xch = (LAS float*)(lds + XCH_OFF); E.epoch = 0u;
        pg8::gemm_phase<pg8::EpiProj, pg8::PlainSched, true, true>(lds + RING_OFF, 1024, S, E, tid);
    }
    SEAM(PH_PROJ);

    if (IN(PH_RETKV)) { PHASE_IDS
        for (int item = vcu; item < 8 * NCHUNK; item += G)
            ret::kv_item(item, lds + RING_OFF, (const bf16*)(ws + WS_RK), (const bf16*)(ws + WS_RV), args.in[3], args.in[4], (float*)(ws + WS_KV), tid);
    }
    SEAM(PH_RETKV);

    if (IN(PH_ATTN)) { PHASE_IDS
        for (long gid = (long)vcu * 512 + tid; gid < 2 * 8 * 16384; gid += (long)G * 512) ret::scan_thread(gid, args.in[3], args.in[4], (const float*)(ws + WS_KV), (bf16*)(ws + WS_S));
    }

    if (IN(PH_ATTN)) { PHASE_IDS
        for (int u = vcu; u < BATCH * 4 * (SEQ / 256); u += G) {
            const int bh = u >> 5, qb = u & 31, b = bh >> 2, h = bh & 3, kvh = h >> 1;
            const size_t q0 = ((size_t)b * SEQ + (size_t)qb * 256) * 512 + (size_t)h * 128, k0 = (size_t)b * SEQ * 256 + (size_t)kvh * 128;
            attn::attn_dense_body<attn::bf16>((const attn::bf16*)(ws + WS_AQ) + q0, (const attn::bf16*)(ws + WS_AK) + k0, (const attn::bf16*)(ws + WS_AV) + k0,
                                              (attn::bf16*)(ws + WS_ATT) + q0, SEQ, (char*)lds_raw, tid);
            __syncthreads();
        }
    }
    SEAM(PH_ATTN);

    if (IN(PH_RETOUT)) { PHASE_IDS
        for (int item = vcu; item < 8 * NCHUNK; item += G)
            ret::out_item(item, lds + RING_OFF, (const bf16*)(ws + WS_RQ), (const bf16*)(ws + WS_RK), (const bf16*)(ws + WS_RV), (const bf16*)(ws + WS_RGS), args.in[3], args.in[4],
                          (const bf16*)(ws + WS_S), args.in[5], (bf16*)(ws + WS_YRIN), tid);
    }
    SEAM(PH_RETOUT);

    if (IN(PH_BRANCH)) { PHASE_IDS
        pg8::BranchSched S; S.init(T, D_MODEL, G, bx); S.A0 = (const char*)(ws + WS_YRIN); S.A1 = (const char*)(ws + WS_ATT); S.B0 = (const char*)(ws + WS_WR); S.B1 = (const char*)(ws + WS_WA); S.tstep = (size_t)256 * 512 * 2;
        pg8::EpiBranch E; E.grs = (const bf16*)(ws + WS_GRS); E.gas = (const bf16*)(ws + WS_GAS); E.mixed = (bf16*)(ws + WS_MIXED);
        pg8::gemm_phase<pg8::EpiBranch, pg8::BranchSched, true, true>(lds + RING_OFF, 512, S, E, tid);
    }
    SEAM(PH_BRANCH);

    if (IN(PH_WO)) { PHASE_IDS
        pg8::PlainSched S; S.init(T, D_MODEL, G, bx); S.A = (const char*)(ws + WS_MIXED); S.Bt = (const char*)(ws + WS_WO); S.tstep = (size_t)256 * 1024 * 2;
        pg8::EpiResid E; E.x = args.in[0]; E.x1 = (float*)(ws + WS_X1);
        pg8::gemm_phase<pg8::EpiResid, pg8::PlainSched, true, true>(lds + RING_OFF, 1024, S, E, tid);
    }
    SEAM(PH_WO);

    if (IN(PH_ROUTER)) { PHASE_IDS
        LAS float* wl = (LAS float*)(lds + RING_OFF);
        { const GAS float* src = (const GAS float*)args.in[12]; for (int i = tid; i < 1024 * 16; i += NWAVES * 64) wl[(i & 15) * 1024 + (i >> 4)] = src[i]; }
        __syncthreads();
        const float* x1 = (const float*)(ws + WS_X1); const float* gain = args.in[11]; bf16* h2 = (bf16*)(ws + WS_H); float* aff = (float*)(ws + WS_AFF);
        const GAS f32x4* gr = (const GAS f32x4*)gain + lane;
        f32x4 v[4];
        if (gw < T) { const GAS f32x4* xr = (const GAS f32x4*)(x1 + (size_t)gw * D_MODEL) + lane;
#pragma unroll
            for (int j = 0; j < 4; ++j) v[j] = xr[64 * j]; }
        for (int m = gw; m < T; m += NGW) {
            f32x4 nv[4];
            { const int mn = (m + NGW < T) ? m + NGW : m; const GAS f32x4* xn = (const GAS f32x4*)(x1 + (size_t)mn * D_MODEL) + lane;
#pragma unroll
              for (int j = 0; j < 4; ++j) nv[j] = xn[64 * j]; }
            float s = 0.f;
#pragma unroll
            for (int j = 0; j < 4; ++j) s += (v[j].x * v[j].x + v[j].y * v[j].y) + (v[j].z * v[j].z + v[j].w * v[j].w);
            const float rstd = 1.f / sqrtf(wave_sum(s) * (1.f / D_MODEL) + EPS);
            float lg[NE];
#pragma unroll
            for (int e = 0; e < NE; ++e) lg[e] = 0.f;
            GAS unsigned* o4 = (GAS unsigned*)((unsigned char*)h2 + (size_t)m * D_MODEL) + lane;
#pragma unroll
            for (int j = 0; j < 4; ++j) { const f32x4 g4 = gr[64 * j]; const f32x4 hv = v[j] * g4 * rstd;
                o4[64 * j] = pk4_fp8(hv.x, hv.y, hv.z, hv.w);
#pragma unroll
                for (int e = 0; e < NE; ++e) { const f32x4 w = *(const LAS f32x4*)(wl + e * 1024 + 4 * lane + 256 * j); lg[e] += (hv.x * w.x + hv.y * w.y) + (hv.z * w.z + hv.w * w.w); if ((e & 3) == 3) asm volatile("" ::: "memory"); }
                asm volatile("" ::: "memory"); }
            float r8[8], r4[4], r2[2], r1;
            { const bool b = (lane & 32) != 0;
#pragma unroll
              for (int e = 0; e < 8; ++e) { const float keep = b ? lg[e + 8] : lg[e], send = b ? lg[e] : lg[e + 8]; r8[e] = keep + __shfl_xor(send, 32); } }
            { const bool b = (lane & 16) != 0;
#pragma unroll
              for (int e = 0; e < 4; ++e) { const float keep = b ? r8[e + 4] : r8[e], send = b ? r8[e] : r8[e + 4]; r4[e] = keep + __shfl_xor(send, 16); } }
            { const bool b = (lane & 8) != 0;
#pragma unroll
              for (int e = 0; e < 2; ++e) { const float keep = b ? r4[e + 2] : r4[e], send = b ? r4[e] : r4[e + 2]; r2[e] = keep + __shfl_xor(send, 8); } }
            { const bool b = (lane & 4) != 0; const float keep = b ? r2[1] : r2[0], send = b ? r2[0] : r2[1]; r1 = keep + __shfl_xor(send, 4); }
            r1 += __shfl_xor(r1, 2); r1 += __shfl_xor(r1, 1);
            float mx = r1; mx = fmaxf(mx, __shfl_xor(mx, 4)); mx = fmaxf(mx, __shfl_xor(mx, 8)); mx = fmaxf(mx, __shfl_xor(mx, 16)); mx = fmaxf(mx, __shfl_xor(mx, 32));
            const float pe = expf(r1 - mx); float den = pe; den += __shfl_xor(den, 4); den += __shfl_xor(den, 8); den += __shfl_xor(den, 16); den += __shfl_xor(den, 32);
            if ((lane & 3) == 0) aff[(size_t)m * NE + (((lane >> 5) & 1) * 8 + ((lane >> 4) & 1) * 4 + ((lane >> 3) & 1) * 2 + ((lane >> 2) & 1))] = pe / den;
#pragma unroll
            for (int j = 0; j < 4; ++j) v[j] = nv[j];
        }
        __syncthreads();
    }
    SEAM(PH_ROUTER);

    if (IN(PH_TOPK)) { PHASE_IDS
        if (vcu >= NZ) {
            const int lane_c = lane;
            LAS float* scr = (LAS float*)(lds + RING_OFF + wave * 16384); const float* wd = args.in[15]; constexpr int I_D = 44 * 32;
            for (int it = (vcu - NZ) * NWAVES + wave; it < NE * I_D; it += (G - NZ) * NWAVES) { const int e = it / I_D, q = it % I_D;
                transpose_item_f8(wd + (size_t)e * FF * D_MODEL, FF, D_MODEL, (unsigned char*)(ws + WS_WD) + (size_t)e * 1024 * FF, CmId(), scr, q / 32, q % 32, lane_c, WD_SCALE); }
        }
        LAS unsigned* keys = (LAS unsigned*)(lds + RING_OFF); LAS int* hist = (LAS int*)(lds + RING_OFF + 32768); LAS int* sc = (LAS int*)(lds + RING_OFF + 34816); volatile LAS unsigned* sv = (volatile LAS unsigned*)(lds + RING_OFF + 36864);
        const float* aff = (const float*)(ws + WS_AFF); int* idx = (int*)(ws + WS_IDX); float* gate = (float*)(ws + WS_GATE); int* sel = (int*)(ws + WS_SEL);
        for (int z = vcu; z < NZ; z += G) {
            const int b = z / NE, e = z % NE;
            for (int i = tid; i < SEQ; i += 512) keys[i] = __float_as_uint(aff[((size_t)b * SEQ + i) * NE + e]);
            if (tid == 0) { sv[0] = 0u; sv[1] = (unsigned)CAP; }
            __syncthreads();
            unsigned mask = 0u;
            for (int pass = 3; pass >= 0; --pass) {
                const int shift = pass * 8;
                if (tid < 256) hist[tid] = 0;
                __syncthreads();
                const unsigned prefix = sv[0];
                for (int i = tid; i < SEQ; i += 512) { const unsigned k = keys[i]; if ((k & mask) == prefix) atomicAdd((int*)&hist[(k >> shift) & 255u], 1); }
                __syncthreads();
                if (tid < 64) {
                    const int krem = (int)sv[1]; const int h0 = hist[4 * tid], h1 = hist[4 * tid + 1], h2 = hist[4 * tid + 2], h3 = hist[4 * tid + 3];
                    int suf = h0 + h1 + h2 + h3;
#pragma unroll
                    for (int o = 1; o < 64; o <<= 1) { const int t = __shfl_down(suf, o); if (tid + o < 64) suf += t; }
                    int cum = suf - (h0 + h1 + h2 + h3);
                    int dsel = -1, cumsel = 0;
                    if (cum < krem && cum + h3 >= krem) { dsel = 3; cumsel = cum; } cum += h3;
                    if (dsel < 0 && cum < krem && cum + h2 >= krem) { dsel = 2; cumsel = cum; } cum += h2;
                    if (dsel < 0 && cum < krem && cum + h1 >= krem) { dsel = 1; cumsel = cum; } cum += h1;
                    if (dsel < 0 && cum < krem && cum + h0 >= krem) { dsel = 0; cumsel = cum; }
                    if (dsel >= 0) { sv[1] = (unsigned)(krem - cumsel); sv[0] = prefix | ((unsigned)(4 * tid + dsel) << shift); }
                }
                __syncthreads();
                mask |= 0xFFu << shift;
            }
            const unsigned Tk = sv[0]; const int krem = (int)sv[1];
            int cgt = 0, ceq = 0;
            for (int q = 0; q < 16; ++q) { const unsigned k = keys[tid * 16 + q]; cgt += (k > Tk); ceq += (k == Tk); }
            int eqbase, slot;
            { sc[tid] = ceq; __syncthreads(); for (int off = 1; off < 512; off <<= 1) { const int t = (tid >= off) ? sc[tid - off] : 0; __syncthreads(); sc[tid] += t; __syncthreads(); } eqbase = sc[tid] - ceq; __syncthreads(); }
            int take = krem - eqbase; take = take < 0 ? 0 : (take > ceq ? ceq : take);
            { const int v = cgt + take; sc[tid] = v; __syncthreads(); for (int off = 1; off < 512; off <<= 1) { const int t = (tid >= off) ? sc[tid - off] : 0; __syncthreads(); sc[tid] += t; __syncthreads(); } slot = sc[tid] - v; __syncthreads(); }
            int eqr = eqbase;
            for (int q = 0; q < 16; ++q) { const int i = tid * 16 + q; const unsigned k = keys[i]; bool tk = k > Tk; if (k == Tk) { tk = eqr < krem; ++eqr; }
                if (tk) { idx[z * CAP + slot] = i; gate[z * CAP + slot] = __uint_as_float(k); sel[((size_t)b * SEQ + i) * NE + e] = slot; ++slot; } else sel[((size_t)b * SEQ + i) * NE + e] = -1; }
            __syncthreads();
        }
    }
    SEAM(PH_TOPK);


    if (IN(PH_MOE1)) { PHASE_IDS
        pg8::MoeGatherSched S; S.init(NZ * CAP, 5632, G, bx); S.A = (const char*)(ws + WS_H); S.Bt = (const char*)(ws + WS_W1C); S.idx = (const int*)(ws + WS_IDX);
        pg8::EpiSwiglu E; E.act = (unsigned char*)(ws + WS_ACT); E.in_scale = 1.0f / W1_SCALE; E.act_scale = ACT_SCALE;
        pg8::gemm_phase<pg8::EpiSwiglu, pg8::MoeGatherSched, true, true, true>(lds + RING_OFF, 1024 / 2, S, E, tid);
    }
    SEAM(PH_MOE1);

    if (IN(PH_MOE2)) { PHASE_IDS
        pg8::MoeSched S; S.init(NZ * CAP, D_MODEL, G, bx); S.A = (const char*)(ws + WS_ACT); S.Bt = (const char*)(ws + WS_WD); S.kb = (size_t)FF; S.nper = 1024;
        pg8::EpiDown E; E.y = (bf16*)(ws + WS_Y); E.gate = (const float*)(ws + WS_GATE); E.out_scale = 1.0f / (WD_SCALE * ACT_SCALE);
        pg8::gemm_phase<pg8::EpiDown, pg8::MoeSched, true, true, true>(lds + RING_OFF, FF / 2, S, E, tid);
    }
    SEAM(PH_MOE2);

    if (IN(PH_FINAL)) { PHASE_IDS
        const float* x1 = (const float*)(ws + WS_X1); const int* sel = (const int*)(ws + WS_SEL); const bf16* y = (const bf16*)(ws + WS_Y); const float* gain = args.in[16];
        for (int m = gw; m < T; m += NGW) {
            const int b = m / SEQ;
            const GAS f32x4* xr = (const GAS f32x4*)(x1 + (size_t)m * D_MODEL) + lane; const GAS f32x4* gr = (const GAS f32x4*)gain + lane;
            f32x4 v[4];
#pragma unroll
            for (int j = 0; j < 4; ++j) v[j] = xr[64 * j];
            const int mysel = (lane < NE) ? sel[(size_t)m * NE + lane] : -1;
            for (int e = 0; e < NE; ++e) { const int sl = __builtin_amdgcn_readlane(mysel, e);
                if (sl >= 0) { const GAS unsigned long long* yr = (const GAS unsigned long long*)(y + ((size_t)(b * NE + e) * CAP + sl) * D_MODEL) + lane;
#pragma unroll
                    for (int j = 0; j < 4; ++j) { const unsigned long long w = yr[64 * j]; const unsigned lo = (unsigned)w, hi = (unsigned)(w >> 32);
                        v[j].x += __uint_as_float(lo << 16); v[j].y += __uint_as_float(lo & 0xffff0000u); v[j].z += __uint_as_float(hi << 16); v[j].w += __uint_as_float(hi & 0xffff0000u); } } }
            float s = 0.f;
#pragma unroll
            for (int j = 0; j < 4; ++j) s += (v[j].x * v[j].x + v[j].y * v[j].y) + (v[j].z * v[j].z + v[j].w * v[j].w);
            const float rstd = 1.f / sqrtf(wave_sum(s) * (1.f / D_MODEL) + EPS);
            GAS f32x4* o = (GAS f32x4*)(args.out + (size_t)m * D_MODEL) + lane;
#pragma unroll
            for (int j = 0; j < 4; ++j) { const f32x4 g4 = gr[64 * j]; o[64 * j] = v[j] * g4 * rstd; }
        }
    }
#undef IN
#undef SEAM
}

#ifndef MK_DUP
#define MK_DUP (-1)
#endif
#ifndef MK_ONE_LAUNCH
#define MK_ONE_LAUNCH 1
#endif
extern "C" void kernel_launch(void* const* d_in, const int* in_sizes, int n_in, void* d_out, int out_size, void* d_ws, size_t ws_size, hipStream_t stream) {
    static int grid = 0;
    if (grid == 0) {
        if (n_in != 17 || in_sizes[0] != T * D_MODEL || out_size != T * D_MODEL || ws_size < WS_END) { fprintf(stderr, "kernel_launch: shape/workspace mismatch (ws %zu need %zu)\n", ws_size, (size_t)WS_END); grid = -1; return; }
        int dev = 0, cus = 0, per_cu = 0;
        if (hipGetDevice(&dev) != hipSuccess || hipDeviceGetAttribute(&cus, hipDeviceAttributeMultiprocessorCount, dev) != hipSuccess) { grid = -1; return; }
        if (hipFuncSetAttribute((const void*)mega, hipFuncAttributeMaxDynamicSharedMemorySize, LDS_BYTES) != hipSuccess) { fprintf(stderr, "kernel_launch: hipFuncSetAttribute failed\n"); grid = -1; return; }
        if (hipOccupancyMaxActiveBlocksPerMultiprocessor(&per_cu, (const void*)mega, NWAVES * 64, LDS_BYTES) != hipSuccess || per_cu < 1) { fprintf(stderr, "kernel_launch: occupancy query says %d blocks per CU\n", per_cu); (void)hipGetLastError(); grid = -1; return; }
        grid = cus;
    }
    if (grid < 0) return;
    unsigned char* ws = (unsigned char*)d_ws;
    (void)hipMemsetAsync(ws + WS_CTL, 0, CTL_ZERO_BYTES, stream);
    Args a{};
    for (int i = 0; i < 17; ++i) a.in[i] = (const float*)d_in[i];
    a.out = (float*)d_out; a.ws = ws;
#if MK_ONE_LAUNCH
    a.ph_lo = 0; a.ph_hi = PH_END; hipLaunchKernelGGL(mega, dim3(grid), dim3(NWAVES * 64), LDS_BYTES, stream, a);
#if MK_DUP >= 0
    a.ph_lo = MK_DUP; a.ph_hi = MK_DUP + 1; hipLaunchKernelGGL(mega, dim3(grid), dim3(NWAVES * 64), LDS_BYTES, stream, a);
#endif
#else
    for (int ph = 0; ph < PH_END; ++ph) { a.ph_lo = ph; a.ph_hi = ph + 1; hipLaunchKernelGGL(mega, dim3(grid), dim3(NWAVES * 64), LDS_BYTES, stream, a); }
#endif
}
```

```cpp
#include <hip/hip_runtime.h>
#include <hip/hip_bf16.h>
#include <cstdio>
#include <cstdint>
#include <cmath>

constexpr size_t EP_MiB = 1u << 20;
constexpr size_t EP_COS = 2 * EP_MiB, EP_SIN = 4 * EP_MiB, EP_RQ = 382 * EP_MiB, EP_RK = 398 * EP_MiB, EP_RV = 414 * EP_MiB, EP_RGS = 430 * EP_MiB, EP_AQ = 446 * EP_MiB, EP_AK = 462 * EP_MiB, EP_AV = 470 * EP_MiB, EP_GRS = 478 * EP_MiB, EP_GAS = 510 * EP_MiB;
constexpr int D_MODEL = 1024, BATCH = 2, SEQ = 8192, T = BATCH * SEQ;
constexpr int HD = 128, CHUNK = 128, NCHUNK = SEQ / CHUNK;
constexpr int NE = 16, FF = 2816, CAP = 1024, NZ = BATCH * NE;
constexpr int INW = 5120;
constexpr int O_RQ = 0, O_RK = 512, O_RV = 1024, O_RG = 1536, O_AQ = 2048, O_AK = 2560, O_AV = 2816, O_GR = 3072, O_GA = 4096;
constexpr float EPS = 1e-6f;
constexpr float RSQRT_HD = 0.08838834764831845f;
constexpr float W1_SCALE = 32.0f, WD_SCALE = 64.0f, ACT_SCALE = 4.0f;

namespace pg8 {
#define PG8_LAS __attribute__((address_space(3)))
typedef unsigned short bf16_t;
typedef short bf16x8 __attribute__((ext_vector_type(8)));
typedef float f32x4 __attribute__((ext_vector_type(4)));
typedef unsigned u32x4 __attribute__((ext_vector_type(4)));
constexpr int BM = 256, BK = 64, HALF = 128, HTB = HALF * BK * 2  , STAGE_BYTES = 8 * HTB, NXCD = 8, WGM = 8;

__host__ __device__ __forceinline__ int lds_byte(int r, int c) { const int st = (r >> 4) * 2 + (c >> 5), rr = r & 15, cc = c & 31, ob = rr * 64 + cc * 2; return st * 1024 + (ob ^ (((ob >> 9) & 1) << 5)); }
__host__ __device__ __forceinline__ void stage_rc(int b, int& R, int& C) { const int st = b / 1024, sb = b % 1024, swz = sb ^ (((sb >> 9) & 1) << 5); R = (st >> 1) * 16 + swz / 64; C = (st & 1) * 32 + (swz % 64) / 2; }
__host__ __device__ __forceinline__ int perm32(int rho) { const int n = rho >> 4, i = rho & 15; return 8 * (i >> 2) + 4 * n + (i & 3); }

struct Unit { int pm, pn, aux; };
struct Gemm { const bf16_t* A; const bf16_t* Bt; int M, N, K; };

struct StaticOrder {
    int nM, nN, nwg, G, c;
    __host__ __device__ void init(int M, int N, int G_, int c_) { nM = M / BM; nN = N / BM; nwg = nM * nN; G = G_; c = c_; }
    __host__ __device__ bool next(int i, Unit& u) const {
        const long L = (long)i * G + c; if (L >= nwg) return false;
        int wgid = (int)L; { const int q = nwg / NXCD, r = nwg % NXCD, xcd = wgid % NXCD, off = wgid / NXCD; wgid = (xcd < r ? xcd * (q + 1) : r * (q + 1) + (xcd - r) * q) + off; }
        const int nig = WGM * nN, gid = wgid / nig, fm = gid * WGM, gsz = (nM - fm) < WGM ? (nM - fm) : WGM;
        u.pm = fm + ((wgid % nig) % gsz); u.pn = (wgid % nig) / gsz; u.aux = 0; return true;
    }
    __device__ __forceinline__ void a_ready(const Unit&) const {}
    __device__ __forceinline__ void done(const Unit&) const {}
    static constexpr bool GATHER = false;
    __device__ __forceinline__ unsigned gather_off(const Unit&, int, int) const { return 0u; }
    __device__ __forceinline__ bool keep_acc(const Unit&) const { return false; }
};


struct PlainSched : StaticOrder {
    const char* A; const char* Bt; size_t tstep;
    __device__ __forceinline__ void bases(const Unit& u, const char*& a, const char*& b) const { a = A + (size_t)u.pm * tstep; b = Bt + (size_t)u.pn * tstep; }
};

typedef float f32x2_t __attribute__((ext_vector_type(2))); typedef __bf16 bf16x2_t __attribute__((ext_vector_type(2)));
__device__ __forceinline__ unsigned cvt_pk_bf16(float lo, float hi) { f32x2_t v = {lo, hi}; bf16x2_t b = __builtin_convertvector(v, bf16x2_t); return __builtin_bit_cast(unsigned, b); }
__device__ __forceinline__ u32x4 pack8(const f32x4 a, const f32x4 b) { u32x4 w; w.x = cvt_pk_bf16(a[0], a[1]); w.y = cvt_pk_bf16(a[2], a[3]); w.z = cvt_pk_bf16(b[0], b[1]); w.w = cvt_pk_bf16(b[2], b[3]); return w; }
__device__ __forceinline__ float fast_sigmoid(float x) { return __builtin_amdgcn_rcpf(1.0f + __builtin_amdgcn_exp2f(-1.4426950408889634f * x)); }
__device__ __forceinline__ f32x4 sigmoid4(const f32x4 v) { return (f32x4){fast_sigmoid(v[0]), fast_sigmoid(v[1]), fast_sigmoid(v[2]), fast_sigmoid(v[3])}; }
__device__ __forceinline__ f32x4 silu4(const f32x4 v) { return v * sigmoid4(v); }

struct EpiProj {
    static constexpr bool PERM = true, AFTER_DRAIN = false;
    unsigned char* wsb;
    const float *qn, *kn;
    PG8_LAS float* xch;
    mutable unsigned epoch;
    template <int ACT>
    __device__ __forceinline__ void plain(const f32x4 (&acc)[2][2][4][2], bf16_t* base, int ld, int col0, int row0) const {
#pragma unroll
        for (int ai = 0; ai < 2; ++ai)
#pragma unroll
            for (int m = 0; m < 4; ++m) { bf16_t* rowp = base + (size_t)(row0 + ai * HALF + m * 16) * ld + col0;
#pragma unroll
                for (int bj = 0; bj < 2; ++bj) { f32x4 v0 = acc[ai][bj][m][0], v1 = acc[ai][bj][m][1];
                    if (ACT == 1) { v0 = silu4(v0); v1 = silu4(v1); } else if (ACT == 2) { v0 = sigmoid4(v0); v1 = sigmoid4(v1); }
                    *(u32x4*)(rowp + bj * HALF) = pack8(v0, v1); } }
    }
    template <bool NORM>
    __device__ __forceinline__ void rope(const f32x4 (&acc)[2][2][4][2], bf16_t* base, int ld, int col0, int row0, float scale, const float* nw, int wr, int wc, int fr, int fq) const {
        const int g = 4 * wc + fq;
        f32x4 nw1 = {1.f, 1.f, 1.f, 1.f}, nw2 = {1.f, 1.f, 1.f, 1.f};
        if (NORM) {
#pragma unroll
            for (int ai = 0; ai < 2; ++ai)
#pragma unroll
                for (int m = 0; m < 4; ++m)
#pragma unroll
                    for (int bj = 0; bj < 2; ++bj) { const f32x4 a = acc[ai][bj][m][0], b = acc[ai][bj][m][1];
                        float s = (a[0] * a[0] + a[1] * a[1]) + (a[2] * a[2] + a[3] * a[3]) + (b[0] * b[0] + b[1] * b[1]) + (b[2] * b[2] + b[3] * b[3]);
                        s += __shfl_xor(s, 16); s += __shfl_xor(s, 32);
                        if (fq == 0) xch[((ai * HALF + wr * 64 + m * 16 + fr) * 2 + bj) * 4 + wc] = s; }
            asm volatile("s_waitcnt lgkmcnt(0)" ::: "memory");
            PG8_LAS unsigned* cnt = (PG8_LAS unsigned*)(xch + 2048) + wr;
            if ((fr | fq) == 0) __hip_atomic_fetch_add(cnt, 1u, __ATOMIC_RELAXED, __HIP_MEMORY_SCOPE_WORKGROUP);
            epoch += 4u;
            while (__hip_atomic_load(cnt, __ATOMIC_RELAXED, __HIP_MEMORY_SCOPE_WORKGROUP) < epoch) __builtin_amdgcn_s_sleep(1);
            asm volatile("s_waitcnt lgkmcnt(0)" ::: "memory");
            nw1 = *(const f32x4*)(nw + 4 * g); nw2 = *(const f32x4*)(nw + 64 + 4 * g);
        }
#pragma unroll
        for (int ai = 0; ai < 2; ++ai)
#pragma unroll
            for (int m = 0; m < 4; ++m) { const int r = row0 + ai * HALF + m * 16; const int pos = r & 8191;
                const f32x4 c4 = *(const f32x4*)((const float*)(wsb + EP_COS) + (size_t)pos * 64 + 4 * g), s4 = *(const f32x4*)((const float*)(wsb + EP_SIN) + (size_t)pos * 64 + 4 * g);
                bf16_t* rowp = base + (size_t)r * ld + col0;
#pragma unroll
                for (int bj = 0; bj < 2; ++bj) { f32x4 x1 = acc[ai][bj][m][0], x2 = acc[ai][bj][m][1];
                    if (NORM) { const f32x4 p = *(const PG8_LAS f32x4*)(xch + ((ai * HALF + wr * 64 + m * 16 + fr) * 2 + bj) * 4);
                        const float rs = __builtin_amdgcn_rsqf(((p[0] + p[1]) + (p[2] + p[3])) * (1.0f / 128.0f) + 1e-6f);
                        x1 = x1 * (nw1 * rs); x2 = x2 * (nw2 * rs); }
                    const f32x4 y1 = (x1 * c4 - x2 * s4) * scale, y2 = (x1 * s4 + x2 * c4) * scale;
                    *(u32x4*)(rowp + bj * HALF) = pack8(y1, y2); }
                asm volatile("" ::: "memory"); }
    }
    __device__ __forceinline__ void operator()(const f32x4 (&acc)[2][2][4][2], const Unit& u, int wr, int wc, int fr, int fq) const {
        const int row0 = u.pm * BM + wr * 64 + fr, cw = wc * 32 + 8 * fq, pn = u.pn;
        if (pn < 2)       rope<false>(acc, (bf16_t*)(wsb + EP_RQ), 512, pn * 256 + cw, row0, 1.0f, nullptr, wr, wc, fr, fq);
        else if (pn < 4)  rope<false>(acc, (bf16_t*)(wsb + EP_RK), 512, (pn - 2) * 256 + cw, row0, 0.08838834764831845f, nullptr, wr, wc, fr, fq);
        else if (pn < 6)  plain<0>(acc, (bf16_t*)(wsb + EP_RV), 512, (pn - 4) * 256 + cw, row0);
        else if (pn < 8)  plain<1>(acc, (bf16_t*)(wsb + EP_RGS), 512, (pn - 6) * 256 + cw, row0);
        else if (pn < 10) rope<true>(acc, (bf16_t*)(wsb + EP_AQ), 512, (pn - 8) * 256 + cw, row0, 1.0f, qn, wr, wc, fr, fq);
        else if (pn < 11) rope<true>(acc, (bf16_t*)(wsb + EP_AK), 256, cw, row0, 1.0f, kn, wr, wc, fr, fq);
        else if (pn < 12) plain<0>(acc, (bf16_t*)(wsb + EP_AV), 256, cw, row0);
        else if (pn < 16) plain<2>(acc, (bf16_t*)(wsb + EP_GRS), 1024, (pn - 12) * 256 + cw, row0);
        else              plain<2>(acc, (bf16_t*)(wsb + EP_GAS), 1024, (pn - 16) * 256 + cw, row0);
    }
};

struct BranchSched : StaticOrder {
    const char *A0, *A1, *B0, *B1; size_t tstep;
    __device__ __forceinline__ bool next(int i, Unit& u) const { if (!StaticOrder::next(i >> 1, u)) return false; u.aux = i & 1; return true; }
    __device__ __forceinline__ void bases(const Unit& u, const char*& a, const char*& b) const { a = (u.aux ? A1 : A0) + (size_t)u.pm * tstep; b = (u.aux ? B1 : B0) + (size_t)u.pn * tstep; }
    __device__ __forceinline__ bool keep_acc(const Unit& nxt) const { return nxt.aux == 1; }
};
__device__ __forceinline__ void unpack8(const u32x4 w, f32x4& a, f32x4& b) {
    a = (f32x4){__uint_as_float(w.x << 16), __uint_as_float(w.x & 0xffff0000u), __uint_as_float(w.y << 16), __uint_as_float(w.y & 0xffff0000u)};
    b = (f32x4){__uint_as_float(w.z << 16), __uint_as_float(w.z & 0xffff0000u), __uint_as_float(w.w << 16), __uint_as_float(w.w & 0xffff0000u)};
}
struct EpiBranch {
    static constexpr bool PERM = true, AFTER_DRAIN = false;
    const bf16_t *grs, *gas; bf16_t* mixed;
    __device__ __forceinline__ void operator()(f32x4 (&acc)[2][2][4][2], const Unit& u, int wr, int wc, int fr, int fq) const {
        const int row0 = u.pm * BM + wr * 64 + fr, col0 = u.pn * BM + wc * 32 + 8 * fq;
#pragma unroll
        for (int ai = 0; ai < 2; ++ai)
#pragma unroll
            for (int m = 0; m < 4; ++m) { const size_t off = (size_t)(row0 + ai * HALF + m * 16) * 1024 + col0;
#pragma unroll
                for (int bj = 0; bj < 2; ++bj) { f32x4 ga0, ga1; unpack8(*(const u32x4*)(gas + off + bj * HALF), ga0, ga1);
                    if (u.aux == 0) { f32x4 gr0, gr1; unpack8(*(const u32x4*)(grs + off + bj * HALF), gr0, gr1);
#pragma unroll
                        for (int k = 0; k < 4; ++k) { acc[ai][bj][m][0][k] *= gr0[k] * __builtin_amdgcn_rcpf(fmaxf(ga0[k], 1e-30f)); acc[ai][bj][m][1][k] *= gr1[k] * __builtin_amdgcn_rcpf(fmaxf(ga1[k], 1e-30f)); } }
                    else *(u32x4*)(mixed + off + bj * HALF) = pack8(acc[ai][bj][m][0] * ga0, acc[ai][bj][m][1] * ga1); }
                asm volatile("" ::: "memory"); }
    }
};
struct EpiResid {
    static constexpr bool PERM = false, AFTER_DRAIN = false;
    const float* x; float* x1;
    __device__ __forceinline__ void operator()(const f32x4 (&acc)[2][2][4][2], const Unit& u, int wr, int wc, int fr, int fq) const {
        const int row0 = u.pm * BM + wr * 64 + fr, col0 = u.pn * BM + wc * 32 + 4 * fq;
#pragma unroll
        for (int ai = 0; ai < 2; ++ai)
#pragma unroll
            for (int m = 0; m < 4; ++m) { const size_t off = (size_t)(row0 + ai * HALF + m * 16) * 1024 + col0;
#pragma unroll
                for (int bj = 0; bj < 2; ++bj)
#pragma unroll
                    for (int n = 0; n < 2; ++n) { const f32x4 xv = *(const f32x4*)(x + off + bj * HALF + n * 16); *(f32x4*)(x1 + off + bj * HALF + n * 16) = xv + acc[ai][bj][m][n]; }
                if (m & 1) asm volatile("" ::: "memory"); }
    }
};
__device__ __forceinline__ int moe_rowbase(int pm) { return ((((pm >> 2) & 1) * 16 + (pm >> 3)) * 1024) + (pm & 3) * 256; }
struct MoeSched : StaticOrder {
    const char *A, *Bt; size_t kb; int nper;
    __device__ __forceinline__ void bases(const Unit& u, const char*& a, const char*& b) const { a = A + (size_t)moe_rowbase(u.pm) * kb; b = Bt + ((size_t)(u.pm >> 3) * nper + (size_t)u.pn * 256) * kb; }
};
struct MoeGatherSched : StaticOrder {
    static constexpr bool GATHER = true;
    const char *A, *Bt; const int* idx;
    __device__ __forceinline__ void bases(const Unit& u, const char*& a, const char*& b) const { a = A; b = Bt + ((size_t)(u.pm >> 3) * 5632 + (size_t)u.pn * 256) * 1024; }
    __device__ __forceinline__ unsigned gather_off(const Unit& u, int r, int c) const { const int tok = ((u.pm >> 2) & 1) * 8192 + idx[moe_rowbase(u.pm) + r]; return (unsigned)(tok * 1024 + c * 2); }
};
struct EpiSwiglu {
    static constexpr bool PERM = true, AFTER_DRAIN = false;
    unsigned char* act; float in_scale, act_scale;
    __device__ __forceinline__ void operator()(const f32x4 (&acc)[2][2][4][2], const Unit& u, int wr, int wc, int fr, int fq) const {
        const int row0 = moe_rowbase(u.pm) + wr * 64 + fr, col0 = u.pn * HALF + wc * 32 + 8 * fq;
#pragma unroll
        for (int ai = 0; ai < 2; ++ai)
#pragma unroll
            for (int m = 0; m < 4; ++m) { f32x4 v0 = silu4(acc[ai][0][m][0] * in_scale) * (acc[ai][1][m][0] * (in_scale * act_scale)), v1 = silu4(acc[ai][0][m][1] * in_scale) * (acc[ai][1][m][1] * (in_scale * act_scale));
#pragma unroll
                for (int k = 0; k < 4; ++k) { v0[k] = __builtin_amdgcn_fmed3f(v0[k], -448.0f, 448.0f); v1[k] = __builtin_amdgcn_fmed3f(v1[k], -448.0f, 448.0f); }
                const unsigned lo = (unsigned)__builtin_amdgcn_cvt_pk_fp8_f32(v0[2], v0[3], __builtin_amdgcn_cvt_pk_fp8_f32(v0[0], v0[1], 0, false), true), hi = (unsigned)__builtin_amdgcn_cvt_pk_fp8_f32(v1[2], v1[3], __builtin_amdgcn_cvt_pk_fp8_f32(v1[0], v1[1], 0, false), true);
                *(unsigned long long*)(act + (size_t)(row0 + ai * HALF + m * 16) * 2816 + col0) = (unsigned long long)lo | ((unsigned long long)hi << 32); }
    }
};
struct EpiDown {
    static constexpr bool PERM = true, AFTER_DRAIN = false;
    bf16_t* y; const float* gate; float out_scale;
    __device__ __forceinline__ void operator()(const f32x4 (&acc)[2][2][4][2], const Unit& u, int wr, int wc, int fr, int fq) const {
        const int row0 = moe_rowbase(u.pm) + wr * 64 + fr, col0 = u.pn * BM + wc * 32 + 8 * fq;
#pragma unroll
        for (int ai = 0; ai < 2; ++ai)
#pragma unroll
            for (int m = 0; m < 4; ++m) { const int r = row0 + ai * HALF + m * 16; const float g = gate[r] * out_scale;
#pragma unroll
                for (int bj = 0; bj < 2; ++bj) *(u32x4*)(y + (size_t)r * 1024 + col0 + bj * HALF) = pack8(acc[ai][bj][m][0] * g, acc[ai][bj][m][1] * g); }
    }
};
typedef int v4i32 __attribute__((ext_vector_type(4)));
typedef int v8i32 __attribute__((ext_vector_type(8)));
__device__ __forceinline__ v8i32 cat8(const bf16x8 lo, const bf16x8 hi) { const v4i32 l = __builtin_bit_cast(v4i32, lo), h = __builtin_bit_cast(v4i32, hi); return __builtin_shufflevector(l, h, 0, 1, 2, 3, 4, 5, 6, 7); }
__device__ __forceinline__ void mfma_f8_inplace(f32x4& acc, const v8i32 b8, const v8i32 a8, const int sc) {
    asm volatile("v_mfma_scale_f32_16x16x128_f8f6f4 %0, %1, %2, %0, %3, %3 op_sel_hi:[0,0,0]" : "+v"(acc) : "v"(b8), "v"(a8), "v"(sc)); }
template <class Epi, class Sched, bool ALIGN_EPI = false, bool SP2 = false, bool FP8 = false>
__device__ __forceinline__ void gemm_phase(PG8_LAS unsigned char* lds, const int K_, const Sched& S, const Epi& E, const int tid) {
    const int wid = __builtin_amdgcn_readfirstlane(tid >> 6), lane = tid & 63, wr = wid >> 2, wc = wid & 3, fr = lane & 15, fq = lane >> 4;
    const int K = K_, nt = K / BK;
    unsigned voffA[2], voffB[2];
#pragma unroll
    for (int i = 0; i < 2; ++i) { int R, C; stage_rc(tid * 16 + i * 8192, R, C); const int Rb = Epi::PERM ? ((R & ~31) + perm32(R & 31)) : R;
        voffA[i] = (unsigned)(R * K + C) * 2u; voffB[i] = (unsigned)(Rb * K + C) * 2u; }
    unsigned va0[2] = {0u, 0u}, va1[2] = {0u, 0u}, vn0[2] = {0u, 0u}, vn1[2] = {0u, 0u};
    int gR[2], gC[2];
#pragma unroll
    for (int i = 0; i < 2; ++i) stage_rc(tid * 16 + i * 8192, gR[i], gC[i]);
    const size_t kstep = (size_t)(BK * 2);
    const size_t hstep = (size_t)HALF * K * 2;
        const unsigned ldsw = (unsigned)wid * 1024u;
    const int aoff = lds_byte(wr * 64 + fr, fq * 8), boff = lds_byte(wc * 32 + fr, fq * 8);
#define PG8_SA(b, h) (((b) * 2 + (h)) * HTB)
#define PG8_SB(b, h) ((4 + (b) * 2 + (h)) * HTB)
#define PG8_STAGE(bufoff, gbase, voff) do { _Pragma("unroll") for (int _i = 0; _i < 2; ++_i) \
        __builtin_amdgcn_global_load_lds((const unsigned*)((const char*)(gbase) + (voff)[_i]), (PG8_LAS unsigned*)(lds + (bufoff) + ldsw + _i * 8192), 16, 0, 0); } while (0)
#define PG8_STAGE_A(bufoff, gbase, h, usenext) do { if constexpr (Sched::GATHER) { unsigned vo_[2]; \
        vo_[0] = (usenext) ? ((h) ? vn1[0] : vn0[0]) : ((h) ? va1[0] : va0[0]); vo_[1] = (usenext) ? ((h) ? vn1[1] : vn0[1]) : ((h) ? va1[1] : va0[1]); PG8_STAGE(bufoff, gbase, vo_); } \
        else { PG8_STAGE(bufoff, (gbase) + ((h) ? hstep : (size_t)0), voffA); } } while (0)
#define PG8_LDA(dst, b, h) do { if constexpr (FP8) { _Pragma("unroll") for (int m = 0; m < 4; ++m) dst##8[m] = cat8(*(const PG8_LAS bf16x8*)(lds + PG8_SA(b, h) + aoff + m * 2048), *(const PG8_LAS bf16x8*)(lds + PG8_SA(b, h) + aoff + m * 2048 + 1024)); } else { \
        _Pragma("unroll") for (int m = 0; m < 4; ++m) _Pragma("unroll") for (int k = 0; k < 2; ++k) dst[m][k] = *(const PG8_LAS bf16x8*)(lds + PG8_SA(b, h) + aoff + m * 2048 + k * 1024); } } while (0)
#define PG8_LDB(dst, b, h) do { if constexpr (FP8) { _Pragma("unroll") for (int n = 0; n < 2; ++n) dst##8[n] = cat8(*(const PG8_LAS bf16x8*)(lds + PG8_SB(b, h) + boff + n * 2048), *(const PG8_LAS bf16x8*)(lds + PG8_SB(b, h) + boff + n * 2048 + 1024)); } else { \
        _Pragma("unroll") for (int n = 0; n < 2; ++n) _Pragma("unroll") for (int k = 0; k < 2; ++k) dst[n][k] = *(const PG8_LAS bf16x8*)(lds + PG8_SB(b, h) + boff + n * 2048 + k * 1024); } } while (0)
#define PG8_MMA(ai, bj, At, Bt) do { __builtin_amdgcn_s_setprio(1); if constexpr (FP8) { _Pragma("unroll") for (int m = 0; m < 4; ++m) _Pragma("unroll") for (int n = 0; n < 2; ++n) \
        mfma_f8_inplace(acc[ai][bj][m][n], Bt##8[n], At##8[m], 0x7f7f7f7f); } else { \
        _Pragma("unroll") for (int m = 0; m < 4; ++m) _Pragma("unroll") for (int n = 0; n < 2; ++n) _Pragma("unroll") for (int k = 0; k < 2; ++k) \
        acc[ai][bj][m][n] = __builtin_amdgcn_mfma_f32_16x16x32_bf16(Bt[n][k], At[m][k], acc[ai][bj][m][n], 0, 0, 0); } __builtin_amdgcn_s_setprio(0); } while (0)
#define PG8_WAIT_V(n) asm volatile("s_waitcnt vmcnt(" #n ")" ::: "memory")
#define PG8_WAIT_L(n) asm volatile("s_waitcnt lgkmcnt(" #n ")" ::: "memory")
#define PG8_BAR __builtin_amdgcn_s_barrier()
#define PG8_SCHED __builtin_amdgcn_sched_barrier(0)
    Unit cur, nxt; int ui = 0;
    if (!S.next(0, cur)) return;
    f32x4 acc[2][2][4][2];
#pragma unroll
    for (int a = 0; a < 2; ++a)
#pragma unroll
        for (int b = 0; b < 2; ++b)
#pragma unroll
            for (int m = 0; m < 4; ++m)
#pragma unroll
                for (int n = 0; n < 2; ++n) acc[a][b][m][n] = (f32x4){0.f, 0.f, 0.f, 0.f};
    bf16x8 At[4][2], B0[2][2], B1[2][2]; v8i32 At8[4], B08[2], B18[2];
    const char* cA; const char* cB; S.bases(cur, cA, cB);
    if constexpr (Sched::GATHER) {
#pragma unroll
        for (int i = 0; i < 2; ++i) { va0[i] = S.gather_off(cur, gR[i], gC[i]); va1[i] = S.gather_off(cur, gR[i] + HALF, gC[i]); } }
    S.a_ready(cur);
    if constexpr (SP2) {
        PG8_STAGE(PG8_SB(0, 0), cB, voffB); PG8_STAGE(PG8_SB(0, 1), cB + hstep, voffB); PG8_STAGE_A(PG8_SA(0, 0), cA, 0, false); PG8_STAGE_A(PG8_SA(0, 1), cA, 1, false);
        if (wr == 1) PG8_BAR;
        PG8_WAIT_V(2); PG8_BAR;
        PG8_STAGE(PG8_SB(1, 0), cB + kstep, voffB); PG8_STAGE_A(PG8_SA(1, 0), cA + kstep, 0, false); PG8_STAGE(PG8_SB(1, 1), cB + hstep + kstep, voffB);
        PG8_WAIT_V(6); PG8_BAR;
    } else {
        PG8_STAGE(PG8_SB(0, 0), cB, voffB); PG8_STAGE_A(PG8_SA(0, 0), cA, 0, false); PG8_STAGE(PG8_SB(0, 1), cB + hstep, voffB); PG8_STAGE_A(PG8_SA(0, 1), cA, 1, false);
        if (wr == 1) PG8_BAR;
        PG8_WAIT_V(4); PG8_BAR;
        PG8_STAGE(PG8_SB(1, 0), cB + kstep, voffB); PG8_STAGE_A(PG8_SA(1, 0), cA + kstep, 0, false); PG8_STAGE(PG8_SB(1, 1), cB + hstep + kstep, voffB);
        PG8_WAIT_V(6); PG8_BAR;
    }
    for (;;) {
        const bool has_next = S.next(ui + 1, nxt);
        const char* nA = cA; const char* nB = cB; if (has_next) S.bases(nxt, nA, nB);
        if constexpr (Sched::GATHER) { if (has_next) {
#pragma unroll
            for (int i = 0; i < 2; ++i) { vn0[i] = S.gather_off(nxt, gR[i], gC[i]); vn1[i] = S.gather_off(nxt, gR[i] + HALF, gC[i]); } }
            else {
#pragma unroll
            for (int i = 0; i < 2; ++i) { vn0[i] = va0[i]; vn1[i] = va1[i]; } } }
#pragma unroll 1
        for (int t = 0; t < nt; t += 2) {
            const bool last = (t == nt - 2);
            const char* a1 = cA + (size_t)(t + 1) * kstep;
            const char* a2 = last ? nA : cA + (size_t)(t + 2) * kstep; const char* b2 = last ? nB : cB + (size_t)(t + 2) * kstep;
            const char* a3 = a2 + kstep; const char* b3 = b2 + kstep;
            if (last && has_next) S.a_ready(nxt);
            if constexpr (SP2) {
            PG8_LDB(B0, 0, 0); PG8_LDB(B1, 0, 1); PG8_SCHED; PG8_LDA(At, 0, 0); PG8_STAGE_A(PG8_SA(1, 1), a1, 1, false);
            PG8_WAIT_V(8); PG8_WAIT_L(0); PG8_BAR; PG8_MMA(0, 0, At, B0); PG8_MMA(0, 1, At, B1); PG8_BAR; PG8_SCHED;
            PG8_LDA(At, 0, 1); PG8_STAGE(PG8_SB(0, 0), b2, voffB); PG8_STAGE(PG8_SB(0, 1), b2 + hstep, voffB); PG8_STAGE_A(PG8_SA(0, 0), a2, 0, last);
            PG8_WAIT_V(8); PG8_WAIT_L(0); PG8_BAR; PG8_MMA(1, 0, At, B0); PG8_MMA(1, 1, At, B1); PG8_BAR; PG8_SCHED;
            PG8_LDB(B0, 1, 0); PG8_LDB(B1, 1, 1); PG8_SCHED; PG8_LDA(At, 1, 0); PG8_STAGE_A(PG8_SA(0, 1), a2, 1, last);
            PG8_WAIT_V(8); PG8_WAIT_L(0); PG8_BAR; PG8_MMA(0, 0, At, B0); PG8_MMA(0, 1, At, B1); PG8_BAR; PG8_SCHED;
            PG8_LDA(At, 1, 1); PG8_STAGE(PG8_SB(1, 0), b3, voffB); PG8_STAGE(PG8_SB(1, 1), b3 + hstep, voffB); PG8_STAGE_A(PG8_SA(1, 0), a3, 0, last);
            PG8_WAIT_V(8); PG8_WAIT_L(0); PG8_BAR; PG8_MMA(1, 0, At, B0); PG8_MMA(1, 1, At, B1); PG8_BAR; PG8_SCHED;
            } else {
            PG8_LDB(B0, 0, 0); PG8_SCHED; PG8_LDA(At, 0, 0); PG8_STAGE_A(PG8_SA(1, 1), a1, 1, false);
            PG8_WAIT_L(8); PG8_BAR; PG8_WAIT_L(0); PG8_MMA(0, 0, At, B0); PG8_BAR; PG8_SCHED;
            PG8_LDB(B1, 0, 1); PG8_STAGE(PG8_SB(0, 0), b2, voffB);
            PG8_BAR; PG8_WAIT_L(0); PG8_MMA(0, 1, At, B1); PG8_BAR;
            PG8_LDA(At, 0, 1); PG8_STAGE_A(PG8_SA(0, 0), a2, 0, last);
            PG8_BAR; PG8_WAIT_L(0); PG8_MMA(1, 0, At, B0); PG8_BAR; PG8_SCHED;
            PG8_STAGE(PG8_SB(0, 1), b2 + hstep, voffB);
            PG8_WAIT_V(6); PG8_BAR; PG8_MMA(1, 1, At, B1); PG8_BAR;
            PG8_LDB(B0, 1, 0); PG8_SCHED; PG8_LDA(At, 1, 0); PG8_STAGE_A(PG8_SA(0, 1), a2, 1, last);
            PG8_WAIT_L(8); PG8_BAR; PG8_WAIT_L(0); PG8_MMA(0, 0, At, B0); PG8_BAR; PG8_SCHED;
            PG8_LDB(B1, 1, 1); PG8_STAGE(PG8_SB(1, 0), b3, voffB);
            PG8_BAR; PG8_WAIT_L(0); PG8_MMA(0, 1, At, B1); PG8_BAR;
            PG8_LDA(At, 1, 1); PG8_STAGE_A(PG8_SA(1, 0), a3, 0, last);
            PG8_BAR; PG8_WAIT_L(0); PG8_MMA(1, 0, At, B0); PG8_BAR; PG8_SCHED;
            PG8_STAGE(PG8_SB(1, 1), b3 + hstep, voffB);
            PG8_WAIT_V(6); PG8_BAR; PG8_MMA(1, 1, At, B1); PG8_BAR;
            }
        }
        if constexpr (FP8) asm volatile("s_nop 15\n\ts_nop 15" ::: "memory");
        if constexpr (ALIGN_EPI) { if (wr == 0) PG8_BAR; }
        if constexpr (!Epi::AFTER_DRAIN) { int le_; asm volatile("v_mbcnt_lo_u32_b32 %0, -1, 0\n\tv_mbcnt_hi_u32_b32 %0, -1, %0" : "=v"(le_));
            E(acc, cur, wr, wc, le_ & 15, le_ >> 4); S.done(cur); }
        if (!has_next) break;
        if (!S.keep_acc(nxt)) {
#pragma unroll
        for (int a = 0; a < 2; ++a)
#pragma unroll
            for (int b = 0; b < 2; ++b)
#pragma unroll
                for (int m = 0; m < 4; ++m)
#pragma unroll
                    for (int n = 0; n < 2; ++n) acc[a][b][m][n] = (f32x4){0.f, 0.f, 0.f, 0.f};
        }
        cur = nxt; cA = nA; cB = nB; ++ui;
        if constexpr (Sched::GATHER) {
#pragma unroll
            for (int i = 0; i < 2; ++i) { va0[i] = vn0[i]; va1[i] = vn1[i]; } }
        if constexpr (ALIGN_EPI) { if (wr == 1) PG8_BAR; }
    }
    PG8_WAIT_V(0);
    if constexpr (!ALIGN_EPI) { if (wr == 0) PG8_BAR; }
    PG8_BAR;
    if constexpr (Epi::AFTER_DRAIN) { E.fused(acc, cur, wr, wc, fr, fq, lds, wid, lane); S.done(cur); }
#undef PG8_SA
#undef PG8_SB
#undef PG8_STAGE
#undef PG8_STAGE_A
#undef PG8_LDA
#undef PG8_LDB
#undef PG8_MMA
#undef PG8_WAIT_V
#undef PG8_WAIT_L
#undef PG8_BAR
#undef PG8_SCHED
}
}


namespace attn {
using bf16 = __hip_bfloat16;
constexpr int   D = 128, NW = 8, QBLK = 32, KVBLK = 64;
constexpr float SCALE = 0.088388347648318440f;
constexpr float THR = 8.f;
constexpr int SDEPTH = 2;
constexpr int LDQ = 512, LDK = 256, LDO = 512;
constexpr size_t SHM_V = KVBLK * D * 2, SHM_K = KVBLK * D * 2, SHM_ATTN = 2 * SHM_V + 2 * SHM_K + NW * 64 * 4;
using bf16x8 = __attribute__((ext_vector_type(8))) short;
using s16x4  = __attribute__((ext_vector_type(4))) short;
using f32x16 = __attribute__((ext_vector_type(16))) float;
using f32x8  = __attribute__((ext_vector_type(8))) float;
using u32x4  = __attribute__((ext_vector_type(4))) unsigned;
#define KSWZ(row, colB) ((row) * 256 + ((colB) ^ (((row) & 7) << 4)))
#define SBAR() __builtin_amdgcn_sched_barrier(0)
__device__ __forceinline__ int crow(int r, int hi) { return (r & 3) + 8 * (r >> 2) + 4 * hi; }
typedef float f32x2_t __attribute__((ext_vector_type(2))); typedef __bf16 bf16x2_t __attribute__((ext_vector_type(2)));
__device__ __forceinline__ unsigned cvtpk(float lo, float hi) { f32x2_t v = {lo, hi}; bf16x2_t b = __builtin_convertvector(v, bf16x2_t); return __builtin_bit_cast(unsigned, b); }
template <typename TIn> struct Stage;
template <> struct Stage<bf16>  { using T = bf16x8;
  __device__ static __forceinline__ T ld8(const bf16* p) { return *reinterpret_cast<const bf16x8*>(p); }
  __device__ static __forceinline__ bf16x8 tobf(T x) { return x; } };
template <> struct Stage<float> { using T = f32x8;
  __device__ static __forceinline__ T ld8(const float* p) { return *reinterpret_cast<const f32x8*>(p); }
  __device__ static __forceinline__ bf16x8 tobf(T x) {
    u32x4 w = {cvtpk(x[0], x[1]), cvtpk(x[2], x[3]), cvtpk(x[4], x[5]), cvtpk(x[6], x[7])}; return *reinterpret_cast<bf16x8*>(&w); } };

__device__ __forceinline__ void partialSM(f32x16& p0, f32x16& p1, float& m_reg, float& mn, float& alpha) {
  constexpr float C = SCALE * 1.4426950408889634f;
  float pmax = p0[0]; for (int r = 1; r < 16; ++r) pmax = fmaxf(pmax, p0[r]); for (int r = 0; r < 16; ++r) pmax = fmaxf(pmax, p1[r]);
  { auto rr = __builtin_amdgcn_permlane32_swap(__float_as_uint(pmax), __float_as_uint(pmax), false, false);
    pmax = fmaxf(__uint_as_float(rr[0]), __uint_as_float(rr[1])); }
  if (__builtin_expect(__all(pmax - m_reg <= THR / SCALE), 1)) { mn = m_reg; alpha = 1.f; }
  else { mn = fmaxf(m_reg, pmax); alpha = __builtin_amdgcn_exp2f((m_reg - mn) * C); m_reg = mn; }
  float mnC = -mn * C;
  for (int r = 0; r < 16; ++r) p0[r] = fmaf(p0[r], C, mnC); for (int r = 0; r < 16; ++r) p1[r] = fmaf(p1[r], C, mnC);
  for (int r = 0; r < 16; ++r) p0[r] = __builtin_amdgcn_exp2f(p0[r]);
}
__device__ __forceinline__ void finishSM(f32x16& p0, f32x16& p1, float alpha, float& l_reg, bf16x8& pa0, bf16x8& pa1, bf16x8& pa2, bf16x8& pa3) {
  for (int r = 0; r < 16; ++r) p1[r] = __builtin_amdgcn_exp2f(p1[r]);
  float ps = 0; for (int r = 0; r < 16; ++r) ps += p0[r]; for (int r = 0; r < 16; ++r) ps += p1[r];
  { auto rr = __builtin_amdgcn_permlane32_swap(__float_as_uint(ps), __float_as_uint(ps), false, false);
    ps = __uint_as_float(rr[0]) + __uint_as_float(rr[1]); }
  l_reg = l_reg * alpha + ps;
#define PK4(P, BASE, OUT) do { unsigned a0 = cvtpk(P[BASE + 0], P[BASE + 1]), a1 = cvtpk(P[BASE + 2], P[BASE + 3]);   \
    unsigned b0 = cvtpk(P[BASE + 4], P[BASE + 5]), b1 = cvtpk(P[BASE + 6], P[BASE + 7]);                              \
    auto r0 = __builtin_amdgcn_permlane32_swap(a0, b0, false, false); auto r1 = __builtin_amdgcn_permlane32_swap(a1, b1, false, false); \
    u32x4 w = {r0[0], r1[0], r0[1], r1[1]}; OUT = *reinterpret_cast<bf16x8*>(&w); } while (0)
  PK4(p0, 0, pa0); PK4(p0, 8, pa1); PK4(p1, 0, pa2); PK4(p1, 8, pa3);
#undef PK4
}
__device__ __forceinline__ void qkt(f32x16& p0, f32x16& p1, const bf16* Ks, const bf16x8* qr, int r32, int hi) {
  p0 = f32x16{}; p1 = f32x16{};
  for (int d0 = 0; d0 < 8; ++d0) { int cb = (d0 * 16 + hi * 8) * 2;
    bf16x8 b0 = *reinterpret_cast<const bf16x8*>((const char*)Ks + KSWZ(r32, cb));
    bf16x8 b1 = *reinterpret_cast<const bf16x8*>((const char*)Ks + KSWZ(32 + r32, cb));
    p0 = __builtin_amdgcn_mfma_f32_32x32x16_bf16(b0, qr[d0], p0, 0, 0, 0);
    p1 = __builtin_amdgcn_mfma_f32_32x32x16_bf16(b1, qr[d0], p1, 0, 0, 0); }
}
__device__ __forceinline__ int v_st(int k, int c) { const int kk = (k & ~0xC) | ((k & 4) << 1) | ((k & 8) >> 1); return ((kk >> 3) * 4 + (c >> 5)) * 512 + ((kk & 7) * 32 + (c & 31)) * 2; }
__device__ __forceinline__ int v_rd_base(int lane) { return ((lane & 3) << 3) | (((lane >> 2) & 3) << 6) | (((lane >> 4) & 1) << 5) | (((lane >> 5) & 1) << 8); }
constexpr int v_rd_off(int d0, int ks, int half) { return d0 * 512 + ks * 4096 + half * 2048; }
template <int OFF> __device__ __forceinline__ s16x4 tr_read(int vb) {
  s16x4 r; asm volatile("ds_read_b64_tr_b16 %0, %1 offset:%2" : "=&v"(r) : "v"(vb), "i"(OFF) : "memory"); return r;
}
template <int D0> __device__ __forceinline__ void pv_one(f32x16& od, int vb, bf16x8 pa0, bf16x8 pa1, bf16x8 pa2, bf16x8 pa3) {
  const s16x4 l0 = tr_read<v_rd_off(D0, 0, 0)>(vb), h0 = tr_read<v_rd_off(D0, 0, 1)>(vb), l1 = tr_read<v_rd_off(D0, 1, 0)>(vb), h1 = tr_read<v_rd_off(D0, 1, 1)>(vb);
  const s16x4 l2 = tr_read<v_rd_off(D0, 2, 0)>(vb), h2 = tr_read<v_rd_off(D0, 2, 1)>(vb), l3 = tr_read<v_rd_off(D0, 3, 0)>(vb), h3 = tr_read<v_rd_off(D0, 3, 1)>(vb);
  asm volatile("s_waitcnt lgkmcnt(0)" ::: "memory"); SBAR();
#define PK(L, H) (bf16x8){L[0], L[1], L[2], L[3], H[0], H[1], H[2], H[3]}
  od = __builtin_amdgcn_mfma_f32_32x32x16_bf16(pa0, PK(l0, h0), od, 0, 0, 0);
  od = __builtin_amdgcn_mfma_f32_32x32x16_bf16(pa1, PK(l1, h1), od, 0, 0, 0);
  od = __builtin_amdgcn_mfma_f32_32x32x16_bf16(pa2, PK(l2, h2), od, 0, 0, 0);
  od = __builtin_amdgcn_mfma_f32_32x32x16_bf16(pa3, PK(l3, h3), od, 0, 0, 0);
#undef PK
}
__device__ __forceinline__ void pv_d0(f32x16* o, int vb, bf16x8 pa0, bf16x8 pa1, bf16x8 pa2, bf16x8 pa3) {
  pv_one<0>(o[0], vb, pa0, pa1, pa2, pa3); pv_one<1>(o[1], vb, pa0, pa1, pa2, pa3); pv_one<2>(o[2], vb, pa0, pa1, pa2, pa3); pv_one<3>(o[3], vb, pa0, pa1, pa2, pa3);
}

template <typename TQ>
__device__ __forceinline__ void attn_dense_body(const TQ* __restrict__ Qb, const bf16* __restrict__ Kh, const bf16* __restrict__ Vh,
                                                bf16* __restrict__ Ob, int seq, char* lds, const int tid) {
  using St = Stage<bf16>; using SQ = Stage<TQ>;
  const int wid = tid >> 6, lane = tid & 63, r32 = lane & 31, hi = lane >> 5;
  bf16* V_lds = (bf16*)lds; bf16* K_lds = (bf16*)(lds + 2 * SHM_V);
  float* ws = (float*)(lds + 2 * SHM_V + 2 * SHM_K) + wid * 64; float* li_l = ws; float* al_l = ws + 32;
  float m_reg = -1e30f, l_reg = 0; f32x16 o[4] = {}; bf16x8 qr[8];
  const TQ* Qw = Qb + (long)(wid * QBLK + r32) * LDQ + hi * 8;
#pragma unroll
  for (int d0 = 0; d0 < 8; ++d0) qr[d0] = SQ::tobf(SQ::ld8(Qw + d0 * 16));
  const int sr = tid >> 4, sc = (tid & 15) * 8, vst0 = v_st(sr, sc), vst1 = v_st(32 + sr, sc);
  const int vb0 = (int)(uintptr_t)V_lds + v_rd_base(lane);
  struct { typename St::T vs0, vs1, ks0, ks1; } sr_[SDEPTH];
#define SLOAD(i, k0) do { sr_[i].vs0 = St::ld8(&Vh[(long)((k0) + sr) * LDK + sc]); sr_[i].vs1 = St::ld8(&Vh[(long)((k0) + 32 + sr) * LDK + sc]); \
    sr_[i].ks0 = St::ld8(&Kh[(long)((k0) + sr) * LDK + sc]); sr_[i].ks1 = St::ld8(&Kh[(long)((k0) + 32 + sr) * LDK + sc]); } while (0)
#define SWRITE(b, i) do { *(bf16x8*)((char*)V_lds + (b) * SHM_V + vst0) = St::tobf(sr_[i].vs0);          \
    *(bf16x8*)((char*)V_lds + (b) * SHM_V + vst1) = St::tobf(sr_[i].vs1); int kc = sc * 2;               \
    *(bf16x8*)((char*)K_lds + (b) * SHM_K + KSWZ(sr, kc)) = St::tobf(sr_[i].ks0);                       \
    *(bf16x8*)((char*)K_lds + (b) * SHM_K + KSWZ(32 + sr, kc)) = St::tobf(sr_[i].ks1); } while (0)
#define SWAIT() do { if constexpr (SDEPTH == 2) asm volatile("s_waitcnt vmcnt(4)" ::: "memory"); else asm volatile("s_waitcnt vmcnt(0)" ::: "memory"); } while (0)
#define RESC(a) do { if (__any((a) < 1.f)) { if (hi == 0) al_l[r32] = (a); asm volatile("s_waitcnt lgkmcnt(0)" ::: "memory"); \
    for (int d = 0; d < 4; ++d) for (int r = 0; r < 16; ++r) o[d][r] *= al_l[crow(r, hi)]; } } while (0)
  f32x16 pA0, pA1, pB0, pB1; float mnA, mnB, alA, alB; bf16x8 pa0, pa1, pa2, pa3; const int NT = seq / KVBLK;
  constexpr int SE = 0, SO = SDEPTH - 1;
  SLOAD(SE, 0); asm volatile("s_waitcnt vmcnt(0)" ::: "memory"); SWRITE(0, SE); __syncthreads();
  qkt(pA0, pA1, K_lds, qr, r32, hi); partialSM(pA0, pA1, m_reg, mnA, alA);
  SLOAD(SO, KVBLK); if constexpr (SDEPTH == 2) { if (2 < NT) SLOAD(SE, 2 * KVBLK); }
  SWAIT(); SWRITE(1, SO); __syncthreads();
  for (int j = 1; j + 1 < NT; j += 2) {
    SBAR(); qkt(pB0, pB1, (bf16*)((char*)K_lds + SHM_K), qr, r32, hi);
    finishSM(pA0, pA1, alA, l_reg, pa0, pa1, pa2, pa3); SBAR();
    SLOAD(SO, (j + SDEPTH) * KVBLK); SBAR();
    pv_d0(o, vb0, pa0, pa1, pa2, pa3); partialSM(pB0, pB1, m_reg, mnB, alB);
    __syncthreads(); SWAIT(); SWRITE(0, SE);
    RESC(alB); __syncthreads();
    SBAR(); qkt(pA0, pA1, K_lds, qr, r32, hi);
    finishSM(pB0, pB1, alB, l_reg, pa0, pa1, pa2, pa3); SBAR();
    if (SDEPTH == 1 || j + 3 < NT) SLOAD(SE, (j + 1 + SDEPTH) * KVBLK); SBAR();
    pv_d0(o, vb0 + (int)SHM_V, pa0, pa1, pa2, pa3); partialSM(pA0, pA1, m_reg, mnA, alA);
    __syncthreads(); SWAIT(); SWRITE(1, SO);
    RESC(alA); __syncthreads();
  }
  SBAR(); qkt(pB0, pB1, (bf16*)((char*)K_lds + SHM_K), qr, r32, hi);
  finishSM(pA0, pA1, alA, l_reg, pa0, pa1, pa2, pa3); SBAR();
  pv_d0(o, vb0, pa0, pa1, pa2, pa3); partialSM(pB0, pB1, m_reg, mnB, alB);
  __syncthreads(); RESC(alB);
  finishSM(pB0, pB1, alB, l_reg, pa0, pa1, pa2, pa3); SBAR();
  pv_d0(o, vb0 + (int)SHM_V, pa0, pa1, pa2, pa3);
  if (hi == 0) li_l[r32] = l_reg; asm volatile("s_waitcnt lgkmcnt(0)" ::: "memory");
  float rli[16];
#pragma unroll
  for (int r = 0; r < 16; ++r) rli[r] = __builtin_amdgcn_rcpf(li_l[crow(r, hi)]);
  bf16* Ow = Ob + (long)(wid * QBLK) * LDO;
#pragma unroll
  for (int r = 0; r < 16; ++r) { int orow = crow(r, hi);
    for (int d0 = 0; d0 < 4; ++d0) Ow[(long)orow * LDO + d0 * 32 + r32] = __float2bfloat16(o[d0][r] * rli[r]); }
#undef SLOAD
#undef SWRITE
#undef SWAIT
#undef RESC
}

#undef KSWZ
#undef SBAR
}
#define GAS __attribute__((address_space(1)))
#define LAS __attribute__((address_space(3)))
typedef unsigned short bf16;
typedef unsigned v4u __attribute__((ext_vector_type(4)));
typedef float f32x4 __attribute__((ext_vector_type(4)));
typedef short bf16x8 __attribute__((ext_vector_type(8)));
typedef GAS unsigned gu32;
typedef GAS unsigned long long gu64;
#define RLX_AGENT __ATOMIC_RELAXED, __HIP_MEMORY_SCOPE_AGENT
#define LDS_WAIT() asm volatile("s_waitcnt lgkmcnt(0)" ::: "memory")
#define VM_WAIT() asm volatile("s_waitcnt vmcnt(0)" ::: "memory")
__device__ __forceinline__ unsigned long long rt() { return __builtin_amdgcn_s_memrealtime(); }
__device__ __forceinline__ unsigned f2bf(float f) { unsigned u = __builtin_bit_cast(unsigned, f); return (u + 0x7fffu + ((u >> 16) & 1u)) >> 16; }
__device__ __forceinline__ unsigned pk2(float lo, float hi) { return f2bf(lo) | (f2bf(hi) << 16); }

#define XB_TMO      128
#define XB_XCNT(j)  (256  + 64 * (j))
#define XB_XSUB(j)  (1280 + 64 * (j))
#define XB_XGEN(j)  (2304 + 64 * (j))
#define XB_TOP      3328
#define XB_TOPGEN   3392
#define XCD_BAR_WORDS 3456
#define XB_SPIN_CAP (1u << 18)

__device__ __forceinline__ unsigned xb_ld(unsigned* p)              { return __hip_atomic_load(p, __ATOMIC_RELAXED, __HIP_MEMORY_SCOPE_AGENT); }
__device__ __forceinline__ unsigned xb_add(unsigned* p, unsigned v) { return __hip_atomic_fetch_add(p, v, __ATOMIC_RELAXED, __HIP_MEMORY_SCOPE_AGENT); }
__device__ __forceinline__ unsigned xb_xcc_id() { return (unsigned)__builtin_amdgcn_s_getreg((3 << 11) | 20) & 0xFu; }
#define XB_SPIN(cond, bar) do { unsigned _sp = 0; while (cond) { __builtin_amdgcn_s_sleep(1); \
    if ((++_sp & 255u) == 0u) { if (xb_ld(&(bar)[XB_TMO])) break; if (_sp > XB_SPIN_CAP) { atomicAdd(&(bar)[XB_TMO], 1u); break; } } } } while (0)

struct XcdBarrier {
    unsigned* bar; unsigned x;
    volatile LAS unsigned* st;
};

__device__ __forceinline__ XcdBarrier xcd_barrier_post(unsigned* bar, volatile LAS unsigned* st) {
    XcdBarrier b; b.bar = bar; b.x = xb_xcc_id(); b.st = st;
    if (threadIdx.x == 0) (void)xb_add(&bar[XB_XCNT(b.x)], 1u);
    return b;
}
__device__ __forceinline__ void xcd_barrier_complete(unsigned* bar, unsigned x, unsigned& nloc, unsigned& nx) {
    const unsigned G = gridDim.x * gridDim.y * gridDim.z;
    unsigned sum, cnt, mine, sp = 0u;
    for (;;) {
        sum = 0u; cnt = 0u; mine = 0u;
#pragma unroll
        for (unsigned j = 0; j < 16; ++j) { const unsigned c = xb_ld(&bar[XB_XCNT(j)]); sum += c; cnt += (c > 0u) ? 1u : 0u; mine = (j == x) ? c : mine; }
        if (sum == G) break;
        __builtin_amdgcn_s_sleep(1);
        if ((++sp & 255u) == 0u) { if (xb_ld(&bar[XB_TMO])) break; if (sp > XB_SPIN_CAP) { atomicAdd(&bar[XB_TMO], 1u); break; } }
    }
    nloc = mine > 0u ? mine : 1u; nx = cnt > 0u ? cnt : 1u;
}

__device__ __forceinline__ void xcd_barrier(const XcdBarrier& b, const int tid_) {
    asm volatile("s_waitcnt vmcnt(0)" ::: "memory");
    __syncthreads();
    if (tid_ == 0) {
        unsigned* bar = b.bar;
        __builtin_amdgcn_s_waitcnt(0);
        unsigned nloc = b.st[0], nx = b.st[1];
        if (nloc == 0u) { xcd_barrier_complete(bar, b.x, nloc, nx); b.st[0] = nloc; b.st[1] = nx; }
        const unsigned old = xb_add(&bar[XB_XSUB(b.x)], 1u);
        const unsigned gen = old / nloc;
        if (old + 1u == (gen + 1u) * nloc) {
            __builtin_amdgcn_fence(__ATOMIC_RELEASE, "agent");
            asm volatile("s_waitcnt vmcnt(0)" ::: "memory");
            const unsigned og = xb_add(&bar[XB_TOP], 1u);
            const unsigned tg = og / nx;
            if (og + 1u == (tg + 1u) * nx) xb_add(&bar[XB_TOPGEN], 1u);
            else XB_SPIN(xb_ld(&bar[XB_TOPGEN]) == tg, bar);
            __builtin_amdgcn_fence(__ATOMIC_ACQUIRE, "agent");
            xb_add(&bar[XB_XGEN(b.x)], 1u);
            asm volatile("s_waitcnt vmcnt(0)" ::: "memory");
        } else {
            XB_SPIN(xb_ld(&bar[XB_XGEN(b.x)]) == gen, bar);
            __builtin_amdgcn_fence(__ATOMIC_ACQUIRE, "agent");
            asm volatile("s_waitcnt vmcnt(0)" ::: "memory");
        }
    }
    __syncthreads();
}


constexpr size_t MiB = 1u << 20;
constexpr size_t WS_CTL = 0, CTL_ZERO_BYTES = 64 * 1024;
constexpr size_t WS_AFF = 1 * MiB;
constexpr size_t WS_COS = 2 * MiB, WS_SIN = 4 * MiB;
constexpr size_t WS_IDX = 6 * MiB, WS_GATE = 6 * MiB + 256 * 1024, WS_SEL = 7 * MiB;
constexpr size_t WS_WIN = 8 * MiB;
constexpr size_t WS_WR = 18 * MiB, WS_WA = 19 * MiB, WS_WO = 20 * MiB;
constexpr size_t WS_W1C = 22 * MiB;
constexpr size_t WS_WD = 198 * MiB;
constexpr size_t WS_X1 = 286 * MiB;
constexpr size_t WS_H = 350 * MiB;
constexpr size_t WS_RQ = 382 * MiB, WS_RK = 398 * MiB, WS_RV = 414 * MiB, WS_RGS = 430 * MiB;
constexpr size_t WS_AQ = 446 * MiB, WS_AK = 462 * MiB, WS_AV = 470 * MiB;
constexpr size_t WS_GRS = 478 * MiB, WS_GAS = 510 * MiB;
constexpr size_t WS_KV = 542 * MiB;
constexpr size_t WS_S = 606 * MiB;
constexpr size_t WS_YRIN = 638 * MiB, WS_ATT = 654 * MiB;
constexpr size_t WS_MIXED = 670 * MiB;
constexpr size_t WS_XE = 382 * MiB, WS_ACT = 446 * MiB, WS_Y = 622 * MiB;
constexpr size_t WS_END = 704 * MiB;
static_assert(EP_COS == WS_COS && EP_SIN == WS_SIN && EP_RQ == WS_RQ && EP_RK == WS_RK && EP_RV == WS_RV && EP_RGS == WS_RGS && EP_AQ == WS_AQ && EP_AK == WS_AK && EP_AV == WS_AV && EP_GRS == WS_GRS && EP_GAS == WS_GAS, "epilogue offsets vs d_ws map");
constexpr int CW_BAR = 4096;

constexpr int RING_OFF = 0, RING_BYTES = 131072;
constexpr int LDSCTL_OFF = RING_BYTES, MISC_OFF = LDSCTL_OFF + 320;
constexpr int XCH_OFF = RING_BYTES + 1024;
constexpr int LDS_BYTES = 147456;
constexpr int NWAVES = 8;

__device__ __forceinline__ float wave_sum(float v) {
#pragma unroll
    for (int o = 1; o < 64; o <<= 1) v += __shfl_xor(v, o);
    return v;
}
__device__ __forceinline__ float bf2f(bf16 v) { return __uint_as_float((unsigned)v << 16); }

template <class CM>
__device__ __forceinline__ void transpose_item(const float* W, int K, int N, bf16* WT, const CM cm, LAS float* scr, int kb, int nb, int lane) {
    const int k0 = 64 * kb, n0 = 32 * nb;
    const int srccol = cm(n0 + (lane & 31));
    float tv[32];
#pragma unroll
    for (int i = 0; i < 32; ++i) tv[i] = __builtin_nontemporal_load(W + (size_t)(k0 + 2 * i + (lane >> 5)) * N + srccol);
#pragma unroll
    for (int i = 0; i < 32; ++i) scr[(2 * i + (lane >> 5)) * 33 + (lane & 31)] = tv[i];
    LDS_WAIT(); asm volatile("" ::: "memory");
    const int c = lane & 7;
#pragma unroll
    for (int j = 0; j < 4; ++j) { const int n = (lane >> 3) + 8 * j; const LAS float* s = scr + (8 * c) * 33 + n;
        v4u o; o.x = pk2(s[0 * 33], s[1 * 33]); o.y = pk2(s[2 * 33], s[3 * 33]); o.z = pk2(s[4 * 33], s[5 * 33]); o.w = pk2(s[6 * 33], s[7 * 33]);
        __builtin_nontemporal_store(o, (GAS v4u*)(WT + (size_t)(n0 + n) * K + k0 + 8 * c)); }
    LDS_WAIT(); asm volatile("" ::: "memory");
}
__device__ __forceinline__ unsigned pk4_fp8(float a, float b, float c, float d) { int w = 0; w = __builtin_amdgcn_cvt_pk_fp8_f32(a, b, w, false); w = __builtin_amdgcn_cvt_pk_fp8_f32(c, d, w, true); return (unsigned)w; }
template <class CM>
__device__ __forceinline__ void transpose_item_f8(const float* W, int K, int N, unsigned char* WT, const CM cm, LAS float* scr, int kb, int nb, int lane, float scale) {
    const int k0 = 64 * kb, n0 = 32 * nb;
    const int srccol = cm(n0 + (lane & 31));
    float tv[32];
#pragma unroll
    for (int i = 0; i < 32; ++i) tv[i] = __builtin_nontemporal_load(W + (size_t)(k0 + 2 * i + (lane >> 5)) * N + srccol);
#pragma unroll
    for (int i = 0; i < 32; ++i) scr[(2 * i + (lane >> 5)) * 33 + (lane & 31)] = tv[i];
    LDS_WAIT(); asm volatile("" ::: "memory");
    const int c = lane & 7;
#pragma unroll
    for (int j = 0; j < 4; ++j) { const int n = (lane >> 3) + 8 * j; const LAS float* sp = scr + (8 * c) * 33 + n;
        const unsigned lo = pk4_fp8(sp[0 * 33] * scale, sp[1 * 33] * scale, sp[2 * 33] * scale, sp[3 * 33] * scale), hi = pk4_fp8(sp[4 * 33] * scale, sp[5 * 33] * scale, sp[6 * 33] * scale, sp[7 * 33] * scale);
        __builtin_nontemporal_store((unsigned long long)lo | ((unsigned long long)hi << 32), (GAS unsigned long long*)(WT + (size_t)(n0 + n) * K + k0 + 8 * c)); }
    LDS_WAIT(); asm volatile("" ::: "memory");
}
struct CmId { __device__ __forceinline__ int operator()(int n) const { return n; } };
struct CmWin {
    __device__ __forceinline__ int operator()(int n) const {
        const bool rope = (n < 1024) || (n >= 2048 && n < 2816);
        const int L = n & 127, g = L >> 3, i = L & 7, o = (i < 4) ? (4 * g + i) : (64 + 4 * g + (i - 4));
        return rope ? ((n & ~127) + o) : n; }
};
struct CmW1 { __device__ __forceinline__ int operator()(int n) const { return 128 * (n >> 8) + (n & 127); } };

__device__ __forceinline__ void rms_row_to_bf16(const float* xrow, const float* gain, bf16* orow, int lane) {
    const GAS f32x4* xr = (const GAS f32x4*)xrow + lane; const GAS f32x4* gr = (const GAS f32x4*)gain + lane;
    f32x4 v[4]; float s = 0.f;
#pragma unroll
    for (int j = 0; j < 4; ++j) { v[j] = xr[64 * j]; s += (v[j].x * v[j].x + v[j].y * v[j].y) + (v[j].z * v[j].z + v[j].w * v[j].w); }
    const float rstd = 1.f / sqrtf(wave_sum(s) * (1.f / D_MODEL) + EPS);
    GAS unsigned long long* o8 = (GAS unsigned long long*)orow + lane;
#pragma unroll
    for (int j = 0; j < 4; ++j) { const f32x4 g4 = gr[64 * j]; o8[64 * j] = (unsigned long long)pk2(v[j].x * rstd * g4.x, v[j].y * rstd * g4.y) | ((unsigned long long)pk2(v[j].z * rstd * g4.z, v[j].w * rstd * g4.w) << 32); }
}


namespace ret {
typedef short bf16x8 __attribute__((ext_vector_type(8)));
typedef short v4i16 __attribute__((ext_vector_type(4)));
constexpr int PITCH = 272;
constexpr int TILE_B = 128 * PITCH;
constexpr int STRIP_B = 16 * PITCH;
__device__ __forceinline__ float lg2_of(const float* p, int h) { return log1pf(-expf(p[h])) * 1.4426950408889634f; }
__device__ __forceinline__ unsigned cvt2(float lo, float hi) { typedef float f2 __attribute__((ext_vector_type(2))); typedef __bf16 b2 __attribute__((ext_vector_type(2))); f2 v = {lo, hi}; b2 b = __builtin_convertvector(v, b2); return __builtin_bit_cast(unsigned, b); }
__device__ __forceinline__ bf16x8 frag_tr(LAS const unsigned char* tile, int k0, int n0, int lane) {
    const int g = lane >> 4, q = (lane >> 2) & 3, p = lane & 3;
    LAS const unsigned char* a = tile + (k0 + 8 * g + q) * PITCH + (n0 + 4 * p) * 2;
    const v4i16 lo = __builtin_amdgcn_ds_read_tr16_b64_v4i16((LAS v4i16*)a);
    const v4i16 hi = __builtin_amdgcn_ds_read_tr16_b64_v4i16((LAS v4i16*)(a + 4 * PITCH));
    return (bf16x8){lo[0], lo[1], lo[2], lo[3], hi[0], hi[1], hi[2], hi[3]};
}
__device__ __forceinline__ bf16x8 frag_row(LAS const unsigned char* tile, int r0, int k0, int lane) { return *(LAS const bf16x8*)(tile + (r0 + (lane & 15)) * PITCH + (k0 + 8 * (lane >> 4)) * 2); }
__device__ __forceinline__ void stage_tile(LAS unsigned char* tile, const bf16* src, long tok0, int h, int tid) {
#pragma unroll
    for (int i = 0; i < 4; ++i) { const int q = tid + 512 * i, row = q >> 4, ch = q & 15;
        const v4u v = *(const GAS v4u*)(src + (tok0 + row) * 512 + h * HD + ch * 8); *(LAS v4u*)(tile + row * PITCH + ch * 16) = v; }
}
__device__ __forceinline__ void kv_item(int item, LAS unsigned char* lds, const bf16* rk, const bf16* rv, const float* pf, const float* pb, float* kv, int tid) {
    asm volatile("" : "+v"(tid));
    const int c = item & 63, bh = item >> 6, b = bh >> 2, h = bh & 3, lane = tid & 63, w = tid >> 6, g = lane >> 4;
    const long tok0 = (long)b * SEQ + (long)c * CHUNK;
    LAS unsigned char* Kl = lds; LAS unsigned char* Vl = lds + TILE_B;
    stage_tile(Kl, rk, tok0, h, tid); stage_tile(Vl, rv, tok0, h, tid);
    __syncthreads();
    const float lf = lg2_of(pf, h), lb = lg2_of(pb, h);
    f32x4 accf[8], accb[8];
#pragma unroll
    for (int n = 0; n < 8; ++n) { accf[n] = (f32x4){0.f, 0.f, 0.f, 0.f}; accb[n] = (f32x4){0.f, 0.f, 0.f, 0.f}; }
#pragma unroll
    for (int kk = 0; kk < 4; ++kk) {
        const bf16x8 a = frag_tr(Vl, 32 * kk, 16 * w, lane);
        bf16x8 af, ab;
        { unsigned pf_[4], pb_[4];
#pragma unroll
          for (int t = 0; t < 8; t += 2) { const int j = 32 * kk + 8 * g + t;
              const float v0 = __uint_as_float((unsigned)(unsigned short)a[t] << 16), v1 = __uint_as_float((unsigned)(unsigned short)a[t + 1] << 16);
              pf_[t >> 1] = cvt2(v0 * __builtin_amdgcn_exp2f(lf * (float)(127 - j)), v1 * __builtin_amdgcn_exp2f(lf * (float)(126 - j)));
              pb_[t >> 1] = cvt2(v0 * __builtin_amdgcn_exp2f(lb * (float)j), v1 * __builtin_amdgcn_exp2f(lb * (float)(j + 1))); }
          const v4u wf_ = {pf_[0], pf_[1], pf_[2], pf_[3]}, wb_ = {pb_[0], pb_[1], pb_[2], pb_[3]};
          af = __builtin_bit_cast(bf16x8, wf_); ab = __builtin_bit_cast(bf16x8, wb_); }
#pragma unroll
        for (int n = 0; n < 8; ++n) { const bf16x8 bk = frag_tr(Kl, 32 * kk, 16 * n, lane);
            accf[n] = __builtin_amdgcn_mfma_f32_16x16x32_bf16(af, bk, accf[n], 0, 0, 0); accb[n] = __builtin_amdgcn_mfma_f32_16x16x32_bf16(ab, bk, accb[n], 0, 0, 0); }
    }
    float* of = kv + (((long)0 * 8 + bh) * NCHUNK + c) * (HD * HD); float* ob = kv + (((long)1 * 8 + bh) * NCHUNK + c) * (HD * HD);
#pragma unroll
    for (int n = 0; n < 8; ++n)
#pragma unroll
        for (int r = 0; r < 4; ++r) { const int o = (16 * w + 4 * g + r) * HD + 16 * n + (lane & 15); of[o] = accf[n][r]; ob[o] = accb[n][r]; }
    __syncthreads();
}
__device__ __forceinline__ void scan_thread(long gid, const float* pf, const float* pb, const float* kv, bf16* S) {
    const int el = (int)(gid & 16383), bh = (int)((gid >> 14) & 7), dir = (int)(gid >> 17), h = bh & 3;
    const float gC = __builtin_amdgcn_exp2f(lg2_of(dir ? pb : pf, h) * (float)CHUNK);
    const float* p = kv + (((long)dir * 8 + bh) * NCHUNK) * (HD * HD) + el; bf16* o = S + (((long)dir * 8 + bh) * NCHUNK) * (HD * HD) + el;
    float st = 0.f;
    if (dir == 0) {
#pragma unroll 8
        for (int c = 0; c < NCHUNK; ++c) { const float v = p[(long)c * HD * HD]; o[(long)c * HD * HD] = (bf16)f2bf(st); st = st * gC + v; } }
    else {
#pragma unroll 8
        for (int c = NCHUNK - 1; c >= 0; --c) { const float v = p[(long)c * HD * HD]; o[(long)c * HD * HD] = (bf16)f2bf(st); st = st * gC + v; } }
}
__device__ __forceinline__ void out_item(int item, LAS unsigned char* lds, const bf16* rq, const bf16* rk, const bf16* rv, const bf16* rgs, const float* pf, const float* pb,
                                         const bf16* S, const float* gain, bf16* yrin, int tid) {
    asm volatile("" : "+v"(tid));
    const int c = item & 63, bh = item >> 6, b = bh >> 2, h = bh & 3, lane = tid & 63, w = tid >> 6, g = lane >> 4, lc = lane & 15;
    const long tok0 = (long)b * SEQ + (long)c * CHUNK;
    LAS unsigned char* Kl = lds; LAS unsigned char* Vl = lds + TILE_B; LAS unsigned char* strip = lds + 2 * TILE_B + w * STRIP_B;
    stage_tile(Kl, rk, tok0, h, tid); stage_tile(Vl, rv, tok0, h, tid);
    bf16x8 qa[4];
#pragma unroll
    for (int kk = 0; kk < 4; ++kk) qa[kk] = *(const GAS bf16x8*)(rq + (tok0 + 16 * w + lc) * 512 + h * HD + 32 * kk + 8 * g);
    __syncthreads();
    const float lf = lg2_of(pf, h), lb = lg2_of(pb, h);
    {
        f32x4 sc[8];
#pragma unroll
        for (int n = 0; n < 8; ++n) { sc[n] = (f32x4){0.f, 0.f, 0.f, 0.f};
#pragma unroll
            for (int kk = 0; kk < 4; ++kk) sc[n] = __builtin_amdgcn_mfma_f32_16x16x32_bf16(qa[kk], frag_row(Kl, 16 * n, 32 * kk, lane), sc[n], 0, 0, 0); }
#pragma unroll
        for (int n = 0; n < 8; ++n)
#pragma unroll
            for (int r = 0; r < 4; ++r) { const int i = 16 * w + 4 * g + r, j = 16 * n + lc; const int df = i - j;
                const float dec = __builtin_amdgcn_exp2f(df >= 0 ? lf * (float)df : lb * (float)(-df));
                *(LAS unsigned short*)(strip + (4 * g + r) * PITCH + j * 2) = (unsigned short)f2bf(sc[n][r] * dec); }
    }
    asm volatile("s_waitcnt lgkmcnt(0)" ::: "memory");
    bf16x8 qf[4], qb[4];
    { const int ia = 16 * w + lc; const float cf = __builtin_amdgcn_exp2f(lf * (float)(ia + 1)), cb = __builtin_amdgcn_exp2f(lb * (float)(CHUNK - ia));
#pragma unroll
      for (int kk = 0; kk < 4; ++kk) { unsigned pf_[4], pb_[4];
#pragma unroll
          for (int t = 0; t < 8; t += 2) { const float v0 = __uint_as_float((unsigned)(unsigned short)qa[kk][t] << 16), v1 = __uint_as_float((unsigned)(unsigned short)qa[kk][t + 1] << 16);
              pf_[t >> 1] = cvt2(v0 * cf, v1 * cf); pb_[t >> 1] = cvt2(v0 * cb, v1 * cb); }
          const v4u wf_ = {pf_[0], pf_[1], pf_[2], pf_[3]}, wb_ = {pb_[0], pb_[1], pb_[2], pb_[3]};
          qf[kk] = __builtin_bit_cast(bf16x8, wf_); qb[kk] = __builtin_bit_cast(bf16x8, wb_); } }
    f32x4 o[8];
#pragma unroll
    for (int n = 0; n < 8; ++n) o[n] = (f32x4){0.f, 0.f, 0.f, 0.f};
    const bf16* Sf = S + (((long)0 * 8 + bh) * NCHUNK + c) * (HD * HD); const bf16* Sb = S + (((long)1 * 8 + bh) * NCHUNK + c) * (HD * HD);
#pragma unroll
    for (int kh = 0; kh < 2; ++kh) {
        bf16x8 bfv[2][8], bbv[2][8];
#pragma unroll
        for (int k2 = 0; k2 < 2; ++k2)
#pragma unroll
            for (int n = 0; n < 8; ++n) { const int kk = 2 * kh + k2; bfv[k2][n] = *(const GAS bf16x8*)(Sf + (16 * n + lc) * HD + 32 * kk + 8 * g); bbv[k2][n] = *(const GAS bf16x8*)(Sb + (16 * n + lc) * HD + 32 * kk + 8 * g); }
#pragma unroll
        for (int k2 = 0; k2 < 2; ++k2) { const int kk = 2 * kh + k2;
            const bf16x8 sa = frag_row(strip, 0, 32 * kk, lane);
#pragma unroll
            for (int n = 0; n < 8; ++n) {
                o[n] = __builtin_amdgcn_mfma_f32_16x16x32_bf16(sa, frag_tr(Vl, 32 * kk, 16 * n, lane), o[n], 0, 0, 0);
                o[n] = __builtin_amdgcn_mfma_f32_16x16x32_bf16(qf[kk], bfv[k2][n], o[n], 0, 0, 0); o[n] = __builtin_amdgcn_mfma_f32_16x16x32_bf16(qb[kk], bbv[k2][n], o[n], 0, 0, 0); } }
        asm volatile("" ::: "memory");
    }
    asm volatile("s_waitcnt lgkmcnt(0)" ::: "memory");
#pragma unroll
    for (int r = 0; r < 4; ++r) {
        float y[8]; float s = 0.f;
#pragma unroll
        for (int n = 0; n < 8; ++n) { y[n] = o[n][r]; s += y[n]; }
        s += __shfl_xor(s, 1); s += __shfl_xor(s, 2); s += __shfl_xor(s, 4); s += __shfl_xor(s, 8);
        const float mu = s * (1.0f / HD); float s2 = 0.f;
#pragma unroll
        for (int n = 0; n < 8; ++n) { y[n] -= mu; s2 += y[n] * y[n]; }
        s2 += __shfl_xor(s2, 1); s2 += __shfl_xor(s2, 2); s2 += __shfl_xor(s2, 4); s2 += __shfl_xor(s2, 8);
        const float rstd = 1.0f / sqrtf(s2 * (1.0f / HD) + EPS);
#pragma unroll
        for (int n = 0; n < 8; ++n) *(LAS unsigned short*)(strip + (4 * g + r) * PITCH + (16 * n + lc) * 2) = (unsigned short)f2bf(y[n] * rstd); }
    asm volatile("s_waitcnt lgkmcnt(0)" ::: "memory");
    { const int row = lane >> 2, qc = lane & 3; const long ro = (tok0 + 16 * w + row) * 512 + h * HD;
#pragma unroll
      for (int t = 0; t < 4; ++t) { const int e0 = 32 * qc + 8 * t;
          const v4u yv = *(LAS const v4u*)(strip + row * PITCH + e0 * 2);
          const f32x4 y0 = {__uint_as_float(yv.x << 16), __uint_as_float(yv.x & 0xffff0000u), __uint_as_float(yv.y << 16), __uint_as_float(yv.y & 0xffff0000u)};
          const f32x4 y1 = {__uint_as_float(yv.z << 16), __uint_as_float(yv.z & 0xffff0000u), __uint_as_float(yv.w << 16), __uint_as_float(yv.w & 0xffff0000u)};
          const f32x4 g0 = *(const GAS f32x4*)(gain + h * HD + e0), g1 = *(const GAS f32x4*)(gain + h * HD + e0 + 4);
          const v4u rg = *(const GAS v4u*)(rgs + ro + e0);
          const f32x4 r0 = {__uint_as_float(rg.x << 16), __uint_as_float(rg.x & 0xffff0000u), __uint_as_float(rg.y << 16), __uint_as_float(rg.y & 0xffff0000u)};
          const f32x4 r1 = {__uint_as_float(rg.z << 16), __uint_as_float(rg.z & 0xffff0000u), __uint_as_float(rg.w << 16), __uint_as_float(rg.w & 0xffff0000u)};
          const f32x4 a0 = y0 * g0 * r0, a1 = y1 * g1 * r1;
          v4u ov; ov.x = cvt2(a0[0], a0[1]); ov.y = cvt2(a0[2], a0[3]); ov.z = cvt2(a1[0], a1[1]); ov.w = cvt2(a1[2], a1[3]);
          *(GAS v4u*)(yrin + ro + e0) = ov; } }
    __syncthreads();
}
}

struct Args { const float* in[17]; float* out; unsigned char* ws; int ph_lo, ph_hi; };
constexpr int PH_PROLOGUE = 0, PH_PROJ = 1, PH_RETKV = 2, PH_ATTN = 3, PH_RETOUT = 4, PH_BRANCH = 5, PH_WO = 6, PH_ROUTER = 7, PH_TOPK = 8, PH_GATHER = 9, PH_MOE1 = 10, PH_MOE2 = 11, PH_FINAL = 12, PH_END = 13;
#ifndef MK_EXPERT_CVT
#define MK_EXPERT_CVT 1
#endif

__global__ void __launch_bounds__(NWAVES * 64, 2) mega(Args args) {
    extern __shared__ __attribute__((aligned(16))) unsigned char lds_raw[];
    LAS unsigned char* lds = (LAS unsigned char*)lds_raw;
    volatile LAS unsigned* MISC = (volatile LAS unsigned*)(lds + MISC_OFF);
    const int wave = __builtin_amdgcn_readfirstlane((int)threadIdx.x >> 6);
#define PHASE_IDS int lane; asm volatile("v_mbcnt_lo_u32_b32 %0, -1, 0\n\tv_mbcnt_hi_u32_b32 %0, -1, %0" : "=v"(lane)); const int tid = wave * 64 + lane; (void)tid;
    const int G = gridDim.x; const int bx = blockIdx.x; const int vcu = (G % 8 == 0) ? (bx % 8) * (G / 8) + bx / 8 : bx;
    unsigned char* ws = args.ws;
    gu32* ctl = (gu32*)(ws + WS_CTL);
    for (int u = threadIdx.x; u < (LDS_BYTES - LDSCTL_OFF) / 4; u += NWAVES * 64) ((LAS unsigned*)(lds + LDSCTL_OFF))[u] = 0u;
    __syncthreads();
    const bool one_launch = (args.ph_hi - args.ph_lo) > 1;
    XcdBarrier bar; bar.bar = (unsigned*)(ctl + CW_BAR); bar.x = 0; bar.st = nullptr;
    if (one_launch) bar = xcd_barrier_post((unsigned*)(ctl + CW_BAR), MISC + 8);
    const int lo = args.ph_lo, hi = args.ph_hi;
#define IN(k) (lo <= (k) && (k) < hi)
#define SEAM(k) do { if (IN(k) && IN((k) + 1)) { PHASE_IDS xcd_barrier(bar, tid); } } while (0)
    const int gw = vcu * NWAVES + wave, NGW = G * NWAVES;

    if (IN(PH_PROLOGUE)) { PHASE_IDS
        LAS float* scr = (LAS float*)(lds + RING_OFF + wave * 16384);
        const float* w_in = args.in[2]; const float* w_ret = args.in[6]; const float* w_att = args.in[9]; const float* w_o = args.in[10];
        const float* wg = args.in[13]; const float* wu = args.in[14];
        constexpr int I_IN = 16 * 160, I_R = 8 * 32, I_A = 8 * 32, I_O = 16 * 32, I_1 = 16 * 176;
        constexpr int NSMALL = I_IN + I_R + I_A + I_O;
        const int NITEMS = NSMALL + NE * I_1;
        for (int it = gw; it < NITEMS; it += NGW) {
            int r = it;
            if (r < I_IN) { transpose_item(w_in, 1024, INW, (bf16*)(ws + WS_WIN), CmWin(), scr, r / 160, r % 160, lane); continue; } r -= I_IN;
            if (r < I_R) { transpose_item(w_ret, 512, D_MODEL, (bf16*)(ws + WS_WR), CmId(), scr, r / 32, r % 32, lane); continue; } r -= I_R;
            if (r < I_A) { transpose_item(w_att, 512, D_MODEL, (bf16*)(ws + WS_WA), CmId(), scr, r / 32, r % 32, lane); continue; } r -= I_A;
            if (r < I_O) { transpose_item(w_o, 1024, D_MODEL, (bf16*)(ws + WS_WO), CmId(), scr, r / 32, r % 32, lane); continue; } r -= I_O;
            { const int e = r / I_1, q = r % I_1, kb = q / 176, nb = q % 176; const bool up = (nb >> 2) & 1;
                transpose_item_f8((up ? wu : wg) + (size_t)e * D_MODEL * FF, 1024, FF, (unsigned char*)(ws + WS_W1C) + (size_t)e * 5632 * 1024, CmW1(), scr, kb, nb, lane, W1_SCALE); }
        }
        for (int m = gw; m < T; m += NGW) rms_row_to_bf16(args.in[0] + (size_t)m * D_MODEL, args.in[1], (bf16*)(ws + WS_H) + (size_t)m * D_MODEL, lane);
        { float* ct = (float*)(ws + WS_COS); float* st = (float*)(ws + WS_SIN);
          for (int e = (vcu * NWAVES * 64) + tid; e < SEQ * 64; e += G * NWAVES * 64) { const int pos = e >> 6, j = e & 63;
              const float freq = powf(10000.0f, -(float)(j & 31) / 32.0f); const float ang = (float)(j < 32 ? (pos >> 6) : (pos & 63)) * freq;
              ct[e] = cosf(ang); st[e] = sinf(ang); } }
    }
    SEAM(PH_PROLOGUE);

    if (IN(PH_PROJ)) { PHASE_IDS
        pg8::PlainSched S; S.init(T, INW, G, bx); S.A = (const char*)(ws + WS_H); S.Bt = (const char*)(ws + WS_WIN); S.tstep = (size_t)256 * 1024 * 2;
        pg8::EpiProj E; E.wsb = ws; E.qn = args.in[7]; E.kn = args.in[8]; E.xch = (LAS float*)(lds + XCH_OFF); E.epoch = 0u;
        pg8::gemm_phase<pg8::EpiProj, pg8::PlainSched, true, true>(lds + RING_OFF, 1024, S, E, tid);
    }
    SEAM(PH_PROJ);

    if (IN(PH_RETKV)) { PHASE_IDS
        for (int item = vcu; item < 8 * NCHUNK; item += G)
            ret::kv_item(item, lds + RING_OFF, (const bf16*)(ws + WS_RK), (const bf16*)(ws + WS_RV), args.in[3], args.in[4], (float*)(ws + WS_KV), tid);
    }
    SEAM(PH_RETKV);

    if (IN(PH_ATTN)) { PHASE_IDS
        for (long gid = (long)vcu * 512 + tid; gid < 2 * 8 * 16384; gid += (long)G * 512) ret::scan_thread(gid, args.in[3], args.in[4], (const float*)(ws + WS_KV), (bf16*)(ws + WS_S));
    }

    if (IN(PH_ATTN)) { PHASE_IDS
        for (int u = vcu; u < BATCH * 4 * (SEQ / 256); u += G) {
            const int bh = u >> 5, qb = u & 31, b = bh >> 2, h = bh & 3, kvh = h >> 1;
            const size_t q0 = ((size_t)b * SEQ + (size_t)qb * 256) * 512 + (size_t)h * 128, k0 = (size_t)b * SEQ * 256 + (size_t)kvh * 128;
            attn::attn_dense_body<attn::bf16>((const attn::bf16*)(ws + WS_AQ) + q0, (const attn::bf16*)(ws + WS_AK) + k0, (const attn::bf16*)(ws + WS_AV) + k0,
                                              (attn::bf16*)(ws + WS_ATT) + q0, SEQ, (char*)lds_raw, tid);
            __syncthreads();
        }
    }
    SEAM(PH_ATTN);

    if (IN(PH_RETOUT)) { PHASE_IDS
        for (int item = vcu; item < 8 * NCHUNK; item += G)
            ret::out_item(item, lds + RING_OFF, (const bf16*)(ws + WS_RQ), (const bf16*)(ws + WS_RK), (const bf16*)(ws + WS_RV), (const bf16*)(ws + WS_RGS), args.in[3], args.in[4],
                          (const bf16*)(ws + WS_S), args.in[5], (bf16*)(ws + WS_YRIN), tid);
    }
    SEAM(PH_RETOUT);

    if (IN(PH_BRANCH)) { PHASE_IDS
        pg8::BranchSched S; S.init(T, D_MODEL, G, bx); S.A0 = (const char*)(ws + WS_YRIN); S.A1 = (const char*)(ws + WS_ATT); S.B0 = (const char*)(ws + WS_WR); S.B1 = (const char*)(ws + WS_WA); S.tstep = (size_t)256 * 512 * 2;
        pg8::EpiBranch E; E.grs = (const bf16*)(ws + WS_GRS); E.gas = (const bf16*)(ws + WS_GAS); E.mixed = (bf16*)(ws + WS_MIXED);
        pg8::gemm_phase<pg8::EpiBranch, pg8::BranchSched, true, true>(lds + RING_OFF, 512, S, E, tid);
    }
    SEAM(PH_BRANCH);

    if (IN(PH_WO)) { PHASE_IDS
        pg8::PlainSched S; S.init(T, D_MODEL, G, bx); S.A = (const char*)(ws + WS_MIXED); S.Bt = (const char*)(ws + WS_WO); S.tstep = (size_t)256 * 1024 * 2;
        pg8::EpiResid E; E.x = args.in[0]; E.x1 = (float*)(ws + WS_X1);
        pg8::gemm_phase<pg8::EpiResid, pg8::PlainSched, true, true>(lds + RING_OFF, 1024, S, E, tid);
    }
    SEAM(PH_WO);

    if (IN(PH_ROUTER)) { PHASE_IDS
        LAS float* wl = (LAS float*)(lds + RING_OFF);
        { const GAS float* src = (const GAS float*)args.in[12]; for (int i = tid; i < 1024 * 16; i += NWAVES * 64) wl[(i & 15) * 1024 + (i >> 4)] = src[i]; }
        __syncthreads();
        const float* x1 = (const float*)(ws + WS_X1); const float* gain = args.in[11]; bf16* h2 = (bf16*)(ws + WS_H); float* aff = (float*)(ws + WS_AFF);
        const GAS f32x4* gr = (const GAS f32x4*)gain + lane;
        f32x4 v[4];
        if (gw < T) { const GAS f32x4* xr = (const GAS f32x4*)(x1 + (size_t)gw * D_MODEL) + lane;
#pragma unroll
            for (int j = 0; j < 4; ++j) v[j] = xr[64 * j]; }
        for (int m = gw; m < T; m += NGW) {
            f32x4 nv[4];
            { const int mn = (m + NGW < T) ? m + NGW : m; const GAS f32x4* xn = (const GAS f32x4*)(x1 + (size_t)mn * D_MODEL) + lane;
#pragma unroll
              for (int j = 0; j < 4; ++j) nv[j] = xn[64 * j]; }
            float s = 0.f;
#pragma unroll
            for (int j = 0; j < 4; ++j) s += (v[j].x * v[j].x + v[j].y * v[j].y) + (v[j].z * v[j].z + v[j].w * v[j].w);
            const float rstd = 1.f / sqrtf(wave_sum(s) * (1.f / D_MODEL) + EPS);
            float lg[NE];
#pragma unroll
            for (int e = 0; e < NE; ++e) lg[e] = 0.f;
            GAS unsigned* o4 = (GAS unsigned*)((unsigned char*)h2 + (size_t)m * D_MODEL) + lane;
#pragma unroll
            for (int j = 0; j < 4; ++j) { const f32x4 g4 = gr[64 * j]; const f32x4 hv = v[j] * g4 * rstd;
                o4[64 * j] = pk4_fp8(hv.x, hv.y, hv.z, hv.w);
#pragma unroll
                for (int e = 0; e < NE; ++e) { const f32x4 w = *(const LAS f32x4*)(wl + e * 1024 + 4 * lane + 256 * j); lg[e] += (hv.x * w.x + hv.y * w.y) + (hv.z * w.z + hv.w * w.w); if ((e & 3) == 3) asm volatile("" ::: "memory"); }
                asm volatile("" ::: "memory"); }
            float r8[8], r4[4], r2[2], r1;
            { const bool b = (lane & 32) != 0;
#pragma unroll
              for (int e = 0; e < 8; ++e) { const float keep = b ? lg[e + 8] : lg[e], send = b ? lg[e] : lg[e + 8]; r8[e] = keep + __shfl_xor(send, 32); } }
            { const bool b = (lane & 16) != 0;
#pragma unroll
              for (int e = 0; e < 4; ++e) { const float keep = b ? r8[e + 4] : r8[e], send = b ? r8[e] : r8[e + 4]; r4[e] = keep + __shfl_xor(send, 16); } }
            { const bool b = (lane & 8) != 0;
#pragma unroll
              for (int e = 0; e < 2; ++e) { const float keep = b ? r4[e + 2] : r4[e], send = b ? r4[e] : r4[e + 2]; r2[e] = keep + __shfl_xor(send, 8); } }
            { const bool b = (lane & 4) != 0; const float keep = b ? r2[1] : r2[0], send = b ? r2[0] : r2[1]; r1 = keep + __shfl_xor(send, 4); }
            r1 += __shfl_xor(r1, 2); r1 += __shfl_xor(r1, 1);
            float mx = r1; mx = fmaxf(mx, __shfl_xor(mx, 4)); mx = fmaxf(mx, __shfl_xor(mx, 8)); mx = fmaxf(mx, __shfl_xor(mx, 16)); mx = fmaxf(mx, __shfl_xor(mx, 32));
            const float pe = expf(r1 - mx); float den = pe; den += __shfl_xor(den, 4); den += __shfl_xor(den, 8); den += __shfl_xor(den, 16); den += __shfl_xor(den, 32);
            if ((lane & 3) == 0) aff[(size_t)m * NE + (((lane >> 5) & 1) * 8 + ((lane >> 4) & 1) * 4 + ((lane >> 3) & 1) * 2 + ((lane >> 2) & 1))] = pe / den;
#pragma unroll
            for (int j = 0; j < 4; ++j) v[j] = nv[j];
        }
        __syncthreads();
    }
    SEAM(PH_ROUTER);

    if (IN(PH_TOPK)) { PHASE_IDS
        if (vcu >= NZ) {
            const int lane_c = lane;
            LAS float* scr = (LAS float*)(lds + RING_OFF + wave * 16384); const float* wd = args.in[15]; constexpr int I_D = 44 * 32;
            for (int it = (vcu - NZ) * NWAVES + wave; it < NE * I_D; it += (G - NZ) * NWAVES) { const int e = it / I_D, q = it % I_D;
                transpose_item_f8(wd + (size_t)e * FF * D_MODEL, FF, D_MODEL, (unsigned char*)(ws + WS_WD) + (size_t)e * 1024 * FF, CmId(), scr, q / 32, q % 32, lane_c, WD_SCALE); }
        }
        LAS unsigned* keys = (LAS unsigned*)(lds + RING_OFF); LAS int* hist = (LAS int*)(lds + RING_OFF + 32768); LAS int* sc = (LAS int*)(lds + RING_OFF + 34816); volatile LAS unsigned* sv = (volatile LAS unsigned*)(lds + RING_OFF + 36864);
        const float* aff = (const float*)(ws + WS_AFF); int* idx = (int*)(ws + WS_IDX); float* gate = (float*)(ws + WS_GATE); int* sel = (int*)(ws + WS_SEL);
        for (int z = vcu; z < NZ; z += G) {
            const int b = z / NE, e = z % NE;
            for (int i = tid; i < SEQ; i += 512) keys[i] = __float_as_uint(aff[((size_t)b * SEQ + i) * NE + e]);
            if (tid == 0) { sv[0] = 0u; sv[1] = (unsigned)CAP; }
            __syncthreads();
            unsigned mask = 0u;
            for (int pass = 3; pass >= 0; --pass) {
                const int shift = pass * 8;
                if (tid < 256) hist[tid] = 0;
                __syncthreads();
                const unsigned prefix = sv[0];
                for (int i = tid; i < SEQ; i += 512) { const unsigned k = keys[i]; if ((k & mask) == prefix) atomicAdd((int*)&hist[(k >> shift) & 255u], 1); }
                __syncthreads();
                if (tid < 64) {
                    const int krem = (int)sv[1]; const int h0 = hist[4 * tid], h1 = hist[4 * tid + 1], h2 = hist[4 * tid + 2], h3 = hist[4 * tid + 3];
                    int suf = h0 + h1 + h2 + h3;
#pragma unroll
                    for (int o = 1; o < 64; o <<= 1) { const int t = __shfl_down(suf, o); if (tid + o < 64) suf += t; }
                    int cum = suf - (h0 + h1 + h2 + h3);
                    int dsel = -1, cumsel = 0;
                    if (cum < krem && cum + h3 >= krem) { dsel = 3; cumsel = cum; } cum += h3;
                    if (dsel < 0 && cum < krem && cum + h2 >= krem) { dsel = 2; cumsel = cum; } cum += h2;
                    if (dsel < 0 && cum < krem && cum + h1 >= krem) { dsel = 1; cumsel = cum; } cum += h1;
                    if (dsel < 0 && cum < krem && cum + h0 >= krem) { dsel = 0; cumsel = cum; }
                    if (dsel >= 0) { sv[1] = (unsigned)(krem - cumsel); sv[0] = prefix | ((unsigned)(4 * tid + dsel) << shift); }
                }
                __syncthreads();
                mask |= 0xFFu << shift;
            }
            const unsigned Tk = sv[0]; const int krem = (int)sv[1];
            int cgt = 0, ceq = 0;
            for (int q = 0; q < 16; ++q) { const unsigned k = keys[tid * 16 + q]; cgt += (k > Tk); ceq += (k == Tk); }
            int eqbase, slot;
            { sc[tid] = ceq; __syncthreads(); for (int off = 1; off < 512; off <<= 1) { const int t = (tid >= off) ? sc[tid - off] : 0; __syncthreads(); sc[tid] += t; __syncthreads(); } eqbase = sc[tid] - ceq; __syncthreads(); }
            int take = krem - eqbase; take = take < 0 ? 0 : (take > ceq ? ceq : take);
            { const int v = cgt + take; sc[tid] = v; __syncthreads(); for (int off = 1; off < 512; off <<= 1) { const int t = (tid >= off) ? sc[tid - off] : 0; __syncthreads(); sc[tid] += t; __syncthreads(); } slot = sc[tid] - v; __syncthreads(); }
            int eqr = eqbase;
            for (int q = 0; q < 16; ++q) { const int i = tid * 16 + q; const unsigned k = keys[i]; bool tk = k > Tk; if (k == Tk) { tk = eqr < krem; ++eqr; }
                if (tk) { idx[z * CAP + slot] = i; gate[z * CAP + slot] = __uint_as_float(k); sel[((size_t)b * SEQ + i) * NE + e] = slot; ++slot; } else sel[((size_t)b * SEQ + i) * NE + e] = -1; }
            __syncthreads();
        }
    }
    SEAM(PH_TOPK);


    if (IN(PH_MOE1)) { PHASE_IDS
        pg8::MoeGatherSched S; S.init(NZ * CAP, 5632, G, bx); S.A = (const char*)(ws + WS_H); S.Bt = (const char*)(ws + WS_W1C); S.idx = (const int*)(ws + WS_IDX);
        pg8::EpiSwiglu E; E.act = (unsigned char*)(ws + WS_ACT); E.in_scale = 1.0f / W1_SCALE; E.act_scale = ACT_SCALE;
        pg8::gemm_phase<pg8::EpiSwiglu, pg8::MoeGatherSched, true, true, true>(lds + RING_OFF, 1024 / 2, S, E, tid);
    }
    SEAM(PH_MOE1);

    if (IN(PH_MOE2)) { PHASE_IDS
        pg8::MoeSched S; S.init(NZ * CAP, D_MODEL, G, bx); S.A = (const char*)(ws + WS_ACT); S.Bt = (const char*)(ws + WS_WD); S.kb = (size_t)FF; S.nper = 1024;
        pg8::EpiDown E; E.y = (bf16*)(ws + WS_Y); E.gate = (const float*)(ws + WS_GATE); E.out_scale = 1.0f / (WD_SCALE * ACT_SCALE);
        pg8::gemm_phase<pg8::EpiDown, pg8::MoeSched, true, true, true>(lds + RING_OFF, FF / 2, S, E, tid);
    }
    SEAM(PH_MOE2);

    if (IN(PH_FINAL)) { PHASE_IDS
        const float* x1 = (const float*)(ws + WS_X1); const int* sel = (const int*)(ws + WS_SEL); const bf16* y = (const bf16*)(ws + WS_Y); const float* gain = args.in[16];
        for (int m = gw; m < T; m += NGW) {
            const int b = m / SEQ;
            const GAS f32x4* xr = (const GAS f32x4*)(x1 + (size_t)m * D_MODEL) + lane; const GAS f32x4* gr = (const GAS f32x4*)gain + lane;
            f32x4 v[4];
#pragma unroll
            for (int j = 0; j < 4; ++j) v[j] = xr[64 * j];
            const int mysel = (lane < NE) ? sel[(size_t)m * NE + lane] : -1;
            for (int e = 0; e < NE; ++e) { const int sl = __builtin_amdgcn_readlane(mysel, e);
                if (sl >= 0) { const GAS unsigned long long* yr = (const GAS unsigned long long*)(y + ((size_t)(b * NE + e) * CAP + sl) * D_MODEL) + lane;
#pragma unroll
                    for (int j = 0; j < 4; ++j) { const unsigned long long w = yr[64 * j]; const unsigned lo = (unsigned)w, hi = (unsigned)(w >> 32);
                        v[j].x += __uint_as_float(lo << 16); v[j].y += __uint_as_float(lo & 0xffff0000u); v[j].z += __uint_as_float(hi << 16); v[j].w += __uint_as_float(hi & 0xffff0000u); } } }
            float s = 0.f;
#pragma unroll
            for (int j = 0; j < 4; ++j) s += (v[j].x * v[j].x + v[j].y * v[j].y) + (v[j].z * v[j].z + v[j].w * v[j].w);
            const float rstd = 1.f / sqrtf(wave_sum(s) * (1.f / D_MODEL) + EPS);
            GAS f32x4* o = (GAS f32x4*)(args.out + (size_t)m * D_MODEL) + lane;
#pragma unroll
            for (int j = 0; j < 4; ++j) { const f32x4 g4 = gr[64 * j]; o[64 * j] = v[j] * g4 * rstd; }
        }
    }
#undef IN
#undef SEAM
}

#ifndef MK_DUP
#define MK_DUP (-1)
#endif
#ifndef MK_ONE_LAUNCH
#define MK_ONE_LAUNCH 1
#endif
extern "C" void kernel_launch(void* const* d_in, const int* in_sizes, int n_in, void* d_out, int out_size, void* d_ws, size_t ws_size, hipStream_t stream) {
    static int grid = 0;
    if (grid == 0) {
        if (n_in != 17 || in_sizes[0] != T * D_MODEL || out_size != T * D_MODEL || ws_size < WS_END) { fprintf(stderr, "kernel_launch: shape/workspace mismatch (ws %zu need %zu)\n", ws_size, (size_t)WS_END); grid = -1; return; }
        int dev = 0, cus = 0, per_cu = 0;
        if (hipGetDevice(&dev) != hipSuccess || hipDeviceGetAttribute(&cus, hipDeviceAttributeMultiprocessorCount, dev) != hipSuccess) { grid = -1; return; }
        if (hipFuncSetAttribute((const void*)mega, hipFuncAttributeMaxDynamicSharedMemorySize, LDS_BYTES) != hipSuccess) { fprintf(stderr, "kernel_launch: hipFuncSetAttribute failed\n"); grid = -1; return; }
        if (hipOccupancyMaxActiveBlocksPerMultiprocessor(&per_cu, (const void*)mega, NWAVES * 64, LDS_BYTES) != hipSuccess || per_cu < 1) { fprintf(stderr, "kernel_launch: occupancy query says %d blocks per CU\n", per_cu); (void)hipGetLastError(); grid = -1; return; }
        grid = cus;
    }
    if (grid < 0) return;
    unsigned char* ws = (unsigned char*)d_ws;
    (void)hipMemsetAsync(ws + WS_CTL, 0, CTL_ZERO_BYTES, stream);
    Args a{};
    for (int i = 0; i < 17; ++i) a.in[i] = (const float*)d_in[i];
    a.out = (float*)d_out; a.ws = ws;
#if MK_ONE_LAUNCH
    a.ph_lo = 0; a.ph_hi = PH_END; hipLaunchKernelGGL(mega, dim3(grid), dim3(NWAVES * 64), LDS_BYTES, stream, a);
#if MK_DUP >= 0
    a.ph_lo = MK_DUP; a.ph_hi = MK_DUP + 1; hipLaunchKernelGGL(mega, dim3(grid), dim3(NWAVES * 64), LDS_BYTES, stream, a);
#endif
#else
    for (int ph = 0; ph < PH_END; ++ph) { a.ph_lo = ph; a.ph_hi = ph + 1; hipLaunchKernelGGL(mega, dim3(grid), dim3(NWAVES * 64), LDS_BYTES, stream, a); }
#endif
}
```

```cpp
#include <hip/hip_runtime.h>
#ifndef MK_W1_EARLY_PCT
#define MK_W1_EARLY_PCT 0
#endif
#include <hip/hip_bf16.h>
#include <cstdio>
#include <cstdint>
#include <cmath>

constexpr size_t EP_MiB = 1u << 20;
constexpr size_t EP_COS = 2 * EP_MiB, EP_SIN = 4 * EP_MiB, EP_RQ = 382 * EP_MiB, EP_RK = 398 * EP_MiB, EP_RV = 414 * EP_MiB, EP_RGS = 430 * EP_MiB, EP_AQ = 446 * EP_MiB, EP_AK = 462 * EP_MiB, EP_AV = 470 * EP_MiB, EP_GRS = 478 * EP_MiB, EP_GAS = 510 * EP_MiB;
constexpr int D_MODEL = 1024, BATCH = 2, SEQ = 8192, T = BATCH * SEQ;
constexpr int HD = 128, CHUNK = 128, NCHUNK = SEQ / CHUNK;
constexpr int NE = 16, FF = 2816, CAP = 1024, NZ = BATCH * NE;
constexpr int INW = 5120;
constexpr int O_RQ = 0, O_RK = 512, O_RV = 1024, O_RG = 1536, O_AQ = 2048, O_AK = 2560, O_AV = 2816, O_GR = 3072, O_GA = 4096;
constexpr float EPS = 1e-6f;
constexpr float RSQRT_HD = 0.08838834764831845f;
constexpr float W1_SCALE = 32.0f, WD_SCALE = 64.0f, ACT_SCALE = 4.0f;

namespace pg8 {
#define PG8_LAS __attribute__((address_space(3)))
typedef unsigned short bf16_t;
typedef short bf16x8 __attribute__((ext_vector_type(8)));
typedef float f32x4 __attribute__((ext_vector_type(4)));
typedef unsigned u32x4 __attribute__((ext_vector_type(4)));
constexpr int BM = 256, BK = 64, HALF = 128, HTB = HALF * BK * 2  , STAGE_BYTES = 8 * HTB, NXCD = 8, WGM = 8;

__host__ __device__ __forceinline__ int lds_byte(int r, int c) { const int st = (r >> 4) * 2 + (c >> 5), rr = r & 15, cc = c & 31, ob = rr * 64 + cc * 2; return st * 1024 + (ob ^ (((ob >> 9) & 1) << 5)); }
__host__ __device__ __forceinline__ void stage_rc(int b, int& R, int& C) { const int st = b / 1024, sb = b % 1024, swz = sb ^ (((sb >> 9) & 1) << 5); R = (st >> 1) * 16 + swz / 64; C = (st & 1) * 32 + (swz % 64) / 2; }
__host__ __device__ __forceinline__ int perm32(int rho) { const int n = rho >> 4, i = rho & 15; return 8 * (i >> 2) + 4 * n + (i & 3); }

struct Unit { int pm, pn, aux; };
struct Gemm { const bf16_t* A; const bf16_t* Bt; int M, N, K; };

struct StaticOrder {
    int nM, nN, nwg, G, c;
    __host__ __device__ void init(int M, int N, int G_, int c_) { nM = M / BM; nN = N / BM; nwg = nM * nN; G = G_; c = c_; }
    __host__ __device__ bool next(int i, Unit& u) const {
        const long L = (long)i * G + c; if (L >= nwg) return false;
        int wgid = (int)L; { const int q = nwg / NXCD, r = nwg % NXCD, xcd = wgid % NXCD, off = wgid / NXCD; wgid = (xcd < r ? xcd * (q + 1) : r * (q + 1) + (xcd - r) * q) + off; }
        const int nig = WGM * nN, gid = wgid / nig, fm = gid * WGM, gsz = (nM - fm) < WGM ? (nM - fm) : WGM;
        u.pm = fm + ((wgid % nig) % gsz); u.pn = (wgid % nig) / gsz; u.aux = 0; return true;
    }
    __device__ __forceinline__ void a_ready(const Unit&) const {}
    __device__ __forceinline__ void done(const Unit&) const {}
    static constexpr bool GATHER = false;
    __device__ __forceinline__ unsigned gather_off(const Unit&, int, int) const { return 0u; }
    __device__ __forceinline__ bool keep_acc(const Unit&) const { return false; }
};


struct PlainSched : StaticOrder {
    const char* A; const char* Bt; size_t tstep;
    __device__ __forceinline__ void bases(const Unit& u, const char*& a, const char*& b) const { a = A + (size_t)u.pm * tstep; b = Bt + (size_t)u.pn * tstep; }
};

typedef float f32x2_t __attribute__((ext_vector_type(2))); typedef __bf16 bf16x2_t __attribute__((ext_vector_type(2)));
__device__ __forceinline__ unsigned cvt_pk_bf16(float lo, float hi) { f32x2_t v = {lo, hi}; bf16x2_t b = __builtin_convertvector(v, bf16x2_t); return __builtin_bit_cast(unsigned, b); }
__device__ __forceinline__ u32x4 pack8(const f32x4 a, const f32x4 b) { u32x4 w; w.x = cvt_pk_bf16(a[0], a[1]); w.y = cvt_pk_bf16(a[2], a[3]); w.z = cvt_pk_bf16(b[0], b[1]); w.w = cvt_pk_bf16(b[2], b[3]); return w; }
__device__ __forceinline__ float fast_sigmoid(float x) { return __builtin_amdgcn_rcpf(1.0f + __builtin_amdgcn_exp2f(-1.4426950408889634f * x)); }
__device__ __forceinline__ f32x4 sigmoid4(const f32x4 v) { return (f32x4){fast_sigmoid(v[0]), fast_sigmoid(v[1]), fast_sigmoid(v[2]), fast_sigmoid(v[3])}; }
__device__ __forceinline__ f32x4 silu4(const f32x4 v) { return v * sigmoid4(v); }

struct EpiProj {
    static constexpr bool PERM = true, AFTER_DRAIN = false;
    unsigned char* wsb;
    const float *qn, *kn;
    PG8_LAS float* xch;
    mutable unsigned epoch;
    template <int ACT>
    __device__ __forceinline__ void plain(const f32x4 (&acc)[2][2][4][2], bf16_t* base, int ld, int col0, int row0) const {
#pragma unroll
        for (int ai = 0; ai < 2; ++ai)
#pragma unroll
            for (int m = 0; m < 4; ++m) { bf16_t* rowp = base + (size_t)(row0 + ai * HALF + m * 16) * ld + col0;
#pragma unroll
                for (int bj = 0; bj < 2; ++bj) { f32x4 v0 = acc[ai][bj][m][0], v1 = acc[ai][bj][m][1];
                    if (ACT == 1) { v0 = silu4(v0); v1 = silu4(v1); } else if (ACT == 2) { v0 = sigmoid4(v0); v1 = sigmoid4(v1); }
                    *(u32x4*)(rowp + bj * HALF) = pack8(v0, v1); } }
    }
    template <bool NORM>
    __device__ __forceinline__ void rope(const f32x4 (&acc)[2][2][4][2], bf16_t* base, int ld, int col0, int row0, float scale, const float* nw, int wr, int wc, int fr, int fq) const {
        const int g = 4 * wc + fq;
        f32x4 nw1 = {1.f, 1.f, 1.f, 1.f}, nw2 = {1.f, 1.f, 1.f, 1.f};
        if (NORM) {
#pragma unroll
            for (int ai = 0; ai < 2; ++ai)
#pragma unroll
                for (int m = 0; m < 4; ++m)
#pragma unroll
                    for (int bj = 0; bj < 2; ++bj) { const f32x4 a = acc[ai][bj][m][0], b = acc[ai][bj][m][1];
                        float s = (a[0] * a[0] + a[1] * a[1]) + (a[2] * a[2] + a[3] * a[3]) + (b[0] * b[0] + b[1] * b[1]) + (b[2] * b[2] + b[3] * b[3]);
                        s += __shfl_xor(s, 16); s += __shfl_xor(s, 32);
                        if (fq == 0) xch[((ai * HALF + wr * 64 + m * 16 + fr) * 2 + bj) * 4 + wc] = s; }
            asm volatile("s_waitcnt lgkmcnt(0)" ::: "memory");
            PG8_LAS unsigned* cnt = (PG8_LAS unsigned*)(xch + 2048) + wr;
            if ((fr | fq) == 0) __hip_atomic_fetch_add(cnt, 1u, __ATOMIC_RELAXED, __HIP_MEMORY_SCOPE_WORKGROUP);
            epoch += 4u;
            while (__hip_atomic_load(cnt, __ATOMIC_RELAXED, __HIP_MEMORY_SCOPE_WORKGROUP) < epoch) __builtin_amdgcn_s_sleep(1);
            asm volatile("s_waitcnt lgkmcnt(0)" ::: "memory");
            nw1 = *(const f32x4*)(nw + 4 * g); nw2 = *(const f32x4*)(nw + 64 + 4 * g);
        }
#pragma unroll
        for (int ai = 0; ai < 2; ++ai)
#pragma unroll
            for (int m = 0; m < 4; ++m) { const int r = row0 + ai * HALF + m * 16; const int pos = r & 8191;
                const f32x4 c4 = *(const f32x4*)((const float*)(wsb + EP_COS) + (size_t)pos * 64 + 4 * g), s4 = *(const f32x4*)((const float*)(wsb + EP_SIN) + (size_t)pos * 64 + 4 * g);
                bf16_t* rowp = base + (size_t)r * ld + col0;
#pragma unroll
                for (int bj = 0; bj < 2; ++bj) { f32x4 x1 = acc[ai][bj][m][0], x2 = acc[ai][bj][m][1];
                    if (NORM) { const f32x4 p = *(const PG8_LAS f32x4*)(xch + ((ai * HALF + wr * 64 + m * 16 + fr) * 2 + bj) * 4);
                        const float rs = __builtin_amdgcn_rsqf(((p[0] + p[1]) + (p[2] + p[3])) * (1.0f / 128.0f) + 1e-6f);
                        x1 = x1 * (nw1 * rs); x2 = x2 * (nw2 * rs); }
                    const f32x4 y1 = (x1 * c4 - x2 * s4) * scale, y2 = (x1 * s4 + x2 * c4) * scale;
                    *(u32x4*)(rowp + bj * HALF) = pack8(y1, y2); }
                asm volatile("" ::: "memory"); }
    }
    __device__ __forceinline__ void operator()(const f32x4 (&acc)[2][2][4][2], const Unit& u, int wr, int wc, int fr, int fq) const {
        const int row0 = u.pm * BM + wr * 64 + fr, cw = wc * 32 + 8 * fq, pn = u.pn;
        if (pn < 2)       rope<false>(acc, (bf16_t*)(wsb + EP_RQ), 512, pn * 256 + cw, row0, 1.0f, nullptr, wr, wc, fr, fq);
        else if (pn < 4)  rope<false>(acc, (bf16_t*)(wsb + EP_RK), 512, (pn - 2) * 256 + cw, row0, 0.08838834764831845f, nullptr, wr, wc, fr, fq);
        else if (pn < 6)  plain<0>(acc, (bf16_t*)(wsb + EP_RV), 512, (pn - 4) * 256 + cw, row0);
        else if (pn < 8)  plain<1>(acc, (bf16_t*)(wsb + EP_RGS), 512, (pn - 6) * 256 + cw, row0);
        else if (pn < 10) rope<true>(acc, (bf16_t*)(wsb + EP_AQ), 512, (pn - 8) * 256 + cw, row0, 1.0f, qn, wr, wc, fr, fq);
        else if (pn < 11) rope<true>(acc, (bf16_t*)(wsb + EP_AK), 256, cw, row0, 1.0f, kn, wr, wc, fr, fq);
        else if (pn < 12) plain<0>(acc, (bf16_t*)(wsb + EP_AV), 256, cw, row0);
        else if (pn < 16) plain<2>(acc, (bf16_t*)(wsb + EP_GRS), 1024, (pn - 12) * 256 + cw, row0);
        else              plain<2>(acc, (bf16_t*)(wsb + EP_GAS), 1024, (pn - 16) * 256 + cw, row0);
    }
};

struct BranchSched : StaticOrder {
    const char *A0, *A1, *B0, *B1; size_t tstep;
    __device__ __forceinline__ bool next(int i, Unit& u) const { if (!StaticOrder::next(i >> 1, u)) return false; u.aux = i & 1; return true; }
    __device__ __forceinline__ void bases(const Unit& u, const char*& a, const char*& b) const { a = (u.aux ? A1 : A0) + (size_t)u.pm * tstep; b = (u.aux ? B1 : B0) + (size_t)u.pn * tstep; }
    __device__ __forceinline__ bool keep_acc(const Unit& nxt) const { return nxt.aux == 1; }
};
__device__ __forceinline__ void unpack8(const u32x4 w, f32x4& a, f32x4& b) {
    a = (f32x4){__uint_as_float(w.x << 16), __uint_as_float(w.x & 0xffff0000u), __uint_as_float(w.y << 16), __uint_as_float(w.y & 0xffff0000u)};
    b = (f32x4){__uint_as_float(w.z << 16), __uint_as_float(w.z & 0xffff0000u), __uint_as_float(w.w << 16), __uint_as_float(w.w & 0xffff0000u)};
}
struct EpiBranch {
    static constexpr bool PERM = true, AFTER_DRAIN = false;
    const bf16_t *grs, *gas; bf16_t* mixed;
    __device__ __forceinline__ void operator()(f32x4 (&acc)[2][2][4][2], const Unit& u, int wr, int wc, int fr, int fq) const {
        const int row0 = u.pm * BM + wr * 64 + fr, col0 = u.pn * BM + wc * 32 + 8 * fq;
#pragma unroll
        for (int ai = 0; ai < 2; ++ai)
#pragma unroll
            for (int m = 0; m < 4; ++m) { const size_t off = (size_t)(row0 + ai * HALF + m * 16) * 1024 + col0;
#pragma unroll
                for (int bj = 0; bj < 2; ++bj) { f32x4 ga0, ga1; unpack8(*(const u32x4*)(gas + off + bj * HALF), ga0, ga1);
                    if (u.aux == 0) { f32x4 gr0, gr1; unpack8(*(const u32x4*)(grs + off + bj * HALF), gr0, gr1);
#pragma unroll
                        for (int k = 0; k < 4; ++k) { acc[ai][bj][m][0][k] *= gr0[k] * __builtin_amdgcn_rcpf(fmaxf(ga0[k], 1e-30f)); acc[ai][bj][m][1][k] *= gr1[k] * __builtin_amdgcn_rcpf(fmaxf(ga1[k], 1e-30f)); } }
                    else *(u32x4*)(mixed + off + bj * HALF) = pack8(acc[ai][bj][m][0] * ga0, acc[ai][bj][m][1] * ga1); }
                asm volatile("" ::: "memory"); }
    }
};
struct EpiResid {
    static constexpr bool PERM = false, AFTER_DRAIN = false;
    const float* x; float* x1;
    __device__ __forceinline__ void operator()(const f32x4 (&acc)[2][2][4][2], const Unit& u, int wr, int wc, int fr, int fq) const {
        const int row0 = u.pm * BM + wr * 64 + fr, col0 = u.pn * BM + wc * 32 + 4 * fq;
#pragma unroll
        for (int ai = 0; ai < 2; ++ai)
#pragma unroll
            for (int m = 0; m < 4; ++m) { const size_t off = (size_t)(row0 + ai * HALF + m * 16) * 1024 + col0;
#pragma unroll
                for (int bj = 0; bj < 2; ++bj)
#pragma unroll
                    for (int n = 0; n < 2; ++n) { const f32x4 xv = *(const f32x4*)(x + off + bj * HALF + n * 16); *(f32x4*)(x1 + off + bj * HALF + n * 16) = xv + acc[ai][bj][m][n]; }
                if (m & 1) asm volatile("" ::: "memory"); }
    }
};
__device__ __forceinline__ int moe_rowbase(int pm) { return ((((pm >> 2) & 1) * 16 + (pm >> 3)) * 1024) + (pm & 3) * 256; }
struct MoeSched : StaticOrder {
    const char *A, *Bt; size_t kb; int nper;
    __device__ __forceinline__ void bases(const Unit& u, const char*& a, const char*& b) const { a = A + (size_t)moe_rowbase(u.pm) * kb; b = Bt + ((size_t)(u.pm >> 3) * nper + (size_t)u.pn * 256) * kb; }
};
struct MoeGatherSched : StaticOrder {
    static constexpr bool GATHER = true;
    const char *A, *Bt; const int* idx;
    __device__ __forceinline__ void bases(const Unit& u, const char*& a, const char*& b) const { a = A; b = Bt + ((size_t)(u.pm >> 3) * 5632 + (size_t)u.pn * 256) * 1024; }
    __device__ __forceinline__ unsigned gather_off(const Unit& u, int r, int c) const { const int tok = ((u.pm >> 2) & 1) * 8192 + idx[moe_rowbase(u.pm) + r]; return (unsigned)(tok * 1024 + c * 2); }
};
struct EpiSwiglu {
    static constexpr bool PERM = true, AFTER_DRAIN = false;
    unsigned char* act; float in_scale, act_scale;
    __device__ __forceinline__ void operator()(const f32x4 (&acc)[2][2][4][2], const Unit& u, int wr, int wc, int fr, int fq) const {
        const int row0 = moe_rowbase(u.pm) + wr * 64 + fr, col0 = u.pn * HALF + wc * 32 + 8 * fq;
#pragma unroll
        for (int ai = 0; ai < 2; ++ai)
#pragma unroll
            for (int m = 0; m < 4; ++m) { f32x4 v0 = silu4(acc[ai][0][m][0] * in_scale) * (acc[ai][1][m][0] * (in_scale * act_scale)), v1 = silu4(acc[ai][0][m][1] * in_scale) * (acc[ai][1][m][1] * (in_scale * act_scale));
#pragma unroll
                for (int k = 0; k < 4; ++k) { v0[k] = __builtin_amdgcn_fmed3f(v0[k], -448.0f, 448.0f); v1[k] = __builtin_amdgcn_fmed3f(v1[k], -448.0f, 448.0f); }
                const unsigned lo = (unsigned)__builtin_amdgcn_cvt_pk_fp8_f32(v0[2], v0[3], __builtin_amdgcn_cvt_pk_fp8_f32(v0[0], v0[1], 0, false), true), hi = (unsigned)__builtin_amdgcn_cvt_pk_fp8_f32(v1[2], v1[3], __builtin_amdgcn_cvt_pk_fp8_f32(v1[0], v1[1], 0, false), true);
                *(unsigned long long*)(act + (size_t)(row0 + ai * HALF + m * 16) * 2816 + col0) = (unsigned long long)lo | ((unsigned long long)hi << 32); }
    }
};
struct EpiDown {
    static constexpr bool PERM = true, AFTER_DRAIN = false;
    bf16_t* y; const float* gate; float out_scale;
    __device__ __forceinline__ void operator()(const f32x4 (&acc)[2][2][4][2], const Unit& u, int wr, int wc, int fr, int fq) const {
        const int row0 = moe_rowbase(u.pm) + wr * 64 + fr, col0 = u.pn * BM + wc * 32 + 8 * fq;
#pragma unroll
        for (int ai = 0; ai < 2; ++ai)
#pragma unroll
            for (int m = 0; m < 4; ++m) { const int r = row0 + ai * HALF + m * 16; const float g = gate[r] * out_scale;
#pragma unroll
                for (int bj = 0; bj < 2; ++bj) *(u32x4*)(y + (size_t)r * 1024 + col0 + bj * HALF) = pack8(acc[ai][bj][m][0] * g, acc[ai][bj][m][1] * g); }
    }
};
typedef int v4i32 __attribute__((ext_vector_type(4)));
typedef int v8i32 __attribute__((ext_vector_type(8)));
__device__ __forceinline__ v8i32 cat8(const bf16x8 lo, const bf16x8 hi) { const v4i32 l = __builtin_bit_cast(v4i32, lo), h = __builtin_bit_cast(v4i32, hi); return __builtin_shufflevector(l, h, 0, 1, 2, 3, 4, 5, 6, 7); }
__device__ __forceinline__ void mfma_f8_inplace(f32x4& acc, const v8i32 b8, const v8i32 a8, const int sc) {
    asm volatile("v_mfma_scale_f32_16x16x128_f8f6f4 %0, %1, %2, %0, %3, %3 op_sel_hi:[0,0,0]" : "+v"(acc) : "v"(b8), "v"(a8), "v"(sc)); }
template <class Epi, class Sched, bool ALIGN_EPI = false, bool SP2 = false, bool FP8 = false>
__device__ __forceinline__ void gemm_phase(PG8_LAS unsigned char* lds, const int K_, const Sched& S, const Epi& E, const int tid) {
    const int wid = __builtin_amdgcn_readfirstlane(tid >> 6), lane = tid & 63, wr = wid >> 2, wc = wid & 3, fr = lane & 15, fq = lane >> 4;
    const int K = K_, nt = K / BK;
    unsigned voffA[2], voffB[2];
#pragma unroll
    for (int i = 0; i < 2; ++i) { int R, C; stage_rc(tid * 16 + i * 8192, R, C); const int Rb = Epi::PERM ? ((R & ~31) + perm32(R & 31)) : R;
        voffA[i] = (unsigned)(R * K + C) * 2u; voffB[i] = (unsigned)(Rb * K + C) * 2u; }
    unsigned va0[2] = {0u, 0u}, va1[2] = {0u, 0u}, vn0[2] = {0u, 0u}, vn1[2] = {0u, 0u};
    int gR[2], gC[2];
#pragma unroll
    for (int i = 0; i < 2; ++i) stage_rc(tid * 16 + i * 8192, gR[i], gC[i]);
    const size_t kstep = (size_t)(BK * 2);
    const size_t hstep = (size_t)HALF * K * 2;
        const unsigned ldsw = (unsigned)wid * 1024u;
    const int aoff = lds_byte(wr * 64 + fr, fq * 8), boff = lds_byte(wc * 32 + fr, fq * 8);
#define PG8_SA(b, h) (((b) * 2 + (h)) * HTB)
#define PG8_SB(b, h) ((4 + (b) * 2 + (h)) * HTB)
#define PG8_STAGE(bufoff, gbase, voff) do { _Pragma("unroll") for (int _i = 0; _i < 2; ++_i) \
        __builtin_amdgcn_global_load_lds((const unsigned*)((const char*)(gbase) + (voff)[_i]), (PG8_LAS unsigned*)(lds + (bufoff) + ldsw + _i * 8192), 16, 0, 0); } while (0)
#define PG8_STAGE_A(bufoff, gbase, h, usenext) do { if constexpr (Sched::GATHER) { unsigned vo_[2]; \
        vo_[0] = (usenext) ? ((h) ? vn1[0] : vn0[0]) : ((h) ? va1[0] : va0[0]); vo_[1] = (usenext) ? ((h) ? vn1[1] : vn0[1]) : ((h) ? va1[1] : va0[1]); PG8_STAGE(bufoff, gbase, vo_); } \
        else { PG8_STAGE(bufoff, (gbase) + ((h) ? hstep : (size_t)0), voffA); } } while (0)
#define PG8_LDA(dst, b, h) do { if constexpr (FP8) { _Pragma("unroll") for (int m = 0; m < 4; ++m) dst##8[m] = cat8(*(const PG8_LAS bf16x8*)(lds + PG8_SA(b, h) + aoff + m * 2048), *(const PG8_LAS bf16x8*)(lds + PG8_SA(b, h) + aoff + m * 2048 + 1024)); } else { \
        _Pragma("unroll") for (int m = 0; m < 4; ++m) _Pragma("unroll") for (int k = 0; k < 2; ++k) dst[m][k] = *(const PG8_LAS bf16x8*)(lds + PG8_SA(b, h) + aoff + m * 2048 + k * 1024); } } while (0)
#define PG8_LDB(dst, b, h) do { if constexpr (FP8) { _Pragma("unroll") for (int n = 0; n < 2; ++n) dst##8[n] = cat8(*(const PG8_LAS bf16x8*)(lds + PG8_SB(b, h) + boff + n * 2048), *(const PG8_LAS bf16x8*)(lds + PG8_SB(b, h) + boff + n * 2048 + 1024)); } else { \
        _Pragma("unroll") for (int n = 0; n < 2; ++n) _Pragma("unroll") for (int k = 0; k < 2; ++k) dst[n][k] = *(const PG8_LAS bf16x8*)(lds + PG8_SB(b, h) + boff + n * 2048 + k * 1024); } } while (0)
#define PG8_MMA(ai, bj, At, Bt) do { __builtin_amdgcn_s_setprio(1); if constexpr (FP8) { _Pragma("unroll") for (int m = 0; m < 4; ++m) _Pragma("unroll") for (int n = 0; n < 2; ++n) \
        mfma_f8_inplace(acc[ai][bj][m][n], Bt##8[n], At##8[m], 0x7f7f7f7f); } else { \
        _Pragma("unroll") for (int m = 0; m < 4; ++m) _Pragma("unroll") for (int n = 0; n < 2; ++n) _Pragma("unroll") for (int k = 0; k < 2; ++k) \
        acc[ai][bj][m][n] = __builtin_amdgcn_mfma_f32_16x16x32_bf16(Bt[n][k], At[m][k], acc[ai][bj][m][n], 0, 0, 0); } __builtin_amdgcn_s_setprio(0); } while (0)
#define PG8_WAIT_V(n) asm volatile("s_waitcnt vmcnt(" #n ")" ::: "memory")
#define PG8_WAIT_L(n) asm volatile("s_waitcnt lgkmcnt(" #n ")" ::: "memory")
#define PG8_BAR __builtin_amdgcn_s_barrier()
#define PG8_SCHED __builtin_amdgcn_sched_barrier(0)
    Unit cur, nxt; int ui = 0;
    if (!S.next(0, cur)) return;
    f32x4 acc[2][2][4][2];
#pragma unroll
    for (int a = 0; a < 2; ++a)
#pragma unroll
        for (int b = 0; b < 2; ++b)
#pragma unroll
            for (int m = 0; m < 4; ++m)
#pragma unroll
                for (int n = 0; n < 2; ++n) acc[a][b][m][n] = (f32x4){0.f, 0.f, 0.f, 0.f};
    bf16x8 At[4][2], B0[2][2], B1[2][2]; v8i32 At8[4], B08[2], B18[2];
    const char* cA; const char* cB; S.bases(cur, cA, cB);
    if constexpr (Sched::GATHER) {
#pragma unroll
        for (int i = 0; i < 2; ++i) { va0[i] = S.gather_off(cur, gR[i], gC[i]); va1[i] = S.gather_off(cur, gR[i] + HALF, gC[i]); } }
    S.a_ready(cur);
    if constexpr (SP2) {
        PG8_STAGE(PG8_SB(0, 0), cB, voffB); PG8_STAGE(PG8_SB(0, 1), cB + hstep, voffB); PG8_STAGE_A(PG8_SA(0, 0), cA, 0, false); PG8_STAGE_A(PG8_SA(0, 1), cA, 1, false);
        if (wr == 1) PG8_BAR;
        PG8_WAIT_V(2); PG8_BAR;
        PG8_STAGE(PG8_SB(1, 0), cB + kstep, voffB); PG8_STAGE_A(PG8_SA(1, 0), cA + kstep, 0, false); PG8_STAGE(PG8_SB(1, 1), cB + hstep + kstep, voffB);
        PG8_WAIT_V(6); PG8_BAR;
    } else {
        PG8_STAGE(PG8_SB(0, 0), cB, voffB); PG8_STAGE_A(PG8_SA(0, 0), cA, 0, false); PG8_STAGE(PG8_SB(0, 1), cB + hstep, voffB); PG8_STAGE_A(PG8_SA(0, 1), cA, 1, false);
        if (wr == 1) PG8_BAR;
        PG8_WAIT_V(4); PG8_BAR;
        PG8_STAGE(PG8_SB(1, 0), cB + kstep, voffB); PG8_STAGE_A(PG8_SA(1, 0), cA + kstep, 0, false); PG8_STAGE(PG8_SB(1, 1), cB + hstep + kstep, voffB);
        PG8_WAIT_V(6); PG8_BAR;
    }
    for (;;) {
        const bool has_next = S.next(ui + 1, nxt);
        const char* nA = cA; const char* nB = cB; if (has_next) S.bases(nxt, nA, nB);
        if constexpr (Sched::GATHER) { if (has_next) {
#pragma unroll
            for (int i = 0; i < 2; ++i) { vn0[i] = S.gather_off(nxt, gR[i], gC[i]); vn1[i] = S.gather_off(nxt, gR[i] + HALF, gC[i]); } }
            else {
#pragma unroll
            for (int i = 0; i < 2; ++i) { vn0[i] = va0[i]; vn1[i] = va1[i]; } } }
#pragma unroll 1
        for (int t = 0; t < nt; t += 2) {
            const bool last = (t == nt - 2);
            const char* a1 = cA + (size_t)(t + 1) * kstep;
            const char* a2 = last ? nA : cA + (size_t)(t + 2) * kstep; const char* b2 = last ? nB : cB + (size_t)(t + 2) * kstep;
            const char* a3 = a2 + kstep; const char* b3 = b2 + kstep;
            if (last && has_next) S.a_ready(nxt);
            if constexpr (SP2) {
            PG8_LDB(B0, 0, 0); PG8_LDB(B1, 0, 1); PG8_SCHED; PG8_LDA(At, 0, 0); PG8_STAGE_A(PG8_SA(1, 1), a1, 1, false);
            PG8_WAIT_V(8); PG8_WAIT_L(0); PG8_BAR; PG8_MMA(0, 0, At, B0); PG8_MMA(0, 1, At, B1); PG8_BAR; PG8_SCHED;
            PG8_LDA(At, 0, 1); PG8_STAGE(PG8_SB(0, 0), b2, voffB); PG8_STAGE(PG8_SB(0, 1), b2 + hstep, voffB); PG8_STAGE_A(PG8_SA(0, 0), a2, 0, last);
            PG8_WAIT_V(8); PG8_WAIT_L(0); PG8_BAR; PG8_MMA(1, 0, At, B0); PG8_MMA(1, 1, At, B1); PG8_BAR; PG8_SCHED;
            PG8_LDB(B0, 1, 0); PG8_LDB(B1, 1, 1); PG8_SCHED; PG8_LDA(At, 1, 0); PG8_STAGE_A(PG8_SA(0, 1), a2, 1, last);
            PG8_WAIT_V(8); PG8_WAIT_L(0); PG8_BAR; PG8_MMA(0, 0, At, B0); PG8_MMA(0, 1, At, B1); PG8_BAR; PG8_SCHED;
            PG8_LDA(At, 1, 1); PG8_STAGE(PG8_SB(1, 0), b3, voffB); PG8_STAGE(PG8_SB(1, 1), b3 + hstep, voffB); PG8_STAGE_A(PG8_SA(1, 0), a3, 0, last);
            PG8_WAIT_V(8); PG8_WAIT_L(0); PG8_BAR; PG8_MMA(1, 0, At, B0); PG8_MMA(1, 1, At, B1); PG8_BAR; PG8_SCHED;
            } else {
            PG8_LDB(B0, 0, 0); PG8_SCHED; PG8_LDA(At, 0, 0); PG8_STAGE_A(PG8_SA(1, 1), a1, 1, false);
            PG8_WAIT_L(8); PG8_BAR; PG8_WAIT_L(0); PG8_MMA(0, 0, At, B0); PG8_BAR; PG8_SCHED;
            PG8_LDB(B1, 0, 1); PG8_STAGE(PG8_SB(0, 0), b2, voffB);
            PG8_BAR; PG8_WAIT_L(0); PG8_MMA(0, 1, At, B1); PG8_BAR;
            PG8_LDA(At, 0, 1); PG8_STAGE_A(PG8_SA(0, 0), a2, 0, last);
            PG8_BAR; PG8_WAIT_L(0); PG8_MMA(1, 0, At, B0); PG8_BAR; PG8_SCHED;
            PG8_STAGE(PG8_SB(0, 1), b2 + hstep, voffB);
            PG8_WAIT_V(6); PG8_BAR; PG8_MMA(1, 1, At, B1); PG8_BAR;
            PG8_LDB(B0, 1, 0); PG8_SCHED; PG8_LDA(At, 1, 0); PG8_STAGE_A(PG8_SA(0, 1), a2, 1, last);
            PG8_WAIT_L(8); PG8_BAR; PG8_WAIT_L(0); PG8_MMA(0, 0, At, B0); PG8_BAR; PG8_SCHED;
            PG8_LDB(B1, 1, 1); PG8_STAGE(PG8_SB(1, 0), b3, voffB);
            PG8_BAR; PG8_WAIT_L(0); PG8_MMA(0, 1, At, B1); PG8_BAR;
            PG8_LDA(At, 1, 1); PG8_STAGE_A(PG8_SA(1, 0), a3, 0, last);
            PG8_BAR; PG8_WAIT_L(0); PG8_MMA(1, 0, At, B0); PG8_BAR; PG8_SCHED;
            PG8_STAGE(PG8_SB(1, 1), b3 + hstep, voffB);
            PG8_WAIT_V(6); PG8_BAR; PG8_MMA(1, 1, At, B1); PG8_BAR;
            }
        }
        if constexpr (FP8) asm volatile("s_nop 15\n\ts_nop 15" ::: "memory");
        if constexpr (ALIGN_EPI) { if (wr == 0) PG8_BAR; }
        if constexpr (!Epi::AFTER_DRAIN) { int le_; asm volatile("v_mbcnt_lo_u32_b32 %0, -1, 0\n\tv_mbcnt_hi_u32_b32 %0, -1, %0" : "=v"(le_));
            E(acc, cur, wr, wc, le_ & 15, le_ >> 4); S.done(cur); }
        if (!has_next) break;
        if (!S.keep_acc(nxt)) {
#pragma unroll
        for (int a = 0; a < 2; ++a)
#pragma unroll
            for (int b = 0; b < 2; ++b)
#pragma unroll
                for (int m = 0; m < 4; ++m)
#pragma unroll
                    for (int n = 0; n < 2; ++n) acc[a][b][m][n] = (f32x4){0.f, 0.f, 0.f, 0.f};
        }
        cur = nxt; cA = nA; cB = nB; ++ui;
        if constexpr (Sched::GATHER) {
#pragma unroll
            for (int i = 0; i < 2; ++i) { va0[i] = vn0[i]; va1[i] = vn1[i]; } }
        if constexpr (ALIGN_EPI) { if (wr == 1) PG8_BAR; }
    }
    PG8_WAIT_V(0);
    if constexpr (!ALIGN_EPI) { if (wr == 0) PG8_BAR; }
    PG8_BAR;
    if constexpr (Epi::AFTER_DRAIN) { E.fused(acc, cur, wr, wc, fr, fq, lds, wid, lane); S.done(cur); }
#undef PG8_SA
#undef PG8_SB
#undef PG8_STAGE
#undef PG8_STAGE_A
#undef PG8_LDA
#undef PG8_LDB
#undef PG8_MMA
#undef PG8_WAIT_V
#undef PG8_WAIT_L
#undef PG8_BAR
#undef PG8_SCHED
}
}


namespace attn {
using bf16 = __hip_bfloat16;
constexpr int   D = 128, NW = 8, QBLK = 32, KVBLK = 64;
constexpr float SCALE = 0.088388347648318440f;
constexpr float THR = 8.f;
constexpr int SDEPTH = 2;
constexpr int LDQ = 512, LDK = 256, LDO = 512;
constexpr size_t SHM_V = KVBLK * D * 2, SHM_K = KVBLK * D * 2, SHM_ATTN = 2 * SHM_V + 2 * SHM_K + NW * 64 * 4;
using bf16x8 = __attribute__((ext_vector_type(8))) short;
using s16x4  = __attribute__((ext_vector_type(4))) short;
using f32x16 = __attribute__((ext_vector_type(16))) float;
using f32x8  = __attribute__((ext_vector_type(8))) float;
using u32x4  = __attribute__((ext_vector_type(4))) unsigned;
#define KSWZ(row, colB) ((row) * 256 + ((colB) ^ (((row) & 7) << 4)))
#define SBAR() __builtin_amdgcn_sched_barrier(0)
__device__ __forceinline__ int crow(int r, int hi) { return (r & 3) + 8 * (r >> 2) + 4 * hi; }
typedef float f32x2_t __attribute__((ext_vector_type(2))); typedef __bf16 bf16x2_t __attribute__((ext_vector_type(2)));
__device__ __forceinline__ unsigned cvtpk(float lo, float hi) { f32x2_t v = {lo, hi}; bf16x2_t b = __builtin_convertvector(v, bf16x2_t); return __builtin_bit_cast(unsigned, b); }
template <typename TIn> struct Stage;
template <> struct Stage<bf16>  { using T = bf16x8;
  __device__ static __forceinline__ T ld8(const bf16* p) { return *reinterpret_cast<const bf16x8*>(p); }
  __device__ static __forceinline__ bf16x8 tobf(T x) { return x; } };
template <> struct Stage<float> { using T = f32x8;
  __device__ static __forceinline__ T ld8(const float* p) { return *reinterpret_cast<const f32x8*>(p); }
  __device__ static __forceinline__ bf16x8 tobf(T x) {
    u32x4 w = {cvtpk(x[0], x[1]), cvtpk(x[2], x[3]), cvtpk(x[4], x[5]), cvtpk(x[6], x[7])}; return *reinterpret_cast<bf16x8*>(&w); } };

__device__ __forceinline__ void partialSM(f32x16& p0, f32x16& p1, float& m_reg, float& mn, float& alpha) {
  constexpr float C = SCALE * 1.4426950408889634f;
  float pmax = p0[0]; for (int r = 1; r < 16; ++r) pmax = fmaxf(pmax, p0[r]); for (int r = 0; r < 16; ++r) pmax = fmaxf(pmax, p1[r]);
  { auto rr = __builtin_amdgcn_permlane32_swap(__float_as_uint(pmax), __float_as_uint(pmax), false, false);
    pmax = fmaxf(__uint_as_float(rr[0]), __uint_as_float(rr[1])); }
  if (__builtin_expect(__all(pmax - m_reg <= THR / SCALE), 1)) { mn = m_reg; alpha = 1.f; }
  else { mn = fmaxf(m_reg, pmax); alpha = __builtin_amdgcn_exp2f((m_reg - mn) * C); m_reg = mn; }
  float mnC = -mn * C;
  for (int r = 0; r < 16; ++r) p0[r] = fmaf(p0[r], C, mnC); for (int r = 0; r < 16; ++r) p1[r] = fmaf(p1[r], C, mnC);
  for (int r = 0; r < 16; ++r) p0[r] = __builtin_amdgcn_exp2f(p0[r]);
}
__device__ __forceinline__ void finishSM(f32x16& p0, f32x16& p1, float alpha, float& l_reg, bf16x8& pa0, bf16x8& pa1, bf16x8& pa2, bf16x8& pa3) {
  for (int r = 0; r < 16; ++r) p1[r] = __builtin_amdgcn_exp2f(p1[r]);
  float ps = 0; for (int r = 0; r < 16; ++r) ps += p0[r]; for (int r = 0; r < 16; ++r) ps += p1[r];
  { auto rr = __builtin_amdgcn_permlane32_swap(__float_as_uint(ps), __float_as_uint(ps), false, false);
    ps = __uint_as_float(rr[0]) + __uint_as_float(rr[1]); }
  l_reg = l_reg * alpha + ps;
#define PK4(P, BASE, OUT) do { unsigned a0 = cvtpk(P[BASE + 0], P[BASE + 1]), a1 = cvtpk(P[BASE + 2], P[BASE + 3]);   \
    unsigned b0 = cvtpk(P[BASE + 4], P[BASE + 5]), b1 = cvtpk(P[BASE + 6], P[BASE + 7]);                              \
    auto r0 = __builtin_amdgcn_permlane32_swap(a0, b0, false, false); auto r1 = __builtin_amdgcn_permlane32_swap(a1, b1, false, false); \
    u32x4 w = {r0[0], r1[0], r0[1], r1[1]}; OUT = *reinterpret_cast<bf16x8*>(&w); } while (0)
  PK4(p0, 0, pa0); PK4(p0, 8, pa1); PK4(p1, 0, pa2); PK4(p1, 8, pa3);
#undef PK4
}
__device__ __forceinline__ void qkt(f32x16& p0, f32x16& p1, const bf16* Ks, const bf16x8* qr, int r32, int hi) {
  p0 = f32x16{}; p1 = f32x16{};
  for (int d0 = 0; d0 < 8; ++d0) { int cb = (d0 * 16 + hi * 8) * 2;
    bf16x8 b0 = *reinterpret_cast<const bf16x8*>((const char*)Ks + KSWZ(r32, cb));
    bf16x8 b1 = *reinterpret_cast<const bf16x8*>((const char*)Ks + KSWZ(32 + r32, cb));
    p0 = __builtin_amdgcn_mfma_f32_32x32x16_bf16(b0, qr[d0], p0, 0, 0, 0);
    p1 = __builtin_amdgcn_mfma_f32_32x32x16_bf16(b1, qr[d0], p1, 0, 0, 0); }
}
__device__ __forceinline__ int v_st(int k, int c) { const int kk = (k & ~0xC) | ((k & 4) << 1) | ((k & 8) >> 1); return ((kk >> 3) * 4 + (c >> 5)) * 512 + ((kk & 7) * 32 + (c & 31)) * 2; }
__device__ __forceinline__ int v_rd_base(int lane) { return ((lane & 3) << 3) | (((lane >> 2) & 3) << 6) | (((lane >> 4) & 1) << 5) | (((lane >> 5) & 1) << 8); }
constexpr int v_rd_off(int d0, int ks, int half) { return d0 * 512 + ks * 4096 + half * 2048; }
template <int OFF> __device__ __forceinline__ s16x4 tr_read(int vb) {
  s16x4 r; asm volatile("ds_read_b64_tr_b16 %0, %1 offset:%2" : "=&v"(r) : "v"(vb), "i"(OFF) : "memory"); return r;
}
template <int D0> __device__ __forceinline__ void pv_one(f32x16& od, int vb, bf16x8 pa0, bf16x8 pa1, bf16x8 pa2, bf16x8 pa3) {
  const s16x4 l0 = tr_read<v_rd_off(D0, 0, 0)>(vb), h0 = tr_read<v_rd_off(D0, 0, 1)>(vb), l1 = tr_read<v_rd_off(D0, 1, 0)>(vb), h1 = tr_read<v_rd_off(D0, 1, 1)>(vb);
  const s16x4 l2 = tr_read<v_rd_off(D0, 2, 0)>(vb), h2 = tr_read<v_rd_off(D0, 2, 1)>(vb), l3 = tr_read<v_rd_off(D0, 3, 0)>(vb), h3 = tr_read<v_rd_off(D0, 3, 1)>(vb);
  asm volatile("s_waitcnt lgkmcnt(0)" ::: "memory"); SBAR();
#define PK(L, H) (bf16x8){L[0], L[1], L[2], L[3], H[0], H[1], H[2], H[3]}
  od = __builtin_amdgcn_mfma_f32_32x32x16_bf16(pa0, PK(l0, h0), od, 0, 0, 0);
  od = __builtin_amdgcn_mfma_f32_32x32x16_bf16(pa1, PK(l1, h1), od, 0, 0, 0);
  od = __builtin_amdgcn_mfma_f32_32x32x16_bf16(pa2, PK(l2, h2), od, 0, 0, 0);
  od = __builtin_amdgcn_mfma_f32_32x32x16_bf16(pa3, PK(l3, h3), od, 0, 0, 0);
#undef PK
}
__device__ __forceinline__ void pv_d0(f32x16* o, int vb, bf16x8 pa0, bf16x8 pa1, bf16x8 pa2, bf16x8 pa3) {
  pv_one<0>(o[0], vb, pa0, pa1, pa2, pa3); pv_one<1>(o[1], vb, pa0, pa1, pa2, pa3); pv_one<2>(o[2], vb, pa0, pa1, pa2, pa3); pv_one<3>(o[3], vb, pa0, pa1, pa2, pa3);
}

template <typename TQ>
__device__ __forceinline__ void attn_dense_body(const TQ* __restrict__ Qb, const bf16* __restrict__ Kh, const bf16* __restrict__ Vh,
                                                bf16* __restrict__ Ob, int seq, char* lds, const int tid) {
  using St = Stage<bf16>; using SQ = Stage<TQ>;
  const int wid = tid >> 6, lane = tid & 63, r32 = lane & 31, hi = lane >> 5;
  bf16* V_lds = (bf16*)lds; bf16* K_lds = (bf16*)(lds + 2 * SHM_V);
  float* ws = (float*)(lds + 2 * SHM_V + 2 * SHM_K) + wid * 64; float* li_l = ws; float* al_l = ws + 32;
  float m_reg = -1e30f, l_reg = 0; f32x16 o[4] = {}; bf16x8 qr[8];
  const TQ* Qw = Qb + (long)(wid * QBLK + r32) * LDQ + hi * 8;
#pragma unroll
  for (int d0 = 0; d0 < 8; ++d0) qr[d0] = SQ::tobf(SQ::ld8(Qw + d0 * 16));
  const int sr = tid >> 4, sc = (tid & 15) * 8, vst0 = v_st(sr, sc), vst1 = v_st(32 + sr, sc);
  const int vb0 = (int)(uintptr_t)V_lds + v_rd_base(lane);
  struct { typename St::T vs0, vs1, ks0, ks1; } sr_[SDEPTH];
#define SLOAD(i, k0) do { sr_[i].vs0 = St::ld8(&Vh[(long)((k0) + sr) * LDK + sc]); sr_[i].vs1 = St::ld8(&Vh[(long)((k0) + 32 + sr) * LDK + sc]); \
    sr_[i].ks0 = St::ld8(&Kh[(long)((k0) + sr) * LDK + sc]); sr_[i].ks1 = St::ld8(&Kh[(long)((k0) + 32 + sr) * LDK + sc]); } while (0)
#define SWRITE(b, i) do { *(bf16x8*)((char*)V_lds + (b) * SHM_V + vst0) = St::tobf(sr_[i].vs0);          \
    *(bf16x8*)((char*)V_lds + (b) * SHM_V + vst1) = St::tobf(sr_[i].vs1); int kc = sc * 2;               \
    *(bf16x8*)((char*)K_lds + (b) * SHM_K + KSWZ(sr, kc)) = St::tobf(sr_[i].ks0);                       \
    *(bf16x8*)((char*)K_lds + (b) * SHM_K + KSWZ(32 + sr, kc)) = St::tobf(sr_[i].ks1); } while (0)
#define SWAIT() do { if constexpr (SDEPTH == 2) asm volatile("s_waitcnt vmcnt(4)" ::: "memory"); else asm volatile("s_waitcnt vmcnt(0)" ::: "memory"); } while (0)
#define RESC(a) do { if (__any((a) < 1.f)) { if (hi == 0) al_l[r32] = (a); asm volatile("s_waitcnt lgkmcnt(0)" ::: "memory"); \
    for (int d = 0; d < 4; ++d) for (int r = 0; r < 16; ++r) o[d][r] *= al_l[crow(r, hi)]; } } while (0)
  f32x16 pA0, pA1, pB0, pB1; float mnA, mnB, alA, alB; bf16x8 pa0, pa1, pa2, pa3; const int NT = seq / KVBLK;
  constexpr int SE = 0, SO = SDEPTH - 1;
  SLOAD(SE, 0); asm volatile("s_waitcnt vmcnt(0)" ::: "memory"); SWRITE(0, SE); __syncthreads();
  qkt(pA0, pA1, K_lds, qr, r32, hi); partialSM(pA0, pA1, m_reg, mnA, alA);
  SLOAD(SO, KVBLK); if constexpr (SDEPTH == 2) { if (2 < NT) SLOAD(SE, 2 * KVBLK); }
  SWAIT(); SWRITE(1, SO); __syncthreads();
  for (int j = 1; j + 1 < NT; j += 2) {
    SBAR(); qkt(pB0, pB1, (bf16*)((char*)K_lds + SHM_K), qr, r32, hi);
    finishSM(pA0, pA1, alA, l_reg, pa0, pa1, pa2, pa3); SBAR();
    SLOAD(SO, (j + SDEPTH) * KVBLK); SBAR();
    pv_d0(o, vb0, pa0, pa1, pa2, pa3); partialSM(pB0, pB1, m_reg, mnB, alB);
    __syncthreads(); SWAIT(); SWRITE(0, SE);
    RESC(alB); __syncthreads();
    SBAR(); qkt(pA0, pA1, K_lds, qr, r32, hi);
    finishSM(pB0, pB1, alB, l_reg, pa0, pa1, pa2, pa3); SBAR();
    if (SDEPTH == 1 || j + 3 < NT) SLOAD(SE, (j + 1 + SDEPTH) * KVBLK); SBAR();
    pv_d0(o, vb0 + (int)SHM_V, pa0, pa1, pa2, pa3); partialSM(pA0, pA1, m_reg, mnA, alA);
    __syncthreads(); SWAIT(); SWRITE(1, SO);
    RESC(alA); __syncthreads();
  }
  SBAR(); qkt(pB0, pB1, (bf16*)((char*)K_lds + SHM_K), qr, r32, hi);
  finishSM(pA0, pA1, alA, l_reg, pa0, pa1, pa2, pa3); SBAR();
  pv_d0(o, vb0, pa0, pa1, pa2, pa3); partialSM(pB0, pB1, m_reg, mnB, alB);
  __syncthreads(); RESC(alB);
  finishSM(pB0, pB1, alB, l_reg, pa0, pa1, pa2, pa3); SBAR();
  pv_d0(o, vb0 + (int)SHM_V, pa0, pa1, pa2, pa3);
  if (hi == 0) li_l[r32] = l_reg; asm volatile("s_waitcnt lgkmcnt(0)" ::: "memory");
  float rli[16];
#pragma unroll
  for (int r = 0; r < 16; ++r) rli[r] = __builtin_amdgcn_rcpf(li_l[crow(r, hi)]);
  bf16* Ow = Ob + (long)(wid * QBLK) * LDO;
#pragma unroll
  for (int r = 0; r < 16; ++r) { int orow = crow(r, hi);
    for (int d0 = 0; d0 < 4; ++d0) Ow[(long)orow * LDO + d0 * 32 + r32] = __float2bfloat16(o[d0][r] * rli[r]); }
#undef SLOAD
#undef SWRITE
#undef SWAIT
#undef RESC
}

#undef KSWZ
#undef SBAR
}
#define GAS __attribute__((address_space(1)))
#define LAS __attribute__((address_space(3)))
typedef unsigned short bf16;
typedef unsigned v4u __attribute__((ext_vector_type(4)));
typedef float f32x4 __attribute__((ext_vector_type(4)));
typedef short bf16x8 __attribute__((ext_vector_type(8)));
typedef GAS unsigned gu32;
typedef GAS unsigned long long gu64;
#define RLX_AGENT __ATOMIC_RELAXED, __HIP_MEMORY_SCOPE_AGENT
#define LDS_WAIT() asm volatile("s_waitcnt lgkmcnt(0)" ::: "memory")
#define VM_WAIT() asm volatile("s_waitcnt vmcnt(0)" ::: "memory")
__device__ __forceinline__ unsigned long long rt() { return __builtin_amdgcn_s_memrealtime(); }
__device__ __forceinline__ unsigned f2bf(float f) { unsigned u = __builtin_bit_cast(unsigned, f); return (u + 0x7fffu + ((u >> 16) & 1u)) >> 16; }
__device__ __forceinline__ unsigned pk2(float lo, float hi) { return f2bf(lo) | (f2bf(hi) << 16); }

#define XB_TMO      128
#define XB_XCNT(j)  (256  + 64 * (j))
#define XB_XSUB(j)  (1280 + 64 * (j))
#define XB_XGEN(j)  (2304 + 64 * (j))
#define XB_TOP      3328
#define XB_TOPGEN   3392
#define XCD_BAR_WORDS 3456
#define XB_SPIN_CAP (1u << 18)

__device__ __forceinline__ unsigned xb_ld(unsigned* p)              { return __hip_atomic_load(p, __ATOMIC_RELAXED, __HIP_MEMORY_SCOPE_AGENT); }
__device__ __forceinline__ unsigned xb_add(unsigned* p, unsigned v) { return __hip_atomic_fetch_add(p, v, __ATOMIC_RELAXED, __HIP_MEMORY_SCOPE_AGENT); }
__device__ __forceinline__ unsigned xb_xcc_id() { return (unsigned)__builtin_amdgcn_s_getreg((3 << 11) | 20) & 0xFu; }
#define XB_SPIN(cond, bar) do { unsigned _sp = 0; while (cond) { __builtin_amdgcn_s_sleep(1); \
    if ((++_sp & 255u) == 0u) { if (xb_ld(&(bar)[XB_TMO])) break; if (_sp > XB_SPIN_CAP) { atomicAdd(&(bar)[XB_TMO], 1u); break; } } } } while (0)

struct XcdBarrier {
    unsigned* bar; unsigned x;
    volatile LAS unsigned* st;
};

__device__ __forceinline__ XcdBarrier xcd_barrier_post(unsigned* bar, volatile LAS unsigned* st) {
    XcdBarrier b; b.bar = bar; b.x = xb_xcc_id(); b.st = st;
    if (threadIdx.x == 0) (void)xb_add(&bar[XB_XCNT(b.x)], 1u);
    return b;
}
__device__ __forceinline__ void xcd_barrier_complete(unsigned* bar, unsigned x, unsigned& nloc, unsigned& nx) {
    const unsigned G = gridDim.x * gridDim.y * gridDim.z;
    unsigned sum, cnt, mine, sp = 0u;
    for (;;) {
        sum = 0u; cnt = 0u; mine = 0u;
#pragma unroll
        for (unsigned j = 0; j < 16; ++j) { const unsigned c = xb_ld(&bar[XB_XCNT(j)]); sum += c; cnt += (c > 0u) ? 1u : 0u; mine = (j == x) ? c : mine; }
        if (sum == G) break;
        __builtin_amdgcn_s_sleep(1);
        if ((++sp & 255u) == 0u) { if (xb_ld(&bar[XB_TMO])) break; if (sp > XB_SPIN_CAP) { atomicAdd(&bar[XB_TMO], 1u); break; } }
    }
    nloc = mine > 0u ? mine : 1u; nx = cnt > 0u ? cnt : 1u;
}

__device__ __forceinline__ void xcd_barrier(const XcdBarrier& b, const int tid_) {
    asm volatile("s_waitcnt vmcnt(0)" ::: "memory");
    __syncthreads();
    if (tid_ == 0) {
        unsigned* bar = b.bar;
        __builtin_amdgcn_s_waitcnt(0);
        unsigned nloc = b.st[0], nx = b.st[1];
        if (nloc == 0u) { xcd_barrier_complete(bar, b.x, nloc, nx); b.st[0] = nloc; b.st[1] = nx; }
        const unsigned old = xb_add(&bar[XB_XSUB(b.x)], 1u);
        const unsigned gen = old / nloc;
        if (old + 1u == (gen + 1u) * nloc) {
            __builtin_amdgcn_fence(__ATOMIC_RELEASE, "agent");
            asm volatile("s_waitcnt vmcnt(0)" ::: "memory");
            const unsigned og = xb_add(&bar[XB_TOP], 1u);
            const unsigned tg = og / nx;
            if (og + 1u == (tg + 1u) * nx) xb_add(&bar[XB_TOPGEN], 1u);
            else XB_SPIN(xb_ld(&bar[XB_TOPGEN]) == tg, bar);
            __builtin_amdgcn_fence(__ATOMIC_ACQUIRE, "agent");
            xb_add(&bar[XB_XGEN(b.x)], 1u);
            asm volatile("s_waitcnt vmcnt(0)" ::: "memory");
        } else {
            XB_SPIN(xb_ld(&bar[XB_XGEN(b.x)]) == gen, bar);
            __builtin_amdgcn_fence(__ATOMIC_ACQUIRE, "agent");
            asm volatile("s_waitcnt vmcnt(0)" ::: "memory");
        }
    }
    __syncthreads();
}


constexpr size_t MiB = 1u << 20;
constexpr size_t WS_CTL = 0, CTL_ZERO_BYTES = 64 * 1024;
constexpr size_t WS_AFF = 1 * MiB;
constexpr size_t WS_COS = 2 * MiB, WS_SIN = 4 * MiB;
constexpr size_t WS_IDX = 6 * MiB, WS_GATE = 6 * MiB + 256 * 1024, WS_SEL = 7 * MiB;
constexpr size_t WS_WIN = 8 * MiB;
constexpr size_t WS_WR = 18 * MiB, WS_WA = 19 * MiB, WS_WO = 20 * MiB;
constexpr size_t WS_W1C = 22 * MiB;
constexpr size_t WS_WD = 198 * MiB;
constexpr size_t WS_X1 = 286 * MiB;
constexpr size_t WS_H = 350 * MiB;
constexpr size_t WS_RQ = 382 * MiB, WS_RK = 398 * MiB, WS_RV = 414 * MiB, WS_RGS = 430 * MiB;
constexpr size_t WS_AQ = 446 * MiB, WS_AK = 462 * MiB, WS_AV = 470 * MiB;
constexpr size_t WS_GRS = 478 * MiB, WS_GAS = 510 * MiB;
constexpr size_t WS_KV = 542 * MiB;
constexpr size_t WS_S = 606 * MiB;
constexpr size_t WS_YRIN = 638 * MiB, WS_ATT = 654 * MiB;
constexpr size_t WS_MIXED = 670 * MiB;
constexpr size_t WS_XE = 382 * MiB, WS_ACT = 446 * MiB, WS_Y = 622 * MiB;
constexpr size_t WS_END = 704 * MiB;
static_assert(EP_COS == WS_COS && EP_SIN == WS_SIN && EP_RQ == WS_RQ && EP_RK == WS_RK && EP_RV == WS_RV && EP_RGS == WS_RGS && EP_AQ == WS_AQ && EP_AK == WS_AK && EP_AV == WS_AV && EP_GRS == WS_GRS && EP_GAS == WS_GAS, "epilogue offsets vs d_ws map");
constexpr int CW_BAR = 4096;

constexpr int RING_OFF = 0, RING_BYTES = 131072;
constexpr int LDSCTL_OFF = RING_BYTES, MISC_OFF = LDSCTL_OFF + 320;
constexpr int XCH_OFF = RING_BYTES + 1024;
constexpr int LDS_BYTES = 147456;
constexpr int NWAVES = 8;

__device__ __forceinline__ float wave_sum(float v) {
#pragma unroll
    for (int o = 1; o < 64; o <<= 1) v += __shfl_xor(v, o);
    return v;
}
__device__ __forceinline__ float bf2f(bf16 v) { return __uint_as_float((unsigned)v << 16); }

template <class CM>
__device__ __forceinline__ void transpose_item(const float* W, int K, int N, bf16* WT, const CM cm, LAS float* scr, int kb, int nb, int lane) {
    const int k0 = 64 * kb, n0 = 32 * nb;
    const int srccol = cm(n0 + (lane & 31));
    float tv[32];
#pragma unroll
    for (int i = 0; i < 32; ++i) tv[i] = __builtin_nontemporal_load(W + (size_t)(k0 + 2 * i + (lane >> 5)) * N + srccol);
#pragma unroll
    for (int i = 0; i < 32; ++i) scr[(2 * i + (lane >> 5)) * 33 + (lane & 31)] = tv[i];
    LDS_WAIT(); asm volatile("" ::: "memory");
    const int c = lane & 7;
#pragma unroll
    for (int j = 0; j < 4; ++j) { const int n = (lane >> 3) + 8 * j; const LAS float* s = scr + (8 * c) * 33 + n;
        v4u o; o.x = pk2(s[0 * 33], s[1 * 33]); o.y = pk2(s[2 * 33], s[3 * 33]); o.z = pk2(s[4 * 33], s[5 * 33]); o.w = pk2(s[6 * 33], s[7 * 33]);
        __builtin_nontemporal_store(o, (GAS v4u*)(WT + (size_t)(n0 + n) * K + k0 + 8 * c)); }
    LDS_WAIT(); asm volatile("" ::: "memory");
}
__device__ __forceinline__ unsigned pk4_fp8(float a, float b, float c, float d) { int w = 0; w = __builtin_amdgcn_cvt_pk_fp8_f32(a, b, w, false); w = __builtin_amdgcn_cvt_pk_fp8_f32(c, d, w, true); return (unsigned)w; }
template <class CM>
__device__ __forceinline__ void transpose_item_f8(const float* W, int K, int N, unsigned char* WT, const CM cm, LAS float* scr, int kb, int nb, int lane, float scale) {
    const int k0 = 64 * kb, n0 = 32 * nb;
    const int srccol = cm(n0 + (lane & 31));
    float tv[32];
#pragma unroll
    for (int i = 0; i < 32; ++i) tv[i] = __builtin_nontemporal_load(W + (size_t)(k0 + 2 * i + (lane >> 5)) * N + srccol);
#pragma unroll
    for (int i = 0; i < 32; ++i) scr[(2 * i + (lane >> 5)) * 33 + (lane & 31)] = tv[i];
    LDS_WAIT(); asm volatile("" ::: "memory");
    const int c = lane & 7;
#pragma unroll
    for (int j = 0; j < 4; ++j) { const int n = (lane >> 3) + 8 * j; const LAS float* sp = scr + (8 * c) * 33 + n;
        const unsigned lo = pk4_fp8(sp[0 * 33] * scale, sp[1 * 33] * scale, sp[2 * 33] * scale, sp[3 * 33] * scale), hi = pk4_fp8(sp[4 * 33] * scale, sp[5 * 33] * scale, sp[6 * 33] * scale, sp[7 * 33] * scale);
        __builtin_nontemporal_store((unsigned long long)lo | ((unsigned long long)hi << 32), (GAS unsigned long long*)(WT + (size_t)(n0 + n) * K + k0 + 8 * c)); }
    LDS_WAIT(); asm volatile("" ::: "memory");
}
struct CmId { __device__ __forceinline__ int operator()(int n) const { return n; } };
struct CmWin {
    __device__ __forceinline__ int operator()(int n) const {
        const bool rope = (n < 1024) || (n >= 2048 && n < 2816);
        const int L = n & 127, g = L >> 3, i = L & 7, o = (i < 4) ? (4 * g + i) : (64 + 4 * g + (i - 4));
        return rope ? ((n & ~127) + o) : n; }
};
struct CmW1 { __device__ __forceinline__ int operator()(int n) const { return 128 * (n >> 8) + (n & 127); } };

__device__ __forceinline__ void rms_row_to_bf16(const float* xrow, const float* gain, bf16* orow, int lane) {
    const GAS f32x4* xr = (const GAS f32x4*)xrow + lane; const GAS f32x4* gr = (const GAS f32x4*)gain + lane;
    f32x4 v[4]; float s = 0.f;
#pragma unroll
    for (int j = 0; j < 4; ++j) { v[j] = xr[64 * j]; s += (v[j].x * v[j].x + v[j].y * v[j].y) + (v[j].z * v[j].z + v[j].w * v[j].w); }
    const float rstd = 1.f / sqrtf(wave_sum(s) * (1.f / D_MODEL) + EPS);
    GAS unsigned long long* o8 = (GAS unsigned long long*)orow + lane;
#pragma unroll
    for (int j = 0; j < 4; ++j) { const f32x4 g4 = gr[64 * j]; o8[64 * j] = (unsigned long long)pk2(v[j].x * rstd * g4.x, v[j].y * rstd * g4.y) | ((unsigned long long)pk2(v[j].z * rstd * g4.z, v[j].w * rstd * g4.w) << 32); }
}


namespace ret {
typedef short bf16x8 __attribute__((ext_vector_type(8)));
typedef short v4i16 __attribute__((ext_vector_type(4)));
constexpr int PITCH = 272;
constexpr int TILE_B = 128 * PITCH;
constexpr int STRIP_B = 16 * PITCH;
__device__ __forceinline__ float lg2_of(const float* p, int h) { return log1pf(-expf(p[h])) * 1.4426950408889634f; }
__device__ __forceinline__ unsigned cvt2(float lo, float hi) { typedef float f2 __attribute__((ext_vector_type(2))); typedef __bf16 b2 __attribute__((ext_vector_type(2))); f2 v = {lo, hi}; b2 b = __builtin_convertvector(v, b2); return __builtin_bit_cast(unsigned, b); }
__device__ __forceinline__ bf16x8 frag_tr(LAS const unsigned char* tile, int k0, int n0, int lane) {
    const int g = lane >> 4, q = (lane >> 2) & 3, p = lane & 3;
    LAS const unsigned char* a = tile + (k0 + 8 * g + q) * PITCH + (n0 + 4 * p) * 2;
    const v4i16 lo = __builtin_amdgcn_ds_read_tr16_b64_v4i16((LAS v4i16*)a);
    const v4i16 hi = __builtin_amdgcn_ds_read_tr16_b64_v4i16((LAS v4i16*)(a + 4 * PITCH));
    return (bf16x8){lo[0], lo[1], lo[2], lo[3], hi[0], hi[1], hi[2], hi[3]};
}
__device__ __forceinline__ bf16x8 frag_row(LAS const unsigned char* tile, int r0, int k0, int lane) { return *(LAS const bf16x8*)(tile + (r0 + (lane & 15)) * PITCH + (k0 + 8 * (lane >> 4)) * 2); }
__device__ __forceinline__ void stage_tile(LAS unsigned char* tile, const bf16* src, long tok0, int h, int tid) {
#pragma unroll
    for (int i = 0; i < 4; ++i) { const int q = tid + 512 * i, row = q >> 4, ch = q & 15;
        const v4u v = *(const GAS v4u*)(src + (tok0 + row) * 512 + h * HD + ch * 8); *(LAS v4u*)(tile + row * PITCH + ch * 16) = v; }
}
__device__ __forceinline__ void kv_item(int item, LAS unsigned char* lds, const bf16* rk, const bf16* rv, const float* pf, const float* pb, float* kv, int tid) {
    asm volatile("" : "+v"(tid));
    const int c = item & 63, bh = item >> 6, b = bh >> 2, h = bh & 3, lane = tid & 63, w = tid >> 6, g = lane >> 4;
    const long tok0 = (long)b * SEQ + (long)c * CHUNK;
    LAS unsigned char* Kl = lds; LAS unsigned char* Vl = lds + TILE_B;
    stage_tile(Kl, rk, tok0, h, tid); stage_tile(Vl, rv, tok0, h, tid);
    __syncthreads();
    const float lf = lg2_of(pf, h), lb = lg2_of(pb, h);
    f32x4 accf[8], accb[8];
#pragma unroll
    for (int n = 0; n < 8; ++n) { accf[n] = (f32x4){0.f, 0.f, 0.f, 0.f}; accb[n] = (f32x4){0.f, 0.f, 0.f, 0.f}; }
#pragma unroll
    for (int kk = 0; kk < 4; ++kk) {
        const bf16x8 a = frag_tr(Vl, 32 * kk, 16 * w, lane);
        bf16x8 af, ab;
        { unsigned pf_[4], pb_[4];
#pragma unroll
          for (int t = 0; t < 8; t += 2) { const int j = 32 * kk + 8 * g + t;
              const float v0 = __uint_as_float((unsigned)(unsigned short)a[t] << 16), v1 = __uint_as_float((unsigned)(unsigned short)a[t + 1] << 16);
              pf_[t >> 1] = cvt2(v0 * __builtin_amdgcn_exp2f(lf * (float)(127 - j)), v1 * __builtin_amdgcn_exp2f(lf * (float)(126 - j)));
              pb_[t >> 1] = cvt2(v0 * __builtin_amdgcn_exp2f(lb * (float)j), v1 * __builtin_amdgcn_exp2f(lb * (float)(j + 1))); }
          const v4u wf_ = {pf_[0], pf_[1], pf_[2], pf_[3]}, wb_ = {pb_[0], pb_[1], pb_[2], pb_[3]};
          af = __builtin_bit_cast(bf16x8, wf_); ab = __builtin_bit_cast(bf16x8, wb_); }
#pragma unroll
        for (int n = 0; n < 8; ++n) { const bf16x8 bk = frag_tr(Kl, 32 * kk, 16 * n, lane);
            accf[n] = __builtin_amdgcn_mfma_f32_16x16x32_bf16(af, bk, accf[n], 0, 0, 0); accb[n] = __builtin_amdgcn_mfma_f32_16x16x32_bf16(ab, bk, accb[n], 0, 0, 0); }
    }
    float* of = kv + (((long)0 * 8 + bh) * NCHUNK + c) * (HD * HD); float* ob = kv + (((long)1 * 8 + bh) * NCHUNK + c) * (HD * HD);
#pragma unroll
    for (int n = 0; n < 8; ++n)
#pragma unroll
        for (int r = 0; r < 4; ++r) { const int o = (16 * w + 4 * g + r) * HD + 16 * n + (lane & 15); of[o] = accf[n][r]; ob[o] = accb[n][r]; }
    __syncthreads();
}
__device__ __forceinline__ void scan_thread(long gid, const float* pf, const float* pb, const float* kv, bf16* S) {
    const int el = (int)(gid & 16383), bh = (int)((gid >> 14) & 7), dir = (int)(gid >> 17), h = bh & 3;
    const float gC = __builtin_amdgcn_exp2f(lg2_of(dir ? pb : pf, h) * (float)CHUNK);
    const float* p = kv + (((long)dir * 8 + bh) * NCHUNK) * (HD * HD) + el; bf16* o = S + (((long)dir * 8 + bh) * NCHUNK) * (HD * HD) + el;
    float st = 0.f;
    if (dir == 0) {
#pragma unroll 8
        for (int c = 0; c < NCHUNK; ++c) { const float v = p[(long)c * HD * HD]; o[(long)c * HD * HD] = (bf16)f2bf(st); st = st * gC + v; } }
    else {
#pragma unroll 8
        for (int c = NCHUNK - 1; c >= 0; --c) { const float v = p[(long)c * HD * HD]; o[(long)c * HD * HD] = (bf16)f2bf(st); st = st * gC + v; } }
}
__device__ __forceinline__ void out_item(int item, LAS unsigned char* lds, const bf16* rq, const bf16* rk, const bf16* rv, const bf16* rgs, const float* pf, const float* pb,
                                         const bf16* S, const float* gain, bf16* yrin, int tid) {
    asm volatile("" : "+v"(tid));
    const int c = item & 63, bh = item >> 6, b = bh >> 2, h = bh & 3, lane = tid & 63, w = tid >> 6, g = lane >> 4, lc = lane & 15;
    const long tok0 = (long)b * SEQ + (long)c * CHUNK;
    LAS unsigned char* Kl = lds; LAS unsigned char* Vl = lds + TILE_B; LAS unsigned char* strip = lds + 2 * TILE_B + w * STRIP_B;
    stage_tile(Kl, rk, tok0, h, tid); stage_tile(Vl, rv, tok0, h, tid);
    bf16x8 qa[4];
#pragma unroll
    for (int kk = 0; kk < 4; ++kk) qa[kk] = *(const GAS bf16x8*)(rq + (tok0 + 16 * w + lc) * 512 + h * HD + 32 * kk + 8 * g);
    __syncthreads();
    const float lf = lg2_of(pf, h), lb = lg2_of(pb, h);
    {
        f32x4 sc[8];
#pragma unroll
        for (int n = 0; n < 8; ++n) { sc[n] = (f32x4){0.f, 0.f, 0.f, 0.f};
#pragma unroll
            for (int kk = 0; kk < 4; ++kk) sc[n] = __builtin_amdgcn_mfma_f32_16x16x32_bf16(qa[kk], frag_row(Kl, 16 * n, 32 * kk, lane), sc[n], 0, 0, 0); }
#pragma unroll
        for (int n = 0; n < 8; ++n)
#pragma unroll
            for (int r = 0; r < 4; ++r) { const int i = 16 * w + 4 * g + r, j = 16 * n + lc; const int df = i - j;
                const float dec = __builtin_amdgcn_exp2f(df >= 0 ? lf * (float)df : lb * (float)(-df));
                *(LAS unsigned short*)(strip + (4 * g + r) * PITCH + j * 2) = (unsigned short)f2bf(sc[n][r] * dec); }
    }
    asm volatile("s_waitcnt lgkmcnt(0)" ::: "memory");
    bf16x8 qf[4], qb[4];
    { const int ia = 16 * w + lc; const float cf = __builtin_amdgcn_exp2f(lf * (float)(ia + 1)), cb = __builtin_amdgcn_exp2f(lb * (float)(CHUNK - ia));
#pragma unroll
      for (int kk = 0; kk < 4; ++kk) { unsigned pf_[4], pb_[4];
#pragma unroll
          for (int t = 0; t < 8; t += 2) { const float v0 = __uint_as_float((unsigned)(unsigned short)qa[kk][t] << 16), v1 = __uint_as_float((unsigned)(unsigned short)qa[kk][t + 1] << 16);
              pf_[t >> 1] = cvt2(v0 * cf, v1 * cf); pb_[t >> 1] = cvt2(v0 * cb, v1 * cb); }
          const v4u wf_ = {pf_[0], pf_[1], pf_[2], pf_[3]}, wb_ = {pb_[0], pb_[1], pb_[2], pb_[3]};
          qf[kk] = __builtin_bit_cast(bf16x8, wf_); qb[kk] = __builtin_bit_cast(bf16x8, wb_); } }
    f32x4 o[8];
#pragma unroll
    for (int n = 0; n < 8; ++n) o[n] = (f32x4){0.f, 0.f, 0.f, 0.f};
    const bf16* Sf = S + (((long)0 * 8 + bh) * NCHUNK + c) * (HD * HD); const bf16* Sb = S + (((long)1 * 8 + bh) * NCHUNK + c) * (HD * HD);
#pragma unroll
    for (int kh = 0; kh < 2; ++kh) {
        bf16x8 bfv[2][8], bbv[2][8];
#pragma unroll
        for (int k2 = 0; k2 < 2; ++k2)
#pragma unroll
            for (int n = 0; n < 8; ++n) { const int kk = 2 * kh + k2; bfv[k2][n] = *(const GAS bf16x8*)(Sf + (16 * n + lc) * HD + 32 * kk + 8 * g); bbv[k2][n] = *(const GAS bf16x8*)(Sb + (16 * n + lc) * HD + 32 * kk + 8 * g); }
#pragma unroll
        for (int k2 = 0; k2 < 2; ++k2) { const int kk = 2 * kh + k2;
            const bf16x8 sa = frag_row(strip, 0, 32 * kk, lane);
#pragma unroll
            for (int n = 0; n < 8; ++n) {
                o[n] = __builtin_amdgcn_mfma_f32_16x16x32_bf16(sa, frag_tr(Vl, 32 * kk, 16 * n, lane), o[n], 0, 0, 0);
                o[n] = __builtin_amdgcn_mfma_f32_16x16x32_bf16(qf[kk], bfv[k2][n], o[n], 0, 0, 0); o[n] = __builtin_amdgcn_mfma_f32_16x16x32_bf16(qb[kk], bbv[k2][n], o[n], 0, 0, 0); } }
        asm volatile("" ::: "memory");
    }
    asm volatile("s_waitcnt lgkmcnt(0)" ::: "memory");
#pragma unroll
    for (int r = 0; r < 4; ++r) {
        float y[8]; float s = 0.f;
#pragma unroll
        for (int n = 0; n < 8; ++n) { y[n] = o[n][r]; s += y[n]; }
        s += __shfl_xor(s, 1); s += __shfl_xor(s, 2); s += __shfl_xor(s, 4); s += __shfl_xor(s, 8);
        const float mu = s * (1.0f / HD); float s2 = 0.f;
#pragma unroll
        for (int n = 0; n < 8; ++n) { y[n] -= mu; s2 += y[n] * y[n]; }
        s2 += __shfl_xor(s2, 1); s2 += __shfl_xor(s2, 2); s2 += __shfl_xor(s2, 4); s2 += __shfl_xor(s2, 8);
        const float rstd = 1.0f / sqrtf(s2 * (1.0f / HD) + EPS);
#pragma unroll
        for (int n = 0; n < 8; ++n) *(LAS unsigned short*)(strip + (4 * g + r) * PITCH + (16 * n + lc) * 2) = (unsigned short)f2bf(y[n] * rstd); }
    asm volatile("s_waitcnt lgkmcnt(0)" ::: "memory");
    { const int row = lane >> 2, qc = lane & 3; const long ro = (tok0 + 16 * w + row) * 512 + h * HD;
#pragma unroll
      for (int t = 0; t < 4; ++t) { const int e0 = 32 * qc + 8 * t;
          const v4u yv = *(LAS const v4u*)(strip + row * PITCH + e0 * 2);
          const f32x4 y0 = {__uint_as_float(yv.x << 16), __uint_as_float(yv.x & 0xffff0000u), __uint_as_float(yv.y << 16), __uint_as_float(yv.y & 0xffff0000u)};
          const f32x4 y1 = {__uint_as_float(yv.z << 16), __uint_as_float(yv.z & 0xffff0000u), __uint_as_float(yv.w << 16), __uint_as_float(yv.w & 0xffff0000u)};
          const f32x4 g0 = *(const GAS f32x4*)(gain + h * HD + e0), g1 = *(const GAS f32x4*)(gain + h * HD + e0 + 4);
          const v4u rg = *(const GAS v4u*)(rgs + ro + e0);
          const f32x4 r0 = {__uint_as_float(rg.x << 16), __uint_as_float(rg.x & 0xffff0000u), __uint_as_float(rg.y << 16), __uint_as_float(rg.y & 0xffff0000u)};
          const f32x4 r1 = {__uint_as_float(rg.z << 16), __uint_as_float(rg.z & 0xffff0000u), __uint_as_float(rg.w << 16), __uint_as_float(rg.w & 0xffff0000u)};
          const f32x4 a0 = y0 * g0 * r0, a1 = y1 * g1 * r1;
          v4u ov; ov.x = cvt2(a0[0], a0[1]); ov.y = cvt2(a0[2], a0[3]); ov.z = cvt2(a1[0], a1[1]); ov.w = cvt2(a1[2], a1[3]);
          *(GAS v4u*)(yrin + ro + e0) = ov; } }
    __syncthreads();
}
}

constexpr int W1_ITEMS = 16 * (16 * 176), W1_EARLY = (W1_ITEMS * MK_W1_EARLY_PCT) / 100;
struct Args { const float* in[17]; float* out; unsigned char* ws; int ph_lo, ph_hi; };
constexpr int PH_PROLOGUE = 0, PH_PROJ = 1, PH_RETKV = 2, PH_ATTN = 3, PH_RETOUT = 4, PH_BRANCH = 5, PH_WO = 6, PH_ROUTER = 7, PH_TOPK = 8, PH_GATHER = 9, PH_MOE1 = 10, PH_MOE2 = 11, PH_FINAL = 12, PH_END = 13;
#ifndef MK_EXPERT_CVT
#define MK_EXPERT_CVT 1
#endif

__global__ void __launch_bounds__(NWAVES * 64, 2) mega(Args args) {
    extern __shared__ __attribute__((aligned(16))) unsigned char lds_raw[];
    LAS unsigned char* lds = (LAS unsigned char*)lds_raw;
    volatile LAS unsigned* MISC = (volatile LAS unsigned*)(lds + MISC_OFF);
    const int wave = __builtin_amdgcn_readfirstlane((int)threadIdx.x >> 6);
#define PHASE_IDS int lane; asm volatile("v_mbcnt_lo_u32_b32 %0, -1, 0\n\tv_mbcnt_hi_u32_b32 %0, -1, %0" : "=v"(lane)); const int tid = wave * 64 + lane; (void)tid;
    const int G = gridDim.x; const int bx = blockIdx.x; const int vcu = (G % 8 == 0) ? (bx % 8) * (G / 8) + bx / 8 : bx;
    unsigned char* ws = args.ws;
    gu32* ctl = (gu32*)(ws + WS_CTL);
    for (int u = threadIdx.x; u < (LDS_BYTES - LDSCTL_OFF) / 4; u += NWAVES * 64) ((LAS unsigned*)(lds + LDSCTL_OFF))[u] = 0u;
    __syncthreads();
    const bool one_launch = (args.ph_hi - args.ph_lo) > 1;
    XcdBarrier bar; bar.bar = (unsigned*)(ctl + CW_BAR); bar.x = 0; bar.st = nullptr;
    if (one_launch) bar = xcd_barrier_post((unsigned*)(ctl + CW_BAR), MISC + 8);
    const int lo = args.ph_lo, hi = args.ph_hi;
#define IN(k) (lo <= (k) && (k) < hi)
#define SEAM(k) do { if (IN(k) && IN((k) + 1)) { PHASE_IDS xcd_barrier(bar, tid); } } while (0)
    const int gw = vcu * NWAVES + wave, NGW = G * NWAVES;

    if (IN(PH_PROLOGUE)) { PHASE_IDS
        LAS float* scr = (LAS float*)(lds + RING_OFF + wave * 16384);
        const float* w_in = args.in[2]; const float* w_ret = args.in[6]; const float* w_att = args.in[9]; const float* w_o = args.in[10];
        const float* wg = args.in[13]; const float* wu = args.in[14];
        constexpr int I_IN = 16 * 160, I_R = 8 * 32, I_A = 8 * 32, I_O = 16 * 32, I_1 = 16 * 176;
        constexpr int NSMALL = I_IN + I_R + I_A + I_O;
        const int NITEMS = NSMALL + W1_EARLY;
        for (int it = gw; it < NITEMS; it += NGW) {
            int r = it;
            if (r < I_IN) { transpose_item(w_in, 1024, INW, (bf16*)(ws + WS_WIN), CmWin(), scr, r / 160, r % 160, lane); continue; } r -= I_IN;
            if (r < I_R) { transpose_item(w_ret, 512, D_MODEL, (bf16*)(ws + WS_WR), CmId(), scr, r / 32, r % 32, lane); continue; } r -= I_R;
            if (r < I_A) { transpose_item(w_att, 512, D_MODEL, (bf16*)(ws + WS_WA), CmId(), scr, r / 32, r % 32, lane); continue; } r -= I_A;
            if (r < I_O) { transpose_item(w_o, 1024, D_MODEL, (bf16*)(ws + WS_WO), CmId(), scr, r / 32, r % 32, lane); continue; } r -= I_O;
            { const int e = r / I_1, q = r % I_1, kb = q / 176, nb = q % 176; const bool up = (nb >> 2) & 1;
                transpose_item_f8((up ? wu : wg) + (size_t)e * D_MODEL * FF, 1024, FF, (unsigned char*)(ws + WS_W1C) + (size_t)e * 5632 * 1024, CmW1(), scr, kb, nb, lane, W1_SCALE); }
        }
        for (int m = gw; m < T; m += NGW) rms_row_to_bf16(args.in[0] + (size_t)m * D_MODEL, args.in[1], (bf16*)(ws + WS_H) + (size_t)m * D_MODEL, lane);
        { float* ct = (float*)(ws + WS_COS); float* st = (float*)(ws + WS_SIN);
          for (int e = (vcu * NWAVES * 64) + tid; e < SEQ * 64; e += G * NWAVES * 64) { const int pos = e >> 6, j = e & 63;
              const float freq = powf(10000.0f, -(float)(j & 31) / 32.0f); const float ang = (float)(j < 32 ? (pos >> 6) : (pos & 63)) * freq;
              ct[e] = cosf(ang); st[e] = sinf(ang); } }
    }
    SEAM(PH_PROLOGUE);

    if (IN(PH_PROJ)) { PHASE_IDS
        pg8::PlainSched S; S.init(T, INW, G, bx); S.A = (const char*)(ws + WS_H); S.Bt = (const char*)(ws + WS_WIN); S.tstep = (size_t)256 * 1024 * 2;
        pg8::EpiProj E; E.wsb = ws; E.qn = args.in[7]; E.kn = args.in[8]; E.xch = (LAS float*)(lds + XCH_OFF); E.epoch = 0u;
        pg8::gemm_phase<pg8::EpiProj, pg8::PlainSched, true, true>(lds + RING_OFF, 1024, S, E, tid);
    }
    SEAM(PH_PROJ);

    if (IN(PH_RETKV)) { PHASE_IDS
        for (int item = vcu; item < 8 * NCHUNK; item += G)
            ret::kv_item(item, lds + RING_OFF, (const bf16*)(ws + WS_RK), (const bf16*)(ws + WS_RV), args.in[3], args.in[4], (float*)(ws + WS_KV), tid);
    }
    SEAM(PH_RETKV);

    if (IN(PH_ATTN)) { PHASE_IDS
        for (long gid = (long)vcu * 512 + tid; gid < 2 * 8 * 16384; gid += (long)G * 512) ret::scan_thread(gid, args.in[3], args.in[4], (const float*)(ws + WS_KV), (bf16*)(ws + WS_S));
    }

    if (IN(PH_ATTN)) { PHASE_IDS
        for (int u = vcu; u < BATCH * 4 * (SEQ / 256); u += G) {
            const int bh = u >> 5, qb = u & 31, b = bh >> 2, h = bh & 3, kvh = h >> 1;
            const size_t q0 = ((size_t)b * SEQ + (size_t)qb * 256) * 512 + (size_t)h * 128, k0 = (size_t)b * SEQ * 256 + (size_t)kvh * 128;
            attn::attn_dense_body<attn::bf16>((const attn::bf16*)(ws + WS_AQ) + q0, (const attn::bf16*)(ws + WS_AK) + k0, (const attn::bf16*)(ws + WS_AV) + k0,
                                              (attn::bf16*)(ws + WS_ATT) + q0, SEQ, (char*)lds_raw, tid);
            __syncthreads();
        }
    }
    SEAM(PH_ATTN);

    if (IN(PH_RETOUT)) { PHASE_IDS
        for (int item = vcu; item < 8 * NCHUNK; item += G)
            ret::out_item(item, lds + RING_OFF, (const bf16*)(ws + WS_RQ), (const bf16*)(ws + WS_RK), (const bf16*)(ws + WS_RV), (const bf16*)(ws + WS_RGS), args.in[3], args.in[4],
                          (const bf16*)(ws + WS_S), args.in[5], (bf16*)(ws + WS_YRIN), tid);
    }
    SEAM(PH_RETOUT);

    if (IN(PH_BRANCH)) { PHASE_IDS
        pg8::BranchSched S; S.init(T, D_MODEL, G, bx); S.A0 = (const char*)(ws + WS_YRIN); S.A1 = (const char*)(ws + WS_ATT); S.B0 = (const char*)(ws + WS_WR); S.B1 = (const char*)(ws + WS_WA); S.tstep = (size_t)256 * 512 * 2;
        pg8::EpiBranch E; E.grs = (const bf16*)(ws + WS_GRS); E.gas = (const bf16*)(ws + WS_GAS); E.mixed = (bf16*)(ws + WS_MIXED);
        pg8::gemm_phase<pg8::EpiBranch, pg8::BranchSched, true, true>(lds + RING_OFF, 512, S, E, tid);
    }
    SEAM(PH_BRANCH);

    if (IN(PH_WO)) { PHASE_IDS
        pg8::PlainSched S; S.init(T, D_MODEL, G, bx); S.A = (const char*)(ws + WS_MIXED); S.Bt = (const char*)(ws + WS_WO); S.tstep = (size_t)256 * 1024 * 2;
        pg8::EpiResid E; E.x = args.in[0]; E.x1 = (float*)(ws + WS_X1);
        pg8::gemm_phase<pg8::EpiResid, pg8::PlainSched, true, true>(lds + RING_OFF, 1024, S, E, tid);
    }
    SEAM(PH_WO);

    if (IN(PH_ROUTER)) { PHASE_IDS
        LAS float* wl = (LAS float*)(lds + RING_OFF);
        { const GAS float* src = (const GAS float*)args.in[12]; for (int i = tid; i < 1024 * 16; i += NWAVES * 64) wl[(i & 15) * 1024 + (i >> 4)] = src[i]; }
        __syncthreads();
        const float* x1 = (const float*)(ws + WS_X1); const float* gain = args.in[11]; bf16* h2 = (bf16*)(ws + WS_H); float* aff = (float*)(ws + WS_AFF);
        if (wave >= 4) {
            LAS float* scr = (LAS float*)(lds + RING_OFF + 65536 + (wave - 4) * 16384); const float* wg = args.in[13]; const float* wu = args.in[14]; constexpr int I_1 = 16 * 176;
            for (int it = W1_EARLY + vcu * 4 + (wave - 4); it < W1_ITEMS; it += G * 4) { const int e = it / I_1, q = it % I_1, kb = q / 176, nb = q % 176; const bool up = (nb >> 2) & 1;
                transpose_item_f8((up ? wu : wg) + (size_t)e * D_MODEL * FF, 1024, FF, (unsigned char*)(ws + WS_W1C) + (size_t)e * 5632 * 1024, CmW1(), scr, kb, nb, lane, W1_SCALE); }
        } else {
        const int gw = vcu * 4 + wave, NGW = G * 4;
        const GAS f32x4* gr = (const GAS f32x4*)gain + lane;
        f32x4 v[4];
        if (gw < T) { const GAS f32x4* xr = (const GAS f32x4*)(x1 + (size_t)gw * D_MODEL) + lane;
#pragma unroll
            for (int j = 0; j < 4; ++j) v[j] = xr[64 * j]; }
        for (int m = gw; m < T; m += NGW) {
            f32x4 nv[4];
            { const int mn = (m + NGW < T) ? m + NGW : m; const GAS f32x4* xn = (const GAS f32x4*)(x1 + (size_t)mn * D_MODEL) + lane;
#pragma unroll
              for (int j = 0; j < 4; ++j) nv[j] = xn[64 * j]; }
            float s = 0.f;
#pragma unroll
            for (int j = 0; j < 4; ++j) s += (v[j].x * v[j].x + v[j].y * v[j].y) + (v[j].z * v[j].z + v[j].w * v[j].w);
            const float rstd = 1.f / sqrtf(wave_sum(s) * (1.f / D_MODEL) + EPS);
            float lg[NE];
#pragma unroll
            for (int e = 0; e < NE; ++e) lg[e] = 0.f;
            GAS unsigned* o4 = (GAS unsigned*)((unsigned char*)h2 + (size_t)m * D_MODEL) + lane;
#pragma unroll
            for (int j = 0; j < 4; ++j) { const f32x4 g4 = gr[64 * j]; const f32x4 hv = v[j] * g4 * rstd;
                o4[64 * j] = pk4_fp8(hv.x, hv.y, hv.z, hv.w);
#pragma unroll
                for (int e = 0; e < NE; ++e) { const f32x4 w = *(const LAS f32x4*)(wl + e * 1024 + 4 * lane + 256 * j); lg[e] += (hv.x * w.x + hv.y * w.y) + (hv.z * w.z + hv.w * w.w); if ((e & 3) == 3) asm volatile("" ::: "memory"); }
                asm volatile("" ::: "memory"); }
            float r8[8], r4[4], r2[2], r1;
            { const bool b = (lane & 32) != 0;
#pragma unroll
              for (int e = 0; e < 8; ++e) { const float keep = b ? lg[e + 8] : lg[e], send = b ? lg[e] : lg[e + 8]; r8[e] = keep + __shfl_xor(send, 32); } }
            { const bool b = (lane & 16) != 0;
#pragma unroll
              for (int e = 0; e < 4; ++e) { const float keep = b ? r8[e + 4] : r8[e], send = b ? r8[e] : r8[e + 4]; r4[e] = keep + __shfl_xor(send, 16); } }
            { const bool b = (lane & 8) != 0;
#pragma unroll
              for (int e = 0; e < 2; ++e) { const float keep = b ? r4[e + 2] : r4[e], send = b ? r4[e] : r4[e + 2]; r2[e] = keep + __shfl_xor(send, 8); } }
            { const bool b = (lane & 4) != 0; const float keep = b ? r2[1] : r2[0], send = b ? r2[0] : r2[1]; r1 = keep + __shfl_xor(send, 4); }
            r1 += __shfl_xor(r1, 2); r1 += __shfl_xor(r1, 1);
            float mx = r1; mx = fmaxf(mx, __shfl_xor(mx, 4)); mx = fmaxf(mx, __shfl_xor(mx, 8)); mx = fmaxf(mx, __shfl_xor(mx, 16)); mx = fmaxf(mx, __shfl_xor(mx, 32));
            const float pe = expf(r1 - mx); float den = pe; den += __shfl_xor(den, 4); den += __shfl_xor(den, 8); den += __shfl_xor(den, 16); den += __shfl_xor(den, 32);
            if ((lane & 3) == 0) aff[(size_t)m * NE + (((lane >> 5) & 1) * 8 + ((lane >> 4) & 1) * 4 + ((lane >> 3) & 1) * 2 + ((lane >> 2) & 1))] = pe / den;
#pragma unroll
            for (int j = 0; j < 4; ++j) v[j] = nv[j];
        }
        }
        __syncthreads();
    }
    SEAM(PH_ROUTER);

    if (IN(PH_TOPK)) { PHASE_IDS
        if (vcu >= NZ) {
            const int lane_c = lane;
            LAS float* scr = (LAS float*)(lds + RING_OFF + wave * 16384); const float* wd = args.in[15]; constexpr int I_D = 44 * 32;
            for (int it = (vcu - NZ) * NWAVES + wave; it < NE * I_D; it += (G - NZ) * NWAVES) { const int e = it / I_D, q = it % I_D;
                transpose_item_f8(wd + (size_t)e * FF * D_MODEL, FF, D_MODEL, (unsigned char*)(ws + WS_WD) + (size_t)e * 1024 * FF, CmId(), scr, q / 32, q % 32, lane_c, WD_SCALE); }
        }
        LAS unsigned* keys = (LAS unsigned*)(lds + RING_OFF); LAS int* hist = (LAS int*)(lds + RING_OFF + 32768); LAS int* sc = (LAS int*)(lds + RING_OFF + 34816); volatile LAS unsigned* sv = (volatile LAS unsigned*)(lds + RING_OFF + 36864);
        const float* aff = (const float*)(ws + WS_AFF); int* idx = (int*)(ws + WS_IDX); float* gate = (float*)(ws + WS_GATE); int* sel = (int*)(ws + WS_SEL);
        for (int z = vcu; z < NZ; z += G) {
            const int b = z / NE, e = z % NE;
            for (int i = tid; i < SEQ; i += 512) keys[i] = __float_as_uint(aff[((size_t)b * SEQ + i) * NE + e]);
            if (tid == 0) { sv[0] = 0u; sv[1] = (unsigned)CAP; }
            __syncthreads();
            unsigned mask = 0u;
            for (int pass = 3; pass >= 0; --pass) {
                const int shift = pass * 8;
                if (tid < 256) hist[tid] = 0;
                __syncthreads();
                const unsigned prefix = sv[0];
                for (int i = tid; i < SEQ; i += 512) { const unsigned k = keys[i]; if ((k & mask) == prefix) atomicAdd((int*)&hist[(k >> shift) & 255u], 1); }
                __syncthreads();
                if (tid < 64) {
                    const int krem = (int)sv[1]; const int h0 = hist[4 * tid], h1 = hist[4 * tid + 1], h2 = hist[4 * tid + 2], h3 = hist[4 * tid + 3];
                    int suf = h0 + h1 + h2 + h3;
#pragma unroll
                    for (int o = 1; o < 64; o <<= 1) { const int t = __shfl_down(suf, o); if (tid + o < 64) suf += t; }
                    int cum = suf - (h0 + h1 + h2 + h3);
                    int dsel = -1, cumsel = 0;
                    if (cum < krem && cum + h3 >= krem) { dsel = 3; cumsel = cum; } cum += h3;
                    if (dsel < 0 && cum < krem && cum + h2 >= krem) { dsel = 2; cumsel = cum; } cum += h2;
                    if (dsel < 0 && cum < krem && cum + h1 >= krem) { dsel = 1; cumsel = cum; } cum += h1;
                    if (dsel < 0 && cum < krem && cum + h0 >= krem) { dsel = 0; cumsel = cum; }
                    if (dsel >= 0) { sv[1] = (unsigned)(krem - cumsel); sv[0] = prefix | ((unsigned)(4 * tid + dsel) << shift); }
                }
                __syncthreads();
                mask |= 0xFFu << shift;
            }
            const unsigned Tk = sv[0]; const int krem = (int)sv[1];
            int cgt = 0, ceq = 0;
            for (int q = 0; q < 16; ++q) { const unsigned k = keys[tid * 16 + q]; cgt += (k > Tk); ceq += (k == Tk); }
            int eqbase, slot;
            { sc[tid] = ceq; __syncthreads(); for (int off = 1; off < 512; off <<= 1) { const int t = (tid >= off) ? sc[tid - off] : 0; __syncthreads(); sc[tid] += t; __syncthreads(); } eqbase = sc[tid] - ceq; __syncthreads(); }
            int take = krem - eqbase; take = take < 0 ? 0 : (take > ceq ? ceq : take);
            { const int v = cgt + take; sc[tid] = v; __syncthreads(); for (int off = 1; off < 512; off <<= 1) { const int t = (tid >= off) ? sc[tid - off] : 0; __syncthreads(); sc[tid] += t; __syncthreads(); } slot = sc[tid] - v; __syncthreads(); }
            int eqr = eqbase;
            for (int q = 0; q < 16; ++q) { const int i = tid * 16 + q; const unsigned k = keys[i]; bool tk = k > Tk; if (k == Tk) { tk = eqr < krem; ++eqr; }
                if (tk) { idx[z * CAP + slot] = i; gate[z * CAP + slot] = __uint_as_float(k); sel[((size_t)b * SEQ + i) * NE + e] = slot; ++slot; } else sel[((size_t)b * SEQ + i) * NE + e] = -1; }
            __syncthreads();
        }
    }
    SEAM(PH_TOPK);


    if (IN(PH_MOE1)) { PHASE_IDS
        pg8::MoeGatherSched S; S.init(NZ * CAP, 5632, G, bx); S.A = (const char*)(ws + WS_H); S.Bt = (const char*)(ws + WS_W1C); S.idx = (const int*)(ws + WS_IDX);
        pg8::EpiSwiglu E; E.act = (unsigned char*)(ws + WS_ACT); E.in_scale = 1.0f / W1_SCALE; E.act_scale = ACT_SCALE;
        pg8::gemm_phase<pg8::EpiSwiglu, pg8::MoeGatherSched, true, true, true>(lds + RING_OFF, 1024 / 2, S, E, tid);
    }
    SEAM(PH_MOE1);

    if (IN(PH_MOE2)) { PHASE_IDS
        pg8::MoeSched S; S.init(NZ * CAP, D_MODEL, G, bx); S.A = (const char*)(ws + WS_ACT); S.Bt = (const char*)(ws + WS_WD); S.kb = (size_t)FF; S.nper = 1024;
        pg8::EpiDown E; E.y = (bf16*)(ws + WS_Y); E.gate = (const float*)(ws + WS_GATE); E.out_scale = 1.0f / (WD_SCALE * ACT_SCALE);
        pg8::gemm_phase<pg8::EpiDown, pg8::MoeSched, true, true, true>(lds + RING_OFF, FF / 2, S, E, tid);
    }
    SEAM(PH_MOE2);

    if (IN(PH_FINAL)) { PHASE_IDS
        const float* x1 = (const float*)(ws + WS_X1); const int* sel = (const int*)(ws + WS_SEL); const bf16* y = (const bf16*)(ws + WS_Y); const float* gain = args.in[16];
        for (int m = gw; m < T; m += NGW) {
            const int b = m / SEQ;
            const GAS f32x4* xr = (const GAS f32x4*)(x1 + (size_t)m * D_MODEL) + lane; const GAS f32x4* gr = (const GAS f32x4*)gain + lane;
            f32x4 v[4];
#pragma unroll
            for (int j = 0; j < 4; ++j) v[j] = xr[64 * j];
            const int mysel = (lane < NE) ? sel[(size_t)m * NE + lane] : -1;
            for (int e = 0; e < NE; ++e) { const int sl = __builtin_amdgcn_readlane(mysel, e);
                if (sl >= 0) { const GAS unsigned long long* yr = (const GAS unsigned long long*)(y + ((size_t)(b * NE + e) * CAP + sl) * D_MODEL) + lane;
#pragma unroll
                    for (int j = 0; j < 4; ++j) { const unsigned long long w = yr[64 * j]; const unsigned lo = (unsigned)w, hi = (unsigned)(w >> 32);
                        v[j].x += __uint_as_float(lo << 16); v[j].y += __uint_as_float(lo & 0xffff0000u); v[j].z += __uint_as_float(hi << 16); v[j].w += __uint_as_float(hi & 0xffff0000u); } } }
            float s = 0.f;
#pragma unroll
            for (int j = 0; j < 4; ++j) s += (v[j].x * v[j].x + v[j].y * v[j].y) + (v[j].z * v[j].z + v[j].w * v[j].w);
            const float rstd = 1.f / sqrtf(wave_sum(s) * (1.f / D_MODEL) + EPS);
            GAS f32x4* o = (GAS f32x4*)(args.out + (size_t)m * D_MODEL) + lane;
#pragma unroll
            for (int j = 0; j < 4; ++j) { const f32x4 g4 = gr[64 * j]; o[64 * j] = v[j] * g4 * rstd; }
        }
    }
#undef IN
#undef SEAM
}

#ifndef MK_DUP
#define MK_DUP (-1)
#endif
#ifndef MK_ONE_LAUNCH
#define MK_ONE_LAUNCH 1
#endif
extern "C" void kernel_launch(void* const* d_in, const int* in_sizes, int n_in, void* d_out, int out_size, void* d_ws, size_t ws_size, hipStream_t stream) {
    static int grid = 0;
    if (grid == 0) {
        if (n_in != 17 || in_sizes[0] != T * D_MODEL || out_size != T * D_MODEL || ws_size < WS_END) { fprintf(stderr, "kernel_launch: shape/workspace mismatch (ws %zu need %zu)\n", ws_size, (size_t)WS_END); grid = -1; return; }
        int dev = 0, cus = 0, per_cu = 0;
        if (hipGetDevice(&dev) != hipSuccess || hipDeviceGetAttribute(&cus, hipDeviceAttributeMultiprocessorCount, dev) != hipSuccess) { grid = -1; return; }
        if (hipFuncSetAttribute((const void*)mega, hipFuncAttributeMaxDynamicSharedMemorySize, LDS_BYTES) != hipSuccess) { fprintf(stderr, "kernel_launch: hipFuncSetAttribute failed\n"); grid = -1; return; }
        if (hipOccupancyMaxActiveBlocksPerMultiprocessor(&per_cu, (const void*)mega, NWAVES * 64, LDS_BYTES) != hipSuccess || per_cu < 1) { fprintf(stderr, "kernel_launch: occupancy query says %d blocks per CU\n", per_cu); (void)hipGetLastError(); grid = -1; return; }
        grid = cus;
    }
    if (grid < 0) return;
    unsigned char* ws = (unsigned char*)d_ws;
    (void)hipMemsetAsync(ws + WS_CTL, 0, CTL_ZERO_BYTES, stream);
    Args a{};
    for (int i = 0; i < 17; ++i) a.in[i] = (const float*)d_in[i];
    a.out = (float*)d_out; a.ws = ws;
#if MK_ONE_LAUNCH
    a.ph_lo = 0; a.ph_hi = PH_END; hipLaunchKernelGGL(mega, dim3(grid), dim3(NWAVES * 64), LDS_BYTES, stream, a);
#if MK_DUP >= 0
    a.ph_lo = MK_DUP; a.ph_hi = MK_DUP + 1; hipLaunchKernelGGL(mega, dim3(grid), dim3(NWAVES * 64), LDS_BYTES, stream, a);
#endif
#else
    for (int ph = 0; ph < PH_END; ++ph) { a.ph_lo = ph; a.ph_hi = ph + 1; hipLaunchKernelGGL(mega, dim3(grid), dim3(NWAVES * 64), LDS_BYTES, stream, a); }
#endif
}
```

```cpp
#include <hip/hip_runtime.h>
#ifndef MK_W1_EARLY_PCT
#define MK_W1_EARLY_PCT 0
#endif
#include <hip/hip_bf16.h>
#include <cstdio>
#include <cstdint>
#include <cmath>

constexpr size_t EP_MiB = 1u << 20;
constexpr size_t EP_COS = 2 * EP_MiB, EP_SIN = 4 * EP_MiB, EP_RQ = 382 * EP_MiB, EP_RK = 398 * EP_MiB, EP_RV = 414 * EP_MiB, EP_RGS = 430 * EP_MiB, EP_AQ = 446 * EP_MiB, EP_AK = 462 * EP_MiB, EP_AV = 470 * EP_MiB, EP_GRS = 478 * EP_MiB, EP_GAS = 510 * EP_MiB;
constexpr int D_MODEL = 1024, BATCH = 2, SEQ = 8192, T = BATCH * SEQ;
constexpr int HD = 128, CHUNK = 128, NCHUNK = SEQ / CHUNK;
constexpr int NE = 16, FF = 2816, CAP = 1024, NZ = BATCH * NE;
constexpr int INW = 5120;
constexpr int O_RQ = 0, O_RK = 512, O_RV = 1024, O_RG = 1536, O_AQ = 2048, O_AK = 2560, O_AV = 2816, O_GR = 3072, O_GA = 4096;
constexpr float EPS = 1e-6f;
constexpr float RSQRT_HD = 0.08838834764831845f;
constexpr float W1_SCALE = 32.0f, WD_SCALE = 64.0f, ACT_SCALE = 4.0f;

namespace pg8 {
#define PG8_LAS __attribute__((address_space(3)))
typedef unsigned short bf16_t;
typedef short bf16x8 __attribute__((ext_vector_type(8)));
typedef float f32x4 __attribute__((ext_vector_type(4)));
typedef unsigned u32x4 __attribute__((ext_vector_type(4)));
constexpr int BM = 256, BK = 64, HALF = 128, HTB = HALF * BK * 2  , STAGE_BYTES = 8 * HTB, NXCD = 8, WGM = 8;

__host__ __device__ __forceinline__ int lds_byte(int r, int c) { const int st = (r >> 4) * 2 + (c >> 5), rr = r & 15, cc = c & 31, ob = rr * 64 + cc * 2; return st * 1024 + (ob ^ (((ob >> 9) & 1) << 5)); }
__host__ __device__ __forceinline__ void stage_rc(int b, int& R, int& C) { const int st = b / 1024, sb = b % 1024, swz = sb ^ (((sb >> 9) & 1) << 5); R = (st >> 1) * 16 + swz / 64; C = (st & 1) * 32 + (swz % 64) / 2; }
__host__ __device__ __forceinline__ int perm32(int rho) { const int n = rho >> 4, i = rho & 15; return 8 * (i >> 2) + 4 * n + (i & 3); }

struct Unit { int pm, pn, aux; };
struct Gemm { const bf16_t* A; const bf16_t* Bt; int M, N, K; };

struct StaticOrder {
    int nM, nN, nwg, G, c;
    __host__ __device__ void init(int M, int N, int G_, int c_) { nM = M / BM; nN = N / BM; nwg = nM * nN; G = G_; c = c_; }
    __host__ __device__ bool next(int i, Unit& u) const {
        const long L = (long)i * G + c; if (L >= nwg) return false;
        int wgid = (int)L; { const int q = nwg / NXCD, r = nwg % NXCD, xcd = wgid % NXCD, off = wgid / NXCD; wgid = (xcd < r ? xcd * (q + 1) : r * (q + 1) + (xcd - r) * q) + off; }
        const int nig = WGM * nN, gid = wgid / nig, fm = gid * WGM, gsz = (nM - fm) < WGM ? (nM - fm) : WGM;
        u.pm = fm + ((wgid % nig) % gsz); u.pn = (wgid % nig) / gsz; u.aux = 0; return true;
    }
    __device__ __forceinline__ void a_ready(const Unit&) const {}
    __device__ __forceinline__ void done(const Unit&) const {}
    static constexpr bool GATHER = false;
    __device__ __forceinline__ unsigned gather_off(const Unit&, int, int) const { return 0u; }
    __device__ __forceinline__ bool keep_acc(const Unit&) const { return false; }
};


struct PlainSched : StaticOrder {
    const char* A; const char* Bt; size_t tstep;
    __device__ __forceinline__ void bases(const Unit& u, const char*& a, const char*& b) const { a = A + (size_t)u.pm * tstep; b = Bt + (size_t)u.pn * tstep; }
};

typedef float f32x2_t __attribute__((ext_vector_type(2))); typedef __bf16 bf16x2_t __attribute__((ext_vector_type(2)));
__device__ __forceinline__ unsigned cvt_pk_bf16(float lo, float hi) { f32x2_t v = {lo, hi}; bf16x2_t b = __builtin_convertvector(v, bf16x2_t); return __builtin_bit_cast(unsigned, b); }
__device__ __forceinline__ u32x4 pack8(const f32x4 a, const f32x4 b) { u32x4 w; w.x = cvt_pk_bf16(a[0], a[1]); w.y = cvt_pk_bf16(a[2], a[3]); w.z = cvt_pk_bf16(b[0], b[1]); w.w = cvt_pk_bf16(b[2], b[3]); return w; }
__device__ __forceinline__ float fast_sigmoid(float x) { return __builtin_amdgcn_rcpf(1.0f + __builtin_amdgcn_exp2f(-1.4426950408889634f * x)); }
__device__ __forceinline__ f32x4 sigmoid4(const f32x4 v) { return (f32x4){fast_sigmoid(v[0]), fast_sigmoid(v[1]), fast_sigmoid(v[2]), fast_sigmoid(v[3])}; }
__device__ __forceinline__ f32x4 silu4(const f32x4 v) { return v * sigmoid4(v); }

struct EpiProj {
    static constexpr bool PERM = true, AFTER_DRAIN = false;
    unsigned char* wsb;
    const float *qn, *kn;
    PG8_LAS float* xch;
    mutable unsigned epoch;
    template <int ACT>
    __device__ __forceinline__ void plain(const f32x4 (&acc)[2][2][4][2], bf16_t* base, int ld, int col0, int row0) const {
#pragma unroll
        for (int ai = 0; ai < 2; ++ai)
#pragma unroll
            for (int m = 0; m < 4; ++m) { bf16_t* rowp = base + (size_t)(row0 + ai * HALF + m * 16) * ld + col0;
#pragma unroll
                for (int bj = 0; bj < 2; ++bj) { f32x4 v0 = acc[ai][bj][m][0], v1 = acc[ai][bj][m][1];
                    if (ACT == 1) { v0 = silu4(v0); v1 = silu4(v1); } else if (ACT == 2) { v0 = sigmoid4(v0); v1 = sigmoid4(v1); }
                    *(u32x4*)(rowp + bj * HALF) = pack8(v0, v1); } }
    }
    template <bool NORM>
    __device__ __forceinline__ void rope(const f32x4 (&acc)[2][2][4][2], bf16_t* base, int ld, int col0, int row0, float scale, const float* nw, int wr, int wc, int fr, int fq) const {
        const int g = 4 * wc + fq;
        f32x4 nw1 = {1.f, 1.f, 1.f, 1.f}, nw2 = {1.f, 1.f, 1.f, 1.f};
        if (NORM) {
#pragma unroll
            for (int ai = 0; ai < 2; ++ai)
#pragma unroll
                for (int m = 0; m < 4; ++m)
#pragma unroll
                    for (int bj = 0; bj < 2; ++bj) { const f32x4 a = acc[ai][bj][m][0], b = acc[ai][bj][m][1];
                        float s = (a[0] * a[0] + a[1] * a[1]) + (a[2] * a[2] + a[3] * a[3]) + (b[0] * b[0] + b[1] * b[1]) + (b[2] * b[2] + b[3] * b[3]);
                        s += __shfl_xor(s, 16); s += __shfl_xor(s, 32);
                        if (fq == 0) xch[((ai * HALF + wr * 64 + m * 16 + fr) * 2 + bj) * 4 + wc] = s; }
            asm volatile("s_waitcnt lgkmcnt(0)" ::: "memory");
            PG8_LAS unsigned* cnt = (PG8_LAS unsigned*)(xch + 2048) + wr;
            if ((fr | fq) == 0) __hip_atomic_fetch_add(cnt, 1u, __ATOMIC_RELAXED, __HIP_MEMORY_SCOPE_WORKGROUP);
            epoch += 4u;
            while (__hip_atomic_load(cnt, __ATOMIC_RELAXED, __HIP_MEMORY_SCOPE_WORKGROUP) < epoch) __builtin_amdgcn_s_sleep(1);
            asm volatile("s_waitcnt lgkmcnt(0)" ::: "memory");
            nw1 = *(const f32x4*)(nw + 4 * g); nw2 = *(const f32x4*)(nw + 64 + 4 * g);
        }
#pragma unroll
        for (int ai = 0; ai < 2; ++ai)
#pragma unroll
            for (int m = 0; m < 4; ++m) { const int r = row0 + ai * HALF + m * 16; const int pos = r & 8191;
                const f32x4 c4 = *(const f32x4*)((const float*)(wsb + EP_COS) + (size_t)pos * 64 + 4 * g), s4 = *(const f32x4*)((const float*)(wsb + EP_SIN) + (size_t)pos * 64 + 4 * g);
                bf16_t* rowp = base + (size_t)r * ld + col0;
#pragma unroll
                for (int bj = 0; bj < 2; ++bj) { f32x4 x1 = acc[ai][bj][m][0], x2 = acc[ai][bj][m][1];
                    if (NORM) { const f32x4 p = *(const PG8_LAS f32x4*)(xch + ((ai * HALF + wr * 64 + m * 16 + fr) * 2 + bj) * 4);
                        const float rs = __builtin_amdgcn_rsqf(((p[0] + p[1]) + (p[2] + p[3])) * (1.0f / 128.0f) + 1e-6f);
                        x1 = x1 * (nw1 * rs); x2 = x2 * (nw2 * rs); }
                    const f32x4 y1 = (x1 * c4 - x2 * s4) * scale, y2 = (x1 * s4 + x2 * c4) * scale;
                    *(u32x4*)(rowp + bj * HALF) = pack8(y1, y2); }
                asm volatile("" ::: "memory"); }
    }
    __device__ __forceinline__ void operator()(const f32x4 (&acc)[2][2][4][2], const Unit& u, int wr, int wc, int fr, int fq) const {
        const int row0 = u.pm * BM + wr * 64 + fr, cw = wc * 32 + 8 * fq, pn = u.pn;
        if (pn < 2)       rope<false>(acc, (bf16_t*)(wsb + EP_RQ), 512, pn * 256 + cw, row0, 1.0f, nullptr, wr, wc, fr, fq);
        else if (pn < 4)  rope<false>(acc, (bf16_t*)(wsb + EP_RK), 512, (pn - 2) * 256 + cw, row0, 0.08838834764831845f, nullptr, wr, wc, fr, fq);
        else if (pn < 6)  plain<0>(acc, (bf16_t*)(wsb + EP_RV), 512, (pn - 4) * 256 + cw, row0);
        else if (pn < 8)  plain<1>(acc, (bf16_t*)(wsb + EP_RGS), 512, (pn - 6) * 256 + cw, row0);
        else if (pn < 10) rope<true>(acc, (bf16_t*)(wsb + EP_AQ), 512, (pn - 8) * 256 + cw, row0, 1.0f, qn, wr, wc, fr, fq);
        else if (pn < 11) rope<true>(acc, (bf16_t*)(wsb + EP_AK), 256, cw, row0, 1.0f, kn, wr, wc, fr, fq);
        else if (pn < 12) plain<0>(acc, (bf16_t*)(wsb + EP_AV), 256, cw, row0);
        else if (pn < 16) plain<2>(acc, (bf16_t*)(wsb + EP_GRS), 1024, (pn - 12) * 256 + cw, row0);
        else              plain<2>(acc, (bf16_t*)(wsb + EP_GAS), 1024, (pn - 16) * 256 + cw, row0);
    }
};

struct BranchSched : StaticOrder {
    const char *A0, *A1, *B0, *B1; size_t tstep;
    __device__ __forceinline__ bool next(int i, Unit& u) const { if (!StaticOrder::next(i >> 1, u)) return false; u.aux = i & 1; return true; }
    __device__ __forceinline__ void bases(const Unit& u, const char*& a, const char*& b) const { a = (u.aux ? A1 : A0) + (size_t)u.pm * tstep; b = (u.aux ? B1 : B0) + (size_t)u.pn * tstep; }
    __device__ __forceinline__ bool keep_acc(const Unit& nxt) const { return nxt.aux == 1; }
};
__device__ __forceinline__ void unpack8(const u32x4 w, f32x4& a, f32x4& b) {
    a = (f32x4){__uint_as_float(w.x << 16), __uint_as_float(w.x & 0xffff0000u), __uint_as_float(w.y << 16), __uint_as_float(w.y & 0xffff0000u)};
    b = (f32x4){__uint_as_float(w.z << 16), __uint_as_float(w.z & 0xffff0000u), __uint_as_float(w.w << 16), __uint_as_float(w.w & 0xffff0000u)};
}
struct EpiBranch {
    static constexpr bool PERM = true, AFTER_DRAIN = false;
    const bf16_t *grs, *gas; bf16_t* mixed;
    __device__ __forceinline__ void operator()(f32x4 (&acc)[2][2][4][2], const Unit& u, int wr, int wc, int fr, int fq) const {
        const int row0 = u.pm * BM + wr * 64 + fr, col0 = u.pn * BM + wc * 32 + 8 * fq;
#pragma unroll
        for (int ai = 0; ai < 2; ++ai)
#pragma unroll
            for (int m = 0; m < 4; ++m) { const size_t off = (size_t)(row0 + ai * HALF + m * 16) * 1024 + col0;
#pragma unroll
                for (int bj = 0; bj < 2; ++bj) { f32x4 ga0, ga1; unpack8(*(const u32x4*)(gas + off + bj * HALF), ga0, ga1);
                    if (u.aux == 0) { f32x4 gr0, gr1; unpack8(*(const u32x4*)(grs + off + bj * HALF), gr0, gr1);
#pragma unroll
                        for (int k = 0; k < 4; ++k) { acc[ai][bj][m][0][k] *= gr0[k] * __builtin_amdgcn_rcpf(fmaxf(ga0[k], 1e-30f)); acc[ai][bj][m][1][k] *= gr1[k] * __builtin_amdgcn_rcpf(fmaxf(ga1[k], 1e-30f)); } }
                    else *(u32x4*)(mixed + off + bj * HALF) = pack8(acc[ai][bj][m][0] * ga0, acc[ai][bj][m][1] * ga1); }
                asm volatile("" ::: "memory"); }
    }
};
struct EpiResid {
    static constexpr bool PERM = false, AFTER_DRAIN = false;
    const float* x; float* x1;
    __device__ __forceinline__ void operator()(const f32x4 (&acc)[2][2][4][2], const Unit& u, int wr, int wc, int fr, int fq) const {
        const int row0 = u.pm * BM + wr * 64 + fr, col0 = u.pn * BM + wc * 32 + 4 * fq;
#pragma unroll
        for (int ai = 0; ai < 2; ++ai)
#pragma unroll
            for (int m = 0; m < 4; ++m) { const size_t off = (size_t)(row0 + ai * HALF + m * 16) * 1024 + col0;
#pragma unroll
                for (int bj = 0; bj < 2; ++bj)
#pragma unroll
                    for (int n = 0; n < 2; ++n) { const f32x4 xv = *(const f32x4*)(x + off + bj * HALF + n * 16); *(f32x4*)(x1 + off + bj * HALF + n * 16) = xv + acc[ai][bj][m][n]; }
                if (m & 1) asm volatile("" ::: "memory"); }
    }
};
__device__ __forceinline__ int moe_rowbase(int pm) { return ((((pm >> 2) & 1) * 16 + (pm >> 3)) * 1024) + (pm & 3) * 256; }
struct MoeSched : StaticOrder {
    const char *A, *Bt; size_t kb; int nper;
    __device__ __forceinline__ void bases(const Unit& u, const char*& a, const char*& b) const { a = A + (size_t)moe_rowbase(u.pm) * kb; b = Bt + ((size_t)(u.pm >> 3) * nper + (size_t)u.pn * 256) * kb; }
};
struct MoeGatherSched : StaticOrder {
    static constexpr bool GATHER = true;
    const char *A, *Bt; const int* idx;
    __device__ __forceinline__ void bases(const Unit& u, const char*& a, const char*& b) const { a = A; b = Bt + ((size_t)(u.pm >> 3) * 5632 + (size_t)u.pn * 256) * 1024; }
    __device__ __forceinline__ unsigned gather_off(const Unit& u, int r, int c) const { const int tok = ((u.pm >> 2) & 1) * 8192 + idx[moe_rowbase(u.pm) + r]; return (unsigned)(tok * 1024 + c * 2); }
};
struct EpiSwiglu {
    static constexpr bool PERM = true, AFTER_DRAIN = false;
    unsigned char* act; float in_scale, act_scale;
    __device__ __forceinline__ void operator()(const f32x4 (&acc)[2][2][4][2], const Unit& u, int wr, int wc, int fr, int fq) const {
        const int row0 = moe_rowbase(u.pm) + wr * 64 + fr, col0 = u.pn * HALF + wc * 32 + 8 * fq;
#pragma unroll
        for (int ai = 0; ai < 2; ++ai)
#pragma unroll
            for (int m = 0; m < 4; ++m) { f32x4 v0 = silu4(acc[ai][0][m][0] * in_scale) * (acc[ai][1][m][0] * (in_scale * act_scale)), v1 = silu4(acc[ai][0][m][1] * in_scale) * (acc[ai][1][m][1] * (in_scale * act_scale));
#pragma unroll
                for (int k = 0; k < 4; ++k) { v0[k] = __builtin_amdgcn_fmed3f(v0[k], -448.0f, 448.0f); v1[k] = __builtin_amdgcn_fmed3f(v1[k], -448.0f, 448.0f); }
                const unsigned lo = (unsigned)__builtin_amdgcn_cvt_pk_fp8_f32(v0[2], v0[3], __builtin_amdgcn_cvt_pk_fp8_f32(v0[0], v0[1], 0, false), true), hi = (unsigned)__builtin_amdgcn_cvt_pk_fp8_f32(v1[2], v1[3], __builtin_amdgcn_cvt_pk_fp8_f32(v1[0], v1[1], 0, false), true);
                *(unsigned long long*)(act + (size_t)(row0 + ai * HALF + m * 16) * 2816 + col0) = (unsigned long long)lo | ((unsigned long long)hi << 32); }
    }
};
struct EpiDown {
    static constexpr bool PERM = true, AFTER_DRAIN = false;
    bf16_t* y; const float* gate; float out_scale;
    __device__ __forceinline__ void operator()(const f32x4 (&acc)[2][2][4][2], const Unit& u, int wr, int wc, int fr, int fq) const {
        const int row0 = moe_rowbase(u.pm) + wr * 64 + fr, col0 = u.pn * BM + wc * 32 + 8 * fq;
#pragma unroll
        for (int ai = 0; ai < 2; ++ai)
#pragma unroll
            for (int m = 0; m < 4; ++m) { const int r = row0 + ai * HALF + m * 16; const float g = gate[r] * out_scale;
#pragma unroll
                for (int bj = 0; bj < 2; ++bj) *(u32x4*)(y + (size_t)r * 1024 + col0 + bj * HALF) = pack8(acc[ai][bj][m][0] * g, acc[ai][bj][m][1] * g); }
    }
};
typedef int v4i32 __attribute__((ext_vector_type(4)));
typedef int v8i32 __attribute__((ext_vector_type(8)));
__device__ __forceinline__ v8i32 cat8(const bf16x8 lo, const bf16x8 hi) { const v4i32 l = __builtin_bit_cast(v4i32, lo), h = __builtin_bit_cast(v4i32, hi); return __builtin_shufflevector(l, h, 0, 1, 2, 3, 4, 5, 6, 7); }
__device__ __forceinline__ void mfma_f8_inplace(f32x4& acc, const v8i32 b8, const v8i32 a8, const int sc) {
    asm volatile("v_mfma_scale_f32_16x16x128_f8f6f4 %0, %1, %2, %0, %3, %3 op_sel_hi:[0,0,0]" : "+v"(acc) : "v"(b8), "v"(a8), "v"(sc)); }
template <class Epi, class Sched, bool ALIGN_EPI = false, bool SP2 = false, bool FP8 = false>
__device__ __forceinline__ void gemm_phase(PG8_LAS unsigned char* lds, const int K_, const Sched& S, const Epi& E, const int tid) {
    const int wid = __builtin_amdgcn_readfirstlane(tid >> 6), lane = tid & 63, wr = wid >> 2, wc = wid & 3, fr = lane & 15, fq = lane >> 4;
    const int K = K_, nt = K / BK;
    unsigned voffA[2], voffB[2];
#pragma unroll
    for (int i = 0; i < 2; ++i) { int R, C; stage_rc(tid * 16 + i * 8192, R, C); const int Rb = Epi::PERM ? ((R & ~31) + perm32(R & 31)) : R;
        voffA[i] = (unsigned)(R * K + C) * 2u; voffB[i] = (unsigned)(Rb * K + C) * 2u; }
    unsigned va0[2] = {0u, 0u}, va1[2] = {0u, 0u}, vn0[2] = {0u, 0u}, vn1[2] = {0u, 0u};
    int gR[2], gC[2];
#pragma unroll
    for (int i = 0; i < 2; ++i) stage_rc(tid * 16 + i * 8192, gR[i], gC[i]);
    const size_t kstep = (size_t)(BK * 2);
    const size_t hstep = (size_t)HALF * K * 2;
        const unsigned ldsw = (unsigned)wid * 1024u;
    const int aoff = lds_byte(wr * 64 + fr, fq * 8), boff = lds_byte(wc * 32 + fr, fq * 8);
#define PG8_SA(b, h) (((b) * 2 + (h)) * HTB)
#define PG8_SB(b, h) ((4 + (b) * 2 + (h)) * HTB)
#define PG8_STAGE(bufoff, gbase, voff) do { _Pragma("unroll") for (int _i = 0; _i < 2; ++_i) \
        __builtin_amdgcn_global_load_lds((const unsigned*)((const char*)(gbase) + (voff)[_i]), (PG8_LAS unsigned*)(lds + (bufoff) + ldsw + _i * 8192), 16, 0, 0); } while (0)
#define PG8_STAGE_A(bufoff, gbase, h, usenext) do { if constexpr (Sched::GATHER) { unsigned vo_[2]; \
        vo_[0] = (usenext) ? ((h) ? vn1[0] : vn0[0]) : ((h) ? va1[0] : va0[0]); vo_[1] = (usenext) ? ((h) ? vn1[1] : vn0[1]) : ((h) ? va1[1] : va0[1]); PG8_STAGE(bufoff, gbase, vo_); } \
        else { PG8_STAGE(bufoff, (gbase) + ((h) ? hstep : (size_t)0), voffA); } } while (0)
#define PG8_LDA(dst, b, h) do { if constexpr (FP8) { _Pragma("unroll") for (int m = 0; m < 4; ++m) dst##8[m] = cat8(*(const PG8_LAS bf16x8*)(lds + PG8_SA(b, h) + aoff + m * 2048), *(const PG8_LAS bf16x8*)(lds + PG8_SA(b, h) + aoff + m * 2048 + 1024)); } else { \
        _Pragma("unroll") for (int m = 0; m < 4; ++m) _Pragma("unroll") for (int k = 0; k < 2; ++k) dst[m][k] = *(const PG8_LAS bf16x8*)(lds + PG8_SA(b, h) + aoff + m * 2048 + k * 1024); } } while (0)
#define PG8_LDB(dst, b, h) do { if constexpr (FP8) { _Pragma("unroll") for (int n = 0; n < 2; ++n) dst##8[n] = cat8(*(const PG8_LAS bf16x8*)(lds + PG8_SB(b, h) + boff + n * 2048), *(const PG8_LAS bf16x8*)(lds + PG8_SB(b, h) + boff + n * 2048 + 1024)); } else { \
        _Pragma("unroll") for (int n = 0; n < 2; ++n) _Pragma("unroll") for (int k = 0; k < 2; ++k) dst[n][k] = *(const PG8_LAS bf16x8*)(lds + PG8_SB(b, h) + boff + n * 2048 + k * 1024); } } while (0)
#define PG8_MMA(ai, bj, At, Bt) do { __builtin_amdgcn_s_setprio(1); if constexpr (FP8) { _Pragma("unroll") for (int m = 0; m < 4; ++m) _Pragma("unroll") for (int n = 0; n < 2; ++n) \
        mfma_f8_inplace(acc[ai][bj][m][n], Bt##8[n], At##8[m], 0x7f7f7f7f); } else { \
        _Pragma("unroll") for (int m = 0; m < 4; ++m) _Pragma("unroll") for (int n = 0; n < 2; ++n) _Pragma("unroll") for (int k = 0; k < 2; ++k) \
        acc[ai][bj][m][n] = __builtin_amdgcn_mfma_f32_16x16x32_bf16(Bt[n][k], At[m][k], acc[ai][bj][m][n], 0, 0, 0); } __builtin_amdgcn_s_setprio(0); } while (0)
#define PG8_WAIT_V(n) asm volatile("s_waitcnt vmcnt(" #n ")" ::: "memory")
#define PG8_WAIT_L(n) asm volatile("s_waitcnt lgkmcnt(" #n ")" ::: "memory")
#define PG8_BAR __builtin_amdgcn_s_barrier()
#define PG8_SCHED __builtin_amdgcn_sched_barrier(0)
    Unit cur, nxt; int ui = 0;
    if (!S.next(0, cur)) return;
    f32x4 acc[2][2][4][2];
#pragma unroll
    for (int a = 0; a < 2; ++a)
#pragma unroll
        for (int b = 0; b < 2; ++b)
#pragma unroll
            for (int m = 0; m < 4; ++m)
#pragma unroll
                for (int n = 0; n < 2; ++n) acc[a][b][m][n] = (f32x4){0.f, 0.f, 0.f, 0.f};
    bf16x8 At[4][2], B0[2][2], B1[2][2]; v8i32 At8[4], B08[2], B18[2];
    const char* cA; const char* cB; S.bases(cur, cA, cB);
    if constexpr (Sched::GATHER) {
#pragma unroll
        for (int i = 0; i < 2; ++i) { va0[i] = S.gather_off(cur, gR[i], gC[i]); va1[i] = S.gather_off(cur, gR[i] + HALF, gC[i]); } }
    S.a_ready(cur);
    if constexpr (SP2) {
        PG8_STAGE(PG8_SB(0, 0), cB, voffB); PG8_STAGE(PG8_SB(0, 1), cB + hstep, voffB); PG8_STAGE_A(PG8_SA(0, 0), cA, 0, false); PG8_STAGE_A(PG8_SA(0, 1), cA, 1, false);
        if (wr == 1) PG8_BAR;
        PG8_WAIT_V(2); PG8_BAR;
        PG8_STAGE(PG8_SB(1, 0), cB + kstep, voffB); PG8_STAGE_A(PG8_SA(1, 0), cA + kstep, 0, false); PG8_STAGE(PG8_SB(1, 1), cB + hstep + kstep, voffB);
        PG8_WAIT_V(6); PG8_BAR;
    } else {
        PG8_STAGE(PG8_SB(0, 0), cB, voffB); PG8_STAGE_A(PG8_SA(0, 0), cA, 0, false); PG8_STAGE(PG8_SB(0, 1), cB + hstep, voffB); PG8_STAGE_A(PG8_SA(0, 1), cA, 1, false);
        if (wr == 1) PG8_BAR;
        PG8_WAIT_V(4); PG8_BAR;
        PG8_STAGE(PG8_SB(1, 0), cB + kstep, voffB); PG8_STAGE_A(PG8_SA(1, 0), cA + kstep, 0, false); PG8_STAGE(PG8_SB(1, 1), cB + hstep + kstep, voffB);
        PG8_WAIT_V(6); PG8_BAR;
    }
    for (;;) {
        const bool has_next = S.next(ui + 1, nxt);
        const char* nA = cA; const char* nB = cB; if (has_next) S.bases(nxt, nA, nB);
        if constexpr (Sched::GATHER) { if (has_next) {
#pragma unroll
            for (int i = 0; i < 2; ++i) { vn0[i] = S.gather_off(nxt, gR[i], gC[i]); vn1[i] = S.gather_off(nxt, gR[i] + HALF, gC[i]); } }
            else {
#pragma unroll
            for (int i = 0; i < 2; ++i) { vn0[i] = va0[i]; vn1[i] = va1[i]; } } }
#pragma unroll 1
        for (int t = 0; t < nt; t += 2) {
            const bool last = (t == nt - 2);
            const char* a1 = cA + (size_t)(t + 1) * kstep;
            const char* a2 = last ? nA : cA + (size_t)(t + 2) * kstep; const char* b2 = last ? nB : cB + (size_t)(t + 2) * kstep;
            const char* a3 = a2 + kstep; const char* b3 = b2 + kstep;
            if (last && has_next) S.a_ready(nxt);
            if constexpr (SP2) {
            PG8_LDB(B0, 0, 0); PG8_LDB(B1, 0, 1); PG8_SCHED; PG8_LDA(At, 0, 0); PG8_STAGE_A(PG8_SA(1, 1), a1, 1, false);
            PG8_WAIT_V(8); PG8_WAIT_L(0); PG8_BAR; PG8_MMA(0, 0, At, B0); PG8_MMA(0, 1, At, B1); PG8_BAR; PG8_SCHED;
            PG8_LDA(At, 0, 1); PG8_STAGE(PG8_SB(0, 0), b2, voffB); PG8_STAGE(PG8_SB(0, 1), b2 + hstep, voffB); PG8_STAGE_A(PG8_SA(0, 0), a2, 0, last);
            PG8_WAIT_V(8); PG8_WAIT_L(0); PG8_BAR; PG8_MMA(1, 0, At, B0); PG8_MMA(1, 1, At, B1); PG8_BAR; PG8_SCHED;
            PG8_LDB(B0, 1, 0); PG8_LDB(B1, 1, 1); PG8_SCHED; PG8_LDA(At, 1, 0); PG8_STAGE_A(PG8_SA(0, 1), a2, 1, last);
            PG8_WAIT_V(8); PG8_WAIT_L(0); PG8_BAR; PG8_MMA(0, 0, At, B0); PG8_MMA(0, 1, At, B1); PG8_BAR; PG8_SCHED;
            PG8_LDA(At, 1, 1); PG8_STAGE(PG8_SB(1, 0), b3, voffB); PG8_STAGE(PG8_SB(1, 1), b3 + hstep, voffB); PG8_STAGE_A(PG8_SA(1, 0), a3, 0, last);
            PG8_WAIT_V(8); PG8_WAIT_L(0); PG8_BAR; PG8_MMA(1, 0, At, B0); PG8_MMA(1, 1, At, B1); PG8_BAR; PG8_SCHED;
            } else {
            PG8_LDB(B0, 0, 0); PG8_SCHED; PG8_LDA(At, 0, 0); PG8_STAGE_A(PG8_SA(1, 1), a1, 1, false);
            PG8_WAIT_L(8); PG8_BAR; PG8_WAIT_L(0); PG8_MMA(0, 0, At, B0); PG8_BAR; PG8_SCHED;
            PG8_LDB(B1, 0, 1); PG8_STAGE(PG8_SB(0, 0), b2, voffB);
            PG8_BAR; PG8_WAIT_L(0); PG8_MMA(0, 1, At, B1); PG8_BAR;
            PG8_LDA(At, 0, 1); PG8_STAGE_A(PG8_SA(0, 0), a2, 0, last);
            PG8_BAR; PG8_WAIT_L(0); PG8_MMA(1, 0, At, B0); PG8_BAR; PG8_SCHED;
            PG8_STAGE(PG8_SB(0, 1), b2 + hstep, voffB);
            PG8_WAIT_V(6); PG8_BAR; PG8_MMA(1, 1, At, B1); PG8_BAR;
            PG8_LDB(B0, 1, 0); PG8_SCHED; PG8_LDA(At, 1, 0); PG8_STAGE_A(PG8_SA(0, 1), a2, 1, last);
            PG8_WAIT_L(8); PG8_BAR; PG8_WAIT_L(0); PG8_MMA(0, 0, At, B0); PG8_BAR; PG8_SCHED;
            PG8_LDB(B1, 1, 1); PG8_STAGE(PG8_SB(1, 0), b3, voffB);
            PG8_BAR; PG8_WAIT_L(0); PG8_MMA(0, 1, At, B1); PG8_BAR;
            PG8_LDA(At, 1, 1); PG8_STAGE_A(PG8_SA(1, 0), a3, 0, last);
            PG8_BAR; PG8_WAIT_L(0); PG8_MMA(1, 0, At, B0); PG8_BAR; PG8_SCHED;
            PG8_STAGE(PG8_SB(1, 1), b3 + hstep, voffB);
            PG8_WAIT_V(6); PG8_BAR; PG8_MMA(1, 1, At, B1); PG8_BAR;
            }
        }
        if constexpr (FP8) asm volatile("s_nop 15\n\ts_nop 15" ::: "memory");
        if constexpr (ALIGN_EPI) { if (wr == 0) PG8_BAR; }
        if constexpr (!Epi::AFTER_DRAIN) { int le_; asm volatile("v_mbcnt_lo_u32_b32 %0, -1, 0\n\tv_mbcnt_hi_u32_b32 %0, -1, %0" : "=v"(le_));
            E(acc, cur, wr, wc, le_ & 15, le_ >> 4); S.done(cur); }
        if (!has_next) break;
        if (!S.keep_acc(nxt)) {
#pragma unroll
        for (int a = 0; a < 2; ++a)
#pragma unroll
            for (int b = 0; b < 2; ++b)
#pragma unroll
                for (int m = 0; m < 4; ++m)
#pragma unroll
                    for (int n = 0; n < 2; ++n) acc[a][b][m][n] = (f32x4){0.f, 0.f, 0.f, 0.f};
        }
        cur = nxt; cA = nA; cB = nB; ++ui;
        if constexpr (Sched::GATHER) {
#pragma unroll
            for (int i = 0; i < 2; ++i) { va0[i] = vn0[i]; va1[i] = vn1[i]; } }
        if constexpr (ALIGN_EPI) { if (wr == 1) PG8_BAR; }
    }
    PG8_WAIT_V(0);
    if constexpr (!ALIGN_EPI) { if (wr == 0) PG8_BAR; }
    PG8_BAR;
    if constexpr (Epi::AFTER_DRAIN) { E.fused(acc, cur, wr, wc, fr, fq, lds, wid, lane); S.done(cur); }
#undef PG8_SA
#undef PG8_SB
#undef PG8_STAGE
#undef PG8_STAGE_A
#undef PG8_LDA
#undef PG8_LDB
#undef PG8_MMA
#undef PG8_WAIT_V
#undef PG8_WAIT_L
#undef PG8_BAR
#undef PG8_SCHED
}
}


namespace attn {
using bf16 = __hip_bfloat16;
constexpr int   D = 128, NW = 8, QBLK = 32, KVBLK = 64;
constexpr float SCALE = 0.088388347648318440f;
constexpr float THR = 8.f;
constexpr int SDEPTH = 2;
constexpr int LDQ = 512, LDK = 256, LDO = 512;
constexpr size_t SHM_V = KVBLK * D * 2, SHM_K = KVBLK * D * 2, SHM_ATTN = 2 * SHM_V + 2 * SHM_K + NW * 64 * 4;
using bf16x8 = __attribute__((ext_vector_type(8))) short;
using s16x4  = __attribute__((ext_vector_type(4))) short;
using f32x16 = __attribute__((ext_vector_type(16))) float;
using f32x8  = __attribute__((ext_vector_type(8))) float;
using u32x4  = __attribute__((ext_vector_type(4))) unsigned;
#define KSWZ(row, colB) ((row) * 256 + ((colB) ^ (((row) & 7) << 4)))
#define SBAR() __builtin_amdgcn_sched_barrier(0)
__device__ __forceinline__ int crow(int r, int hi) { return (r & 3) + 8 * (r >> 2) + 4 * hi; }
typedef float f32x2_t __attribute__((ext_vector_type(2))); typedef __bf16 bf16x2_t __attribute__((ext_vector_type(2)));
__device__ __forceinline__ unsigned cvtpk(float lo, float hi) { f32x2_t v = {lo, hi}; bf16x2_t b = __builtin_convertvector(v, bf16x2_t); return __builtin_bit_cast(unsigned, b); }
template <typename TIn> struct Stage;
template <> struct Stage<bf16>  { using T = bf16x8;
  __device__ static __forceinline__ T ld8(const bf16* p) { return *reinterpret_cast<const bf16x8*>(p); }
  __device__ static __forceinline__ bf16x8 tobf(T x) { return x; } };
template <> struct Stage<float> { using T = f32x8;
  __device__ static __forceinline__ T ld8(const float* p) { return *reinterpret_cast<const f32x8*>(p); }
  __device__ static __forceinline__ bf16x8 tobf(T x) {
    u32x4 w = {cvtpk(x[0], x[1]), cvtpk(x[2], x[3]), cvtpk(x[4], x[5]), cvtpk(x[6], x[7])}; return *reinterpret_cast<bf16x8*>(&w); } };

__device__ __forceinline__ void partialSM(f32x16& p0, f32x16& p1, float& m_reg, float& mn, float& alpha) {
  constexpr float C = SCALE * 1.4426950408889634f;
  float pmax = p0[0]; for (int r = 1; r < 16; ++r) pmax = fmaxf(pmax, p0[r]); for (int r = 0; r < 16; ++r) pmax = fmaxf(pmax, p1[r]);
  { auto rr = __builtin_amdgcn_permlane32_swap(__float_as_uint(pmax), __float_as_uint(pmax), false, false);
    pmax = fmaxf(__uint_as_float(rr[0]), __uint_as_float(rr[1])); }
  if (__builtin_expect(__all(pmax - m_reg <= THR / SCALE), 1)) { mn = m_reg; alpha = 1.f; }
  else { mn = fmaxf(m_reg, pmax); alpha = __builtin_amdgcn_exp2f((m_reg - mn) * C); m_reg = mn; }
  float mnC = -mn * C;
  for (int r = 0; r < 16; ++r) p0[r] = fmaf(p0[r], C, mnC); for (int r = 0; r < 16; ++r) p1[r] = fmaf(p1[r], C, mnC);
  for (int r = 0; r < 16; ++r) p0[r] = __builtin_amdgcn_exp2f(p0[r]);
}
__device__ __forceinline__ void finishSM(f32x16& p0, f32x16& p1, float alpha, float& l_reg, bf16x8& pa0, bf16x8& pa1, bf16x8& pa2, bf16x8& pa3) {
  for (int r = 0; r < 16; ++r) p1[r] = __builtin_amdgcn_exp2f(p1[r]);
  float ps = 0; for (int r = 0; r < 16; ++r) ps += p0[r]; for (int r = 0; r < 16; ++r) ps += p1[r];
  { auto rr = __builtin_amdgcn_permlane32_swap(__float_as_uint(ps), __float_as_uint(ps), false, false);
    ps = __uint_as_float(rr[0]) + __uint_as_float(rr[1]); }
  l_reg = l_reg * alpha + ps;
#define PK4(P, BASE, OUT) do { unsigned a0 = cvtpk(P[BASE + 0], P[BASE + 1]), a1 = cvtpk(P[BASE + 2], P[BASE + 3]);   \
    unsigned b0 = cvtpk(P[BASE + 4], P[BASE + 5]), b1 = cvtpk(P[BASE + 6], P[BASE + 7]);                              \
    auto r0 = __builtin_amdgcn_permlane32_swap(a0, b0, false, false); auto r1 = __builtin_amdgcn_permlane32_swap(a1, b1, false, false); \
    u32x4 w = {r0[0], r1[0], r0[1], r1[1]}; OUT = *reinterpret_cast<bf16x8*>(&w); } while (0)
  PK4(p0, 0, pa0); PK4(p0, 8, pa1); PK4(p1, 0, pa2); PK4(p1, 8, pa3);
#undef PK4
}
__device__ __forceinline__ void qkt(f32x16& p0, f32x16& p1, const bf16* Ks, const bf16x8* qr, int r32, int hi) {
  p0 = f32x16{}; p1 = f32x16{};
  for (int d0 = 0; d0 < 8; ++d0) { int cb = (d0 * 16 + hi * 8) * 2;
    bf16x8 b0 = *reinterpret_cast<const bf16x8*>((const char*)Ks + KSWZ(r32, cb));
    bf16x8 b1 = *reinterpret_cast<const bf16x8*>((const char*)Ks + KSWZ(32 + r32, cb));
    p0 = __builtin_amdgcn_mfma_f32_32x32x16_bf16(b0, qr[d0], p0, 0, 0, 0);
    p1 = __builtin_amdgcn_mfma_f32_32x32x16_bf16(b1, qr[d0], p1, 0, 0, 0); }
}
__device__ __forceinline__ int v_st(int k, int c) { const int kk = (k & ~0xC) | ((k & 4) << 1) | ((k & 8) >> 1); return ((kk >> 3) * 4 + (c >> 5)) * 512 + ((kk & 7) * 32 + (c & 31)) * 2; }
__device__ __forceinline__ int v_rd_base(int lane) { return ((lane & 3) << 3) | (((lane >> 2) & 3) << 6) | (((lane >> 4) & 1) << 5) | (((lane >> 5) & 1) << 8); }
constexpr int v_rd_off(int d0, int ks, int half) { return d0 * 512 + ks * 4096 + half * 2048; }
template <int OFF> __device__ __forceinline__ s16x4 tr_read(int vb) {
  s16x4 r; asm volatile("ds_read_b64_tr_b16 %0, %1 offset:%2" : "=&v"(r) : "v"(vb), "i"(OFF) : "memory"); return r;
}
template <int D0> __device__ __forceinline__ void pv_one(f32x16& od, int vb, bf16x8 pa0, bf16x8 pa1, bf16x8 pa2, bf16x8 pa3) {
  const s16x4 l0 = tr_read<v_rd_off(D0, 0, 0)>(vb), h0 = tr_read<v_rd_off(D0, 0, 1)>(vb), l1 = tr_read<v_rd_off(D0, 1, 0)>(vb), h1 = tr_read<v_rd_off(D0, 1, 1)>(vb);
  const s16x4 l2 = tr_read<v_rd_off(D0, 2, 0)>(vb), h2 = tr_read<v_rd_off(D0, 2, 1)>(vb), l3 = tr_read<v_rd_off(D0, 3, 0)>(vb), h3 = tr_read<v_rd_off(D0, 3, 1)>(vb);
  asm volatile("s_waitcnt lgkmcnt(0)" ::: "memory"); SBAR();
#define PK(L, H) (bf16x8){L[0], L[1], L[2], L[3], H[0], H[1], H[2], H[3]}
  od = __builtin_amdgcn_mfma_f32_32x32x16_bf16(pa0, PK(l0, h0), od, 0, 0, 0);
  od = __builtin_amdgcn_mfma_f32_32x32x16_bf16(pa1, PK(l1, h1), od, 0, 0, 0);
  od = __builtin_amdgcn_mfma_f32_32x32x16_bf16(pa2, PK(l2, h2), od, 0, 0, 0);
  od = __builtin_amdgcn_mfma_f32_32x32x16_bf16(pa3, PK(l3, h3), od, 0, 0, 0);
#undef PK
}
__device__ __forceinline__ void pv_d0(f32x16* o, int vb, bf16x8 pa0, bf16x8 pa1, bf16x8 pa2, bf16x8 pa3) {
  pv_one<0>(o[0], vb, pa0, pa1, pa2, pa3); pv_one<1>(o[1], vb, pa0, pa1, pa2, pa3); pv_one<2>(o[2], vb, pa0, pa1, pa2, pa3); pv_one<3>(o[3], vb, pa0, pa1, pa2, pa3);
}

template <typename TQ>
__device__ __forceinline__ void attn_dense_body(const TQ* __restrict__ Qb, const bf16* __restrict__ Kh, const bf16* __restrict__ Vh,
                                                bf16* __restrict__ Ob, int seq, char* lds, const int tid) {
  using St = Stage<bf16>; using SQ = Stage<TQ>;
  const int wid = tid >> 6, lane = tid & 63, r32 = lane & 31, hi = lane >> 5;
  bf16* V_lds = (bf16*)lds; bf16* K_lds = (bf16*)(lds + 2 * SHM_V);
  float* ws = (float*)(lds + 2 * SHM_V + 2 * SHM_K) + wid * 64; float* li_l = ws; float* al_l = ws + 32;
  float m_reg = -1e30f, l_reg = 0; f32x16 o[4] = {}; bf16x8 qr[8];
  const TQ* Qw = Qb + (long)(wid * QBLK + r32) * LDQ + hi * 8;
#pragma unroll
  for (int d0 = 0; d0 < 8; ++d0) qr[d0] = SQ::tobf(SQ::ld8(Qw + d0 * 16));
  const int sr = tid >> 4, sc = (tid & 15) * 8, vst0 = v_st(sr, sc), vst1 = v_st(32 + sr, sc);
  const int vb0 = (int)(uintptr_t)V_lds + v_rd_base(lane);
  struct { typename St::T vs0, vs1, ks0, ks1; } sr_[SDEPTH];
#define SLOAD(i, k0) do { sr_[i].vs0 = St::ld8(&Vh[(long)((k0) + sr) * LDK + sc]); sr_[i].vs1 = St::ld8(&Vh[(long)((k0) + 32 + sr) * LDK + sc]); \
    sr_[i].ks0 = St::ld8(&Kh[(long)((k0) + sr) * LDK + sc]); sr_[i].ks1 = St::ld8(&Kh[(long)((k0) + 32 + sr) * LDK + sc]); } while (0)
#define SWRITE(b, i) do { *(bf16x8*)((char*)V_lds + (b) * SHM_V + vst0) = St::tobf(sr_[i].vs0);          \
    *(bf16x8*)((char*)V_lds + (b) * SHM_V + vst1) = St::tobf(sr_[i].vs1); int kc = sc * 2;               \
    *(bf16x8*)((char*)K_lds + (b) * SHM_K + KSWZ(sr, kc)) = St::tobf(sr_[i].ks0);                       \
    *(bf16x8*)((char*)K_lds + (b) * SHM_K + KSWZ(32 + sr, kc)) = St::tobf(sr_[i].ks1); } while (0)
#define SWAIT() do { if constexpr (SDEPTH == 2) asm volatile("s_waitcnt vmcnt(4)" ::: "memory"); else asm volatile("s_waitcnt vmcnt(0)" ::: "memory"); } while (0)
#define RESC(a) do { if (__any((a) < 1.f)) { if (hi == 0) al_l[r32] = (a); asm volatile("s_waitcnt lgkmcnt(0)" ::: "memory"); \
    for (int d = 0; d < 4; ++d) for (int r = 0; r < 16; ++r) o[d][r] *= al_l[crow(r, hi)]; } } while (0)
  f32x16 pA0, pA1, pB0, pB1; float mnA, mnB, alA, alB; bf16x8 pa0, pa1, pa2, pa3; const int NT = seq / KVBLK;
  constexpr int SE = 0, SO = SDEPTH - 1;
  SLOAD(SE, 0); asm volatile("s_waitcnt vmcnt(0)" ::: "memory"); SWRITE(0, SE); __syncthreads();
  qkt(pA0, pA1, K_lds, qr, r32, hi); partialSM(pA0, pA1, m_reg, mnA, alA);
  SLOAD(SO, KVBLK); if constexpr (SDEPTH == 2) { if (2 < NT) SLOAD(SE, 2 * KVBLK); }
  SWAIT(); SWRITE(1, SO); __syncthreads();
  for (int j = 1; j + 1 < NT; j += 2) {
    SBAR(); qkt(pB0, pB1, (bf16*)((char*)K_lds + SHM_K), qr, r32, hi);
    finishSM(pA0, pA1, alA, l_reg, pa0, pa1, pa2, pa3); SBAR();
    SLOAD(SO, (j + SDEPTH) * KVBLK); SBAR();
    pv_d0(o, vb0, pa0, pa1, pa2, pa3); partialSM(pB0, pB1, m_reg, mnB, alB);
    __syncthreads(); SWAIT(); SWRITE(0, SE);
    RESC(alB); __syncthreads();
    SBAR(); qkt(pA0, pA1, K_lds, qr, r32, hi);
    finishSM(pB0, pB1, alB, l_reg, pa0, pa1, pa2, pa3); SBAR();
    if (SDEPTH == 1 || j + 3 < NT) SLOAD(SE, (j + 1 + SDEPTH) * KVBLK); SBAR();
    pv_d0(o, vb0 + (int)SHM_V, pa0, pa1, pa2, pa3); partialSM(pA0, pA1, m_reg, mnA, alA);
    __syncthreads(); SWAIT(); SWRITE(1, SO);
    RESC(alA); __syncthreads();
  }
  SBAR(); qkt(pB0, pB1, (bf16*)((char*)K_lds + SHM_K), qr, r32, hi);
  finishSM(pA0, pA1, alA, l_reg, pa0, pa1, pa2, pa3); SBAR();
  pv_d0(o, vb0, pa0, pa1, pa2, pa3); partialSM(pB0, pB1, m_reg, mnB, alB);
  __syncthreads(); RESC(alB);
  finishSM(pB0, pB1, alB, l_reg, pa0, pa1, pa2, pa3); SBAR();
  pv_d0(o, vb0 + (int)SHM_V, pa0, pa1, pa2, pa3);
  if (hi == 0) li_l[r32] = l_reg; asm volatile("s_waitcnt lgkmcnt(0)" ::: "memory");
  float rli[16];
#pragma unroll
  for (int r = 0; r < 16; ++r) rli[r] = __builtin_amdgcn_rcpf(li_l[crow(r, hi)]);
  bf16* Ow = Ob + (long)(wid * QBLK) * LDO;
#pragma unroll
  for (int r = 0; r < 16; ++r) { int orow = crow(r, hi);
    for (int d0 = 0; d0 < 4; ++d0) Ow[(long)orow * LDO + d0 * 32 + r32] = __float2bfloat16(o[d0][r] * rli[r]); }
#undef SLOAD
#undef SWRITE
#undef SWAIT
#undef RESC
}

constexpr float THR8 = 4.f;
using v8i = __attribute__((ext_vector_type(8))) int;
using v4i = __attribute__((ext_vector_type(4))) int;
__device__ __forceinline__ v8i cat8i(const v4i lo, const v4i hi) { return __builtin_shufflevector(lo, hi, 0, 1, 2, 3, 4, 5, 6, 7); }
__device__ __forceinline__ int pk4f8(float a, float b, float c, float d) { int w = 0; w = __builtin_amdgcn_cvt_pk_fp8_f32(a, b, w, false); w = __builtin_amdgcn_cvt_pk_fp8_f32(c, d, w, true); return w; }
__device__ __forceinline__ void partialSM8(f32x16& p0, f32x16& p1, float& m_reg, float& mn, float& alpha) {
  constexpr float C = SCALE * 1.4426950408889634f;
  float pmax = p0[0]; for (int r = 1; r < 16; ++r) pmax = fmaxf(pmax, p0[r]); for (int r = 0; r < 16; ++r) pmax = fmaxf(pmax, p1[r]);
  { auto rr = __builtin_amdgcn_permlane32_swap(__float_as_uint(pmax), __float_as_uint(pmax), false, false);
    pmax = fmaxf(__uint_as_float(rr[0]), __uint_as_float(rr[1])); }
  if (__builtin_expect(__all(pmax - m_reg <= THR8 / SCALE), 1)) { mn = m_reg; alpha = 1.f; }
  else { mn = fmaxf(m_reg, pmax); alpha = __builtin_amdgcn_exp2f((m_reg - mn) * C); m_reg = mn; }
  float mnC = -mn * C;
  for (int r = 0; r < 16; ++r) p0[r] = fmaf(p0[r], C, mnC); for (int r = 0; r < 16; ++r) p1[r] = fmaf(p1[r], C, mnC);
  for (int r = 0; r < 16; ++r) p0[r] = __builtin_amdgcn_exp2f(p0[r]);
}
__device__ __forceinline__ void finishSM8(f32x16& p0, f32x16& p1, float alpha, float& l_reg, v8i& pa) {
  for (int r = 0; r < 16; ++r) p1[r] = __builtin_amdgcn_exp2f(p1[r]);
  float ps = 0; for (int r = 0; r < 16; ++r) ps += p0[r]; for (int r = 0; r < 16; ++r) ps += p1[r];
  { auto rr = __builtin_amdgcn_permlane32_swap(__float_as_uint(ps), __float_as_uint(ps), false, false);
    ps = __uint_as_float(rr[0]) + __uint_as_float(rr[1]); }
  l_reg = l_reg * alpha + ps;
  pa[0] = pk4f8(p0[0], p0[1], p0[2], p0[3]);   pa[1] = pk4f8(p0[4], p0[5], p0[6], p0[7]);   pa[2] = pk4f8(p0[8], p0[9], p0[10], p0[11]); pa[3] = pk4f8(p0[12], p0[13], p0[14], p0[15]);
  pa[4] = pk4f8(p1[0], p1[1], p1[2], p1[3]);   pa[5] = pk4f8(p1[4], p1[5], p1[6], p1[7]);   pa[6] = pk4f8(p1[8], p1[9], p1[10], p1[11]); pa[7] = pk4f8(p1[12], p1[13], p1[14], p1[15]);
}
__device__ __forceinline__ void qkt8(f32x16& p0, f32x16& p1, const char* Ks, const v8i* qr8, int r32, int hi) {
  const int sw = r32 & 7; const char* k0 = Ks + r32 * 128; const char* k1 = Ks + (32 + r32) * 128;
#pragma unroll
  for (int s = 0; s < 2; ++s) { const int c0 = 4 * s + 2 * hi;
    const v8i a0 = cat8i(*(const v4i*)(k0 + ((c0 ^ sw) << 4)), *(const v4i*)(k0 + (((c0 + 1) ^ sw) << 4)));
    const v8i a1 = cat8i(*(const v4i*)(k1 + ((c0 ^ sw) << 4)), *(const v4i*)(k1 + (((c0 + 1) ^ sw) << 4)));
    if (s == 0) { p0 = __builtin_amdgcn_mfma_scale_f32_32x32x64_f8f6f4(a0, qr8[0], f32x16{}, 0, 0, 0, 0x7f7f7f7f, 0, 0x7f7f7f7f); p1 = __builtin_amdgcn_mfma_scale_f32_32x32x64_f8f6f4(a1, qr8[0], f32x16{}, 0, 0, 0, 0x7f7f7f7f, 0, 0x7f7f7f7f); }
    else { p0 = __builtin_amdgcn_mfma_scale_f32_32x32x64_f8f6f4(a0, qr8[1], p0, 0, 0, 0, 0x7f7f7f7f, 0, 0x7f7f7f7f); p1 = __builtin_amdgcn_mfma_scale_f32_32x32x64_f8f6f4(a1, qr8[1], p1, 0, 0, 0, 0x7f7f7f7f, 0, 0x7f7f7f7f); } }
}
__device__ __forceinline__ void pv8(f32x16* o, const char* Vs, const v8i pa, int r32, int hi) {
#pragma unroll
  for (int d0 = 0; d0 < 4; ++d0) { const int d = 32 * d0 + r32, sw = (d >> 2) & 3, c0 = 2 * hi; const char* vr = Vs + d * 64;
    const v8i b = cat8i(*(const v4i*)(vr + ((c0 ^ sw) << 4)), *(const v4i*)(vr + (((c0 + 1) ^ sw) << 4)));
    asm volatile("s_nop 4\n\tv_mfma_scale_f32_32x32x64_f8f6f4 %0, %1, %2, %0, %3, %3 op_sel_hi:[0,0,0]" : "+v"(o[d0]) : "v"(pa), "v"(b), "v"(0x7f7f7f7f)); }
}
__device__ __forceinline__ void attn8_body(const bf16* __restrict__ Qb, const unsigned char* __restrict__ K8h, const unsigned char* __restrict__ V8h,
                                           bf16* __restrict__ Ob, int seq, char* lds, const int tid) {
  const int wid = tid >> 6, lane = tid & 63, r32 = lane & 31, hi = lane >> 5;
  char* V_lds = lds; char* K_lds = lds + 16384;
  float* ws = (float*)(lds + 32768) + wid * 64; float* li_l = ws; float* al_l = ws + 32;
  float m_reg = -1e30f, l_reg = 0; f32x16 o[4] = {}; v8i qr8[2];
  { const bf16* Qw = Qb + (long)(wid * QBLK + r32) * LDQ + hi * 32;
#pragma unroll
    for (int s = 0; s < 2; ++s)
#pragma unroll
      for (int q = 0; q < 4; ++q) { const bf16x8 x = *reinterpret_cast<const bf16x8*>(Qw + s * 64 + q * 8); float f[8];
#pragma unroll
        for (int i = 0; i < 8; ++i) f[i] = __uint_as_float((unsigned)(unsigned short)x[i] << 16);
        qr8[s][2 * q] = pk4f8(f[0], f[1], f[2], f[3]); qr8[s][2 * q + 1] = pk4f8(f[4], f[5], f[6], f[7]); } }
  const int krow = tid >> 3, kch = tid & 7, kdst = krow * 128 + ((kch ^ (krow & 7)) << 4);
  struct { u32x4 k, v; } sr_[SDEPTH];
#define SLOAD(i, t) do { sr_[i].k = *reinterpret_cast<const u32x4*>(K8h + ((long)(t) * 64 + krow) * 128 + kch * 16); sr_[i].v = *reinterpret_cast<const u32x4*>(V8h + (long)(t) * 8192 + tid * 16); } while (0)
#define SWRITE(b, i) do { *(u32x4*)(K_lds + (b) * 8192 + kdst) = sr_[i].k; *(u32x4*)(V_lds + (b) * 8192 + tid * 16) = sr_[i].v; } while (0)
#define SWAIT() do { if constexpr (SDEPTH == 2) asm volatile("s_waitcnt vmcnt(2)" ::: "memory"); else asm volatile("s_waitcnt vmcnt(0)" ::: "memory"); } while (0)
#define RESC(a) do { if (__any((a) < 1.f)) { if (hi == 0) al_l[r32] = (a); asm volatile("s_nop 15\n\ts_nop 15\n\ts_waitcnt lgkmcnt(0)" ::: "memory"); \
    for (int d = 0; d < 4; ++d) for (int r = 0; r < 16; ++r) o[d][r] *= al_l[crow(r, hi)]; } } while (0)
  f32x16 pA0, pA1, pB0, pB1; float mnA, mnB, alA, alB; v8i pa; const int NT = seq / KVBLK;
  constexpr int SE = 0, SO = SDEPTH - 1;
  SLOAD(SE, 0); asm volatile("s_waitcnt vmcnt(0)" ::: "memory"); SWRITE(0, SE); __syncthreads();
  qkt8(pA0, pA1, K_lds, qr8, r32, hi); partialSM8(pA0, pA1, m_reg, mnA, alA);
  SLOAD(SO, 1); if constexpr (SDEPTH == 2) { if (2 < NT) SLOAD(SE, 2); }
  SWAIT(); SWRITE(1, SO); __syncthreads();
  for (int j = 1; j + 1 < NT; j += 2) {
    SBAR(); qkt8(pB0, pB1, K_lds + 8192, qr8, r32, hi);
    finishSM8(pA0, pA1, alA, l_reg, pa); SBAR();
    SLOAD(SO, j + SDEPTH); SBAR();
    pv8(o, V_lds, pa, r32, hi); partialSM8(pB0, pB1, m_reg, mnB, alB);
    __syncthreads(); SWAIT(); SWRITE(0, SE);
    RESC(alB); __syncthreads();
    SBAR(); qkt8(pA0, pA1, K_lds, qr8, r32, hi);
    finishSM8(pB0, pB1, alB, l_reg, pa); SBAR();
    if (SDEPTH == 1 || j + 3 < NT) SLOAD(SE, j + 1 + SDEPTH); SBAR();
    pv8(o, V_lds + 8192, pa, r32, hi); partialSM8(pA0, pA1, m_reg, mnA, alA);
    __syncthreads(); SWAIT(); SWRITE(1, SO);
    RESC(alA); __syncthreads();
  }
  SBAR(); qkt8(pB0, pB1, K_lds + 8192, qr8, r32, hi);
  finishSM8(pA0, pA1, alA, l_reg, pa); SBAR();
  pv8(o, V_lds, pa, r32, hi); partialSM8(pB0, pB1, m_reg, mnB, alB);
  __syncthreads(); RESC(alB);
  finishSM8(pB0, pB1, alB, l_reg, pa); SBAR();
  pv8(o, V_lds + 8192, pa, r32, hi);
  if (hi == 0) li_l[r32] = l_reg; asm volatile("s_nop 15\n\ts_nop 15\n\ts_waitcnt lgkmcnt(0)" ::: "memory");
  float rli[16];
#pragma unroll
  for (int r = 0; r < 16; ++r) rli[r] = __builtin_amdgcn_rcpf(li_l[crow(r, hi)]);
  bf16* Ow = Ob + (long)(wid * QBLK) * LDO;
#pragma unroll
  for (int r = 0; r < 16; ++r) { int orow = crow(r, hi);
    for (int d0 = 0; d0 < 4; ++d0) Ow[(long)orow * LDO + d0 * 32 + r32] = __float2bfloat16(o[d0][r] * rli[r]); }
#undef SLOAD
#undef SWRITE
#undef SWAIT
#undef RESC
}

#undef KSWZ
#undef SBAR
}
#define GAS __attribute__((address_space(1)))
#define LAS __attribute__((address_space(3)))
typedef unsigned short bf16;
typedef unsigned v4u __attribute__((ext_vector_type(4)));
typedef float f32x4 __attribute__((ext_vector_type(4)));
typedef short bf16x8 __attribute__((ext_vector_type(8)));
typedef GAS unsigned gu32;
typedef GAS unsigned long long gu64;
#define RLX_AGENT __ATOMIC_RELAXED, __HIP_MEMORY_SCOPE_AGENT
#define LDS_WAIT() asm volatile("s_waitcnt lgkmcnt(0)" ::: "memory")
#define VM_WAIT() asm volatile("s_waitcnt vmcnt(0)" ::: "memory")
__device__ __forceinline__ unsigned long long rt() { return __builtin_amdgcn_s_memrealtime(); }
__device__ __forceinline__ unsigned f2bf(float f) { unsigned u = __builtin_bit_cast(unsigned, f); return (u + 0x7fffu + ((u >> 16) & 1u)) >> 16; }
__device__ __forceinline__ unsigned pk2(float lo, float hi) { return f2bf(lo) | (f2bf(hi) << 16); }

#define XB_TMO      128
#define XB_XCNT(j)  (256  + 64 * (j))
#define XB_XSUB(j)  (1280 + 64 * (j))
#define XB_XGEN(j)  (2304 + 64 * (j))
#define XB_TOP      3328
#define XB_TOPGEN   3392
#define XCD_BAR_WORDS 3456
#define XB_SPIN_CAP (1u << 18)

__device__ __forceinline__ unsigned xb_ld(unsigned* p)              { return __hip_atomic_load(p, __ATOMIC_RELAXED, __HIP_MEMORY_SCOPE_AGENT); }
__device__ __forceinline__ unsigned xb_add(unsigned* p, unsigned v) { return __hip_atomic_fetch_add(p, v, __ATOMIC_RELAXED, __HIP_MEMORY_SCOPE_AGENT); }
__device__ __forceinline__ unsigned xb_xcc_id() { return (unsigned)__builtin_amdgcn_s_getreg((3 << 11) | 20) & 0xFu; }
#define XB_SPIN(cond, bar) do { unsigned _sp = 0; while (cond) { __builtin_amdgcn_s_sleep(1); \
    if ((++_sp & 255u) == 0u) { if (xb_ld(&(bar)[XB_TMO])) break; if (_sp > XB_SPIN_CAP) { atomicAdd(&(bar)[XB_TMO], 1u); break; } } } } while (0)

struct XcdBarrier {
    unsigned* bar; unsigned x;
    volatile LAS unsigned* st;
};

__device__ __forceinline__ XcdBarrier xcd_barrier_post(unsigned* bar, volatile LAS unsigned* st) {
    XcdBarrier b; b.bar = bar; b.x = xb_xcc_id(); b.st = st;
    if (threadIdx.x == 0) (void)xb_add(&bar[XB_XCNT(b.x)], 1u);
    return b;
}
__device__ __forceinline__ void xcd_barrier_complete(unsigned* bar, unsigned x, unsigned& nloc, unsigned& nx) {
    const unsigned G = gridDim.x * gridDim.y * gridDim.z;
    unsigned sum, cnt, mine, sp = 0u;
    for (;;) {
        sum = 0u; cnt = 0u; mine = 0u;
#pragma unroll
        for (unsigned j = 0; j < 16; ++j) { const unsigned c = xb_ld(&bar[XB_XCNT(j)]); sum += c; cnt += (c > 0u) ? 1u : 0u; mine = (j == x) ? c : mine; }
        if (sum == G) break;
        __builtin_amdgcn_s_sleep(1);
        if ((++sp & 255u) == 0u) { if (xb_ld(&bar[XB_TMO])) break; if (sp > XB_SPIN_CAP) { atomicAdd(&bar[XB_TMO], 1u); break; } }
    }
    nloc = mine > 0u ? mine : 1u; nx = cnt > 0u ? cnt : 1u;
}

__device__ __forceinline__ void xcd_barrier(const XcdBarrier& b, const int tid_) {
    asm volatile("s_waitcnt vmcnt(0)" ::: "memory");
    __syncthreads();
    if (tid_ == 0) {
        unsigned* bar = b.bar;
        __builtin_amdgcn_s_waitcnt(0);
        unsigned nloc = b.st[0], nx = b.st[1];
        if (nloc == 0u) { xcd_barrier_complete(bar, b.x, nloc, nx); b.st[0] = nloc; b.st[1] = nx; }
        const unsigned old = xb_add(&bar[XB_XSUB(b.x)], 1u);
        const unsigned gen = old / nloc;
        if (old + 1u == (gen + 1u) * nloc) {
            __builtin_amdgcn_fence(__ATOMIC_RELEASE, "agent");
            asm volatile("s_waitcnt vmcnt(0)" ::: "memory");
            const unsigned og = xb_add(&bar[XB_TOP], 1u);
            const unsigned tg = og / nx;
            if (og + 1u == (tg + 1u) * nx) xb_add(&bar[XB_TOPGEN], 1u);
            else XB_SPIN(xb_ld(&bar[XB_TOPGEN]) == tg, bar);
            __builtin_amdgcn_fence(__ATOMIC_ACQUIRE, "agent");
            xb_add(&bar[XB_XGEN(b.x)], 1u);
            asm volatile("s_waitcnt vmcnt(0)" ::: "memory");
        } else {
            XB_SPIN(xb_ld(&bar[XB_XGEN(b.x)]) == gen, bar);
            __builtin_amdgcn_fence(__ATOMIC_ACQUIRE, "agent");
            asm volatile("s_waitcnt vmcnt(0)" ::: "memory");
        }
    }
    __syncthreads();
}


constexpr size_t MiB = 1u << 20;
constexpr size_t WS_CTL = 0, CTL_ZERO_BYTES = 64 * 1024;
constexpr size_t WS_AFF = 1 * MiB;
constexpr size_t WS_COS = 2 * MiB, WS_SIN = 4 * MiB;
constexpr size_t WS_IDX = 6 * MiB, WS_GATE = 6 * MiB + 256 * 1024, WS_SEL = 7 * MiB;
constexpr size_t WS_WIN = 8 * MiB;
constexpr size_t WS_WR = 18 * MiB, WS_WA = 19 * MiB, WS_WO = 20 * MiB;
constexpr size_t WS_W1C = 22 * MiB;
constexpr size_t WS_WD = 198 * MiB;
constexpr size_t WS_X1 = 286 * MiB;
constexpr size_t WS_H = 350 * MiB;
constexpr size_t WS_RQ = 382 * MiB, WS_RK = 398 * MiB, WS_RV = 414 * MiB, WS_RGS = 430 * MiB;
constexpr size_t WS_AQ = 446 * MiB, WS_AK = 462 * MiB, WS_AV = 470 * MiB;
constexpr size_t WS_GRS = 478 * MiB, WS_GAS = 510 * MiB;
constexpr size_t WS_KV = 542 * MiB;
constexpr size_t WS_S = 606 * MiB;
constexpr size_t WS_YRIN = 638 * MiB, WS_ATT = 654 * MiB;
constexpr size_t WS_MIXED = 670 * MiB;
constexpr size_t WS_XE = 382 * MiB, WS_ACT = 446 * MiB, WS_Y = 622 * MiB;
constexpr size_t WS_K8 = 244 * MiB, WS_VT8 = 248 * MiB;
constexpr size_t WS_END = 704 * MiB;
static_assert(EP_COS == WS_COS && EP_SIN == WS_SIN && EP_RQ == WS_RQ && EP_RK == WS_RK && EP_RV == WS_RV && EP_RGS == WS_RGS && EP_AQ == WS_AQ && EP_AK == WS_AK && EP_AV == WS_AV && EP_GRS == WS_GRS && EP_GAS == WS_GAS, "epilogue offsets vs d_ws map");
constexpr int CW_BAR = 4096;

constexpr int RING_OFF = 0, RING_BYTES = 131072;
constexpr int LDSCTL_OFF = RING_BYTES, MISC_OFF = LDSCTL_OFF + 320;
constexpr int XCH_OFF = RING_BYTES + 1024;
constexpr int LDS_BYTES = 147456;
constexpr int NWAVES = 8;

__device__ __forceinline__ float wave_sum(float v) {
#pragma unroll
    for (int o = 1; o < 64; o <<= 1) v += __shfl_xor(v, o);
    return v;
}
__device__ __forceinline__ float bf2f(bf16 v) { return __uint_as_float((unsigned)v << 16); }

template <class CM>
__device__ __forceinline__ void transpose_item(const float* W, int K, int N, bf16* WT, const CM cm, LAS float* scr, int kb, int nb, int lane) {
    const int k0 = 64 * kb, n0 = 32 * nb;
    const int srccol = cm(n0 + (lane & 31));
    float tv[32];
#pragma unroll
    for (int i = 0; i < 32; ++i) tv[i] = __builtin_nontemporal_load(W + (size_t)(k0 + 2 * i + (lane >> 5)) * N + srccol);
#pragma unroll
    for (int i = 0; i < 32; ++i) scr[(2 * i + (lane >> 5)) * 33 + (lane & 31)] = tv[i];
    LDS_WAIT(); asm volatile("" ::: "memory");
    const int c = lane & 7;
#pragma unroll
    for (int j = 0; j < 4; ++j) { const int n = (lane >> 3) + 8 * j; const LAS float* s = scr + (8 * c) * 33 + n;
        v4u o; o.x = pk2(s[0 * 33], s[1 * 33]); o.y = pk2(s[2 * 33], s[3 * 33]); o.z = pk2(s[4 * 33], s[5 * 33]); o.w = pk2(s[6 * 33], s[7 * 33]);
        __builtin_nontemporal_store(o, (GAS v4u*)(WT + (size_t)(n0 + n) * K + k0 + 8 * c)); }
    LDS_WAIT(); asm volatile("" ::: "memory");
}
__device__ __forceinline__ unsigned pk4_fp8(float a, float b, float c, float d) { int w = 0; w = __builtin_amdgcn_cvt_pk_fp8_f32(a, b, w, false); w = __builtin_amdgcn_cvt_pk_fp8_f32(c, d, w, true); return (unsigned)w; }
template <class CM>
__device__ __forceinline__ void transpose_item_f8(const float* W, int K, int N, unsigned char* WT, const CM cm, LAS float* scr, int kb, int nb, int lane, float scale) {
    const int k0 = 64 * kb, n0 = 32 * nb;
    const int srccol = cm(n0 + (lane & 31));
    float tv[32];
#pragma unroll
    for (int i = 0; i < 32; ++i) tv[i] = __builtin_nontemporal_load(W + (size_t)(k0 + 2 * i + (lane >> 5)) * N + srccol);
#pragma unroll
    for (int i = 0; i < 32; ++i) scr[(2 * i + (lane >> 5)) * 33 + (lane & 31)] = tv[i];
    LDS_WAIT(); asm volatile("" ::: "memory");
    const int c = lane & 7;
#pragma unroll
    for (int j = 0; j < 4; ++j) { const int n = (lane >> 3) + 8 * j; const LAS float* sp = scr + (8 * c) * 33 + n;
        const unsigned lo = pk4_fp8(sp[0 * 33] * scale, sp[1 * 33] * scale, sp[2 * 33] * scale, sp[3 * 33] * scale), hi = pk4_fp8(sp[4 * 33] * scale, sp[5 * 33] * scale, sp[6 * 33] * scale, sp[7 * 33] * scale);
        __builtin_nontemporal_store((unsigned long long)lo | ((unsigned long long)hi << 32), (GAS unsigned long long*)(WT + (size_t)(n0 + n) * K + k0 + 8 * c)); }
    LDS_WAIT(); asm volatile("" ::: "memory");
}
struct CmId { __device__ __forceinline__ int operator()(int n) const { return n; } };
struct CmWin {
    __device__ __forceinline__ int operator()(int n) const {
        const bool rope = (n < 1024) || (n >= 2048 && n < 2816);
        const int L = n & 127, g = L >> 3, i = L & 7, o = (i < 4) ? (4 * g + i) : (64 + 4 * g + (i - 4));
        return rope ? ((n & ~127) + o) : n; }
};
struct CmW1 { __device__ __forceinline__ int operator()(int n) const { return 128 * (n >> 8) + (n & 127); } };

__device__ __forceinline__ void rms_row_to_bf16(const float* xrow, const float* gain, bf16* orow, int lane) {
    const GAS f32x4* xr = (const GAS f32x4*)xrow + lane; const GAS f32x4* gr = (const GAS f32x4*)gain + lane;
    f32x4 v[4]; float s = 0.f;
#pragma unroll
    for (int j = 0; j < 4; ++j) { v[j] = xr[64 * j]; s += (v[j].x * v[j].x + v[j].y * v[j].y) + (v[j].z * v[j].z + v[j].w * v[j].w); }
    const float rstd = 1.f / sqrtf(wave_sum(s) * (1.f / D_MODEL) + EPS);
    GAS unsigned long long* o8 = (GAS unsigned long long*)orow + lane;
#pragma unroll
    for (int j = 0; j < 4; ++j) { const f32x4 g4 = gr[64 * j]; o8[64 * j] = (unsigned long long)pk2(v[j].x * rstd * g4.x, v[j].y * rstd * g4.y) | ((unsigned long long)pk2(v[j].z * rstd * g4.z, v[j].w * rstd * g4.w) << 32); }
}


namespace ret {
typedef short bf16x8 __attribute__((ext_vector_type(8)));
typedef short v4i16 __attribute__((ext_vector_type(4)));
constexpr int PITCH = 272;
constexpr int TILE_B = 128 * PITCH;
constexpr int STRIP_B = 16 * PITCH;
__device__ __forceinline__ float lg2_of(const float* p, int h) { return log1pf(-expf(p[h])) * 1.4426950408889634f; }
__device__ __forceinline__ unsigned cvt2(float lo, float hi) { typedef float f2 __attribute__((ext_vector_type(2))); typedef __bf16 b2 __attribute__((ext_vector_type(2))); f2 v = {lo, hi}; b2 b = __builtin_convertvector(v, b2); return __builtin_bit_cast(unsigned, b); }
__device__ __forceinline__ bf16x8 frag_tr(LAS const unsigned char* tile, int k0, int n0, int lane) {
    const int g = lane >> 4, q = (lane >> 2) & 3, p = lane & 3;
    LAS const unsigned char* a = tile + (k0 + 8 * g + q) * PITCH + (n0 + 4 * p) * 2;
    const v4i16 lo = __builtin_amdgcn_ds_read_tr16_b64_v4i16((LAS v4i16*)a);
    const v4i16 hi = __builtin_amdgcn_ds_read_tr16_b64_v4i16((LAS v4i16*)(a + 4 * PITCH));
    return (bf16x8){lo[0], lo[1], lo[2], lo[3], hi[0], hi[1], hi[2], hi[3]};
}
__device__ __forceinline__ bf16x8 frag_row(LAS const unsigned char* tile, int r0, int k0, int lane) { return *(LAS const bf16x8*)(tile + (r0 + (lane & 15)) * PITCH + (k0 + 8 * (lane >> 4)) * 2); }
__device__ __forceinline__ void stage_tile(LAS unsigned char* tile, const bf16* src, long tok0, int h, int tid) {
#pragma unroll
    for (int i = 0; i < 4; ++i) { const int q = tid + 512 * i, row = q >> 4, ch = q & 15;
        const v4u v = *(const GAS v4u*)(src + (tok0 + row) * 512 + h * HD + ch * 8); *(LAS v4u*)(tile + row * PITCH + ch * 16) = v; }
}
__device__ __forceinline__ void kv_item(int item, LAS unsigned char* lds, const bf16* rk, const bf16* rv, const float* pf, const float* pb, float* kv, int tid) {
    asm volatile("" : "+v"(tid));
    const int c = item & 63, bh = item >> 6, b = bh >> 2, h = bh & 3, lane = tid & 63, w = tid >> 6, g = lane >> 4;
    const long tok0 = (long)b * SEQ + (long)c * CHUNK;
    LAS unsigned char* Kl = lds; LAS unsigned char* Vl = lds + TILE_B;
    stage_tile(Kl, rk, tok0, h, tid); stage_tile(Vl, rv, tok0, h, tid);
    __syncthreads();
    const float lf = lg2_of(pf, h), lb = lg2_of(pb, h);
    f32x4 accf[8], accb[8];
#pragma unroll
    for (int n = 0; n < 8; ++n) { accf[n] = (f32x4){0.f, 0.f, 0.f, 0.f}; accb[n] = (f32x4){0.f, 0.f, 0.f, 0.f}; }
#pragma unroll
    for (int kk = 0; kk < 4; ++kk) {
        const bf16x8 a = frag_tr(Vl, 32 * kk, 16 * w, lane);
        bf16x8 af, ab;
        { unsigned pf_[4], pb_[4];
#pragma unroll
          for (int t = 0; t < 8; t += 2) { const int j = 32 * kk + 8 * g + t;
              const float v0 = __uint_as_float((unsigned)(unsigned short)a[t] << 16), v1 = __uint_as_float((unsigned)(unsigned short)a[t + 1] << 16);
              pf_[t >> 1] = cvt2(v0 * __builtin_amdgcn_exp2f(lf * (float)(127 - j)), v1 * __builtin_amdgcn_exp2f(lf * (float)(126 - j)));
              pb_[t >> 1] = cvt2(v0 * __builtin_amdgcn_exp2f(lb * (float)j), v1 * __builtin_amdgcn_exp2f(lb * (float)(j + 1))); }
          const v4u wf_ = {pf_[0], pf_[1], pf_[2], pf_[3]}, wb_ = {pb_[0], pb_[1], pb_[2], pb_[3]};
          af = __builtin_bit_cast(bf16x8, wf_); ab = __builtin_bit_cast(bf16x8, wb_); }
#pragma unroll
        for (int n = 0; n < 8; ++n) { const bf16x8 bk = frag_tr(Kl, 32 * kk, 16 * n, lane);
            accf[n] = __builtin_amdgcn_mfma_f32_16x16x32_bf16(af, bk, accf[n], 0, 0, 0); accb[n] = __builtin_amdgcn_mfma_f32_16x16x32_bf16(ab, bk, accb[n], 0, 0, 0); }
    }
    float* of = kv + (((long)0 * 8 + bh) * NCHUNK + c) * (HD * HD); float* ob = kv + (((long)1 * 8 + bh) * NCHUNK + c) * (HD * HD);
#pragma unroll
    for (int n = 0; n < 8; ++n)
#pragma unroll
        for (int r = 0; r < 4; ++r) { const int o = (16 * w + 4 * g + r) * HD + 16 * n + (lane & 15); of[o] = accf[n][r]; ob[o] = accb[n][r]; }
    __syncthreads();
}
__device__ __forceinline__ void scan_thread(long gid, const float* pf, const float* pb, const float* kv, bf16* S) {
    const int el = (int)(gid & 16383), bh = (int)((gid >> 14) & 7), dir = (int)(gid >> 17), h = bh & 3;
    const float gC = __builtin_amdgcn_exp2f(lg2_of(dir ? pb : pf, h) * (float)CHUNK);
    const float* p = kv + (((long)dir * 8 + bh) * NCHUNK) * (HD * HD) + el; bf16* o = S + (((long)dir * 8 + bh) * NCHUNK) * (HD * HD) + el;
    float st = 0.f;
    if (dir == 0) {
#pragma unroll 8
        for (int c = 0; c < NCHUNK; ++c) { const float v = p[(long)c * HD * HD]; o[(long)c * HD * HD] = (bf16)f2bf(st); st = st * gC + v; } }
    else {
#pragma unroll 8
        for (int c = NCHUNK - 1; c >= 0; --c) { const float v = p[(long)c * HD * HD]; o[(long)c * HD * HD] = (bf16)f2bf(st); st = st * gC + v; } }
}
__device__ __forceinline__ void out_item(int item, LAS unsigned char* lds, const bf16* rq, const bf16* rk, const bf16* rv, const bf16* rgs, const float* pf, const float* pb,
                                         const bf16* S, const float* gain, bf16* yrin, int tid) {
    asm volatile("" : "+v"(tid));
    const int c = item & 63, bh = item >> 6, b = bh >> 2, h = bh & 3, lane = tid & 63, w = tid >> 6, g = lane >> 4, lc = lane & 15;
    const long tok0 = (long)b * SEQ + (long)c * CHUNK;
    LAS unsigned char* Kl = lds; LAS unsigned char* Vl = lds + TILE_B; LAS unsigned char* strip = lds + 2 * TILE_B + w * STRIP_B;
    stage_tile(Kl, rk, tok0, h, tid); stage_tile(Vl, rv, tok0, h, tid);
    bf16x8 qa[4];
#pragma unroll
    for (int kk = 0; kk < 4; ++kk) qa[kk] = *(const GAS bf16x8*)(rq + (tok0 + 16 * w + lc) * 512 + h * HD + 32 * kk + 8 * g);
    __syncthreads();
    const float lf = lg2_of(pf, h), lb = lg2_of(pb, h);
    {
        f32x4 sc[8];
#pragma unroll
        for (int n = 0; n < 8; ++n) { sc[n] = (f32x4){0.f, 0.f, 0.f, 0.f};
#pragma unroll
            for (int kk = 0; kk < 4; ++kk) sc[n] = __builtin_amdgcn_mfma_f32_16x16x32_bf16(qa[kk], frag_row(Kl, 16 * n, 32 * kk, lane), sc[n], 0, 0, 0); }
#pragma unroll
        for (int n = 0; n < 8; ++n)
#pragma unroll
            for (int r = 0; r < 4; ++r) { const int i = 16 * w + 4 * g + r, j = 16 * n + lc; const int df = i - j;
                const float dec = __builtin_amdgcn_exp2f(df >= 0 ? lf * (float)df : lb * (float)(-df));
                *(LAS unsigned short*)(strip + (4 * g + r) * PITCH + j * 2) = (unsigned short)f2bf(sc[n][r] * dec); }
    }
    asm volatile("s_waitcnt lgkmcnt(0)" ::: "memory");
    bf16x8 qf[4], qb[4];
    { const int ia = 16 * w + lc; const float cf = __builtin_amdgcn_exp2f(lf * (float)(ia + 1)), cb = __builtin_amdgcn_exp2f(lb * (float)(CHUNK - ia));
#pragma unroll
      for (int kk = 0; kk < 4; ++kk) { unsigned pf_[4], pb_[4];
#pragma unroll
          for (int t = 0; t < 8; t += 2) { const float v0 = __uint_as_float((unsigned)(unsigned short)qa[kk][t] << 16), v1 = __uint_as_float((unsigned)(unsigned short)qa[kk][t + 1] << 16);
              pf_[t >> 1] = cvt2(v0 * cf, v1 * cf); pb_[t >> 1] = cvt2(v0 * cb, v1 * cb); }
          const v4u wf_ = {pf_[0], pf_[1], pf_[2], pf_[3]}, wb_ = {pb_[0], pb_[1], pb_[2], pb_[3]};
          qf[kk] = __builtin_bit_cast(bf16x8, wf_); qb[kk] = __builtin_bit_cast(bf16x8, wb_); } }
    f32x4 o[8];
#pragma unroll
    for (int n = 0; n < 8; ++n) o[n] = (f32x4){0.f, 0.f, 0.f, 0.f};
    const bf16* Sf = S + (((long)0 * 8 + bh) * NCHUNK + c) * (HD * HD); const bf16* Sb = S + (((long)1 * 8 + bh) * NCHUNK + c) * (HD * HD);
#pragma unroll
    for (int kh = 0; kh < 2; ++kh) {
        bf16x8 bfv[2][8], bbv[2][8];
#pragma unroll
        for (int k2 = 0; k2 < 2; ++k2)
#pragma unroll
            for (int n = 0; n < 8; ++n) { const int kk = 2 * kh + k2; bfv[k2][n] = *(const GAS bf16x8*)(Sf + (16 * n + lc) * HD + 32 * kk + 8 * g); bbv[k2][n] = *(const GAS bf16x8*)(Sb + (16 * n + lc) * HD + 32 * kk + 8 * g); }
#pragma unroll
        for (int k2 = 0; k2 < 2; ++k2) { const int kk = 2 * kh + k2;
            const bf16x8 sa = frag_row(strip, 0, 32 * kk, lane);
#pragma unroll
            for (int n = 0; n < 8; ++n) {
                o[n] = __builtin_amdgcn_mfma_f32_16x16x32_bf16(sa, frag_tr(Vl, 32 * kk, 16 * n, lane), o[n], 0, 0, 0);
                o[n] = __builtin_amdgcn_mfma_f32_16x16x32_bf16(qf[kk], bfv[k2][n], o[n], 0, 0, 0); o[n] = __builtin_amdgcn_mfma_f32_16x16x32_bf16(qb[kk], bbv[k2][n], o[n], 0, 0, 0); } }
        asm volatile("" ::: "memory");
    }
    asm volatile("s_waitcnt lgkmcnt(0)" ::: "memory");
#pragma unroll
    for (int r = 0; r < 4; ++r) {
        float y[8]; float s = 0.f;
#pragma unroll
        for (int n = 0; n < 8; ++n) { y[n] = o[n][r]; s += y[n]; }
        s += __shfl_xor(s, 1); s += __shfl_xor(s, 2); s += __shfl_xor(s, 4); s += __shfl_xor(s, 8);
        const float mu = s * (1.0f / HD); float s2 = 0.f;
#pragma unroll
        for (int n = 0; n < 8; ++n) { y[n] -= mu; s2 += y[n] * y[n]; }
        s2 += __shfl_xor(s2, 1); s2 += __shfl_xor(s2, 2); s2 += __shfl_xor(s2, 4); s2 += __shfl_xor(s2, 8);
        const float rstd = 1.0f / sqrtf(s2 * (1.0f / HD) + EPS);
#pragma unroll
        for (int n = 0; n < 8; ++n) *(LAS unsigned short*)(strip + (4 * g + r) * PITCH + (16 * n + lc) * 2) = (unsigned short)f2bf(y[n] * rstd); }
    asm volatile("s_waitcnt lgkmcnt(0)" ::: "memory");
    { const int row = lane >> 2, qc = lane & 3; const long ro = (tok0 + 16 * w + row) * 512 + h * HD;
#pragma unroll
      for (int t = 0; t < 4; ++t) { const int e0 = 32 * qc + 8 * t;
          const v4u yv = *(LAS const v4u*)(strip + row * PITCH + e0 * 2);
          const f32x4 y0 = {__uint_as_float(yv.x << 16), __uint_as_float(yv.x & 0xffff0000u), __uint_as_float(yv.y << 16), __uint_as_float(yv.y & 0xffff0000u)};
          const f32x4 y1 = {__uint_as_float(yv.z << 16), __uint_as_float(yv.z & 0xffff0000u), __uint_as_float(yv.w << 16), __uint_as_float(yv.w & 0xffff0000u)};
          const f32x4 g0 = *(const GAS f32x4*)(gain + h * HD + e0), g1 = *(const GAS f32x4*)(gain + h * HD + e0 + 4);
          const v4u rg = *(const GAS v4u*)(rgs + ro + e0);
          const f32x4 r0 = {__uint_as_float(rg.x << 16), __uint_as_float(rg.x & 0xffff0000u), __uint_as_float(rg.y << 16), __uint_as_float(rg.y & 0xffff0000u)};
          const f32x4 r1 = {__uint_as_float(rg.z << 16), __uint_as_float(rg.z & 0xffff0000u), __uint_as_float(rg.w << 16), __uint_as_float(rg.w & 0xffff0000u)};
          const f32x4 a0 = y0 * g0 * r0, a1 = y1 * g1 * r1;
          v4u ov; ov.x = cvt2(a0[0], a0[1]); ov.y = cvt2(a0[2], a0[3]); ov.z = cvt2(a1[0], a1[1]); ov.w = cvt2(a1[2], a1[3]);
          *(GAS v4u*)(yrin + ro + e0) = ov; } }
    __syncthreads();
}
}

constexpr int W1_ITEMS = 16 * (16 * 176), W1_EARLY = (W1_ITEMS * MK_W1_EARLY_PCT) / 100;
struct Args { const float* in[17]; float* out; unsigned char* ws; int ph_lo, ph_hi; };
constexpr int PH_PROLOGUE = 0, PH_PROJ = 1, PH_RETKV = 2, PH_ATTN = 3, PH_RETOUT = 4, PH_BRANCH = 5, PH_WO = 6, PH_ROUTER = 7, PH_TOPK = 8, PH_GATHER = 9, PH_MOE1 = 10, PH_MOE2 = 11, PH_FINAL = 12, PH_END = 13;
#ifndef MK_EXPERT_CVT
#define MK_EXPERT_CVT 1
#endif

__global__ void __launch_bounds__(NWAVES * 64, 2) mega(Args args) {
    extern __shared__ __attribute__((aligned(16))) unsigned char lds_raw[];
    LAS unsigned char* lds = (LAS unsigned char*)lds_raw;
    volatile LAS unsigned* MISC = (volatile LAS unsigned*)(lds + MISC_OFF);
    const int wave = __builtin_amdgcn_readfirstlane((int)threadIdx.x >> 6);
#define PHASE_IDS int lane; asm volatile("v_mbcnt_lo_u32_b32 %0, -1, 0\n\tv_mbcnt_hi_u32_b32 %0, -1, %0" : "=v"(lane)); const int tid = wave * 64 + lane; (void)tid;
    const int G = gridDim.x; const int bx = blockIdx.x; const int vcu = (G % 8 == 0) ? (bx % 8) * (G / 8) + bx / 8 : bx;
    unsigned char* ws = args.ws;
    gu32* ctl = (gu32*)(ws + WS_CTL);
    for (int u = threadIdx.x; u < (LDS_BYTES - LDSCTL_OFF) / 4; u += NWAVES * 64) ((LAS unsigned*)(lds + LDSCTL_OFF))[u] = 0u;
    __syncthreads();
    const bool one_launch = (args.ph_hi - args.ph_lo) > 1;
    XcdBarrier bar; bar.bar = (unsigned*)(ctl + CW_BAR); bar.x = 0; bar.st = nullptr;
    if (one_launch) bar = xcd_barrier_post((unsigned*)(ctl + CW_BAR), MISC + 8);
    const int lo = args.ph_lo, hi = args.ph_hi;
#define IN(k) (lo <= (k) && (k) < hi)
#define SEAM(k) do { if (IN(k) && IN((k) + 1)) { PHASE_IDS xcd_barrier(bar, tid); } } while (0)
    const int gw = vcu * NWAVES + wave, NGW = G * NWAVES;

    if (IN(PH_PROLOGUE)) { PHASE_IDS
        LAS float* scr = (LAS float*)(lds + RING_OFF + wave * 16384);
        const float* w_in = args.in[2]; const float* w_ret = args.in[6]; const float* w_att = args.in[9]; const float* w_o = args.in[10];
        const float* wg = args.in[13]; const float* wu = args.in[14];
        constexpr int I_IN = 16 * 160, I_R = 8 * 32, I_A = 8 * 32, I_O = 16 * 32, I_1 = 16 * 176;
        constexpr int NSMALL = I_IN + I_R + I_A + I_O;
        const int NITEMS = NSMALL + W1_EARLY;
        for (int it = gw; it < NITEMS; it += NGW) {
            int r = it;
            if (r < I_IN) { transpose_item(w_in, 1024, INW, (bf16*)(ws + WS_WIN), CmWin(), scr, r / 160, r % 160, lane); continue; } r -= I_IN;
            if (r < I_R) { transpose_item(w_ret, 512, D_MODEL, (bf16*)(ws + WS_WR), CmId(), scr, r / 32, r % 32, lane); continue; } r -= I_R;
            if (r < I_A) { transpose_item(w_att, 512, D_MODEL, (bf16*)(ws + WS_WA), CmId(), scr, r / 32, r % 32, lane); continue; } r -= I_A;
            if (r < I_O) { transpose_item(w_o, 1024, D_MODEL, (bf16*)(ws + WS_WO), CmId(), scr, r / 32, r % 32, lane); continue; } r -= I_O;
            { const int e = r / I_1, q = r % I_1, kb = q / 176, nb = q % 176; const bool up = (nb >> 2) & 1;
                transpose_item_f8((up ? wu : wg) + (size_t)e * D_MODEL * FF, 1024, FF, (unsigned char*)(ws + WS_W1C) + (size_t)e * 5632 * 1024, CmW1(), scr, kb, nb, lane, W1_SCALE); }
        }
        for (int m = gw; m < T; m += NGW) rms_row_to_bf16(args.in[0] + (size_t)m * D_MODEL, args.in[1], (bf16*)(ws + WS_H) + (size_t)m * D_MODEL, lane);
        { float* ct = (float*)(ws + WS_COS); float* st = (float*)(ws + WS_SIN);
          for (int e = (vcu * NWAVES * 64) + tid; e < SEQ * 64; e += G * NWAVES * 64) { const int pos = e >> 6, j = e & 63;
              const float freq = powf(10000.0f, -(float)(j & 31) / 32.0f); const float ang = (float)(j < 32 ? (pos >> 6) : (pos & 63)) * freq;
              ct[e] = cosf(ang); st[e] = sinf(ang); } }
    }
    SEAM(PH_PROLOGUE);

    if (IN(PH_PROJ)) { PHASE_IDS
        pg8::PlainSched S; S.init(T, INW, G, bx); S.A = (const char*)(ws + WS_H); S.Bt = (const char*)(ws + WS_WIN); S.tstep = (size_t)256 * 1024 * 2;
        pg8::EpiProj E; E.wsb = ws; E.qn = args.in[7]; E.kn = args.in[8]; E.xch = (LAS float*)(lds + XCH_OFF); E.epoch = 0u;
        pg8::gemm_phase<pg8::EpiProj, pg8::PlainSched, true, true>(lds + RING_OFF, 1024, S, E, tid);
    }
    SEAM(PH_PROJ);

    if (IN(PH_RETKV)) { PHASE_IDS
        { const bf16* ak = (const bf16*)(ws + WS_AK); const bf16* av = (const bf16*)(ws + WS_AV); unsigned char* K8 = ws + WS_K8; unsigned char* Vt8 = ws + WS_VT8;
          for (int i = vcu * 512 + tid; i < T * 2 * 16; i += G * 512) { const int dg = i & 15, kvh = (i >> 4) & 1, t = i >> 5, b = t >> 13, tt = t & 8191;
              const v4u kx = *(const GAS v4u*)(ak + (size_t)t * 256 + kvh * 128 + dg * 8), vx = *(const GAS v4u*)(av + (size_t)t * 256 + kvh * 128 + dg * 8);
              float kf[8], vf[8];
              kf[0] = __uint_as_float(kx.x << 16); kf[1] = __uint_as_float(kx.x & 0xffff0000u); kf[2] = __uint_as_float(kx.y << 16); kf[3] = __uint_as_float(kx.y & 0xffff0000u);
              kf[4] = __uint_as_float(kx.z << 16); kf[5] = __uint_as_float(kx.z & 0xffff0000u); kf[6] = __uint_as_float(kx.w << 16); kf[7] = __uint_as_float(kx.w & 0xffff0000u);
              vf[0] = __uint_as_float(vx.x << 16); vf[1] = __uint_as_float(vx.x & 0xffff0000u); vf[2] = __uint_as_float(vx.y << 16); vf[3] = __uint_as_float(vx.y & 0xffff0000u);
              vf[4] = __uint_as_float(vx.z << 16); vf[5] = __uint_as_float(vx.z & 0xffff0000u); vf[6] = __uint_as_float(vx.w << 16); vf[7] = __uint_as_float(vx.w & 0xffff0000u);
              const size_t hb = (size_t)(b * 2 + kvh);
              *(GAS unsigned long long*)(K8 + (hb * 8192 + tt) * 128 + dg * 8) = (unsigned long long)pk4_fp8(kf[0], kf[1], kf[2], kf[3]) | ((unsigned long long)pk4_fp8(kf[4], kf[5], kf[6], kf[7]) << 32);
              const int key = tt & 63, jt = tt >> 6, kk = key & 31, khi = (kk >> 2) & 1, j = (kk & 3) + 4 * (kk >> 3) + 16 * (key >> 5);
              const unsigned v03 = pk4_fp8(vf[0], vf[1], vf[2], vf[3]), v47 = pk4_fp8(vf[4], vf[5], vf[6], vf[7]);
              unsigned char* vt = Vt8 + (hb * 128 + jt) * 8192 + (j & 15);
#pragma unroll
              for (int q = 0; q < 8; ++q) { const int d = dg * 8 + q; vt[d * 64 + (((2 * khi + (j >> 4)) ^ ((d >> 2) & 3)) << 4)] = (unsigned char)(((q < 4 ? v03 : v47) >> (8 * (q & 3))) & 0xffu); } } }
        for (int item = vcu; item < 8 * NCHUNK; item += G)
            ret::kv_item(item, lds + RING_OFF, (const bf16*)(ws + WS_RK), (const bf16*)(ws + WS_RV), args.in[3], args.in[4], (float*)(ws + WS_KV), tid);
    }
    SEAM(PH_RETKV);

    if (IN(PH_ATTN)) { PHASE_IDS
        for (long gid = (long)vcu * 512 + tid; gid < 2 * 8 * 16384; gid += (long)G * 512) ret::scan_thread(gid, args.in[3], args.in[4], (const float*)(ws + WS_KV), (bf16*)(ws + WS_S));
    }

    if (IN(PH_ATTN)) { PHASE_IDS
        for (int u = vcu; u < BATCH * 4 * (SEQ / 256); u += G) {
            const int bh = u >> 5, qb = u & 31, b = bh >> 2, h = bh & 3, kvh = h >> 1;
            const size_t q0 = ((size_t)b * SEQ + (size_t)qb * 256) * 512 + (size_t)h * 128, k0 = (size_t)b * SEQ * 256 + (size_t)kvh * 128;
            attn::attn8_body((const attn::bf16*)(ws + WS_AQ) + q0, ws + WS_K8 + (size_t)(b * 2 + kvh) * 8192 * 128, ws + WS_VT8 + (size_t)(b * 2 + kvh) * 128 * 8192,
                             (attn::bf16*)(ws + WS_ATT) + q0, SEQ, (char*)lds_raw, tid);
            __syncthreads();
        }
    }
    SEAM(PH_ATTN);

    if (IN(PH_RETOUT)) { PHASE_IDS
        for (int item = vcu; item < 8 * NCHUNK; item += G)
            ret::out_item(item, lds + RING_OFF, (const bf16*)(ws + WS_RQ), (const bf16*)(ws + WS_RK), (const bf16*)(ws + WS_RV), (const bf16*)(ws + WS_RGS), args.in[3], args.in[4],
                          (const bf16*)(ws + WS_S), args.in[5], (bf16*)(ws + WS_YRIN), tid);
    }
    SEAM(PH_RETOUT);

    if (IN(PH_BRANCH)) { PHASE_IDS
        pg8::BranchSched S; S.init(T, D_MODEL, G, bx); S.A0 = (const char*)(ws + WS_YRIN); S.A1 = (const char*)(ws + WS_ATT); S.B0 = (const char*)(ws + WS_WR); S.B1 = (const char*)(ws + WS_WA); S.tstep = (size_t)256 * 512 * 2;
        pg8::EpiBranch E; E.grs = (const bf16*)(ws + WS_GRS); E.gas = (const bf16*)(ws + WS_GAS); E.mixed = (bf16*)(ws + WS_MIXED);
        pg8::gemm_phase<pg8::EpiBranch, pg8::BranchSched, true, true>(lds + RING_OFF, 512, S, E, tid);
    }
    SEAM(PH_BRANCH);

    if (IN(PH_WO)) { PHASE_IDS
        pg8::PlainSched S; S.init(T, D_MODEL, G, bx); S.A = (const char*)(ws + WS_MIXED); S.Bt = (const char*)(ws + WS_WO); S.tstep = (size_t)256 * 1024 * 2;
        pg8::EpiResid E; E.x = args.in[0]; E.x1 = (float*)(ws + WS_X1);
        pg8::gemm_phase<pg8::EpiResid, pg8::PlainSched, true, true>(lds + RING_OFF, 1024, S, E, tid);
    }
    SEAM(PH_WO);

    if (IN(PH_ROUTER)) { PHASE_IDS
        LAS float* wl = (LAS float*)(lds + RING_OFF);
        { const GAS float* src = (const GAS float*)args.in[12]; for (int i = tid; i < 1024 * 16; i += NWAVES * 64) wl[(i & 15) * 1024 + (i >> 4)] = src[i]; }
        __syncthreads();
        const float* x1 = (const float*)(ws + WS_X1); const float* gain = args.in[11]; bf16* h2 = (bf16*)(ws + WS_H); float* aff = (float*)(ws + WS_AFF);
        if (wave >= 4) {
            LAS float* scr = (LAS float*)(lds + RING_OFF + 65536 + (wave - 4) * 16384); const float* wg = args.in[13]; const float* wu = args.in[14]; constexpr int I_1 = 16 * 176;
            for (int it = W1_EARLY + vcu * 4 + (wave - 4); it < W1_ITEMS; it += G * 4) { const int e = it / I_1, q = it % I_1, kb = q / 176, nb = q % 176; const bool up = (nb >> 2) & 1;
                transpose_item_f8((up ? wu : wg) + (size_t)e * D_MODEL * FF, 1024, FF, (unsigned char*)(ws + WS_W1C) + (size_t)e * 5632 * 1024, CmW1(), scr, kb, nb, lane, W1_SCALE); }
        } else {
        const int gw = vcu * 4 + wave, NGW = G * 4;
        const GAS f32x4* gr = (const GAS f32x4*)gain + lane;
        f32x4 v[4];
        if (gw < T) { const GAS f32x4* xr = (const GAS f32x4*)(x1 + (size_t)gw * D_MODEL) + lane;
#pragma unroll
            for (int j = 0; j < 4; ++j) v[j] = xr[64 * j]; }
        for (int m = gw; m < T; m += NGW) {
            f32x4 nv[4];
            { const int mn = (m + NGW < T) ? m + NGW : m; const GAS f32x4* xn = (const GAS f32x4*)(x1 + (size_t)mn * D_MODEL) + lane;
#pragma unroll
              for (int j = 0; j < 4; ++j) nv[j] = xn[64 * j]; }
            float s = 0.f;
#pragma unroll
            for (int j = 0; j < 4; ++j) s += (v[j].x * v[j].x + v[j].y * v[j].y) + (v[j].z * v[j].z + v[j].w * v[j].w);
            const float rstd = 1.f / sqrtf(wave_sum(s) * (1.f / D_MODEL) + EPS);
            float lg[NE];
#pragma unroll
            for (int e = 0; e < NE; ++e) lg[e] = 0.f;
            GAS unsigned* o4 = (GAS unsigned*)((unsigned char*)h2 + (size_t)m * D_MODEL) + lane;
#pragma unroll
            for (int j = 0; j < 4; ++j) { const f32x4 g4 = gr[64 * j]; const f32x4 hv = v[j] * g4 * rstd;
                o4[64 * j] = pk4_fp8(hv.x, hv.y, hv.z, hv.w);
#pragma unroll
                for (int e = 0; e < NE; ++e) { const f32x4 w = *(const LAS f32x4*)(wl + e * 1024 + 4 * lane + 256 * j); lg[e] += (hv.x * w.x + hv.y * w.y) + (hv.z * w.z + hv.w * w.w); if ((e & 3) == 3) asm volatile("" ::: "memory"); }
                asm volatile("" ::: "memory"); }
            float r8[8], r4[4], r2[2], r1;
            { const bool b = (lane & 32) != 0;
#pragma unroll
              for (int e = 0; e < 8; ++e) { const float keep = b ? lg[e + 8] : lg[e], send = b ? lg[e] : lg[e + 8]; r8[e] = keep + __shfl_xor(send, 32); } }
            { const bool b = (lane & 16) != 0;
#pragma unroll
              for (int e = 0; e < 4; ++e) { const float keep = b ? r8[e + 4] : r8[e], send = b ? r8[e] : r8[e + 4]; r4[e] = keep + __shfl_xor(send, 16); } }
            { const bool b = (lane & 8) != 0;
#pragma unroll
              for (int e = 0; e < 2; ++e) { const float keep = b ? r4[e + 2] : r4[e], send = b ? r4[e] : r4[e + 2]; r2[e] = keep + __shfl_xor(send, 8); } }
            { const bool b = (lane & 4) != 0; const float keep = b ? r2[1] : r2[0], send = b ? r2[0] : r2[1]; r1 = keep + __shfl_xor(send, 4); }
            r1 += __shfl_xor(r1, 2); r1 += __shfl_xor(r1, 1);
            float mx = r1; mx = fmaxf(mx, __shfl_xor(mx, 4)); mx = fmaxf(mx, __shfl_xor(mx, 8)); mx = fmaxf(mx, __shfl_xor(mx, 16)); mx = fmaxf(mx, __shfl_xor(mx, 32));
            const float pe = expf(r1 - mx); float den = pe; den += __shfl_xor(den, 4); den += __shfl_xor(den, 8); den += __shfl_xor(den, 16); den += __shfl_xor(den, 32);
            if ((lane & 3) == 0) aff[(size_t)m * NE + (((lane >> 5) & 1) * 8 + ((lane >> 4) & 1) * 4 + ((lane >> 3) & 1) * 2 + ((lane >> 2) & 1))] = pe / den;
#pragma unroll
            for (int j = 0; j < 4; ++j) v[j] = nv[j];
        }
        }
        __syncthreads();
    }
    SEAM(PH_ROUTER);

    if (IN(PH_TOPK)) { PHASE_IDS
        if (vcu >= NZ) {
            const int lane_c = lane;
            LAS float* scr = (LAS float*)(lds + RING_OFF + wave * 16384); const float* wd = args.in[15]; constexpr int I_D = 44 * 32;
            for (int it = (vcu - NZ) * NWAVES + wave; it < NE * I_D; it += (G - NZ) * NWAVES) { const int e = it / I_D, q = it % I_D;
                transpose_item_f8(wd + (size_t)e * FF * D_MODEL, FF, D_MODEL, (unsigned char*)(ws + WS_WD) + (size_t)e * 1024 * FF, CmId(), scr, q / 32, q % 32, lane_c, WD_SCALE); }
        }
        LAS unsigned* keys = (LAS unsigned*)(lds + RING_OFF); LAS int* hist = (LAS int*)(lds + RING_OFF + 32768); LAS int* sc = (LAS int*)(lds + RING_OFF + 34816); volatile LAS unsigned* sv = (volatile LAS unsigned*)(lds + RING_OFF + 36864);
        const float* aff = (const float*)(ws + WS_AFF); int* idx = (int*)(ws + WS_IDX); float* gate = (float*)(ws + WS_GATE); int* sel = (int*)(ws + WS_SEL);
        for (int z = vcu; z < NZ; z += G) {
            const int b = z / NE, e = z % NE;
            for (int i = tid; i < SEQ; i += 512) keys[i] = __float_as_uint(aff[((size_t)b * SEQ + i) * NE + e]);
            if (tid == 0) { sv[0] = 0u; sv[1] = (unsigned)CAP; }
            __syncthreads();
            unsigned mask = 0u;
            for (int pass = 3; pass >= 0; --pass) {
                const int shift = pass * 8;
                if (tid < 256) hist[tid] = 0;
                __syncthreads();
                const unsigned prefix = sv[0];
                for (int i = tid; i < SEQ; i += 512) { const unsigned k = keys[i]; if ((k & mask) == prefix) atomicAdd((int*)&hist[(k >> shift) & 255u], 1); }
                __syncthreads();
                if (tid < 64) {
                    const int krem = (int)sv[1]; const int h0 = hist[4 * tid], h1 = hist[4 * tid + 1], h2 = hist[4 * tid + 2], h3 = hist[4 * tid + 3];
                    int suf = h0 + h1 + h2 + h3;
#pragma unroll
                    for (int o = 1; o < 64; o <<= 1) { const int t = __shfl_down(suf, o); if (tid + o < 64) suf += t; }
                    int cum = suf - (h0 + h1 + h2 + h3);
                    int dsel = -1, cumsel = 0;
                    if (cum < krem && cum + h3 >= krem) { dsel = 3; cumsel = cum; } cum += h3;
                    if (dsel < 0 && cum < krem && cum + h2 >= krem) { dsel = 2; cumsel = cum; } cum += h2;
                    if (dsel < 0 && cum < krem && cum + h1 >= krem) { dsel = 1; cumsel = cum; } cum += h1;
                    if (dsel < 0 && cum < krem && cum + h0 >= krem) { dsel = 0; cumsel = cum; }
                    if (dsel >= 0) { sv[1] = (unsigned)(krem - cumsel); sv[0] = prefix | ((unsigned)(4 * tid + dsel) << shift); }
                }
                __syncthreads();
                mask |= 0xFFu << shift;
            }
            const unsigned Tk = sv[0]; const int krem = (int)sv[1];
            int cgt = 0, ceq = 0;
            for (int q = 0; q < 16; ++q) { const unsigned k = keys[tid * 16 + q]; cgt += (k > Tk); ceq += (k == Tk); }
            int eqbase, slot;
            { sc[tid] = ceq; __syncthreads(); for (int off = 1; off < 512; off <<= 1) { const int t = (tid >= off) ? sc[tid - off] : 0; __syncthreads(); sc[tid] += t; __syncthreads(); } eqbase = sc[tid] - ceq; __syncthreads(); }
            int take = krem - eqbase; take = take < 0 ? 0 : (take > ceq ? ceq : take);
            { const int v = cgt + take; sc[tid] = v; __syncthreads(); for (int off = 1; off < 512; off <<= 1) { const int t = (tid >= off) ? sc[tid - off] : 0; __syncthreads(); sc[tid] += t; __syncthreads(); } slot = sc[tid] - v; __syncthreads(); }
            int eqr = eqbase;
            for (int q = 0; q < 16; ++q) { const int i = tid * 16 + q; const unsigned k = keys[i]; bool tk = k > Tk; if (k == Tk) { tk = eqr < krem; ++eqr; }
                if (tk) { idx[z * CAP + slot] = i; gate[z * CAP + slot] = __uint_as_float(k); sel[((size_t)b * SEQ + i) * NE + e] = slot; ++slot; } else sel[((size_t)b * SEQ + i) * NE + e] = -1; }
            __syncthreads();
        }
    }
    SEAM(PH_TOPK);


    if (IN(PH_MOE1)) { PHASE_IDS
        pg8::MoeGatherSched S; S.init(NZ * CAP, 5632, G, bx); S.A = (const char*)(ws + WS_H); S.Bt = (const char*)(ws + WS_W1C); S.idx = (const int*)(ws + WS_IDX);
        pg8::EpiSwiglu E; E.act = (unsigned char*)(ws + WS_ACT); E.in_scale = 1.0f / W1_SCALE; E.act_scale = ACT_SCALE;
        pg8::gemm_phase<pg8::EpiSwiglu, pg8::MoeGatherSched, true, true, true>(lds + RING_OFF, 1024 / 2, S, E, tid);
    }
    SEAM(PH_MOE1);

    if (IN(PH_MOE2)) { PHASE_IDS
        pg8::MoeSched S; S.init(NZ * CAP, D_MODEL, G, bx); S.A = (const char*)(ws + WS_ACT); S.Bt = (const char*)(ws + WS_WD); S.kb = (size_t)FF; S.nper = 1024;
        pg8::EpiDown E; E.y = (bf16*)(ws + WS_Y); E.gate = (const float*)(ws + WS_GATE); E.out_scale = 1.0f / (WD_SCALE * ACT_SCALE);
        pg8::gemm_phase<pg8::EpiDown, pg8::MoeSched, true, true, true>(lds + RING_OFF, FF / 2, S, E, tid);
    }
    SEAM(PH_MOE2);

    if (IN(PH_FINAL)) { PHASE_IDS
        const float* x1 = (const float*)(ws + WS_X1); const int* sel = (const int*)(ws + WS_SEL); const bf16* y = (const bf16*)(ws + WS_Y); const float* gain = args.in[16];
        for (int m = gw; m < T; m += NGW) {
            const int b = m / SEQ;
            const GAS f32x4* xr = (const GAS f32x4*)(x1 + (size_t)m * D_MODEL) + lane; const GAS f32x4* gr = (const GAS f32x4*)gain + lane;
            f32x4 v[4];
#pragma unroll
            for (int j = 0; j < 4; ++j) v[j] = xr[64 * j];
            const int mysel = (lane < NE) ? sel[(size_t)m * NE + lane] : -1;
            for (int e = 0; e < NE; ++e) { const int sl = __builtin_amdgcn_readlane(mysel, e);
                if (sl >= 0) { const GAS unsigned long long* yr = (const GAS unsigned long long*)(y + ((size_t)(b * NE + e) * CAP + sl) * D_MODEL) + lane;
#pragma unroll
                    for (int j = 0; j < 4; ++j) { const unsigned long long w = yr[64 * j]; const unsigned lo = (unsigned)w, hi = (unsigned)(w >> 32);
                        v[j].x += __uint_as_float(lo << 16); v[j].y += __uint_as_float(lo & 0xffff0000u); v[j].z += __uint_as_float(hi << 16); v[j].w += __uint_as_float(hi & 0xffff0000u); } } }
            float s = 0.f;
#pragma unroll
            for (int j = 0; j < 4; ++j) s += (v[j].x * v[j].x + v[j].y * v[j].y) + (v[j].z * v[j].z + v[j].w * v[j].w);
            const float rstd = 1.f / sqrtf(wave_sum(s) * (1.f / D_MODEL) + EPS);
            GAS f32x4* o = (GAS f32x4*)(args.out + (size_t)m * D_MODEL) + lane;
#pragma unroll
            for (int j = 0; j < 4; ++j) { const f32x4 g4 = gr[64 * j]; o[64 * j] = v[j] * g4 * rstd; }
        }
    }
#undef IN
#undef SEAM
}

#ifndef MK_DUP
#define MK_DUP (-1)
#endif
#ifndef MK_ONE_LAUNCH
#define MK_ONE_LAUNCH 1
#endif
extern "C" void kernel_launch(void* const* d_in, const int* in_sizes, int n_in, void* d_out, int out_size, void* d_ws, size_t ws_size, hipStream_t stream) {
    static int grid = 0;
    if (grid == 0) {
        if (n_in != 17 || in_sizes[0] != T * D_MODEL || out_size != T * D_MODEL || ws_size < WS_END) { fprintf(stderr, "kernel_launch: shape/workspace mismatch (ws %zu need %zu)\n", ws_size, (size_t)WS_END); grid = -1; return; }
        int dev = 0, cus = 0, per_cu = 0;
        if (hipGetDevice(&dev) != hipSuccess || hipDeviceGetAttribute(&cus, hipDeviceAttributeMultiprocessorCount, dev) != hipSuccess) { grid = -1; return; }
        if (hipFuncSetAttribute((const void*)mega, hipFuncAttributeMaxDynamicSharedMemorySize, LDS_BYTES) != hipSuccess) { fprintf(stderr, "kernel_launch: hipFuncSetAttribute failed\n"); grid = -1; return; }
        if (hipOccupancyMaxActiveBlocksPerMultiprocessor(&per_cu, (const void*)mega, NWAVES * 64, LDS_BYTES) != hipSuccess || per_cu < 1) { fprintf(stderr, "kernel_launch: occupancy query says %d blocks per CU\n", per_cu); (void)hipGetLastError(); grid = -1; return; }
        grid = cus;
    }
    if (grid < 0) return;
    unsigned char* ws = (unsigned char*)d_ws;
    (void)hipMemsetAsync(ws + WS_CTL, 0, CTL_ZERO_BYTES, stream);
    Args a{};
    for (int i = 0; i < 17; ++i) a.in[i] = (const float*)d_in[i];
    a.out = (float*)d_out; a.ws = ws;
#if MK_ONE_LAUNCH
    a.ph_lo = 0; a.ph_hi = PH_END; hipLaunchKernelGGL(mega, dim3(grid), dim3(NWAVES * 64), LDS_BYTES, stream, a);
#if MK_DUP >= 0
    a.ph_lo = MK_DUP; a.ph_hi = MK_DUP + 1; hipLaunchKernelGGL(mega, dim3(grid), dim3(NWAVES * 64), LDS_BYTES, stream, a);
#endif
#else
    for (int ph = 0; ph < PH_END; ++ph) { a.ph_lo = ph; a.ph_hi = ph + 1; hipLaunchKernelGGL(mega, dim3(grid), dim3(NWAVES * 64), LDS_BYTES, stream, a); }
#endif
}
```

```cpp
#include <hip/hip_runtime.h>
#ifndef MK_W1_EARLY_PCT
#define MK_W1_EARLY_PCT 0
#endif
#include <hip/hip_bf16.h>
#include <cstdio>
#include <cstdint>
#include <cmath>

constexpr size_t EP_MiB = 1u << 20;
constexpr size_t EP_COS = 2 * EP_MiB, EP_SIN = 4 * EP_MiB, EP_RQ = 382 * EP_MiB, EP_RK = 398 * EP_MiB, EP_RV = 414 * EP_MiB, EP_RGS = 430 * EP_MiB, EP_AQ = 446 * EP_MiB, EP_AK = 462 * EP_MiB, EP_AV = 470 * EP_MiB, EP_GRS = 478 * EP_MiB, EP_GAS = 510 * EP_MiB;
constexpr int D_MODEL = 1024, BATCH = 2, SEQ = 8192, T = BATCH * SEQ;
constexpr int HD = 128, CHUNK = 128, NCHUNK = SEQ / CHUNK;
constexpr int NE = 16, FF = 2816, CAP = 1024, NZ = BATCH * NE;
constexpr int INW = 5120;
constexpr int O_RQ = 0, O_RK = 512, O_RV = 1024, O_RG = 1536, O_AQ = 2048, O_AK = 2560, O_AV = 2816, O_GR = 3072, O_GA = 4096;
constexpr float EPS = 1e-6f;
constexpr float RSQRT_HD = 0.08838834764831845f;
constexpr float W1_SCALE = 32.0f, WD_SCALE = 64.0f, ACT_SCALE = 4.0f;

namespace pg8 {
#define PG8_LAS __attribute__((address_space(3)))
typedef unsigned short bf16_t;
typedef short bf16x8 __attribute__((ext_vector_type(8)));
typedef float f32x4 __attribute__((ext_vector_type(4)));
typedef unsigned u32x4 __attribute__((ext_vector_type(4)));
constexpr int BM = 256, BK = 64, HALF = 128, HTB = HALF * BK * 2  , STAGE_BYTES = 8 * HTB, NXCD = 8, WGM = 8;

__host__ __device__ __forceinline__ int lds_byte(int r, int c) { const int st = (r >> 4) * 2 + (c >> 5), rr = r & 15, cc = c & 31, ob = rr * 64 + cc * 2; return st * 1024 + (ob ^ (((ob >> 9) & 1) << 5)); }
__host__ __device__ __forceinline__ void stage_rc(int b, int& R, int& C) { const int st = b / 1024, sb = b % 1024, swz = sb ^ (((sb >> 9) & 1) << 5); R = (st >> 1) * 16 + swz / 64; C = (st & 1) * 32 + (swz % 64) / 2; }
__host__ __device__ __forceinline__ int perm32(int rho) { const int n = rho >> 4, i = rho & 15; return 8 * (i >> 2) + 4 * n + (i & 3); }

struct Unit { int pm, pn, aux; };
struct Gemm { const bf16_t* A; const bf16_t* Bt; int M, N, K; };

struct StaticOrder {
    int nM, nN, nwg, G, c;
    __host__ __device__ void init(int M, int N, int G_, int c_) { nM = M / BM; nN = N / BM; nwg = nM * nN; G = G_; c = c_; }
    __host__ __device__ bool next(int i, Unit& u) const {
        const long L = (long)i * G + c; if (L >= nwg) return false;
        int wgid = (int)L; { const int q = nwg / NXCD, r = nwg % NXCD, xcd = wgid % NXCD, off = wgid / NXCD; wgid = (xcd < r ? xcd * (q + 1) : r * (q + 1) + (xcd - r) * q) + off; }
        const int nig = WGM * nN, gid = wgid / nig, fm = gid * WGM, gsz = (nM - fm) < WGM ? (nM - fm) : WGM;
        u.pm = fm + ((wgid % nig) % gsz); u.pn = (wgid % nig) / gsz; u.aux = 0; return true;
    }
    __device__ __forceinline__ void a_ready(const Unit&) const {}
    __device__ __forceinline__ void done(const Unit&) const {}
    static constexpr bool GATHER = false;
    __device__ __forceinline__ unsigned gather_off(const Unit&, int, int) const { return 0u; }
    __device__ __forceinline__ bool keep_acc(const Unit&) const { return false; }
};


struct PlainSched : StaticOrder {
    const char* A; const char* Bt; size_t tstep;
    __device__ __forceinline__ void bases(const Unit& u, const char*& a, const char*& b) const { a = A + (size_t)u.pm * tstep; b = Bt + (size_t)u.pn * tstep; }
};

typedef float f32x2_t __attribute__((ext_vector_type(2))); typedef __bf16 bf16x2_t __attribute__((ext_vector_type(2)));
__device__ __forceinline__ unsigned cvt_pk_bf16(float lo, float hi) { f32x2_t v = {lo, hi}; bf16x2_t b = __builtin_convertvector(v, bf16x2_t); return __builtin_bit_cast(unsigned, b); }
__device__ __forceinline__ u32x4 pack8(const f32x4 a, const f32x4 b) { u32x4 w; w.x = cvt_pk_bf16(a[0], a[1]); w.y = cvt_pk_bf16(a[2], a[3]); w.z = cvt_pk_bf16(b[0], b[1]); w.w = cvt_pk_bf16(b[2], b[3]); return w; }
__device__ __forceinline__ float fast_sigmoid(float x) { return __builtin_amdgcn_rcpf(1.0f + __builtin_amdgcn_exp2f(-1.4426950408889634f * x)); }
__device__ __forceinline__ f32x4 sigmoid4(const f32x4 v) { return (f32x4){fast_sigmoid(v[0]), fast_sigmoid(v[1]), fast_sigmoid(v[2]), fast_sigmoid(v[3])}; }
__device__ __forceinline__ f32x4 silu4(const f32x4 v) { return v * sigmoid4(v); }

struct EpiProj {
    static constexpr bool PERM = true, AFTER_DRAIN = false;
    unsigned char* wsb;
    const float *qn, *kn;
    PG8_LAS float* xch;
    mutable unsigned epoch;
    template <int ACT>
    __device__ __forceinline__ void plain(const f32x4 (&acc)[2][2][4][2], bf16_t* base, int ld, int col0, int row0) const {
#pragma unroll
        for (int ai = 0; ai < 2; ++ai)
#pragma unroll
            for (int m = 0; m < 4; ++m) { bf16_t* rowp = base + (size_t)(row0 + ai * HALF + m * 16) * ld + col0;
#pragma unroll
                for (int bj = 0; bj < 2; ++bj) { f32x4 v0 = acc[ai][bj][m][0], v1 = acc[ai][bj][m][1];
                    if (ACT == 1) { v0 = silu4(v0); v1 = silu4(v1); } else if (ACT == 2) { v0 = sigmoid4(v0); v1 = sigmoid4(v1); }
                    *(u32x4*)(rowp + bj * HALF) = pack8(v0, v1); } }
    }
    template <bool NORM>
    __device__ __forceinline__ void rope(const f32x4 (&acc)[2][2][4][2], bf16_t* base, int ld, int col0, int row0, float scale, const float* nw, int wr, int wc, int fr, int fq) const {
        const int g = 4 * wc + fq;
        f32x4 nw1 = {1.f, 1.f, 1.f, 1.f}, nw2 = {1.f, 1.f, 1.f, 1.f};
        if (NORM) {
#pragma unroll
            for (int ai = 0; ai < 2; ++ai)
#pragma unroll
                for (int m = 0; m < 4; ++m)
#pragma unroll
                    for (int bj = 0; bj < 2; ++bj) { const f32x4 a = acc[ai][bj][m][0], b = acc[ai][bj][m][1];
                        float s = (a[0] * a[0] + a[1] * a[1]) + (a[2] * a[2] + a[3] * a[3]) + (b[0] * b[0] + b[1] * b[1]) + (b[2] * b[2] + b[3] * b[3]);
                        s += __shfl_xor(s, 16); s += __shfl_xor(s, 32);
                        if (fq == 0) xch[((ai * HALF + wr * 64 + m * 16 + fr) * 2 + bj) * 4 + wc] = s; }
            asm volatile("s_waitcnt lgkmcnt(0)" ::: "memory");
            PG8_LAS unsigned* cnt = (PG8_LAS unsigned*)(xch + 2048) + wr;
            if ((fr | fq) == 0) __hip_atomic_fetch_add(cnt, 1u, __ATOMIC_RELAXED, __HIP_MEMORY_SCOPE_WORKGROUP);
            epoch += 4u;
            while (__hip_atomic_load(cnt, __ATOMIC_RELAXED, __HIP_MEMORY_SCOPE_WORKGROUP) < epoch) __builtin_amdgcn_s_sleep(1);
            asm volatile("s_waitcnt lgkmcnt(0)" ::: "memory");
            nw1 = *(const f32x4*)(nw + 4 * g); nw2 = *(const f32x4*)(nw + 64 + 4 * g);
        }
#pragma unroll
        for (int ai = 0; ai < 2; ++ai)
#pragma unroll
            for (int m = 0; m < 4; ++m) { const int r = row0 + ai * HALF + m * 16; const int pos = r & 8191;
                const f32x4 c4 = *(const f32x4*)((const float*)(wsb + EP_COS) + (size_t)pos * 64 + 4 * g), s4 = *(const f32x4*)((const float*)(wsb + EP_SIN) + (size_t)pos * 64 + 4 * g);
                bf16_t* rowp = base + (size_t)r * ld + col0;
#pragma unroll
                for (int bj = 0; bj < 2; ++bj) { f32x4 x1 = acc[ai][bj][m][0], x2 = acc[ai][bj][m][1];
                    if (NORM) { const f32x4 p = *(const PG8_LAS f32x4*)(xch + ((ai * HALF + wr * 64 + m * 16 + fr) * 2 + bj) * 4);
                        const float rs = __builtin_amdgcn_rsqf(((p[0] + p[1]) + (p[2] + p[3])) * (1.0f / 128.0f) + 1e-6f);
                        x1 = x1 * (nw1 * rs); x2 = x2 * (nw2 * rs); }
                    const f32x4 y1 = (x1 * c4 - x2 * s4) * scale, y2 = (x1 * s4 + x2 * c4) * scale;
                    *(u32x4*)(rowp + bj * HALF) = pack8(y1, y2); }
                asm volatile("" ::: "memory"); }
    }
    __device__ __forceinline__ void operator()(const f32x4 (&acc)[2][2][4][2], const Unit& u, int wr, int wc, int fr, int fq) const {
        const int row0 = u.pm * BM + wr * 64 + fr, cw = wc * 32 + 8 * fq, pn = u.pn;
        if (pn < 2)       rope<false>(acc, (bf16_t*)(wsb + EP_RQ), 512, pn * 256 + cw, row0, 1.0f, nullptr, wr, wc, fr, fq);
        else if (pn < 4)  rope<false>(acc, (bf16_t*)(wsb + EP_RK), 512, (pn - 2) * 256 + cw, row0, 0.08838834764831845f, nullptr, wr, wc, fr, fq);
        else if (pn < 6)  plain<0>(acc, (bf16_t*)(wsb + EP_RV), 512, (pn - 4) * 256 + cw, row0);
        else if (pn < 8)  plain<1>(acc, (bf16_t*)(wsb + EP_RGS), 512, (pn - 6) * 256 + cw, row0);
        else if (pn < 10) rope<true>(acc, (bf16_t*)(wsb + EP_AQ), 512, (pn - 8) * 256 + cw, row0, 1.0f, qn, wr, wc, fr, fq);
        else if (pn < 11) rope<true>(acc, (bf16_t*)(wsb + EP_AK), 256, cw, row0, 1.0f, kn, wr, wc, fr, fq);
        else if (pn < 12) plain<0>(acc, (bf16_t*)(wsb + EP_AV), 256, cw, row0);
        else if (pn < 16) plain<2>(acc, (bf16_t*)(wsb + EP_GRS), 1024, (pn - 12) * 256 + cw, row0);
        else              plain<2>(acc, (bf16_t*)(wsb + EP_GAS), 1024, (pn - 16) * 256 + cw, row0);
    }
};

struct BranchSched : StaticOrder {
    const char *A0, *A1, *B0, *B1; size_t tstep;
    __device__ __forceinline__ bool next(int i, Unit& u) const { if (!StaticOrder::next(i >> 1, u)) return false; u.aux = i & 1; return true; }
    __device__ __forceinline__ void bases(const Unit& u, const char*& a, const char*& b) const { a = (u.aux ? A1 : A0) + (size_t)u.pm * tstep; b = (u.aux ? B1 : B0) + (size_t)u.pn * tstep; }
    __device__ __forceinline__ bool keep_acc(const Unit& nxt) const { return nxt.aux == 1; }
};
__device__ __forceinline__ void unpack8(const u32x4 w, f32x4& a, f32x4& b) {
    a = (f32x4){__uint_as_float(w.x << 16), __uint_as_float(w.x & 0xffff0000u), __uint_as_float(w.y << 16), __uint_as_float(w.y & 0xffff0000u)};
    b = (f32x4){__uint_as_float(w.z << 16), __uint_as_float(w.z & 0xffff0000u), __uint_as_float(w.w << 16), __uint_as_float(w.w & 0xffff0000u)};
}
struct EpiBranch {
    static constexpr bool PERM = true, AFTER_DRAIN = false;
    const bf16_t *grs, *gas; bf16_t* mixed;
    __device__ __forceinline__ void operator()(f32x4 (&acc)[2][2][4][2], const Unit& u, int wr, int wc, int fr, int fq) const {
        const int row0 = u.pm * BM + wr * 64 + fr, col0 = u.pn * BM + wc * 32 + 8 * fq;
#pragma unroll
        for (int ai = 0; ai < 2; ++ai)
#pragma unroll
            for (int m = 0; m < 4; ++m) { const size_t off = (size_t)(row0 + ai * HALF + m * 16) * 1024 + col0;
#pragma unroll
                for (int bj = 0; bj < 2; ++bj) { f32x4 ga0, ga1; unpack8(*(const u32x4*)(gas + off + bj * HALF), ga0, ga1);
                    if (u.aux == 0) { f32x4 gr0, gr1; unpack8(*(const u32x4*)(grs + off + bj * HALF), gr0, gr1);
#pragma unroll
                        for (int k = 0; k < 4; ++k) { acc[ai][bj][m][0][k] *= gr0[k] * __builtin_amdgcn_rcpf(fmaxf(ga0[k], 1e-30f)); acc[ai][bj][m][1][k] *= gr1[k] * __builtin_amdgcn_rcpf(fmaxf(ga1[k], 1e-30f)); } }
                    else *(u32x4*)(mixed + off + bj * HALF) = pack8(acc[ai][bj][m][0] * ga0, acc[ai][bj][m][1] * ga1); }
                asm volatile("" ::: "memory"); }
    }
};
struct EpiResid {
    static constexpr bool PERM = false, AFTER_DRAIN = false;
    const float* x; float* x1;
    __device__ __forceinline__ void operator()(const f32x4 (&acc)[2][2][4][2], const Unit& u, int wr, int wc, int fr, int fq) const {
        const int row0 = u.pm * BM + wr * 64 + fr, col0 = u.pn * BM + wc * 32 + 4 * fq;
#pragma unroll
        for (int ai = 0; ai < 2; ++ai)
#pragma unroll
            for (int m = 0; m < 4; ++m) { const size_t off = (size_t)(row0 + ai * HALF + m * 16) * 1024 + col0;
#pragma unroll
                for (int bj = 0; bj < 2; ++bj)
#pragma unroll
                    for (int n = 0; n < 2; ++n) { const f32x4 xv = *(const f32x4*)(x + off + bj * HALF + n * 16); *(f32x4*)(x1 + off + bj * HALF + n * 16) = xv + acc[ai][bj][m][n]; }
                if (m & 1) asm volatile("" ::: "memory"); }
    }
};
__device__ __forceinline__ int moe_rowbase(int pm) { return ((((pm >> 2) & 1) * 16 + (pm >> 3)) * 1024) + (pm & 3) * 256; }
struct MoeSched : StaticOrder {
    const char *A, *Bt; size_t kb; int nper;
    __device__ __forceinline__ void bases(const Unit& u, const char*& a, const char*& b) const { a = A + (size_t)moe_rowbase(u.pm) * kb; b = Bt + ((size_t)(u.pm >> 3) * nper + (size_t)u.pn * 256) * kb; }
};
struct MoeGatherSched : StaticOrder {
    static constexpr bool GATHER = true;
    const char *A, *Bt; const int* idx;
    __device__ __forceinline__ void bases(const Unit& u, const char*& a, const char*& b) const { a = A; b = Bt + ((size_t)(u.pm >> 3) * 5632 + (size_t)u.pn * 256) * 1024; }
    __device__ __forceinline__ unsigned gather_off(const Unit& u, int r, int c) const { const int tok = ((u.pm >> 2) & 1) * 8192 + idx[moe_rowbase(u.pm) + r]; return (unsigned)(tok * 1024 + c * 2); }
};
struct EpiSwiglu {
    static constexpr bool PERM = true, AFTER_DRAIN = false;
    unsigned char* act; float in_scale, act_scale;
    __device__ __forceinline__ void operator()(const f32x4 (&acc)[2][2][4][2], const Unit& u, int wr, int wc, int fr, int fq) const {
        const int row0 = moe_rowbase(u.pm) + wr * 64 + fr, col0 = u.pn * HALF + wc * 32 + 8 * fq;
#pragma unroll
        for (int ai = 0; ai < 2; ++ai)
#pragma unroll
            for (int m = 0; m < 4; ++m) { f32x4 v0 = silu4(acc[ai][0][m][0] * in_scale) * (acc[ai][1][m][0] * (in_scale * act_scale)), v1 = silu4(acc[ai][0][m][1] * in_scale) * (acc[ai][1][m][1] * (in_scale * act_scale));
#pragma unroll
                for (int k = 0; k < 4; ++k) { v0[k] = __builtin_amdgcn_fmed3f(v0[k], -448.0f, 448.0f); v1[k] = __builtin_amdgcn_fmed3f(v1[k], -448.0f, 448.0f); }
                const unsigned lo = (unsigned)__builtin_amdgcn_cvt_pk_fp8_f32(v0[2], v0[3], __builtin_amdgcn_cvt_pk_fp8_f32(v0[0], v0[1], 0, false), true), hi = (unsigned)__builtin_amdgcn_cvt_pk_fp8_f32(v1[2], v1[3], __builtin_amdgcn_cvt_pk_fp8_f32(v1[0], v1[1], 0, false), true);
                *(unsigned long long*)(act + (size_t)(row0 + ai * HALF + m * 16) * 2816 + col0) = (unsigned long long)lo | ((unsigned long long)hi << 32); }
    }
};
struct EpiDown {
    static constexpr bool PERM = true, AFTER_DRAIN = false;
    bf16_t* y; const float* gate; float out_scale;
    __device__ __forceinline__ void operator()(const f32x4 (&acc)[2][2][4][2], const Unit& u, int wr, int wc, int fr, int fq) const {
        const int row0 = moe_rowbase(u.pm) + wr * 64 + fr, col0 = u.pn * BM + wc * 32 + 8 * fq;
#pragma unroll
        for (int ai = 0; ai < 2; ++ai)
#pragma unroll
            for (int m = 0; m < 4; ++m) { const int r = row0 + ai * HALF + m * 16; const float g = gate[r] * out_scale;
#pragma unroll
                for (int bj = 0; bj < 2; ++bj) *(u32x4*)(y + (size_t)r * 1024 + col0 + bj * HALF) = pack8(acc[ai][bj][m][0] * g, acc[ai][bj][m][1] * g); }
    }
};
typedef int v4i32 __attribute__((ext_vector_type(4)));
typedef int v8i32 __attribute__((ext_vector_type(8)));
__device__ __forceinline__ v8i32 cat8(const bf16x8 lo, const bf16x8 hi) { const v4i32 l = __builtin_bit_cast(v4i32, lo), h = __builtin_bit_cast(v4i32, hi); return __builtin_shufflevector(l, h, 0, 1, 2, 3, 4, 5, 6, 7); }
__device__ __forceinline__ void mfma_f8_inplace(f32x4& acc, const v8i32 b8, const v8i32 a8, const int sc) {
    asm volatile("v_mfma_scale_f32_16x16x128_f8f6f4 %0, %1, %2, %0, %3, %3 op_sel_hi:[0,0,0]" : "+v"(acc) : "v"(b8), "v"(a8), "v"(sc)); }
template <class Epi, class Sched, bool ALIGN_EPI = false, bool SP2 = false, bool FP8 = false>
__device__ __forceinline__ void gemm_phase(PG8_LAS unsigned char* lds, const int K_, const Sched& S, const Epi& E, const int tid) {
    const int wid = __builtin_amdgcn_readfirstlane(tid >> 6), lane = tid & 63, wr = wid >> 2, wc = wid & 3, fr = lane & 15, fq = lane >> 4;
    const int K = K_, nt = K / BK;
    unsigned voffA[2], voffB[2];
#pragma unroll
    for (int i = 0; i < 2; ++i) { int R, C; stage_rc(tid * 16 + i * 8192, R, C); const int Rb = Epi::PERM ? ((R & ~31) + perm32(R & 31)) : R;
        voffA[i] = (unsigned)(R * K + C) * 2u; voffB[i] = (unsigned)(Rb * K + C) * 2u; }
    unsigned va0[2] = {0u, 0u}, va1[2] = {0u, 0u}, vn0[2] = {0u, 0u}, vn1[2] = {0u, 0u};
    int gR[2], gC[2];
#pragma unroll
    for (int i = 0; i < 2; ++i) stage_rc(tid * 16 + i * 8192, gR[i], gC[i]);
    const size_t kstep = (size_t)(BK * 2);
    const size_t hstep = (size_t)HALF * K * 2;
        const unsigned ldsw = (unsigned)wid * 1024u;
    const int aoff = lds_byte(wr * 64 + fr, fq * 8), boff = lds_byte(wc * 32 + fr, fq * 8);
#define PG8_SA(b, h) (((b) * 2 + (h)) * HTB)
#define PG8_SB(b, h) ((4 + (b) * 2 + (h)) * HTB)
#define PG8_STAGE(bufoff, gbase, voff) do { _Pragma("unroll") for (int _i = 0; _i < 2; ++_i) \
        __builtin_amdgcn_global_load_lds((const unsigned*)((const char*)(gbase) + (voff)[_i]), (PG8_LAS unsigned*)(lds + (bufoff) + ldsw + _i * 8192), 16, 0, 0); } while (0)
#define PG8_STAGE_A(bufoff, gbase, h, usenext) do { if constexpr (Sched::GATHER) { unsigned vo_[2]; \
        vo_[0] = (usenext) ? ((h) ? vn1[0] : vn0[0]) : ((h) ? va1[0] : va0[0]); vo_[1] = (usenext) ? ((h) ? vn1[1] : vn0[1]) : ((h) ? va1[1] : va0[1]); PG8_STAGE(bufoff, gbase, vo_); } \
        else { PG8_STAGE(bufoff, (gbase) + ((h) ? hstep : (size_t)0), voffA); } } while (0)
#define PG8_LDA(dst, b, h) do { if constexpr (FP8) { _Pragma("unroll") for (int m = 0; m < 4; ++m) dst##8[m] = cat8(*(const PG8_LAS bf16x8*)(lds + PG8_SA(b, h) + aoff + m * 2048), *(const PG8_LAS bf16x8*)(lds + PG8_SA(b, h) + aoff + m * 2048 + 1024)); } else { \
        _Pragma("unroll") for (int m = 0; m < 4; ++m) _Pragma("unroll") for (int k = 0; k < 2; ++k) dst[m][k] = *(const PG8_LAS bf16x8*)(lds + PG8_SA(b, h) + aoff + m * 2048 + k * 1024); } } while (0)
#define PG8_LDB(dst, b, h) do { if constexpr (FP8) { _Pragma("unroll") for (int n = 0; n < 2; ++n) dst##8[n] = cat8(*(const PG8_LAS bf16x8*)(lds + PG8_SB(b, h) + boff + n * 2048), *(const PG8_LAS bf16x8*)(lds + PG8_SB(b, h) + boff + n * 2048 + 1024)); } else { \
        _Pragma("unroll") for (int n = 0; n < 2; ++n) _Pragma("unroll") for (int k = 0; k < 2; ++k) dst[n][k] = *(const PG8_LAS bf16x8*)(lds + PG8_SB(b, h) + boff + n * 2048 + k * 1024); } } while (0)
#define PG8_MMA(ai, bj, At, Bt) do { __builtin_amdgcn_s_setprio(1); if constexpr (FP8) { _Pragma("unroll") for (int m = 0; m < 4; ++m) _Pragma("unroll") for (int n = 0; n < 2; ++n) \
        mfma_f8_inplace(acc[ai][bj][m][n], Bt##8[n], At##8[m], 0x7f7f7f7f); } else { \
        _Pragma("unroll") for (int m = 0; m < 4; ++m) _Pragma("unroll") for (int n = 0; n < 2; ++n) _Pragma("unroll") for (int k = 0; k < 2; ++k) \
        acc[ai][bj][m][n] = __builtin_amdgcn_mfma_f32_16x16x32_bf16(Bt[n][k], At[m][k], acc[ai][bj][m][n], 0, 0, 0); } __builtin_amdgcn_s_setprio(0); } while (0)
#define PG8_WAIT_V(n) asm volatile("s_waitcnt vmcnt(" #n ")" ::: "memory")
#define PG8_WAIT_L(n) asm volatile("s_waitcnt lgkmcnt(" #n ")" ::: "memory")
#define PG8_BAR __builtin_amdgcn_s_barrier()
#define PG8_SCHED __builtin_amdgcn_sched_barrier(0)
    Unit cur, nxt; int ui = 0;
    if (!S.next(0, cur)) return;
    f32x4 acc[2][2][4][2];
#pragma unroll
    for (int a = 0; a < 2; ++a)
#pragma unroll
        for (int b = 0; b < 2; ++b)
#pragma unroll
            for (int m = 0; m < 4; ++m)
#pragma unroll
                for (int n = 0; n < 2; ++n) acc[a][b][m][n] = (f32x4){0.f, 0.f, 0.f, 0.f};
    bf16x8 At[4][2], B0[2][2], B1[2][2]; v8i32 At8[4], B08[2], B18[2];
    const char* cA; const char* cB; S.bases(cur, cA, cB);
    if constexpr (Sched::GATHER) {
#pragma unroll
        for (int i = 0; i < 2; ++i) { va0[i] = S.gather_off(cur, gR[i], gC[i]); va1[i] = S.gather_off(cur, gR[i] + HALF, gC[i]); } }
    S.a_ready(cur);
    if constexpr (SP2) {
        PG8_STAGE(PG8_SB(0, 0), cB, voffB); PG8_STAGE(PG8_SB(0, 1), cB + hstep, voffB); PG8_STAGE_A(PG8_SA(0, 0), cA, 0, false); PG8_STAGE_A(PG8_SA(0, 1), cA, 1, false);
        if (wr == 1) PG8_BAR;
        PG8_WAIT_V(2); PG8_BAR;
        PG8_STAGE(PG8_SB(1, 0), cB + kstep, voffB); PG8_STAGE_A(PG8_SA(1, 0), cA + kstep, 0, false); PG8_STAGE(PG8_SB(1, 1), cB + hstep + kstep, voffB);
        PG8_WAIT_V(6); PG8_BAR;
    } else {
        PG8_STAGE(PG8_SB(0, 0), cB, voffB); PG8_STAGE_A(PG8_SA(0, 0), cA, 0, false); PG8_STAGE(PG8_SB(0, 1), cB + hstep, voffB); PG8_STAGE_A(PG8_SA(0, 1), cA, 1, false);
        if (wr == 1) PG8_BAR;
        PG8_WAIT_V(4); PG8_BAR;
        PG8_STAGE(PG8_SB(1, 0), cB + kstep, voffB); PG8_STAGE_A(PG8_SA(1, 0), cA + kstep, 0, false); PG8_STAGE(PG8_SB(1, 1), cB + hstep + kstep, voffB);
        PG8_WAIT_V(6); PG8_BAR;
    }
    for (;;) {
        const bool has_next = S.next(ui + 1, nxt);
        const char* nA = cA; const char* nB = cB; if (has_next) S.bases(nxt, nA, nB);
        if constexpr (Sched::GATHER) { if (has_next) {
#pragma unroll
            for (int i = 0; i < 2; ++i) { vn0[i] = S.gather_off(nxt, gR[i], gC[i]); vn1[i] = S.gather_off(nxt, gR[i] + HALF, gC[i]); } }
            else {
#pragma unroll
            for (int i = 0; i < 2; ++i) { vn0[i] = va0[i]; vn1[i] = va1[i]; } } }
#pragma unroll 1
        for (int t = 0; t < nt; t += 2) {
            const bool last = (t == nt - 2);
            const char* a1 = cA + (size_t)(t + 1) * kstep;
            const char* a2 = last ? nA : cA + (size_t)(t + 2) * kstep; const char* b2 = last ? nB : cB + (size_t)(t + 2) * kstep;
            const char* a3 = a2 + kstep; const char* b3 = b2 + kstep;
            if (last && has_next) S.a_ready(nxt);
            if constexpr (SP2) {
            PG8_LDB(B0, 0, 0); PG8_LDB(B1, 0, 1); PG8_SCHED; PG8_LDA(At, 0, 0); PG8_STAGE_A(PG8_SA(1, 1), a1, 1, false);
            PG8_WAIT_V(8); PG8_WAIT_L(0); PG8_BAR; PG8_MMA(0, 0, At, B0); PG8_MMA(0, 1, At, B1); PG8_BAR; PG8_SCHED;
            PG8_LDA(At, 0, 1); PG8_STAGE(PG8_SB(0, 0), b2, voffB); PG8_STAGE(PG8_SB(0, 1), b2 + hstep, voffB); PG8_STAGE_A(PG8_SA(0, 0), a2, 0, last);
            PG8_WAIT_V(8); PG8_WAIT_L(0); PG8_BAR; PG8_MMA(1, 0, At, B0); PG8_MMA(1, 1, At, B1); PG8_BAR; PG8_SCHED;
            PG8_LDB(B0, 1, 0); PG8_LDB(B1, 1, 1); PG8_SCHED; PG8_LDA(At, 1, 0); PG8_STAGE_A(PG8_SA(0, 1), a2, 1, last);
            PG8_WAIT_V(8); PG8_WAIT_L(0); PG8_BAR; PG8_MMA(0, 0, At, B0); PG8_MMA(0, 1, At, B1); PG8_BAR; PG8_SCHED;
            PG8_LDA(At, 1, 1); PG8_STAGE(PG8_SB(1, 0), b3, voffB); PG8_STAGE(PG8_SB(1, 1), b3 + hstep, voffB); PG8_STAGE_A(PG8_SA(1, 0), a3, 0, last);
            PG8_WAIT_V(8); PG8_WAIT_L(0); PG8_BAR; PG8_MMA(1, 0, At, B0); PG8_MMA(1, 1, At, B1); PG8_BAR; PG8_SCHED;
            } else {
            PG8_LDB(B0, 0, 0); PG8_SCHED; PG8_LDA(At, 0, 0); PG8_STAGE_A(PG8_SA(1, 1), a1, 1, false);
            PG8_WAIT_L(8); PG8_BAR; PG8_WAIT_L(0); PG8_MMA(0, 0, At, B0); PG8_BAR; PG8_SCHED;
            PG8_LDB(B1, 0, 1); PG8_STAGE(PG8_SB(0, 0), b2, voffB);
            PG8_BAR; PG8_WAIT_L(0); PG8_MMA(0, 1, At, B1); PG8_BAR;
            PG8_LDA(At, 0, 1); PG8_STAGE_A(PG8_SA(0, 0), a2, 0, last);
            PG8_BAR; PG8_WAIT_L(0); PG8_MMA(1, 0, At, B0); PG8_BAR; PG8_SCHED;
            PG8_STAGE(PG8_SB(0, 1), b2 + hstep, voffB);
            PG8_WAIT_V(6); PG8_BAR; PG8_MMA(1, 1, At, B1); PG8_BAR;
            PG8_LDB(B0, 1, 0); PG8_SCHED; PG8_LDA(At, 1, 0); PG8_STAGE_A(PG8_SA(0, 1), a2, 1, last);
            PG8_WAIT_L(8); PG8_BAR; PG8_WAIT_L(0); PG8_MMA(0, 0, At, B0); PG8_BAR; PG8_SCHED;
            PG8_LDB(B1, 1, 1); PG8_STAGE(PG8_SB(1, 0), b3, voffB);
            PG8_BAR; PG8_WAIT_L(0); PG8_MMA(0, 1, At, B1); PG8_BAR;
            PG8_LDA(At, 1, 1); PG8_STAGE_A(PG8_SA(1, 0), a3, 0, last);
            PG8_BAR; PG8_WAIT_L(0); PG8_MMA(1, 0, At, B0); PG8_BAR; PG8_SCHED;
            PG8_STAGE(PG8_SB(1, 1), b3 + hstep, voffB);
            PG8_WAIT_V(6); PG8_BAR; PG8_MMA(1, 1, At, B1); PG8_BAR;
            }
        }
        if constexpr (FP8) asm volatile("s_nop 15\n\ts_nop 15" ::: "memory");
        if constexpr (ALIGN_EPI) { if (wr == 0) PG8_BAR; }
        if constexpr (!Epi::AFTER_DRAIN) { int le_; asm volatile("v_mbcnt_lo_u32_b32 %0, -1, 0\n\tv_mbcnt_hi_u32_b32 %0, -1, %0" : "=v"(le_));
            E(acc, cur, wr, wc, le_ & 15, le_ >> 4); S.done(cur); }
        if (!has_next) break;
        if (!S.keep_acc(nxt)) {
#pragma unroll
        for (int a = 0; a < 2; ++a)
#pragma unroll
            for (int b = 0; b < 2; ++b)
#pragma unroll
                for (int m = 0; m < 4; ++m)
#pragma unroll
                    for (int n = 0; n < 2; ++n) acc[a][b][m][n] = (f32x4){0.f, 0.f, 0.f, 0.f};
        }
        cur = nxt; cA = nA; cB = nB; ++ui;
        if constexpr (Sched::GATHER) {
#pragma unroll
            for (int i = 0; i < 2; ++i) { va0[i] = vn0[i]; va1[i] = vn1[i]; } }
        if constexpr (ALIGN_EPI) { if (wr == 1) PG8_BAR; }
    }
    PG8_WAIT_V(0);
    if constexpr (!ALIGN_EPI) { if (wr == 0) PG8_BAR; }
    PG8_BAR;
    if constexpr (Epi::AFTER_DRAIN) { E.fused(acc, cur, wr, wc, fr, fq, lds, wid, lane); S.done(cur); }
#undef PG8_SA
#undef PG8_SB
#undef PG8_STAGE
#undef PG8_STAGE_A
#undef PG8_LDA
#undef PG8_LDB
#undef PG8_MMA
#undef PG8_WAIT_V
#undef PG8_WAIT_L
#undef PG8_BAR
#undef PG8_SCHED
}
}


namespace attn {
using bf16 = __hip_bfloat16;
constexpr int   D = 128, NW = 8, QBLK = 32, KVBLK = 64;
constexpr float SCALE = 0.088388347648318440f;
constexpr float THR = 8.f;
constexpr int SDEPTH = 2;
constexpr int LDQ = 512, LDK = 256, LDO = 512;
constexpr size_t SHM_V = KVBLK * D * 2, SHM_K = KVBLK * D * 2, SHM_ATTN = 2 * SHM_V + 2 * SHM_K + NW * 64 * 4;
using bf16x8 = __attribute__((ext_vector_type(8))) short;
using s16x4  = __attribute__((ext_vector_type(4))) short;
using f32x16 = __attribute__((ext_vector_type(16))) float;
using f32x8  = __attribute__((ext_vector_type(8))) float;
using u32x4  = __attribute__((ext_vector_type(4))) unsigned;
#define KSWZ(row, colB) ((row) * 256 + ((colB) ^ (((row) & 7) << 4)))
#define SBAR() __builtin_amdgcn_sched_barrier(0)
__device__ __forceinline__ int crow(int r, int hi) { return (r & 3) + 8 * (r >> 2) + 4 * hi; }
typedef float f32x2_t __attribute__((ext_vector_type(2))); typedef __bf16 bf16x2_t __attribute__((ext_vector_type(2)));
__device__ __forceinline__ unsigned cvtpk(float lo, float hi) { f32x2_t v = {lo, hi}; bf16x2_t b = __builtin_convertvector(v, bf16x2_t); return __builtin_bit_cast(unsigned, b); }
template <typename TIn> struct Stage;
template <> struct Stage<bf16>  { using T = bf16x8;
  __device__ static __forceinline__ T ld8(const bf16* p) { return *reinterpret_cast<const bf16x8*>(p); }
  __device__ static __forceinline__ bf16x8 tobf(T x) { return x; } };
template <> struct Stage<float> { using T = f32x8;
  __device__ static __forceinline__ T ld8(const float* p) { return *reinterpret_cast<const f32x8*>(p); }
  __device__ static __forceinline__ bf16x8 tobf(T x) {
    u32x4 w = {cvtpk(x[0], x[1]), cvtpk(x[2], x[3]), cvtpk(x[4], x[5]), cvtpk(x[6], x[7])}; return *reinterpret_cast<bf16x8*>(&w); } };

__device__ __forceinline__ void partialSM(f32x16& p0, f32x16& p1, float& m_reg, float& mn, float& alpha) {
  constexpr float C = SCALE * 1.4426950408889634f;
  float pmax = p0[0]; for (int r = 1; r < 16; ++r) pmax = fmaxf(pmax, p0[r]); for (int r = 0; r < 16; ++r) pmax = fmaxf(pmax, p1[r]);
  { auto rr = __builtin_amdgcn_permlane32_swap(__float_as_uint(pmax), __float_as_uint(pmax), false, false);
    pmax = fmaxf(__uint_as_float(rr[0]), __uint_as_float(rr[1])); }
  if (__builtin_expect(__all(pmax - m_reg <= THR / SCALE), 1)) { mn = m_reg; alpha = 1.f; }
  else { mn = fmaxf(m_reg, pmax); alpha = __builtin_amdgcn_exp2f((m_reg - mn) * C); m_reg = mn; }
  float mnC = -mn * C;
  for (int r = 0; r < 16; ++r) p0[r] = fmaf(p0[r], C, mnC); for (int r = 0; r < 16; ++r) p1[r] = fmaf(p1[r], C, mnC);
  for (int r = 0; r < 16; ++r) p0[r] = __builtin_amdgcn_exp2f(p0[r]);
}
__device__ __forceinline__ void finishSM(f32x16& p0, f32x16& p1, float alpha, float& l_reg, bf16x8& pa0, bf16x8& pa1, bf16x8& pa2, bf16x8& pa3) {
  for (int r = 0; r < 16; ++r) p1[r] = __builtin_amdgcn_exp2f(p1[r]);
  float ps = 0; for (int r = 0; r < 16; ++r) ps += p0[r]; for (int r = 0; r < 16; ++r) ps += p1[r];
  { auto rr = __builtin_amdgcn_permlane32_swap(__float_as_uint(ps), __float_as_uint(ps), false, false);
    ps = __uint_as_float(rr[0]) + __uint_as_float(rr[1]); }
  l_reg = l_reg * alpha + ps;
#define PK4(P, BASE, OUT) do { unsigned a0 = cvtpk(P[BASE + 0], P[BASE + 1]), a1 = cvtpk(P[BASE + 2], P[BASE + 3]);   \
    unsigned b0 = cvtpk(P[BASE + 4], P[BASE + 5]), b1 = cvtpk(P[BASE + 6], P[BASE + 7]);                              \
    auto r0 = __builtin_amdgcn_permlane32_swap(a0, b0, false, false); auto r1 = __builtin_amdgcn_permlane32_swap(a1, b1, false, false); \
    u32x4 w = {r0[0], r1[0], r0[1], r1[1]}; OUT = *reinterpret_cast<bf16x8*>(&w); } while (0)
  PK4(p0, 0, pa0); PK4(p0, 8, pa1); PK4(p1, 0, pa2); PK4(p1, 8, pa3);
#undef PK4
}
__device__ __forceinline__ void qkt(f32x16& p0, f32x16& p1, const bf16* Ks, const bf16x8* qr, int r32, int hi) {
  p0 = f32x16{}; p1 = f32x16{};
  for (int d0 = 0; d0 < 8; ++d0) { int cb = (d0 * 16 + hi * 8) * 2;
    bf16x8 b0 = *reinterpret_cast<const bf16x8*>((const char*)Ks + KSWZ(r32, cb));
    bf16x8 b1 = *reinterpret_cast<const bf16x8*>((const char*)Ks + KSWZ(32 + r32, cb));
    p0 = __builtin_amdgcn_mfma_f32_32x32x16_bf16(b0, qr[d0], p0, 0, 0, 0);
    p1 = __builtin_amdgcn_mfma_f32_32x32x16_bf16(b1, qr[d0], p1, 0, 0, 0); }
}
__device__ __forceinline__ int v_st(int k, int c) { const int kk = (k & ~0xC) | ((k & 4) << 1) | ((k & 8) >> 1); return ((kk >> 3) * 4 + (c >> 5)) * 512 + ((kk & 7) * 32 + (c & 31)) * 2; }
__device__ __forceinline__ int v_rd_base(int lane) { return ((lane & 3) << 3) | (((lane >> 2) & 3) << 6) | (((lane >> 4) & 1) << 5) | (((lane >> 5) & 1) << 8); }
constexpr int v_rd_off(int d0, int ks, int half) { return d0 * 512 + ks * 4096 + half * 2048; }
template <int OFF> __device__ __forceinline__ s16x4 tr_read(int vb) {
  s16x4 r; asm volatile("ds_read_b64_tr_b16 %0, %1 offset:%2" : "=&v"(r) : "v"(vb), "i"(OFF) : "memory"); return r;
}
template <int D0> __device__ __forceinline__ void pv_one(f32x16& od, int vb, bf16x8 pa0, bf16x8 pa1, bf16x8 pa2, bf16x8 pa3) {
  const s16x4 l0 = tr_read<v_rd_off(D0, 0, 0)>(vb), h0 = tr_read<v_rd_off(D0, 0, 1)>(vb), l1 = tr_read<v_rd_off(D0, 1, 0)>(vb), h1 = tr_read<v_rd_off(D0, 1, 1)>(vb);
  const s16x4 l2 = tr_read<v_rd_off(D0, 2, 0)>(vb), h2 = tr_read<v_rd_off(D0, 2, 1)>(vb), l3 = tr_read<v_rd_off(D0, 3, 0)>(vb), h3 = tr_read<v_rd_off(D0, 3, 1)>(vb);
  asm volatile("s_waitcnt lgkmcnt(0)" ::: "memory"); SBAR();
#define PK(L, H) (bf16x8){L[0], L[1], L[2], L[3], H[0], H[1], H[2], H[3]}
  od = __builtin_amdgcn_mfma_f32_32x32x16_bf16(pa0, PK(l0, h0), od, 0, 0, 0);
  od = __builtin_amdgcn_mfma_f32_32x32x16_bf16(pa1, PK(l1, h1), od, 0, 0, 0);
  od = __builtin_amdgcn_mfma_f32_32x32x16_bf16(pa2, PK(l2, h2), od, 0, 0, 0);
  od = __builtin_amdgcn_mfma_f32_32x32x16_bf16(pa3, PK(l3, h3), od, 0, 0, 0);
#undef PK
}
__device__ __forceinline__ void pv_d0(f32x16* o, int vb, bf16x8 pa0, bf16x8 pa1, bf16x8 pa2, bf16x8 pa3) {
  pv_one<0>(o[0], vb, pa0, pa1, pa2, pa3); pv_one<1>(o[1], vb, pa0, pa1, pa2, pa3); pv_one<2>(o[2], vb, pa0, pa1, pa2, pa3); pv_one<3>(o[3], vb, pa0, pa1, pa2, pa3);
}

template <typename TQ>
__device__ __forceinline__ void attn_dense_body(const TQ* __restrict__ Qb, const bf16* __restrict__ Kh, const bf16* __restrict__ Vh,
                                                bf16* __restrict__ Ob, int seq, char* lds, const int tid) {
  using St = Stage<bf16>; using SQ = Stage<TQ>;
  const int wid = tid >> 6, lane = tid & 63, r32 = lane & 31, hi = lane >> 5;
  bf16* V_lds = (bf16*)lds; bf16* K_lds = (bf16*)(lds + 2 * SHM_V);
  float* ws = (float*)(lds + 2 * SHM_V + 2 * SHM_K) + wid * 64; float* li_l = ws; float* al_l = ws + 32;
  float m_reg = -1e30f, l_reg = 0; f32x16 o[4] = {}; bf16x8 qr[8];
  const TQ* Qw = Qb + (long)(wid * QBLK + r32) * LDQ + hi * 8;
#pragma unroll
  for (int d0 = 0; d0 < 8; ++d0) qr[d0] = SQ::tobf(SQ::ld8(Qw + d0 * 16));
  const int sr = tid >> 4, sc = (tid & 15) * 8, vst0 = v_st(sr, sc), vst1 = v_st(32 + sr, sc);
  const int vb0 = (int)(uintptr_t)V_lds + v_rd_base(lane);
  struct { typename St::T vs0, vs1, ks0, ks1; } sr_[SDEPTH];
#define SLOAD(i, k0) do { sr_[i].vs0 = St::ld8(&Vh[(long)((k0) + sr) * LDK + sc]); sr_[i].vs1 = St::ld8(&Vh[(long)((k0) + 32 + sr) * LDK + sc]); \
    sr_[i].ks0 = St::ld8(&Kh[(long)((k0) + sr) * LDK + sc]); sr_[i].ks1 = St::ld8(&Kh[(long)((k0) + 32 + sr) * LDK + sc]); } while (0)
#define SWRITE(b, i) do { *(bf16x8*)((char*)V_lds + (b) * SHM_V + vst0) = St::tobf(sr_[i].vs0);          \
    *(bf16x8*)((char*)V_lds + (b) * SHM_V + vst1) = St::tobf(sr_[i].vs1); int kc = sc * 2;               \
    *(bf16x8*)((char*)K_lds + (b) * SHM_K + KSWZ(sr, kc)) = St::tobf(sr_[i].ks0);                       \
    *(bf16x8*)((char*)K_lds + (b) * SHM_K + KSWZ(32 + sr, kc)) = St::tobf(sr_[i].ks1); } while (0)
#define SWAIT() do { if constexpr (SDEPTH == 2) asm volatile("s_waitcnt vmcnt(4)" ::: "memory"); else asm volatile("s_waitcnt vmcnt(0)" ::: "memory"); } while (0)
#define RESC(a) do { if (__any((a) < 1.f)) { if (hi == 0) al_l[r32] = (a); asm volatile("s_waitcnt lgkmcnt(0)" ::: "memory"); \
    for (int d = 0; d < 4; ++d) for (int r = 0; r < 16; ++r) o[d][r] *= al_l[crow(r, hi)]; } } while (0)
  f32x16 pA0, pA1, pB0, pB1; float mnA, mnB, alA, alB; bf16x8 pa0, pa1, pa2, pa3; const int NT = seq / KVBLK;
  constexpr int SE = 0, SO = SDEPTH - 1;
  SLOAD(SE, 0); asm volatile("s_waitcnt vmcnt(0)" ::: "memory"); SWRITE(0, SE); __syncthreads();
  qkt(pA0, pA1, K_lds, qr, r32, hi); partialSM(pA0, pA1, m_reg, mnA, alA);
  SLOAD(SO, KVBLK); if constexpr (SDEPTH == 2) { if (2 < NT) SLOAD(SE, 2 * KVBLK); }
  SWAIT(); SWRITE(1, SO); __syncthreads();
  for (int j = 1; j + 1 < NT; j += 2) {
    SBAR(); qkt(pB0, pB1, (bf16*)((char*)K_lds + SHM_K), qr, r32, hi);
    finishSM(pA0, pA1, alA, l_reg, pa0, pa1, pa2, pa3); SBAR();
    SLOAD(SO, (j + SDEPTH) * KVBLK); SBAR();
    pv_d0(o, vb0, pa0, pa1, pa2, pa3); partialSM(pB0, pB1, m_reg, mnB, alB);
    __syncthreads(); SWAIT(); SWRITE(0, SE);
    RESC(alB); __syncthreads();
    SBAR(); qkt(pA0, pA1, K_lds, qr, r32, hi);
    finishSM(pB0, pB1, alB, l_reg, pa0, pa1, pa2, pa3); SBAR();
    if (SDEPTH == 1 || j + 3 < NT) SLOAD(SE, (j + 1 + SDEPTH) * KVBLK); SBAR();
    pv_d0(o, vb0 + (int)SHM_V, pa0, pa1, pa2, pa3); partialSM(pA0, pA1, m_reg, mnA, alA);
    __syncthreads(); SWAIT(); SWRITE(1, SO);
    RESC(alA); __syncthreads();
  }
  SBAR(); qkt(pB0, pB1, (bf16*)((char*)K_lds + SHM_K), qr, r32, hi);
  finishSM(pA0, pA1, alA, l_reg, pa0, pa1, pa2, pa3); SBAR();
  pv_d0(o, vb0, pa0, pa1, pa2, pa3); partialSM(pB0, pB1, m_reg, mnB, alB);
  __syncthreads(); RESC(alB);
  finishSM(pB0, pB1, alB, l_reg, pa0, pa1, pa2, pa3); SBAR();
  pv_d0(o, vb0 + (int)SHM_V, pa0, pa1, pa2, pa3);
  if (hi == 0) li_l[r32] = l_reg; asm volatile("s_waitcnt lgkmcnt(0)" ::: "memory");
  float rli[16];
#pragma unroll
  for (int r = 0; r < 16; ++r) rli[r] = __builtin_amdgcn_rcpf(li_l[crow(r, hi)]);
  bf16* Ow = Ob + (long)(wid * QBLK) * LDO;
#pragma unroll
  for (int r = 0; r < 16; ++r) { int orow = crow(r, hi);
    for (int d0 = 0; d0 < 4; ++d0) Ow[(long)orow * LDO + d0 * 32 + r32] = __float2bfloat16(o[d0][r] * rli[r]); }
#undef SLOAD
#undef SWRITE
#undef SWAIT
#undef RESC
}

constexpr float THR8 = 4.f;
using v8i = __attribute__((ext_vector_type(8))) int;
using v4i = __attribute__((ext_vector_type(4))) int;
__device__ __forceinline__ v8i cat8i(const v4i lo, const v4i hi) { return __builtin_shufflevector(lo, hi, 0, 1, 2, 3, 4, 5, 6, 7); }
__device__ __forceinline__ int pk4f8(float a, float b, float c, float d) { int w = 0; w = __builtin_amdgcn_cvt_pk_fp8_f32(a, b, w, false); w = __builtin_amdgcn_cvt_pk_fp8_f32(c, d, w, true); return w; }
__device__ __forceinline__ void partialSM8(f32x16& p0, f32x16& p1, float& m_reg, float& mn, float& alpha) {
  constexpr float C = SCALE * 1.4426950408889634f;
  float pmax = p0[0]; for (int r = 1; r < 16; ++r) pmax = fmaxf(pmax, p0[r]); for (int r = 0; r < 16; ++r) pmax = fmaxf(pmax, p1[r]);
  { auto rr = __builtin_amdgcn_permlane32_swap(__float_as_uint(pmax), __float_as_uint(pmax), false, false);
    pmax = fmaxf(__uint_as_float(rr[0]), __uint_as_float(rr[1])); }
  if (__builtin_expect(__all(pmax - m_reg <= THR8 / SCALE), 1)) { mn = m_reg; alpha = 1.f; }
  else { mn = fmaxf(m_reg, pmax); alpha = __builtin_amdgcn_exp2f((m_reg - mn) * C); m_reg = mn; }
  float mnC = -mn * C;
  for (int r = 0; r < 16; ++r) p0[r] = fmaf(p0[r], C, mnC); for (int r = 0; r < 16; ++r) p1[r] = fmaf(p1[r], C, mnC);
  for (int r = 0; r < 16; ++r) p0[r] = __builtin_amdgcn_exp2f(p0[r]);
}
__device__ __forceinline__ void finishSM8(f32x16& p0, f32x16& p1, float alpha, float& l_reg, v8i& pa) {
  for (int r = 0; r < 16; ++r) p1[r] = __builtin_amdgcn_exp2f(p1[r]);
  float ps = 0; for (int r = 0; r < 16; ++r) ps += p0[r]; for (int r = 0; r < 16; ++r) ps += p1[r];
  { auto rr = __builtin_amdgcn_permlane32_swap(__float_as_uint(ps), __float_as_uint(ps), false, false);
    ps = __uint_as_float(rr[0]) + __uint_as_float(rr[1]); }
  l_reg = l_reg * alpha + ps;
  pa[0] = pk4f8(p0[0], p0[1], p0[2], p0[3]);   pa[1] = pk4f8(p0[4], p0[5], p0[6], p0[7]);   pa[2] = pk4f8(p0[8], p0[9], p0[10], p0[11]); pa[3] = pk4f8(p0[12], p0[13], p0[14], p0[15]);
  pa[4] = pk4f8(p1[0], p1[1], p1[2], p1[3]);   pa[5] = pk4f8(p1[4], p1[5], p1[6], p1[7]);   pa[6] = pk4f8(p1[8], p1[9], p1[10], p1[11]); pa[7] = pk4f8(p1[12], p1[13], p1[14], p1[15]);
}
__device__ __forceinline__ void qkt8(f32x16& p0, f32x16& p1, const char* Ks, const v8i* qr8, int r32, int hi) {
  const int sw = r32 & 7; const char* k0 = Ks + r32 * 128; const char* k1 = Ks + (32 + r32) * 128;
#pragma unroll
  for (int s = 0; s < 2; ++s) { const int c0 = 4 * s + 2 * hi;
    const v8i a0 = cat8i(*(const v4i*)(k0 + ((c0 ^ sw) << 4)), *(const v4i*)(k0 + (((c0 + 1) ^ sw) << 4)));
    const v8i a1 = cat8i(*(const v4i*)(k1 + ((c0 ^ sw) << 4)), *(const v4i*)(k1 + (((c0 + 1) ^ sw) << 4)));
    if (s == 0) { p0 = __builtin_amdgcn_mfma_scale_f32_32x32x64_f8f6f4(a0, qr8[0], f32x16{}, 0, 0, 0, 0x7f7f7f7f, 0, 0x7f7f7f7f); p1 = __builtin_amdgcn_mfma_scale_f32_32x32x64_f8f6f4(a1, qr8[0], f32x16{}, 0, 0, 0, 0x7f7f7f7f, 0, 0x7f7f7f7f); }
    else { p0 = __builtin_amdgcn_mfma_scale_f32_32x32x64_f8f6f4(a0, qr8[1], p0, 0, 0, 0, 0x7f7f7f7f, 0, 0x7f7f7f7f); p1 = __builtin_amdgcn_mfma_scale_f32_32x32x64_f8f6f4(a1, qr8[1], p1, 0, 0, 0, 0x7f7f7f7f, 0, 0x7f7f7f7f); } }
}
__device__ __forceinline__ void pv8(f32x16* o, const char* Vs, const v8i pa, int r32, int hi) {
#pragma unroll
  for (int d0 = 0; d0 < 4; ++d0) { const int d = 32 * d0 + r32, sw = (d >> 2) & 3, c0 = 2 * hi; const char* vr = Vs + d * 64;
    const v8i b = cat8i(*(const v4i*)(vr + ((c0 ^ sw) << 4)), *(const v4i*)(vr + (((c0 + 1) ^ sw) << 4)));
    asm volatile("s_nop 4\n\tv_mfma_scale_f32_32x32x64_f8f6f4 %0, %1, %2, %0, %3, %3 op_sel_hi:[0,0,0]" : "+v"(o[d0]) : "v"(pa), "v"(b), "v"(0x7f7f7f7f)); }
}
constexpr float CQ8 = SCALE * 1.4426950408889634f * 8.f;
constexpr float THRL = 6.f;
typedef short v2s16 __attribute__((ext_vector_type(2)));
__device__ __forceinline__ int pk4s(float a, float b, float c, float d, float sc) { v2s16 w; w = __builtin_amdgcn_cvt_scalef32_pk_fp8_f32(w, a, b, sc, false); w = __builtin_amdgcn_cvt_scalef32_pk_fp8_f32(w, c, d, sc, true); return __builtin_bit_cast(int, w); }
template <bool FIRST>
__device__ __forceinline__ void partialSM10(f32x16& p0, f32x16& p1, float& Mi, float& sc, float& alpha) {
  float pmax = p0[0]; for (int r = 1; r < 16; ++r) pmax = fmaxf(pmax, p0[r]); for (int r = 0; r < 16; ++r) pmax = fmaxf(pmax, p1[r]);
  { auto rr = __builtin_amdgcn_permlane32_swap(__float_as_uint(pmax), __float_as_uint(pmax), false, false);
    pmax = fmaxf(__uint_as_float(rr[0]), __uint_as_float(rr[1])); }
  if (FIRST) { Mi = __builtin_ceilf(pmax); sc = __builtin_amdgcn_exp2f(Mi); alpha = 1.f; }
  else if (__builtin_expect(__all(pmax <= Mi + THRL), 1)) { alpha = 1.f; }
  else { const float Mn = fmaxf(Mi, __builtin_ceilf(pmax)); alpha = __builtin_amdgcn_exp2f(Mi - Mn); Mi = Mn; sc = __builtin_amdgcn_exp2f(Mi); }
  for (int r = 0; r < 16; ++r) p0[r] = __builtin_amdgcn_exp2f(p0[r]);
}
__device__ __forceinline__ void finishSM10(f32x16& p0, f32x16& p1, const float sc, v8i& pa) {
  for (int r = 0; r < 16; ++r) p1[r] = __builtin_amdgcn_exp2f(p1[r]);
  pa[0] = pk4s(p0[0], p0[1], p0[2], p0[3], sc);   pa[1] = pk4s(p0[4], p0[5], p0[6], p0[7], sc);   pa[2] = pk4s(p0[8], p0[9], p0[10], p0[11], sc); pa[3] = pk4s(p0[12], p0[13], p0[14], p0[15], sc);
  pa[4] = pk4s(p1[0], p1[1], p1[2], p1[3], sc);   pa[5] = pk4s(p1[4], p1[5], p1[6], p1[7], sc);   pa[6] = pk4s(p1[8], p1[9], p1[10], p1[11], sc); pa[7] = pk4s(p1[12], p1[13], p1[14], p1[15], sc);
}
__device__ __forceinline__ void attn8_body(const bf16* __restrict__ Qb, const unsigned char* __restrict__ K8h, const unsigned char* __restrict__ V8h,
                                           bf16* __restrict__ Ob, int seq, char* lds, const int tid) {
  const int wid = __builtin_amdgcn_readfirstlane(tid >> 6), lane = tid & 63, r32 = lane & 31, hi = lane >> 5;
  float* al_l = (float*)(lds + 65536) + wid * 32;
  f32x16 o[4] = {}, ol = {}; v8i qr8[2]; float Mi, sc;
  { const bf16* Qw = Qb + (long)(wid * QBLK + r32) * LDQ + hi * 32;
#pragma unroll
    for (int s = 0; s < 2; ++s)
#pragma unroll
      for (int q = 0; q < 4; ++q) { const bf16x8 x = *reinterpret_cast<const bf16x8*>(Qw + s * 64 + q * 8); float f[8];
#pragma unroll
        for (int i = 0; i < 8; ++i) f[i] = __uint_as_float((unsigned)(unsigned short)x[i] << 16) * CQ8;
        qr8[s][2 * q] = pk4f8(f[0], f[1], f[2], f[3]); qr8[s][2 * q + 1] = pk4f8(f[4], f[5], f[6], f[7]); } }
  typedef __attribute__((address_space(3))) unsigned lds_u32;
  const unsigned char* kg = K8h + tid * 16; const unsigned char* vg = V8h + tid * 16;
#define DMA8(t, slot) do { __builtin_amdgcn_global_load_lds((const unsigned*)(kg + (size_t)(t) * 8192), (lds_u32*)(lds + (slot) * 16384 + wid * 1024), 16, 0, 0); \
    __builtin_amdgcn_global_load_lds((const unsigned*)(vg + (size_t)(t) * 8192), (lds_u32*)(lds + (slot) * 16384 + 8192 + wid * 1024), 16, 0, 0); } while (0)
  const int ksw = (r32 >> 1) & 7, vsw = (r32 >> 2) & 3;
  const int kc0 = r32 * 128 + (((2 * hi) ^ ksw) << 4), kc1 = r32 * 128 + (((2 * hi + 1) ^ ksw) << 4), kc2 = r32 * 128 + (((4 + 2 * hi) ^ ksw) << 4), kc3 = r32 * 128 + (((5 + 2 * hi) ^ ksw) << 4);
  const int vc0 = 8192 + r32 * 64 + (((2 * hi) ^ vsw) << 4), vc1 = 8192 + r32 * 64 + (((2 * hi + 1) ^ vsw) << 4);
  v8i ones8; for (int i = 0; i < 8; ++i) ones8[i] = 0x38383838;
#define LDK(S) do { const char* kb_ = lds + (S) * 16384; ka0 = cat8i(*(const v4i*)(kb_ + kc0), *(const v4i*)(kb_ + kc1)); ka1 = cat8i(*(const v4i*)(kb_ + 4096 + kc0), *(const v4i*)(kb_ + 4096 + kc1)); \
    kb0 = cat8i(*(const v4i*)(kb_ + kc2), *(const v4i*)(kb_ + kc3)); kb1 = cat8i(*(const v4i*)(kb_ + 4096 + kc2), *(const v4i*)(kb_ + 4096 + kc3)); } while (0)
#define LDV(S) do { const char* vb_ = lds + (S) * 16384; vf0 = cat8i(*(const v4i*)(vb_ + vc0), *(const v4i*)(vb_ + vc1)); vf1 = cat8i(*(const v4i*)(vb_ + 2048 + vc0), *(const v4i*)(vb_ + 2048 + vc1)); \
    vf2 = cat8i(*(const v4i*)(vb_ + 4096 + vc0), *(const v4i*)(vb_ + 4096 + vc1)); vf3 = cat8i(*(const v4i*)(vb_ + 6144 + vc0), *(const v4i*)(vb_ + 6144 + vc1)); } while (0)
#define QKT(P0, P1) do { P0 = __builtin_amdgcn_mfma_scale_f32_32x32x64_f8f6f4(ka0, qr8[0], f32x16{}, 0, 0, 0, 0x7f7f7f7f, 0, 0x7c7c7c7c); P1 = __builtin_amdgcn_mfma_scale_f32_32x32x64_f8f6f4(ka1, qr8[0], f32x16{}, 0, 0, 0, 0x7f7f7f7f, 0, 0x7c7c7c7c); \
    P0 = __builtin_amdgcn_mfma_scale_f32_32x32x64_f8f6f4(kb0, qr8[1], P0, 0, 0, 0, 0x7f7f7f7f, 0, 0x7c7c7c7c); P1 = __builtin_amdgcn_mfma_scale_f32_32x32x64_f8f6f4(kb1, qr8[1], P1, 0, 0, 0, 0x7f7f7f7f, 0, 0x7c7c7c7c); } while (0)
#define PVM(OD, VF) asm volatile("s_nop 4\n\tv_mfma_scale_f32_32x32x64_f8f6f4 %0, %1, %2, %0, %3, %3 op_sel_hi:[0,0,0]" : "+v"(OD) : "v"(pa), "v"(VF), "v"(0x7f7f7f7f))
#define PV() do { PVM(o[0], vf0); PVM(o[1], vf1); PVM(o[2], vf2); PVM(o[3], vf3); PVM(ol, ones8); } while (0)
#define RESC(a) do { if (__any((a) < 1.f)) { if (hi == 0) al_l[r32] = (a); asm volatile("s_nop 15\n\ts_nop 15\n\ts_nop 15\n\ts_nop 15\n\ts_nop 15\n\ts_waitcnt lgkmcnt(0)" ::: "memory"); \
    for (int r = 0; r < 16; ++r) { const float al_ = al_l[crow(r, hi)]; for (int d = 0; d < 4; ++d) o[d][r] *= al_; ol[r] *= al_; } } } while (0)
#define TILE(j, PC0, PC1, alC, PP0, PP1, LASTW, DODMA) do { \
    if (LASTW) asm volatile("s_waitcnt vmcnt(0)" ::: "memory"); else asm volatile("s_waitcnt vmcnt(2)" ::: "memory"); \
    __builtin_amdgcn_s_barrier(); asm volatile("" ::: "memory"); if (DODMA) DMA8((j) + 2, ((j) + 2) & 3); \
    SBAR(); LDK((j) & 3); SBAR(); \
    QKT(PC0, PC1); finishSM10(PP0, PP1, sc, pa); SBAR(); LDV(((j) - 1) & 3); SBAR(); \
    PV(); partialSM10<false>(PC0, PC1, Mi, sc, alC); SBAR(); \
    RESC(alC); } while (0)
  f32x16 pA0, pA1, pB0, pB1; float alA, alB; v8i pa, ka0, ka1, kb0, kb1, vf0, vf1, vf2, vf3; const int NT = seq / KVBLK;
  DMA8(0, 0); DMA8(1, 1);
  asm volatile("s_waitcnt vmcnt(2)" ::: "memory"); __builtin_amdgcn_s_barrier(); asm volatile("" ::: "memory"); DMA8(2, 2);
  SBAR(); LDK(0); SBAR(); QKT(pA0, pA1); partialSM10<true>(pA0, pA1, Mi, sc, alA); SBAR();
  for (int j = 1; j + 1 < NT; j += 2) {
    TILE(j, pB0, pB1, alB, pA0, pA1, false, true);
    TILE(j + 1, pA0, pA1, alA, pB0, pB1, false, (j + 3 < NT));
  }
  TILE(NT - 1, pB0, pB1, alB, pA0, pA1, true, false);
  finishSM10(pB0, pB1, sc, pa); SBAR(); LDV((NT - 1) & 3); SBAR();
  PV();
  asm volatile("s_nop 15\n\ts_nop 15\n\ts_nop 15\n\ts_nop 15\n\ts_nop 15" : "+v"(o[0]), "+v"(o[1]), "+v"(o[2]), "+v"(o[3]), "+v"(ol));
  bf16* Ow = Ob + (long)(wid * QBLK) * LDO;
#pragma unroll
  for (int r = 0; r < 16; ++r) { const int orow = crow(r, hi); const float rli = __builtin_amdgcn_rcpf(ol[r]);
    for (int d0 = 0; d0 < 4; ++d0) Ow[(long)orow * LDO + d0 * 32 + r32] = __float2bfloat16(o[d0][r] * rli); }
#undef DMA8
#undef LDK
#undef LDV
#undef QKT
#undef PVM
#undef PV
#undef RESC
#undef TILE
}

#undef KSWZ
#undef SBAR
}
#define GAS __attribute__((address_space(1)))
#define LAS __attribute__((address_space(3)))
typedef unsigned short bf16;
typedef unsigned v4u __attribute__((ext_vector_type(4)));
typedef float f32x4 __attribute__((ext_vector_type(4)));
typedef short bf16x8 __attribute__((ext_vector_type(8)));
typedef GAS unsigned gu32;
typedef GAS unsigned long long gu64;
#define RLX_AGENT __ATOMIC_RELAXED, __HIP_MEMORY_SCOPE_AGENT
#define LDS_WAIT() asm volatile("s_waitcnt lgkmcnt(0)" ::: "memory")
#define VM_WAIT() asm volatile("s_waitcnt vmcnt(0)" ::: "memory")
__device__ __forceinline__ unsigned long long rt() { return __builtin_amdgcn_s_memrealtime(); }
__device__ __forceinline__ unsigned f2bf(float f) { unsigned u = __builtin_bit_cast(unsigned, f); return (u + 0x7fffu + ((u >> 16) & 1u)) >> 16; }
__device__ __forceinline__ unsigned pk2(float lo, float hi) { return f2bf(lo) | (f2bf(hi) << 16); }

#define XB_TMO      128
#define XB_XCNT(j)  (256  + 64 * (j))
#define XB_XSUB(j)  (1280 + 64 * (j))
#define XB_XGEN(j)  (2304 + 64 * (j))
#define XB_TOP      3328
#define XB_TOPGEN   3392
#define XCD_BAR_WORDS 3456
#define XB_SPIN_CAP (1u << 18)

__device__ __forceinline__ unsigned xb_ld(unsigned* p)              { return __hip_atomic_load(p, __ATOMIC_RELAXED, __HIP_MEMORY_SCOPE_AGENT); }
__device__ __forceinline__ unsigned xb_add(unsigned* p, unsigned v) { return __hip_atomic_fetch_add(p, v, __ATOMIC_RELAXED, __HIP_MEMORY_SCOPE_AGENT); }
__device__ __forceinline__ unsigned xb_xcc_id() { return (unsigned)__builtin_amdgcn_s_getreg((3 << 11) | 20) & 0xFu; }
#define XB_SPIN(cond, bar) do { unsigned _sp = 0; while (cond) { __builtin_amdgcn_s_sleep(1); \
    if ((++_sp & 255u) == 0u) { if (xb_ld(&(bar)[XB_TMO])) break; if (_sp > XB_SPIN_CAP) { atomicAdd(&(bar)[XB_TMO], 1u); break; } } } } while (0)

struct XcdBarrier {
    unsigned* bar; unsigned x;
    volatile LAS unsigned* st;
};

__device__ __forceinline__ XcdBarrier xcd_barrier_post(unsigned* bar, volatile LAS unsigned* st) {
    XcdBarrier b; b.bar = bar; b.x = xb_xcc_id(); b.st = st;
    if (threadIdx.x == 0) (void)xb_add(&bar[XB_XCNT(b.x)], 1u);
    return b;
}
__device__ __forceinline__ void xcd_barrier_complete(unsigned* bar, unsigned x, unsigned& nloc, unsigned& nx) {
    const unsigned G = gridDim.x * gridDim.y * gridDim.z;
    unsigned sum, cnt, mine, sp = 0u;
    for (;;) {
        sum = 0u; cnt = 0u; mine = 0u;
#pragma unroll
        for (unsigned j = 0; j < 16; ++j) { const unsigned c = xb_ld(&bar[XB_XCNT(j)]); sum += c; cnt += (c > 0u) ? 1u : 0u; mine = (j == x) ? c : mine; }
        if (sum == G) break;
        __builtin_amdgcn_s_sleep(1);
        if ((++sp & 255u) == 0u) { if (xb_ld(&bar[XB_TMO])) break; if (sp > XB_SPIN_CAP) { atomicAdd(&bar[XB_TMO], 1u); break; } }
    }
    nloc = mine > 0u ? mine : 1u; nx = cnt > 0u ? cnt : 1u;
}

__device__ __forceinline__ void xcd_barrier(const XcdBarrier& b, const int tid_) {
    asm volatile("s_waitcnt vmcnt(0)" ::: "memory");
    __syncthreads();
    if (tid_ == 0) {
        unsigned* bar = b.bar;
        __builtin_amdgcn_s_waitcnt(0);
        unsigned nloc = b.st[0], nx = b.st[1];
        if (nloc == 0u) { xcd_barrier_complete(bar, b.x, nloc, nx); b.st[0] = nloc; b.st[1] = nx; }
        const unsigned old = xb_add(&bar[XB_XSUB(b.x)], 1u);
        const unsigned gen = old / nloc;
        if (old + 1u == (gen + 1u) * nloc) {
            __builtin_amdgcn_fence(__ATOMIC_RELEASE, "agent");
            asm volatile("s_waitcnt vmcnt(0)" ::: "memory");
            const unsigned og = xb_add(&bar[XB_TOP], 1u);
            const unsigned tg = og / nx;
            if (og + 1u == (tg + 1u) * nx) xb_add(&bar[XB_TOPGEN], 1u);
            else XB_SPIN(xb_ld(&bar[XB_TOPGEN]) == tg, bar);
            __builtin_amdgcn_fence(__ATOMIC_ACQUIRE, "agent");
            xb_add(&bar[XB_XGEN(b.x)], 1u);
            asm volatile("s_waitcnt vmcnt(0)" ::: "memory");
        } else {
            XB_SPIN(xb_ld(&bar[XB_XGEN(b.x)]) == gen, bar);
            __builtin_amdgcn_fence(__ATOMIC_ACQUIRE, "agent");
            asm volatile("s_waitcnt vmcnt(0)" ::: "memory");
        }
    }
    __syncthreads();
}


constexpr size_t MiB = 1u << 20;
constexpr size_t WS_CTL = 0, CTL_ZERO_BYTES = 64 * 1024;
constexpr size_t WS_AFF = 1 * MiB;
constexpr size_t WS_COS = 2 * MiB, WS_SIN = 4 * MiB;
constexpr size_t WS_IDX = 6 * MiB, WS_GATE = 6 * MiB + 256 * 1024, WS_SEL = 7 * MiB;
constexpr size_t WS_WIN = 8 * MiB;
constexpr size_t WS_WR = 18 * MiB, WS_WA = 19 * MiB, WS_WO = 20 * MiB;
constexpr size_t WS_W1C = 22 * MiB;
constexpr size_t WS_WD = 198 * MiB;
constexpr size_t WS_X1 = 286 * MiB;
constexpr size_t WS_H = 350 * MiB;
constexpr size_t WS_RQ = 382 * MiB, WS_RK = 398 * MiB, WS_RV = 414 * MiB, WS_RGS = 430 * MiB;
constexpr size_t WS_AQ = 446 * MiB, WS_AK = 462 * MiB, WS_AV = 470 * MiB;
constexpr size_t WS_GRS = 478 * MiB, WS_GAS = 510 * MiB;
constexpr size_t WS_KV = 542 * MiB;
constexpr size_t WS_S = 606 * MiB;
constexpr size_t WS_YRIN = 638 * MiB, WS_ATT = 654 * MiB;
constexpr size_t WS_MIXED = 670 * MiB;
constexpr size_t WS_XE = 382 * MiB, WS_ACT = 446 * MiB, WS_Y = 622 * MiB;
constexpr size_t WS_K8 = 244 * MiB, WS_VT8 = 248 * MiB;
constexpr size_t WS_END = 704 * MiB;
static_assert(EP_COS == WS_COS && EP_SIN == WS_SIN && EP_RQ == WS_RQ && EP_RK == WS_RK && EP_RV == WS_RV && EP_RGS == WS_RGS && EP_AQ == WS_AQ && EP_AK == WS_AK && EP_AV == WS_AV && EP_GRS == WS_GRS && EP_GAS == WS_GAS, "epilogue offsets vs d_ws map");
constexpr int CW_BAR = 4096;

constexpr int RING_OFF = 0, RING_BYTES = 131072;
constexpr int LDSCTL_OFF = RING_BYTES, MISC_OFF = LDSCTL_OFF + 320;
constexpr int XCH_OFF = RING_BYTES + 1024;
constexpr int LDS_BYTES = 147456;
constexpr int NWAVES = 8;

__device__ __forceinline__ float wave_sum(float v) {
#pragma unroll
    for (int o = 1; o < 64; o <<= 1) v += __shfl_xor(v, o);
    return v;
}
__device__ __forceinline__ float bf2f(bf16 v) { return __uint_as_float((unsigned)v << 16); }

template <class CM>
__device__ __forceinline__ void transpose_item(const float* W, int K, int N, bf16* WT, const CM cm, LAS float* scr, int kb, int nb, int lane) {
    const int k0 = 64 * kb, n0 = 32 * nb;
    const int srccol = cm(n0 + (lane & 31));
    float tv[32];
#pragma unroll
    for (int i = 0; i < 32; ++i) tv[i] = __builtin_nontemporal_load(W + (size_t)(k0 + 2 * i + (lane >> 5)) * N + srccol);
#pragma unroll
    for (int i = 0; i < 32; ++i) scr[(2 * i + (lane >> 5)) * 33 + (lane & 31)] = tv[i];
    LDS_WAIT(); asm volatile("" ::: "memory");
    const int c = lane & 7;
#pragma unroll
    for (int j = 0; j < 4; ++j) { const int n = (lane >> 3) + 8 * j; const LAS float* s = scr + (8 * c) * 33 + n;
        v4u o; o.x = pk2(s[0 * 33], s[1 * 33]); o.y = pk2(s[2 * 33], s[3 * 33]); o.z = pk2(s[4 * 33], s[5 * 33]); o.w = pk2(s[6 * 33], s[7 * 33]);
        __builtin_nontemporal_store(o, (GAS v4u*)(WT + (size_t)(n0 + n) * K + k0 + 8 * c)); }
    LDS_WAIT(); asm volatile("" ::: "memory");
}
__device__ __forceinline__ unsigned pk4_fp8(float a, float b, float c, float d) { int w = 0; w = __builtin_amdgcn_cvt_pk_fp8_f32(a, b, w, false); w = __builtin_amdgcn_cvt_pk_fp8_f32(c, d, w, true); return (unsigned)w; }
template <class CM>
__device__ __forceinline__ void transpose_item_f8(const float* W, int K, int N, unsigned char* WT, const CM cm, LAS float* scr, int kb, int nb, int lane, float scale) {
    const int k0 = 64 * kb, n0 = 32 * nb;
    const int srccol = cm(n0 + (lane & 31));
    float tv[32];
#pragma unroll
    for (int i = 0; i < 32; ++i) tv[i] = __builtin_nontemporal_load(W + (size_t)(k0 + 2 * i + (lane >> 5)) * N + srccol);
#pragma unroll
    for (int i = 0; i < 32; ++i) scr[(2 * i + (lane >> 5)) * 33 + (lane & 31)] = tv[i];
    LDS_WAIT(); asm volatile("" ::: "memory");
    const int c = lane & 7;
#pragma unroll
    for (int j = 0; j < 4; ++j) { const int n = (lane >> 3) + 8 * j; const LAS float* sp = scr + (8 * c) * 33 + n;
        const unsigned lo = pk4_fp8(sp[0 * 33] * scale, sp[1 * 33] * scale, sp[2 * 33] * scale, sp[3 * 33] * scale), hi = pk4_fp8(sp[4 * 33] * scale, sp[5 * 33] * scale, sp[6 * 33] * scale, sp[7 * 33] * scale);
        __builtin_nontemporal_store((unsigned long long)lo | ((unsigned long long)hi << 32), (GAS unsigned long long*)(WT + (size_t)(n0 + n) * K + k0 + 8 * c)); }
    LDS_WAIT(); asm volatile("" ::: "memory");
}
struct CmId { __device__ __forceinline__ int operator()(int n) const { return n; } };
struct CmWin {
    __device__ __forceinline__ int operator()(int n) const {
        const bool rope = (n < 1024) || (n >= 2048 && n < 2816);
        const int L = n & 127, g = L >> 3, i = L & 7, o = (i < 4) ? (4 * g + i) : (64 + 4 * g + (i - 4));
        return rope ? ((n & ~127) + o) : n; }
};
struct CmW1 { __device__ __forceinline__ int operator()(int n) const { return 128 * (n >> 8) + (n & 127); } };

__device__ __forceinline__ void rms_row_to_bf16(const float* xrow, const float* gain, bf16* orow, int lane) {
    const GAS f32x4* xr = (const GAS f32x4*)xrow + lane; const GAS f32x4* gr = (const GAS f32x4*)gain + lane;
    f32x4 v[4]; float s = 0.f;
#pragma unroll
    for (int j = 0; j < 4; ++j) { v[j] = xr[64 * j]; s += (v[j].x * v[j].x + v[j].y * v[j].y) + (v[j].z * v[j].z + v[j].w * v[j].w); }
    const float rstd = 1.f / sqrtf(wave_sum(s) * (1.f / D_MODEL) + EPS);
    GAS unsigned long long* o8 = (GAS unsigned long long*)orow + lane;
#pragma unroll
    for (int j = 0; j < 4; ++j) { const f32x4 g4 = gr[64 * j]; o8[64 * j] = (unsigned long long)pk2(v[j].x * rstd * g4.x, v[j].y * rstd * g4.y) | ((unsigned long long)pk2(v[j].z * rstd * g4.z, v[j].w * rstd * g4.w) << 32); }
}


namespace ret {
typedef short bf16x8 __attribute__((ext_vector_type(8)));
typedef short v4i16 __attribute__((ext_vector_type(4)));
constexpr int PITCH = 272;
constexpr int TILE_B = 128 * PITCH;
constexpr int STRIP_B = 16 * PITCH;
__device__ __forceinline__ float lg2_of(const float* p, int h) { return log1pf(-expf(p[h])) * 1.4426950408889634f; }
__device__ __forceinline__ unsigned cvt2(float lo, float hi) { typedef float f2 __attribute__((ext_vector_type(2))); typedef __bf16 b2 __attribute__((ext_vector_type(2))); f2 v = {lo, hi}; b2 b = __builtin_convertvector(v, b2); return __builtin_bit_cast(unsigned, b); }
__device__ __forceinline__ bf16x8 frag_tr(LAS const unsigned char* tile, int k0, int n0, int lane) {
    const int g = lane >> 4, q = (lane >> 2) & 3, p = lane & 3;
    LAS const unsigned char* a = tile + (k0 + 8 * g + q) * PITCH + (n0 + 4 * p) * 2;
    const v4i16 lo = __builtin_amdgcn_ds_read_tr16_b64_v4i16((LAS v4i16*)a);
    const v4i16 hi = __builtin_amdgcn_ds_read_tr16_b64_v4i16((LAS v4i16*)(a + 4 * PITCH));
    return (bf16x8){lo[0], lo[1], lo[2], lo[3], hi[0], hi[1], hi[2], hi[3]};
}
__device__ __forceinline__ bf16x8 frag_row(LAS const unsigned char* tile, int r0, int k0, int lane) { return *(LAS const bf16x8*)(tile + (r0 + (lane & 15)) * PITCH + (k0 + 8 * (lane >> 4)) * 2); }
__device__ __forceinline__ void stage_tile(LAS unsigned char* tile, const bf16* src, long tok0, int h, int tid) {
#pragma unroll
    for (int i = 0; i < 4; ++i) { const int q = tid + 512 * i, row = q >> 4, ch = q & 15;
        const v4u v = *(const GAS v4u*)(src + (tok0 + row) * 512 + h * HD + ch * 8); *(LAS v4u*)(tile + row * PITCH + ch * 16) = v; }
}
__device__ __forceinline__ void kv_item(int item, LAS unsigned char* lds, const bf16* rk, const bf16* rv, const float* pf, const float* pb, float* kv, int tid) {
    asm volatile("" : "+v"(tid));
    const int c = item & 63, bh = item >> 6, b = bh >> 2, h = bh & 3, lane = tid & 63, w = tid >> 6, g = lane >> 4;
    const long tok0 = (long)b * SEQ + (long)c * CHUNK;
    LAS unsigned char* Kl = lds; LAS unsigned char* Vl = lds + TILE_B;
    stage_tile(Kl, rk, tok0, h, tid); stage_tile(Vl, rv, tok0, h, tid);
    __syncthreads();
    const float lf = lg2_of(pf, h), lb = lg2_of(pb, h);
    f32x4 accf[8], accb[8];
#pragma unroll
    for (int n = 0; n < 8; ++n) { accf[n] = (f32x4){0.f, 0.f, 0.f, 0.f}; accb[n] = (f32x4){0.f, 0.f, 0.f, 0.f}; }
#pragma unroll
    for (int kk = 0; kk < 4; ++kk) {
        const bf16x8 a = frag_tr(Vl, 32 * kk, 16 * w, lane);
        bf16x8 af, ab;
        { unsigned pf_[4], pb_[4];
#pragma unroll
          for (int t = 0; t < 8; t += 2) { const int j = 32 * kk + 8 * g + t;
              const float v0 = __uint_as_float((unsigned)(unsigned short)a[t] << 16), v1 = __uint_as_float((unsigned)(unsigned short)a[t + 1] << 16);
              pf_[t >> 1] = cvt2(v0 * __builtin_amdgcn_exp2f(lf * (float)(127 - j)), v1 * __builtin_amdgcn_exp2f(lf * (float)(126 - j)));
              pb_[t >> 1] = cvt2(v0 * __builtin_amdgcn_exp2f(lb * (float)j), v1 * __builtin_amdgcn_exp2f(lb * (float)(j + 1))); }
          const v4u wf_ = {pf_[0], pf_[1], pf_[2], pf_[3]}, wb_ = {pb_[0], pb_[1], pb_[2], pb_[3]};
          af = __builtin_bit_cast(bf16x8, wf_); ab = __builtin_bit_cast(bf16x8, wb_); }
#pragma unroll
        for (int n = 0; n < 8; ++n) { const bf16x8 bk = frag_tr(Kl, 32 * kk, 16 * n, lane);
            accf[n] = __builtin_amdgcn_mfma_f32_16x16x32_bf16(af, bk, accf[n], 0, 0, 0); accb[n] = __builtin_amdgcn_mfma_f32_16x16x32_bf16(ab, bk, accb[n], 0, 0, 0); }
    }
    float* of = kv + (((long)0 * 8 + bh) * NCHUNK + c) * (HD * HD); float* ob = kv + (((long)1 * 8 + bh) * NCHUNK + c) * (HD * HD);
#pragma unroll
    for (int n = 0; n < 8; ++n)
#pragma unroll
        for (int r = 0; r < 4; ++r) { const int o = (16 * w + 4 * g + r) * HD + 16 * n + (lane & 15); of[o] = accf[n][r]; ob[o] = accb[n][r]; }
    __syncthreads();
}
__device__ __forceinline__ void scan_thread(long gid, const float* pf, const float* pb, const float* kv, bf16* S) {
    const int el = (int)(gid & 16383), bh = (int)((gid >> 14) & 7), dir = (int)(gid >> 17), h = bh & 3;
    const float gC = __builtin_amdgcn_exp2f(lg2_of(dir ? pb : pf, h) * (float)CHUNK);
    const float* p = kv + (((long)dir * 8 + bh) * NCHUNK) * (HD * HD) + el; bf16* o = S + (((long)dir * 8 + bh) * NCHUNK) * (HD * HD) + el;
    float st = 0.f;
    if (dir == 0) {
#pragma unroll 8
        for (int c = 0; c < NCHUNK; ++c) { const float v = p[(long)c * HD * HD]; o[(long)c * HD * HD] = (bf16)f2bf(st); st = st * gC + v; } }
    else {
#pragma unroll 8
        for (int c = NCHUNK - 1; c >= 0; --c) { const float v = p[(long)c * HD * HD]; o[(long)c * HD * HD] = (bf16)f2bf(st); st = st * gC + v; } }
}
__device__ __forceinline__ void out_item(int item, LAS unsigned char* lds, const bf16* rq, const bf16* rk, const bf16* rv, const bf16* rgs, const float* pf, const float* pb,
                                         const bf16* S, const float* gain, bf16* yrin, int tid) {
    asm volatile("" : "+v"(tid));
    const int c = item & 63, bh = item >> 6, b = bh >> 2, h = bh & 3, lane = tid & 63, w = tid >> 6, g = lane >> 4, lc = lane & 15;
    const long tok0 = (long)b * SEQ + (long)c * CHUNK;
    LAS unsigned char* Kl = lds; LAS unsigned char* Vl = lds + TILE_B; LAS unsigned char* strip = lds + 2 * TILE_B + w * STRIP_B;
    stage_tile(Kl, rk, tok0, h, tid); stage_tile(Vl, rv, tok0, h, tid);
    bf16x8 qa[4];
#pragma unroll
    for (int kk = 0; kk < 4; ++kk) qa[kk] = *(const GAS bf16x8*)(rq + (tok0 + 16 * w + lc) * 512 + h * HD + 32 * kk + 8 * g);
    __syncthreads();
    const float lf = lg2_of(pf, h), lb = lg2_of(pb, h);
    {
        f32x4 sc[8];
#pragma unroll
        for (int n = 0; n < 8; ++n) { sc[n] = (f32x4){0.f, 0.f, 0.f, 0.f};
#pragma unroll
            for (int kk = 0; kk < 4; ++kk) sc[n] = __builtin_amdgcn_mfma_f32_16x16x32_bf16(qa[kk], frag_row(Kl, 16 * n, 32 * kk, lane), sc[n], 0, 0, 0); }
#pragma unroll
        for (int n = 0; n < 8; ++n)
#pragma unroll
            for (int r = 0; r < 4; ++r) { const int i = 16 * w + 4 * g + r, j = 16 * n + lc; const int df = i - j;
                const float dec = __builtin_amdgcn_exp2f(df >= 0 ? lf * (float)df : lb * (float)(-df));
                *(LAS unsigned short*)(strip + (4 * g + r) * PITCH + j * 2) = (unsigned short)f2bf(sc[n][r] * dec); }
    }
    asm volatile("s_waitcnt lgkmcnt(0)" ::: "memory");
    bf16x8 qf[4], qb[4];
    { const int ia = 16 * w + lc; const float cf = __builtin_amdgcn_exp2f(lf * (float)(ia + 1)), cb = __builtin_amdgcn_exp2f(lb * (float)(CHUNK - ia));
#pragma unroll
      for (int kk = 0; kk < 4; ++kk) { unsigned pf_[4], pb_[4];
#pragma unroll
          for (int t = 0; t < 8; t += 2) { const float v0 = __uint_as_float((unsigned)(unsigned short)qa[kk][t] << 16), v1 = __uint_as_float((unsigned)(unsigned short)qa[kk][t + 1] << 16);
              pf_[t >> 1] = cvt2(v0 * cf, v1 * cf); pb_[t >> 1] = cvt2(v0 * cb, v1 * cb); }
          const v4u wf_ = {pf_[0], pf_[1], pf_[2], pf_[3]}, wb_ = {pb_[0], pb_[1], pb_[2], pb_[3]};
          qf[kk] = __builtin_bit_cast(bf16x8, wf_); qb[kk] = __builtin_bit_cast(bf16x8, wb_); } }
    f32x4 o[8];
#pragma unroll
    for (int n = 0; n < 8; ++n) o[n] = (f32x4){0.f, 0.f, 0.f, 0.f};
    const bf16* Sf = S + (((long)0 * 8 + bh) * NCHUNK + c) * (HD * HD); const bf16* Sb = S + (((long)1 * 8 + bh) * NCHUNK + c) * (HD * HD);
#pragma unroll
    for (int kh = 0; kh < 2; ++kh) {
        bf16x8 bfv[2][8], bbv[2][8];
#pragma unroll
        for (int k2 = 0; k2 < 2; ++k2)
#pragma unroll
            for (int n = 0; n < 8; ++n) { const int kk = 2 * kh + k2; bfv[k2][n] = *(const GAS bf16x8*)(Sf + (16 * n + lc) * HD + 32 * kk + 8 * g); bbv[k2][n] = *(const GAS bf16x8*)(Sb + (16 * n + lc) * HD + 32 * kk + 8 * g); }
#pragma unroll
        for (int k2 = 0; k2 < 2; ++k2) { const int kk = 2 * kh + k2;
            const bf16x8 sa = frag_row(strip, 0, 32 * kk, lane);
#pragma unroll
            for (int n = 0; n < 8; ++n) {
                o[n] = __builtin_amdgcn_mfma_f32_16x16x32_bf16(sa, frag_tr(Vl, 32 * kk, 16 * n, lane), o[n], 0, 0, 0);
                o[n] = __builtin_amdgcn_mfma_f32_16x16x32_bf16(qf[kk], bfv[k2][n], o[n], 0, 0, 0); o[n] = __builtin_amdgcn_mfma_f32_16x16x32_bf16(qb[kk], bbv[k2][n], o[n], 0, 0, 0); } }
        asm volatile("" ::: "memory");
    }
    asm volatile("s_waitcnt lgkmcnt(0)" ::: "memory");
#pragma unroll
    for (int r = 0; r < 4; ++r) {
        float y[8]; float s = 0.f;
#pragma unroll
        for (int n = 0; n < 8; ++n) { y[n] = o[n][r]; s += y[n]; }
        s += __shfl_xor(s, 1); s += __shfl_xor(s, 2); s += __shfl_xor(s, 4); s += __shfl_xor(s, 8);
        const float mu = s * (1.0f / HD); float s2 = 0.f;
#pragma unroll
        for (int n = 0; n < 8; ++n) { y[n] -= mu; s2 += y[n] * y[n]; }
        s2 += __shfl_xor(s2, 1); s2 += __shfl_xor(s2, 2); s2 += __shfl_xor(s2, 4); s2 += __shfl_xor(s2, 8);
        const float rstd = 1.0f / sqrtf(s2 * (1.0f / HD) + EPS);
#pragma unroll
        for (int n = 0; n < 8; ++n) *(LAS unsigned short*)(strip + (4 * g + r) * PITCH + (16 * n + lc) * 2) = (unsigned short)f2bf(y[n] * rstd); }
    asm volatile("s_waitcnt lgkmcnt(0)" ::: "memory");
    { const int row = lane >> 2, qc = lane & 3; const long ro = (tok0 + 16 * w + row) * 512 + h * HD;
#pragma unroll
      for (int t = 0; t < 4; ++t) { const int e0 = 32 * qc + 8 * t;
          const v4u yv = *(LAS const v4u*)(strip + row * PITCH + e0 * 2);
          const f32x4 y0 = {__uint_as_float(yv.x << 16), __uint_as_float(yv.x & 0xffff0000u), __uint_as_float(yv.y << 16), __uint_as_float(yv.y & 0xffff0000u)};
          const f32x4 y1 = {__uint_as_float(yv.z << 16), __uint_as_float(yv.z & 0xffff0000u), __uint_as_float(yv.w << 16), __uint_as_float(yv.w & 0xffff0000u)};
          const f32x4 g0 = *(const GAS f32x4*)(gain + h * HD + e0), g1 = *(const GAS f32x4*)(gain + h * HD + e0 + 4);
          const v4u rg = *(const GAS v4u*)(rgs + ro + e0);
          const f32x4 r0 = {__uint_as_float(rg.x << 16), __uint_as_float(rg.x & 0xffff0000u), __uint_as_float(rg.y << 16), __uint_as_float(rg.y & 0xffff0000u)};
          const f32x4 r1 = {__uint_as_float(rg.z << 16), __uint_as_float(rg.z & 0xffff0000u), __uint_as_float(rg.w << 16), __uint_as_float(rg.w & 0xffff0000u)};
          const f32x4 a0 = y0 * g0 * r0, a1 = y1 * g1 * r1;
          v4u ov; ov.x = cvt2(a0[0], a0[1]); ov.y = cvt2(a0[2], a0[3]); ov.z = cvt2(a1[0], a1[1]); ov.w = cvt2(a1[2], a1[3]);
          *(GAS v4u*)(yrin + ro + e0) = ov; } }
    __syncthreads();
}
}

constexpr int W1_ITEMS = 16 * (16 * 176), W1_EARLY = (W1_ITEMS * MK_W1_EARLY_PCT) / 100;
struct Args { const float* in[17]; float* out; unsigned char* ws; int ph_lo, ph_hi; };
constexpr int PH_PROLOGUE = 0, PH_PROJ = 1, PH_RETKV = 2, PH_ATTN = 3, PH_RETOUT = 4, PH_BRANCH = 5, PH_WO = 6, PH_ROUTER = 7, PH_TOPK = 8, PH_GATHER = 9, PH_MOE1 = 10, PH_MOE2 = 11, PH_FINAL = 12, PH_END = 13;
#ifndef MK_EXPERT_CVT
#define MK_EXPERT_CVT 1
#endif

__global__ void __launch_bounds__(NWAVES * 64, 2) mega(Args args) {
    extern __shared__ __attribute__((aligned(16))) unsigned char lds_raw[];
    LAS unsigned char* lds = (LAS unsigned char*)lds_raw;
    volatile LAS unsigned* MISC = (volatile LAS unsigned*)(lds + MISC_OFF);
    const int wave = __builtin_amdgcn_readfirstlane((int)threadIdx.x >> 6);
#define PHASE_IDS int lane; asm volatile("v_mbcnt_lo_u32_b32 %0, -1, 0\n\tv_mbcnt_hi_u32_b32 %0, -1, %0" : "=v"(lane)); const int tid = wave * 64 + lane; (void)tid;
    const int G = gridDim.x; const int bx = blockIdx.x; const int vcu = (G % 8 == 0) ? (bx % 8) * (G / 8) + bx / 8 : bx;
    unsigned char* ws = args.ws;
    gu32* ctl = (gu32*)(ws + WS_CTL);
    for (int u = threadIdx.x; u < (LDS_BYTES - LDSCTL_OFF) / 4; u += NWAVES * 64) ((LAS unsigned*)(lds + LDSCTL_OFF))[u] = 0u;
    __syncthreads();
    const bool one_launch = (args.ph_hi - args.ph_lo) > 1;
    XcdBarrier bar; bar.bar = (unsigned*)(ctl + CW_BAR); bar.x = 0; bar.st = nullptr;
    if (one_launch) bar = xcd_barrier_post((unsigned*)(ctl + CW_BAR), MISC + 8);
    const int lo = args.ph_lo, hi = args.ph_hi;
#define IN(k) (lo <= (k) && (k) < hi)
#define SEAM(k) do { if (IN(k) && IN((k) + 1)) { PHASE_IDS xcd_barrier(bar, tid); } } while (0)
    const int gw = vcu * NWAVES + wave, NGW = G * NWAVES;

    if (IN(PH_PROLOGUE)) { PHASE_IDS
        LAS float* scr = (LAS float*)(lds + RING_OFF + wave * 16384);
        const float* w_in = args.in[2]; const float* w_ret = args.in[6]; const float* w_att = args.in[9]; const float* w_o = args.in[10];
        const float* wg = args.in[13]; const float* wu = args.in[14];
        constexpr int I_IN = 16 * 160, I_R = 8 * 32, I_A = 8 * 32, I_O = 16 * 32, I_1 = 16 * 176;
        constexpr int NSMALL = I_IN + I_R + I_A + I_O;
        const int NITEMS = NSMALL + W1_EARLY;
        for (int it = gw; it < NITEMS; it += NGW) {
            int r = it;
            if (r < I_IN) { transpose_item(w_in, 1024, INW, (bf16*)(ws + WS_WIN), CmWin(), scr, r / 160, r % 160, lane); continue; } r -= I_IN;
            if (r < I_R) { transpose_item(w_ret, 512, D_MODEL, (bf16*)(ws + WS_WR), CmId(), scr, r / 32, r % 32, lane); continue; } r -= I_R;
            if (r < I_A) { transpose_item(w_att, 512, D_MODEL, (bf16*)(ws + WS_WA), CmId(), scr, r / 32, r % 32, lane); continue; } r -= I_A;
            if (r < I_O) { transpose_item(w_o, 1024, D_MODEL, (bf16*)(ws + WS_WO), CmId(), scr, r / 32, r % 32, lane); continue; } r -= I_O;
            { const int e = r / I_1, q = r % I_1, kb = q / 176, nb = q % 176; const bool up = (nb >> 2) & 1;
                transpose_item_f8((up ? wu : wg) + (size_t)e * D_MODEL * FF, 1024, FF, (unsigned char*)(ws + WS_W1C) + (size_t)e * 5632 * 1024, CmW1(), scr, kb, nb, lane, W1_SCALE); }
        }
        for (int m = gw; m < T; m += NGW) rms_row_to_bf16(args.in[0] + (size_t)m * D_MODEL, args.in[1], (bf16*)(ws + WS_H) + (size_t)m * D_MODEL, lane);
        { float* ct = (float*)(ws + WS_COS); float* st = (float*)(ws + WS_SIN);
          for (int e = (vcu * NWAVES * 64) + tid; e < SEQ * 64; e += G * NWAVES * 64) { const int pos = e >> 6, j = e & 63;
              const float freq = powf(10000.0f, -(float)(j & 31) / 32.0f); const float ang = (float)(j < 32 ? (pos >> 6) : (pos & 63)) * freq;
              ct[e] = cosf(ang); st[e] = sinf(ang); } }
    }
    SEAM(PH_PROLOGUE);

    if (IN(PH_PROJ)) { PHASE_IDS
        pg8::PlainSched S; S.init(T, INW, G, bx); S.A = (const char*)(ws + WS_H); S.Bt = (const char*)(ws + WS_WIN); S.tstep = (size_t)256 * 1024 * 2;
        pg8::EpiProj E; E.wsb = ws; E.qn = args.in[7]; E.kn = args.in[8]; E.xch = (LAS float*)(lds + XCH_OFF); E.epoch = 0u;
        pg8::gemm_phase<pg8::EpiProj, pg8::PlainSched, true, true>(lds + RING_OFF, 1024, S, E, tid);
    }
    SEAM(PH_PROJ);

    if (IN(PH_RETKV)) { PHASE_IDS
        { const bf16* ak = (const bf16*)(ws + WS_AK); const bf16* av = (const bf16*)(ws + WS_AV); unsigned char* K8 = ws + WS_K8; unsigned char* Vt8 = ws + WS_VT8;
          for (int i = vcu * 512 + tid; i < T * 2 * 16; i += G * 512) { const int dg = i & 15, kvh = (i >> 4) & 1, t = i >> 5, b = t >> 13, tt = t & 8191;
              const v4u kx = *(const GAS v4u*)(ak + (size_t)t * 256 + kvh * 128 + dg * 8), vx = *(const GAS v4u*)(av + (size_t)t * 256 + kvh * 128 + dg * 8);
              float kf[8], vf[8];
              kf[0] = __uint_as_float(kx.x << 16); kf[1] = __uint_as_float(kx.x & 0xffff0000u); kf[2] = __uint_as_float(kx.y << 16); kf[3] = __uint_as_float(kx.y & 0xffff0000u);
              kf[4] = __uint_as_float(kx.z << 16); kf[5] = __uint_as_float(kx.z & 0xffff0000u); kf[6] = __uint_as_float(kx.w << 16); kf[7] = __uint_as_float(kx.w & 0xffff0000u);
              vf[0] = __uint_as_float(vx.x << 16); vf[1] = __uint_as_float(vx.x & 0xffff0000u); vf[2] = __uint_as_float(vx.y << 16); vf[3] = __uint_as_float(vx.y & 0xffff0000u);
              vf[4] = __uint_as_float(vx.z << 16); vf[5] = __uint_as_float(vx.z & 0xffff0000u); vf[6] = __uint_as_float(vx.w << 16); vf[7] = __uint_as_float(vx.w & 0xffff0000u);
              const size_t hb = (size_t)(b * 2 + kvh);
              *(GAS unsigned long long*)(K8 + (hb * 8192 + tt) * 128 + ((((dg >> 1) ^ ((tt >> 1) & 7)) << 4) | ((dg & 1) << 3))) = (unsigned long long)pk4_fp8(kf[0], kf[1], kf[2], kf[3]) | ((unsigned long long)pk4_fp8(kf[4], kf[5], kf[6], kf[7]) << 32);
              const int key = tt & 63, jt = tt >> 6, kk = key & 31, khi = (kk >> 2) & 1, j = (kk & 3) + 4 * (kk >> 3) + 16 * (key >> 5);
              const unsigned v03 = pk4_fp8(vf[0], vf[1], vf[2], vf[3]), v47 = pk4_fp8(vf[4], vf[5], vf[6], vf[7]);
              unsigned char* vt = Vt8 + (hb * 128 + jt) * 8192 + (j & 15);
#pragma unroll
              for (int q = 0; q < 8; ++q) { const int d = dg * 8 + q; vt[d * 64 + (((2 * khi + (j >> 4)) ^ ((d >> 2) & 3)) << 4)] = (unsigned char)(((q < 4 ? v03 : v47) >> (8 * (q & 3))) & 0xffu); } } }
        for (int item = vcu; item < 8 * NCHUNK; item += G)
            ret::kv_item(item, lds + RING_OFF, (const bf16*)(ws + WS_RK), (const bf16*)(ws + WS_RV), args.in[3], args.in[4], (float*)(ws + WS_KV), tid);
    }
    SEAM(PH_RETKV);

    if (IN(PH_ATTN)) { PHASE_IDS
        for (long gid = (long)vcu * 512 + tid; gid < 2 * 8 * 16384; gid += (long)G * 512) ret::scan_thread(gid, args.in[3], args.in[4], (const float*)(ws + WS_KV), (bf16*)(ws + WS_S));
    }

    if (IN(PH_ATTN)) { PHASE_IDS
        for (int u = vcu; u < BATCH * 4 * (SEQ / 256); u += G) {
            const int bh = u >> 5, qb = u & 31, b = bh >> 2, h = bh & 3, kvh = h >> 1;
            const size_t q0 = ((size_t)b * SEQ + (size_t)qb * 256) * 512 + (size_t)h * 128, k0 = (size_t)b * SEQ * 256 + (size_t)kvh * 128;
            attn::attn8_body((const attn::bf16*)(ws + WS_AQ) + q0, ws + WS_K8 + (size_t)(b * 2 + kvh) * 8192 * 128, ws + WS_VT8 + (size_t)(b * 2 + kvh) * 128 * 8192,
                             (attn::bf16*)(ws + WS_ATT) + q0, SEQ, (char*)lds_raw, tid);
            __syncthreads();
        }
    }
    SEAM(PH_ATTN);

    if (IN(PH_RETOUT)) { PHASE_IDS
        for (int item = vcu; item < 8 * NCHUNK; item += G)
            ret::out_item(item, lds + RING_OFF, (const bf16*)(ws + WS_RQ), (const bf16*)(ws + WS_RK), (const bf16*)(ws + WS_RV), (const bf16*)(ws + WS_RGS), args.in[3], args.in[4],
                          (const bf16*)(ws + WS_S), args.in[5], (bf16*)(ws + WS_YRIN), tid);
    }
    SEAM(PH_RETOUT);

    if (IN(PH_BRANCH)) { PHASE_IDS
        pg8::BranchSched S; S.init(T, D_MODEL, G, bx); S.A0 = (const char*)(ws + WS_YRIN); S.A1 = (const char*)(ws + WS_ATT); S.B0 = (const char*)(ws + WS_WR); S.B1 = (const char*)(ws + WS_WA); S.tstep = (size_t)256 * 512 * 2;
        pg8::EpiBranch E; E.grs = (const bf16*)(ws + WS_GRS); E.gas = (const bf16*)(ws + WS_GAS); E.mixed = (bf16*)(ws + WS_MIXED);
        pg8::gemm_phase<pg8::EpiBranch, pg8::BranchSched, true, true>(lds + RING_OFF, 512, S, E, tid);
    }
    SEAM(PH_BRANCH);

    if (IN(PH_WO)) { PHASE_IDS
        pg8::PlainSched S; S.init(T, D_MODEL, G, bx); S.A = (const char*)(ws + WS_MIXED); S.Bt = (const char*)(ws + WS_WO); S.tstep = (size_t)256 * 1024 * 2;
        pg8::EpiResid E; E.x = args.in[0]; E.x1 = (float*)(ws + WS_X1);
        pg8::gemm_phase<pg8::EpiResid, pg8::PlainSched, true, true>(lds + RING_OFF, 1024, S, E, tid);
    }
    SEAM(PH_WO);

    if (IN(PH_ROUTER)) { PHASE_IDS
        LAS float* wl = (LAS float*)(lds + RING_OFF);
        { const GAS float* src = (const GAS float*)args.in[12]; for (int i = tid; i < 1024 * 16; i += NWAVES * 64) wl[(i & 15) * 1024 + (i >> 4)] = src[i]; }
        __syncthreads();
        const float* x1 = (const float*)(ws + WS_X1); const float* gain = args.in[11]; bf16* h2 = (bf16*)(ws + WS_H); float* aff = (float*)(ws + WS_AFF);
        if (wave >= 4) {
            LAS float* scr = (LAS float*)(lds + RING_OFF + 65536 + (wave - 4) * 16384); const float* wg = args.in[13]; const float* wu = args.in[14]; constexpr int I_1 = 16 * 176;
            for (int it = W1_EARLY + vcu * 4 + (wave - 4); it < W1_ITEMS; it += G * 4) { const int e = it / I_1, q = it % I_1, kb = q / 176, nb = q % 176; const bool up = (nb >> 2) & 1;
                transpose_item_f8((up ? wu : wg) + (size_t)e * D_MODEL * FF, 1024, FF, (unsigned char*)(ws + WS_W1C) + (size_t)e * 5632 * 1024, CmW1(), scr, kb, nb, lane, W1_SCALE); }
        } else {
        const int gw = vcu * 4 + wave, NGW = G * 4;
        const GAS f32x4* gr = (const GAS f32x4*)gain + lane;
        f32x4 v[4];
        if (gw < T) { const GAS f32x4* xr = (const GAS f32x4*)(x1 + (size_t)gw * D_MODEL) + lane;
#pragma unroll
            for (int j = 0; j < 4; ++j) v[j] = xr[64 * j]; }
        for (int m = gw; m < T; m += NGW) {
            f32x4 nv[4];
            { const int mn = (m + NGW < T) ? m + NGW : m; const GAS f32x4* xn = (const GAS f32x4*)(x1 + (size_t)mn * D_MODEL) + lane;
#pragma unroll
              for (int j = 0; j < 4; ++j) nv[j] = xn[64 * j]; }
            float s = 0.f;
#pragma unroll
            for (int j = 0; j < 4; ++j) s += (v[j].x * v[j].x + v[j].y * v[j].y) + (v[j].z * v[j].z + v[j].w * v[j].w);
            const float rstd = 1.f / sqrtf(wave_sum(s) * (1.f / D_MODEL) + EPS);
            float lg[NE];
#pragma unroll
            for (int e = 0; e < NE; ++e) lg[e] = 0.f;
            GAS unsigned* o4 = (GAS unsigned*)((unsigned char*)h2 + (size_t)m * D_MODEL) + lane;
#pragma unroll
            for (int j = 0; j < 4; ++j) { const f32x4 g4 = gr[64 * j]; const f32x4 hv = v[j] * g4 * rstd;
                o4[64 * j] = pk4_fp8(hv.x, hv.y, hv.z, hv.w);
#pragma unroll
                for (int e = 0; e < NE; ++e) { const f32x4 w = *(const LAS f32x4*)(wl + e * 1024 + 4 * lane + 256 * j); lg[e] += (hv.x * w.x + hv.y * w.y) + (hv.z * w.z + hv.w * w.w); if ((e & 3) == 3) asm volatile("" ::: "memory"); }
                asm volatile("" ::: "memory"); }
            float r8[8], r4[4], r2[2], r1;
            { const bool b = (lane & 32) != 0;
#pragma unroll
              for (int e = 0; e < 8; ++e) { const float keep = b ? lg[e + 8] : lg[e], send = b ? lg[e] : lg[e + 8]; r8[e] = keep + __shfl_xor(send, 32); } }
            { const bool b = (lane & 16) != 0;
#pragma unroll
              for (int e = 0; e < 4; ++e) { const float keep = b ? r8[e + 4] : r8[e], send = b ? r8[e] : r8[e + 4]; r4[e] = keep + __shfl_xor(send, 16); } }
            { const bool b = (lane & 8) != 0;
#pragma unroll
              for (int e = 0; e < 2; ++e) { const float keep = b ? r4[e + 2] : r4[e], send = b ? r4[e] : r4[e + 2]; r2[e] = keep + __shfl_xor(send, 8); } }
            { const bool b = (lane & 4) != 0; const float keep = b ? r2[1] : r2[0], send = b ? r2[0] : r2[1]; r1 = keep + __shfl_xor(send, 4); }
            r1 += __shfl_xor(r1, 2); r1 += __shfl_xor(r1, 1);
            float mx = r1; mx = fmaxf(mx, __shfl_xor(mx, 4)); mx = fmaxf(mx, __shfl_xor(mx, 8)); mx = fmaxf(mx, __shfl_xor(mx, 16)); mx = fmaxf(mx, __shfl_xor(mx, 32));
            const float pe = expf(r1 - mx); float den = pe; den += __shfl_xor(den, 4); den += __shfl_xor(den, 8); den += __shfl_xor(den, 16); den += __shfl_xor(den, 32);
            if ((lane & 3) == 0) aff[(size_t)m * NE + (((lane >> 5) & 1) * 8 + ((lane >> 4) & 1) * 4 + ((lane >> 3) & 1) * 2 + ((lane >> 2) & 1))] = pe / den;
#pragma unroll
            for (int j = 0; j < 4; ++j) v[j] = nv[j];
        }
        }
        __syncthreads();
    }
    SEAM(PH_ROUTER);

    if (IN(PH_TOPK)) { PHASE_IDS
        if (vcu >= NZ) {
            const int lane_c = lane;
            LAS float* scr = (LAS float*)(lds + RING_OFF + wave * 16384); const float* wd = args.in[15]; constexpr int I_D = 44 * 32;
            for (int it = (vcu - NZ) * NWAVES + wave; it < NE * I_D; it += (G - NZ) * NWAVES) { const int e = it / I_D, q = it % I_D;
                transpose_item_f8(wd + (size_t)e * FF * D_MODEL, FF, D_MODEL, (unsigned char*)(ws + WS_WD) + (size_t)e * 1024 * FF, CmId(), scr, q / 32, q % 32, lane_c, WD_SCALE); }
        }
        LAS unsigned* keys = (LAS unsigned*)(lds + RING_OFF); LAS int* hist = (LAS int*)(lds + RING_OFF + 32768); LAS int* sc = (LAS int*)(lds + RING_OFF + 34816); volatile LAS unsigned* sv = (volatile LAS unsigned*)(lds + RING_OFF + 36864);
        const float* aff = (const float*)(ws + WS_AFF); int* idx = (int*)(ws + WS_IDX); float* gate = (float*)(ws + WS_GATE); int* sel = (int*)(ws + WS_SEL);
        for (int z = vcu; z < NZ; z += G) {
            const int b = z / NE, e = z % NE;
            for (int i = tid; i < SEQ; i += 512) keys[i] = __float_as_uint(aff[((size_t)b * SEQ + i) * NE + e]);
            if (tid == 0) { sv[0] = 0u; sv[1] = (unsigned)CAP; }
            __syncthreads();
            unsigned mask = 0u;
            for (int pass = 3; pass >= 0; --pass) {
                const int shift = pass * 8;
                if (tid < 256) hist[tid] = 0;
                __syncthreads();
                const unsigned prefix = sv[0];
                for (int i = tid; i < SEQ; i += 512) { const unsigned k = keys[i]; if ((k & mask) == prefix) atomicAdd((int*)&hist[(k >> shift) & 255u], 1); }
                __syncthreads();
                if (tid < 64) {
                    const int krem = (int)sv[1]; const int h0 = hist[4 * tid], h1 = hist[4 * tid + 1], h2 = hist[4 * tid + 2], h3 = hist[4 * tid + 3];
                    int suf = h0 + h1 + h2 + h3;
#pragma unroll
                    for (int o = 1; o < 64; o <<= 1) { const int t = __shfl_down(suf, o); if (tid + o < 64) suf += t; }
                    int cum = suf - (h0 + h1 + h2 + h3);
                    int dsel = -1, cumsel = 0;
                    if (cum < krem && cum + h3 >= krem) { dsel = 3; cumsel = cum; } cum += h3;
                    if (dsel < 0 && cum < krem && cum + h2 >= krem) { dsel = 2; cumsel = cum; } cum += h2;
                    if (dsel < 0 && cum < krem && cum + h1 >= krem) { dsel = 1; cumsel = cum; } cum += h1;
                    if (dsel < 0 && cum < krem && cum + h0 >= krem) { dsel = 0; cumsel = cum; }
                    if (dsel >= 0) { sv[1] = (unsigned)(krem - cumsel); sv[0] = prefix | ((unsigned)(4 * tid + dsel) << shift); }
                }
                __syncthreads();
                mask |= 0xFFu << shift;
            }
            const unsigned Tk = sv[0]; const int krem = (int)sv[1];
            int cgt = 0, ceq = 0;
            for (int q = 0; q < 16; ++q) { const unsigned k = keys[tid * 16 + q]; cgt += (k > Tk); ceq += (k == Tk); }
            int eqbase, slot;
            { sc[tid] = ceq; __syncthreads(); for (int off = 1; off < 512; off <<= 1) { const int t = (tid >= off) ? sc[tid - off] : 0; __syncthreads(); sc[tid] += t; __syncthreads(); } eqbase = sc[tid] - ceq; __syncthreads(); }
            int take = krem - eqbase; take = take < 0 ? 0 : (take > ceq ? ceq : take);
            { const int v = cgt + take; sc[tid] = v; __syncthreads(); for (int off = 1; off < 512; off <<= 1) { const int t = (tid >= off) ? sc[tid - off] : 0; __syncthreads(); sc[tid] += t; __syncthreads(); } slot = sc[tid] - v; __syncthreads(); }
            int eqr = eqbase;
            for (int q = 0; q < 16; ++q) { const int i = tid * 16 + q; const unsigned k = keys[i]; bool tk = k > Tk; if (k == Tk) { tk = eqr < krem; ++eqr; }
                if (tk) { idx[z * CAP + slot] = i; gate[z * CAP + slot] = __uint_as_float(k); sel[((size_t)b * SEQ + i) * NE + e] = slot; ++slot; } else sel[((size_t)b * SEQ + i) * NE + e] = -1; }
            __syncthreads();
        }
    }
    SEAM(PH_TOPK);


    if (IN(PH_MOE1)) { PHASE_IDS
        pg8::MoeGatherSched S; S.init(NZ * CAP, 5632, G, bx); S.A = (const char*)(ws + WS_H); S.Bt = (const char*)(ws + WS_W1C); S.idx = (const int*)(ws + WS_IDX);
        pg8::EpiSwiglu E; E.act = (unsigned char*)(ws + WS_ACT); E.in_scale = 1.0f / W1_SCALE; E.act_scale = ACT_SCALE;
        pg8::gemm_phase<pg8::EpiSwiglu, pg8::MoeGatherSched, true, true, true>(lds + RING_OFF, 1024 / 2, S, E, tid);
    }
    SEAM(PH_MOE1);

    if (IN(PH_MOE2)) { PHASE_IDS
        pg8::MoeSched S; S.init(NZ * CAP, D_MODEL, G, bx); S.A = (const char*)(ws + WS_ACT); S.Bt = (const char*)(ws + WS_WD); S.kb = (size_t)FF; S.nper = 1024;
        pg8::EpiDown E; E.y = (bf16*)(ws + WS_Y); E.gate = (const float*)(ws + WS_GATE); E.out_scale = 1.0f / (WD_SCALE * ACT_SCALE);
        pg8::gemm_phase<pg8::EpiDown, pg8::MoeSched, true, true, true>(lds + RING_OFF, FF / 2, S, E, tid);
    }
    SEAM(PH_MOE2);

    if (IN(PH_FINAL)) { PHASE_IDS
        const float* x1 = (const float*)(ws + WS_X1); const int* sel = (const int*)(ws + WS_SEL); const bf16* y = (const bf16*)(ws + WS_Y); const float* gain = args.in[16];
        for (int m = gw; m < T; m += NGW) {
            const int b = m / SEQ;
            const GAS f32x4* xr = (const GAS f32x4*)(x1 + (size_t)m * D_MODEL) + lane; const GAS f32x4* gr = (const GAS f32x4*)gain + lane;
            f32x4 v[4];
#pragma unroll
            for (int j = 0; j < 4; ++j) v[j] = xr[64 * j];
            const int mysel = (lane < NE) ? sel[(size_t)m * NE + lane] : -1;
            for (int e = 0; e < NE; ++e) { const int sl = __builtin_amdgcn_readlane(mysel, e);
                if (sl >= 0) { const GAS unsigned long long* yr = (const GAS unsigned long long*)(y + ((size_t)(b * NE + e) * CAP + sl) * D_MODEL) + lane;
#pragma unroll
                    for (int j = 0; j < 4; ++j) { const unsigned long long w = yr[64 * j]; const unsigned lo = (unsigned)w, hi = (unsigned)(w >> 32);
                        v[j].x += __uint_as_float(lo << 16); v[j].y += __uint_as_float(lo & 0xffff0000u); v[j].z += __uint_as_float(hi << 16); v[j].w += __uint_as_float(hi & 0xffff0000u); } } }
            float s = 0.f;
#pragma unroll
            for (int j = 0; j < 4; ++j) s += (v[j].x * v[j].x + v[j].y * v[j].y) + (v[j].z * v[j].z + v[j].w * v[j].w);
            const float rstd = 1.f / sqrtf(wave_sum(s) * (1.f / D_MODEL) + EPS);
            GAS f32x4* o = (GAS f32x4*)(args.out + (size_t)m * D_MODEL) + lane;
#pragma unroll
            for (int j = 0; j < 4; ++j) { const f32x4 g4 = gr[64 * j]; o[64 * j] = v[j] * g4 * rstd; }
        }
    }
#undef IN
#undef SEAM
}

#ifndef MK_DUP
#define MK_DUP (-1)
#endif
#ifndef MK_ONE_LAUNCH
#define MK_ONE_LAUNCH 1
#endif
extern "C" void kernel_launch(void* const* d_in, const int* in_sizes, int n_in, void* d_out, int out_size, void* d_ws, size_t ws_size, hipStream_t stream) {
    static int grid = 0;
    if (grid == 0) {
        if (n_in != 17 || in_sizes[0] != T * D_MODEL || out_size != T * D_MODEL || ws_size < WS_END) { fprintf(stderr, "kernel_launch: shape/workspace mismatch (ws %zu need %zu)\n", ws_size, (size_t)WS_END); grid = -1; return; }
        int dev = 0, cus = 0, per_cu = 0;
        if (hipGetDevice(&dev) != hipSuccess || hipDeviceGetAttribute(&cus, hipDeviceAttributeMultiprocessorCount, dev) != hipSuccess) { grid = -1; return; }
        if (hipFuncSetAttribute((const void*)mega, hipFuncAttributeMaxDynamicSharedMemorySize, LDS_BYTES) != hipSuccess) { fprintf(stderr, "kernel_launch: hipFuncSetAttribute failed\n"); grid = -1; return; }
        if (hipOccupancyMaxActiveBlocksPerMultiprocessor(&per_cu, (const void*)mega, NWAVES * 64, LDS_BYTES) != hipSuccess || per_cu < 1) { fprintf(stderr, "kernel_launch: occupancy query says %d blocks per CU\n", per_cu); (void)hipGetLastError(); grid = -1; return; }
        grid = cus;
    }
    if (grid < 0) return;
    unsigned char* ws = (unsigned char*)d_ws;
    (void)hipMemsetAsync(ws + WS_CTL, 0, CTL_ZERO_BYTES, stream);
    Args a{};
    for (int i = 0; i < 17; ++i) a.in[i] = (const float*)d_in[i];
    a.out = (float*)d_out; a.ws = ws;
#if MK_ONE_LAUNCH
    a.ph_lo = 0; a.ph_hi = PH_END; hipLaunchKernelGGL(mega, dim3(grid), dim3(NWAVES * 64), LDS_BYTES, stream, a);
#if MK_DUP >= 0
    a.ph_lo = MK_DUP; a.ph_hi = MK_DUP + 1; hipLaunchKernelGGL(mega, dim3(grid), dim3(NWAVES * 64), LDS_BYTES, stream, a);
#endif
#else
    for (int ph = 0; ph < PH_END; ++ph) { a.ph_lo = ph; a.ph_hi = ph + 1; hipLaunchKernelGGL(mega, dim3(grid), dim3(NWAVES * 64), LDS_BYTES, stream, a); }
#endif
}
```

```cpp
#include <hip/hip_runtime.h>
#ifndef MK_W1_EARLY_PCT
#define MK_W1_EARLY_PCT 0
#endif
#include <hip/hip_bf16.h>
#include <cstdio>
#include <cstdint>
#include <cmath>

constexpr size_t EP_MiB = 1u << 20;
constexpr size_t EP_COS = 2 * EP_MiB, EP_SIN = 4 * EP_MiB, EP_RQ = 382 * EP_MiB, EP_RK = 398 * EP_MiB, EP_RV = 414 * EP_MiB, EP_RGS = 430 * EP_MiB, EP_AQ = 446 * EP_MiB, EP_AK = 462 * EP_MiB, EP_AV = 470 * EP_MiB, EP_GRS = 478 * EP_MiB, EP_GAS = 510 * EP_MiB;
constexpr int D_MODEL = 1024, BATCH = 2, SEQ = 8192, T = BATCH * SEQ;
constexpr int HD = 128, CHUNK = 128, NCHUNK = SEQ / CHUNK;
constexpr int NE = 16, FF = 2816, CAP = 1024, NZ = BATCH * NE;
constexpr int INW = 5120;
constexpr int O_RQ = 0, O_RK = 512, O_RV = 1024, O_RG = 1536, O_AQ = 2048, O_AK = 2560, O_AV = 2816, O_GR = 3072, O_GA = 4096;
constexpr float EPS = 1e-6f;
constexpr float RSQRT_HD = 0.08838834764831845f;
constexpr float W1_SCALE = 32.0f, WD_SCALE = 64.0f, ACT_SCALE = 4.0f;

namespace pg8 {
#define PG8_LAS __attribute__((address_space(3)))
typedef unsigned short bf16_t;
typedef short bf16x8 __attribute__((ext_vector_type(8)));
typedef float f32x4 __attribute__((ext_vector_type(4)));
typedef unsigned u32x4 __attribute__((ext_vector_type(4)));
constexpr int BM = 256, BK = 64, HALF = 128, HTB = HALF * BK * 2  , STAGE_BYTES = 8 * HTB, NXCD = 8, WGM = 8;

__host__ __device__ __forceinline__ int lds_byte(int r, int c) { const int st = (r >> 4) * 2 + (c >> 5), rr = r & 15, cc = c & 31, ob = rr * 64 + cc * 2; return st * 1024 + (ob ^ (((ob >> 9) & 1) << 5)); }
__host__ __device__ __forceinline__ void stage_rc(int b, int& R, int& C) { const int st = b / 1024, sb = b % 1024, swz = sb ^ (((sb >> 9) & 1) << 5); R = (st >> 1) * 16 + swz / 64; C = (st & 1) * 32 + (swz % 64) / 2; }
__host__ __device__ __forceinline__ int perm32(int rho) { const int n = rho >> 4, i = rho & 15; return 8 * (i >> 2) + 4 * n + (i & 3); }

struct Unit { int pm, pn, aux; };
struct Gemm { const bf16_t* A; const bf16_t* Bt; int M, N, K; };

struct StaticOrder {
    int nM, nN, nwg, G, c;
    __host__ __device__ void init(int M, int N, int G_, int c_) { nM = M / BM; nN = N / BM; nwg = nM * nN; G = G_; c = c_; }
    __host__ __device__ bool next(int i, Unit& u) const {
        const long L = (long)i * G + c; if (L >= nwg) return false;
        int wgid = (int)L; { const int q = nwg / NXCD, r = nwg % NXCD, xcd = wgid % NXCD, off = wgid / NXCD; wgid = (xcd < r ? xcd * (q + 1) : r * (q + 1) + (xcd - r) * q) + off; }
        const int nig = WGM * nN, gid = wgid / nig, fm = gid * WGM, gsz = (nM - fm) < WGM ? (nM - fm) : WGM;
        u.pm = fm + ((wgid % nig) % gsz); u.pn = (wgid % nig) / gsz; u.aux = 0; return true;
    }
    __device__ __forceinline__ void a_ready(const Unit&) const {}
    __device__ __forceinline__ void done(const Unit&) const {}
    static constexpr bool GATHER = false;
    __device__ __forceinline__ unsigned gather_off(const Unit&, int, int) const { return 0u; }
    __device__ __forceinline__ bool keep_acc(const Unit&) const { return false; }
};


struct PlainSched : StaticOrder {
    const char* A; const char* Bt; size_t tstep;
    __device__ __forceinline__ void bases(const Unit& u, const char*& a, const char*& b) const { a = A + (size_t)u.pm * tstep; b = Bt + (size_t)u.pn * tstep; }
};

typedef float f32x2_t __attribute__((ext_vector_type(2))); typedef __bf16 bf16x2_t __attribute__((ext_vector_type(2)));
__device__ __forceinline__ unsigned cvt_pk_bf16(float lo, float hi) { f32x2_t v = {lo, hi}; bf16x2_t b = __builtin_convertvector(v, bf16x2_t); return __builtin_bit_cast(unsigned, b); }
__device__ __forceinline__ u32x4 pack8(const f32x4 a, const f32x4 b) { u32x4 w; w.x = cvt_pk_bf16(a[0], a[1]); w.y = cvt_pk_bf16(a[2], a[3]); w.z = cvt_pk_bf16(b[0], b[1]); w.w = cvt_pk_bf16(b[2], b[3]); return w; }
__device__ __forceinline__ float fast_sigmoid(float x) { return __builtin_amdgcn_rcpf(1.0f + __builtin_amdgcn_exp2f(-1.4426950408889634f * x)); }
__device__ __forceinline__ f32x4 sigmoid4(const f32x4 v) { return (f32x4){fast_sigmoid(v[0]), fast_sigmoid(v[1]), fast_sigmoid(v[2]), fast_sigmoid(v[3])}; }
__device__ __forceinline__ f32x4 silu4(const f32x4 v) { return v * sigmoid4(v); }

struct EpiProj {
    static constexpr bool PERM = true, AFTER_DRAIN = false;
    unsigned char* wsb;
    const float *qn, *kn;
    PG8_LAS float* xch;
    mutable unsigned epoch;
    template <int ACT>
    __device__ __forceinline__ void plain(const f32x4 (&acc)[2][2][4][2], bf16_t* base, int ld, int col0, int row0) const {
#pragma unroll
        for (int ai = 0; ai < 2; ++ai)
#pragma unroll
            for (int m = 0; m < 4; ++m) { bf16_t* rowp = base + (size_t)(row0 + ai * HALF + m * 16) * ld + col0;
#pragma unroll
                for (int bj = 0; bj < 2; ++bj) { f32x4 v0 = acc[ai][bj][m][0], v1 = acc[ai][bj][m][1];
                    if (ACT == 1) { v0 = silu4(v0); v1 = silu4(v1); } else if (ACT == 2) { v0 = sigmoid4(v0); v1 = sigmoid4(v1); }
                    *(u32x4*)(rowp + bj * HALF) = pack8(v0, v1); } }
    }
    template <bool NORM>
    __device__ __forceinline__ void rope(const f32x4 (&acc)[2][2][4][2], bf16_t* base, int ld, int col0, int row0, float scale, const float* nw, int wr, int wc, int fr, int fq) const {
        const int g = 4 * wc + fq;
        f32x4 nw1 = {1.f, 1.f, 1.f, 1.f}, nw2 = {1.f, 1.f, 1.f, 1.f};
        if (NORM) {
#pragma unroll
            for (int ai = 0; ai < 2; ++ai)
#pragma unroll
                for (int m = 0; m < 4; ++m)
#pragma unroll
                    for (int bj = 0; bj < 2; ++bj) { const f32x4 a = acc[ai][bj][m][0], b = acc[ai][bj][m][1];
                        float s = (a[0] * a[0] + a[1] * a[1]) + (a[2] * a[2] + a[3] * a[3]) + (b[0] * b[0] + b[1] * b[1]) + (b[2] * b[2] + b[3] * b[3]);
                        s += __shfl_xor(s, 16); s += __shfl_xor(s, 32);
                        if (fq == 0) xch[((ai * HALF + wr * 64 + m * 16 + fr) * 2 + bj) * 4 + wc] = s; }
            asm volatile("s_waitcnt lgkmcnt(0)" ::: "memory");
            PG8_LAS unsigned* cnt = (PG8_LAS unsigned*)(xch + 2048) + wr;
            if ((fr | fq) == 0) __hip_atomic_fetch_add(cnt, 1u, __ATOMIC_RELAXED, __HIP_MEMORY_SCOPE_WORKGROUP);
            epoch += 4u;
            while (__hip_atomic_load(cnt, __ATOMIC_RELAXED, __HIP_MEMORY_SCOPE_WORKGROUP) < epoch) __builtin_amdgcn_s_sleep(1);
            asm volatile("s_waitcnt lgkmcnt(0)" ::: "memory");
            nw1 = *(const f32x4*)(nw + 4 * g); nw2 = *(const f32x4*)(nw + 64 + 4 * g);
        }
#pragma unroll
        for (int ai = 0; ai < 2; ++ai)
#pragma unroll
            for (int m = 0; m < 4; ++m) { const int r = row0 + ai * HALF + m * 16; const int pos = r & 8191;
                const f32x4 c4 = *(const f32x4*)((const float*)(wsb + EP_COS) + (size_t)pos * 64 + 4 * g), s4 = *(const f32x4*)((const float*)(wsb + EP_SIN) + (size_t)pos * 64 + 4 * g);
                bf16_t* rowp = base + (size_t)r * ld + col0;
#pragma unroll
                for (int bj = 0; bj < 2; ++bj) { f32x4 x1 = acc[ai][bj][m][0], x2 = acc[ai][bj][m][1];
                    if (NORM) { const f32x4 p = *(const PG8_LAS f32x4*)(xch + ((ai * HALF + wr * 64 + m * 16 + fr) * 2 + bj) * 4);
                        const float rs = __builtin_amdgcn_rsqf(((p[0] + p[1]) + (p[2] + p[3])) * (1.0f / 128.0f) + 1e-6f);
                        x1 = x1 * (nw1 * rs); x2 = x2 * (nw2 * rs); }
                    const f32x4 y1 = (x1 * c4 - x2 * s4) * scale, y2 = (x1 * s4 + x2 * c4) * scale;
                    *(u32x4*)(rowp + bj * HALF) = pack8(y1, y2); }
                asm volatile("" ::: "memory"); }
    }
    __device__ __forceinline__ void operator()(const f32x4 (&acc)[2][2][4][2], const Unit& u, int wr, int wc, int fr, int fq) const {
        const int row0 = u.pm * BM + wr * 64 + fr, cw = wc * 32 + 8 * fq, pn = u.pn;
        if (pn < 2)       rope<false>(acc, (bf16_t*)(wsb + EP_RQ), 512, pn * 256 + cw, row0, 1.0f, nullptr, wr, wc, fr, fq);
        else if (pn < 4)  rope<false>(acc, (bf16_t*)(wsb + EP_RK), 512, (pn - 2) * 256 + cw, row0, 0.08838834764831845f, nullptr, wr, wc, fr, fq);
        else if (pn < 6)  plain<0>(acc, (bf16_t*)(wsb + EP_RV), 512, (pn - 4) * 256 + cw, row0);
        else if (pn < 8)  plain<1>(acc, (bf16_t*)(wsb + EP_RGS), 512, (pn - 6) * 256 + cw, row0);
        else if (pn < 10) rope<true>(acc, (bf16_t*)(wsb + EP_AQ), 512, (pn - 8) * 256 + cw, row0, 1.0f, qn, wr, wc, fr, fq);
        else if (pn < 11) rope<true>(acc, (bf16_t*)(wsb + EP_AK), 256, cw, row0, 1.0f, kn, wr, wc, fr, fq);
        else if (pn < 12) plain<0>(acc, (bf16_t*)(wsb + EP_AV), 256, cw, row0);
        else if (pn < 16) plain<2>(acc, (bf16_t*)(wsb + EP_GRS), 1024, (pn - 12) * 256 + cw, row0);
        else              plain<2>(acc, (bf16_t*)(wsb + EP_GAS), 1024, (pn - 16) * 256 + cw, row0);
    }
};

struct BranchSched : StaticOrder {
    const char *A0, *A1, *B0, *B1; size_t tstep;
    __device__ __forceinline__ bool next(int i, Unit& u) const { if (!StaticOrder::next(i >> 1, u)) return false; u.aux = i & 1; return true; }
    __device__ __forceinline__ void bases(const Unit& u, const char*& a, const char*& b) const { a = (u.aux ? A1 : A0) + (size_t)u.pm * tstep; b = (u.aux ? B1 : B0) + (size_t)u.pn * tstep; }
    __device__ __forceinline__ bool keep_acc(const Unit& nxt) const { return nxt.aux == 1; }
};
__device__ __forceinline__ void unpack8(const u32x4 w, f32x4& a, f32x4& b) {
    a = (f32x4){__uint_as_float(w.x << 16), __uint_as_float(w.x & 0xffff0000u), __uint_as_float(w.y << 16), __uint_as_float(w.y & 0xffff0000u)};
    b = (f32x4){__uint_as_float(w.z << 16), __uint_as_float(w.z & 0xffff0000u), __uint_as_float(w.w << 16), __uint_as_float(w.w & 0xffff0000u)};
}
struct EpiBranch {
    static constexpr bool PERM = true, AFTER_DRAIN = false;
    const bf16_t *grs, *gas; bf16_t* mixed;
    __device__ __forceinline__ void operator()(f32x4 (&acc)[2][2][4][2], const Unit& u, int wr, int wc, int fr, int fq) const {
        const int row0 = u.pm * BM + wr * 64 + fr, col0 = u.pn * BM + wc * 32 + 8 * fq;
#pragma unroll
        for (int ai = 0; ai < 2; ++ai)
#pragma unroll
            for (int m = 0; m < 4; ++m) { const size_t off = (size_t)(row0 + ai * HALF + m * 16) * 1024 + col0;
#pragma unroll
                for (int bj = 0; bj < 2; ++bj) { f32x4 ga0, ga1; unpack8(*(const u32x4*)(gas + off + bj * HALF), ga0, ga1);
                    if (u.aux == 0) { f32x4 gr0, gr1; unpack8(*(const u32x4*)(grs + off + bj * HALF), gr0, gr1);
#pragma unroll
                        for (int k = 0; k < 4; ++k) { acc[ai][bj][m][0][k] *= gr0[k] * __builtin_amdgcn_rcpf(fmaxf(ga0[k], 1e-30f)); acc[ai][bj][m][1][k] *= gr1[k] * __builtin_amdgcn_rcpf(fmaxf(ga1[k], 1e-30f)); } }
                    else *(u32x4*)(mixed + off + bj * HALF) = pack8(acc[ai][bj][m][0] * ga0, acc[ai][bj][m][1] * ga1); }
                asm volatile("" ::: "memory"); }
    }
};
struct EpiResid {
    static constexpr bool PERM = false, AFTER_DRAIN = false;
    const float* x; float* x1;
    __device__ __forceinline__ void operator()(const f32x4 (&acc)[2][2][4][2], const Unit& u, int wr, int wc, int fr, int fq) const {
        const int row0 = u.pm * BM + wr * 64 + fr, col0 = u.pn * BM + wc * 32 + 4 * fq;
#pragma unroll
        for (int ai = 0; ai < 2; ++ai)
#pragma unroll
            for (int m = 0; m < 4; ++m) { const size_t off = (size_t)(row0 + ai * HALF + m * 16) * 1024 + col0;
#pragma unroll
                for (int bj = 0; bj < 2; ++bj)
#pragma unroll
                    for (int n = 0; n < 2; ++n) { const f32x4 xv = *(const f32x4*)(x + off + bj * HALF + n * 16); *(f32x4*)(x1 + off + bj * HALF + n * 16) = xv + acc[ai][bj][m][n]; }
                if (m & 1) asm volatile("" ::: "memory"); }
    }
};
__device__ __forceinline__ int moe_rowbase(int pm) { return ((((pm >> 2) & 1) * 16 + (pm >> 3)) * 1024) + (pm & 3) * 256; }
struct MoeSched : StaticOrder {
    const char *A, *Bt; size_t kb; int nper;
    __device__ __forceinline__ void bases(const Unit& u, const char*& a, const char*& b) const { a = A + (size_t)moe_rowbase(u.pm) * kb; b = Bt + ((size_t)(u.pm >> 3) * nper + (size_t)u.pn * 256) * kb; }
};
struct MoeGatherSched : StaticOrder {
    static constexpr bool GATHER = true;
    const char *A, *Bt; const int* idx;
    __device__ __forceinline__ void bases(const Unit& u, const char*& a, const char*& b) const { a = A; b = Bt + ((size_t)(u.pm >> 3) * 5632 + (size_t)u.pn * 256) * 1024; }
    __device__ __forceinline__ unsigned gather_off(const Unit& u, int r, int c) const { const int tok = ((u.pm >> 2) & 1) * 8192 + idx[moe_rowbase(u.pm) + r]; return (unsigned)(tok * 1024 + c * 2); }
};
struct EpiSwiglu {
    static constexpr bool PERM = true, AFTER_DRAIN = false;
    unsigned char* act; float in_scale, act_scale;
    __device__ __forceinline__ void operator()(const f32x4 (&acc)[2][2][4][2], const Unit& u, int wr, int wc, int fr, int fq) const {
        const int row0 = moe_rowbase(u.pm) + wr * 64 + fr, col0 = u.pn * HALF + wc * 32 + 8 * fq;
#pragma unroll
        for (int ai = 0; ai < 2; ++ai)
#pragma unroll
            for (int m = 0; m < 4; ++m) { f32x4 v0 = silu4(acc[ai][0][m][0] * in_scale) * (acc[ai][1][m][0] * (in_scale * act_scale)), v1 = silu4(acc[ai][0][m][1] * in_scale) * (acc[ai][1][m][1] * (in_scale * act_scale));
#pragma unroll
                for (int k = 0; k < 4; ++k) { v0[k] = __builtin_amdgcn_fmed3f(v0[k], -448.0f, 448.0f); v1[k] = __builtin_amdgcn_fmed3f(v1[k], -448.0f, 448.0f); }
                const unsigned lo = (unsigned)__builtin_amdgcn_cvt_pk_fp8_f32(v0[2], v0[3], __builtin_amdgcn_cvt_pk_fp8_f32(v0[0], v0[1], 0, false), true), hi = (unsigned)__builtin_amdgcn_cvt_pk_fp8_f32(v1[2], v1[3], __builtin_amdgcn_cvt_pk_fp8_f32(v1[0], v1[1], 0, false), true);
                *(unsigned long long*)(act + (size_t)(row0 + ai * HALF + m * 16) * 2816 + col0) = (unsigned long long)lo | ((unsigned long long)hi << 32); }
    }
};
struct EpiDown {
    static constexpr bool PERM = true, AFTER_DRAIN = false;
    bf16_t* y; const float* gate; float out_scale;
    __device__ __forceinline__ void operator()(const f32x4 (&acc)[2][2][4][2], const Unit& u, int wr, int wc, int fr, int fq) const {
        const int row0 = moe_rowbase(u.pm) + wr * 64 + fr, col0 = u.pn * BM + wc * 32 + 8 * fq;
#pragma unroll
        for (int ai = 0; ai < 2; ++ai)
#pragma unroll
            for (int m = 0; m < 4; ++m) { const int r = row0 + ai * HALF + m * 16; const float g = gate[r] * out_scale;
#pragma unroll
                for (int bj = 0; bj < 2; ++bj) *(u32x4*)(y + (size_t)r * 1024 + col0 + bj * HALF) = pack8(acc[ai][bj][m][0] * g, acc[ai][bj][m][1] * g); }
    }
};
typedef int v4i32 __attribute__((ext_vector_type(4)));
typedef int v8i32 __attribute__((ext_vector_type(8)));
__device__ __forceinline__ v8i32 cat8(const bf16x8 lo, const bf16x8 hi) { const v4i32 l = __builtin_bit_cast(v4i32, lo), h = __builtin_bit_cast(v4i32, hi); return __builtin_shufflevector(l, h, 0, 1, 2, 3, 4, 5, 6, 7); }
__device__ __forceinline__ void mfma_f8_inplace(f32x4& acc, const v8i32 b8, const v8i32 a8, const int sc) {
    asm volatile("v_mfma_scale_f32_16x16x128_f8f6f4 %0, %1, %2, %0, %3, %3 op_sel_hi:[0,0,0]" : "+v"(acc) : "v"(b8), "v"(a8), "v"(sc)); }
template <class Epi, class Sched, bool ALIGN_EPI = false, bool SP2 = false, bool FP8 = false>
__device__ __forceinline__ void gemm_phase(PG8_LAS unsigned char* lds, const int K_, const Sched& S, const Epi& E, const int tid) {
    const int wid = __builtin_amdgcn_readfirstlane(tid >> 6), lane = tid & 63, wr = wid >> 2, wc = wid & 3, fr = lane & 15, fq = lane >> 4;
    const int K = K_, nt = K / BK;
    unsigned voffA[2], voffB[2];
#pragma unroll
    for (int i = 0; i < 2; ++i) { int R, C; stage_rc(tid * 16 + i * 8192, R, C); const int Rb = Epi::PERM ? ((R & ~31) + perm32(R & 31)) : R;
        voffA[i] = (unsigned)(R * K + C) * 2u; voffB[i] = (unsigned)(Rb * K + C) * 2u; }
    unsigned va0[2] = {0u, 0u}, va1[2] = {0u, 0u}, vn0[2] = {0u, 0u}, vn1[2] = {0u, 0u};
    int gR[2], gC[2];
#pragma unroll
    for (int i = 0; i < 2; ++i) stage_rc(tid * 16 + i * 8192, gR[i], gC[i]);
    const size_t kstep = (size_t)(BK * 2);
    const size_t hstep = (size_t)HALF * K * 2;
        const unsigned ldsw = (unsigned)wid * 1024u;
    const int aoff = lds_byte(wr * 64 + fr, fq * 8), boff = lds_byte(wc * 32 + fr, fq * 8);
#define PG8_SA(b, h) (((b) * 2 + (h)) * HTB)
#define PG8_SB(b, h) ((4 + (b) * 2 + (h)) * HTB)
#define PG8_STAGE(bufoff, gbase, voff) do { _Pragma("unroll") for (int _i = 0; _i < 2; ++_i) \
        __builtin_amdgcn_global_load_lds((const unsigned*)((const char*)(gbase) + (voff)[_i]), (PG8_LAS unsigned*)(lds + (bufoff) + ldsw + _i * 8192), 16, 0, 0); } while (0)
#define PG8_STAGE_A(bufoff, gbase, h, usenext) do { if constexpr (Sched::GATHER) { unsigned vo_[2]; \
        vo_[0] = (usenext) ? ((h) ? vn1[0] : vn0[0]) : ((h) ? va1[0] : va0[0]); vo_[1] = (usenext) ? ((h) ? vn1[1] : vn0[1]) : ((h) ? va1[1] : va0[1]); PG8_STAGE(bufoff, gbase, vo_); } \
        else { PG8_STAGE(bufoff, (gbase) + ((h) ? hstep : (size_t)0), voffA); } } while (0)
#define PG8_LDA(dst, b, h) do { if constexpr (FP8) { _Pragma("unroll") for (int m = 0; m < 4; ++m) dst##8[m] = cat8(*(const PG8_LAS bf16x8*)(lds + PG8_SA(b, h) + aoff + m * 2048), *(const PG8_LAS bf16x8*)(lds + PG8_SA(b, h) + aoff + m * 2048 + 1024)); } else { \
        _Pragma("unroll") for (int m = 0; m < 4; ++m) _Pragma("unroll") for (int k = 0; k < 2; ++k) dst[m][k] = *(const PG8_LAS bf16x8*)(lds + PG8_SA(b, h) + aoff + m * 2048 + k * 1024); } } while (0)
#define PG8_LDB(dst, b, h) do { if constexpr (FP8) { _Pragma("unroll") for (int n = 0; n < 2; ++n) dst##8[n] = cat8(*(const PG8_LAS bf16x8*)(lds + PG8_SB(b, h) + boff + n * 2048), *(const PG8_LAS bf16x8*)(lds + PG8_SB(b, h) + boff + n * 2048 + 1024)); } else { \
        _Pragma("unroll") for (int n = 0; n < 2; ++n) _Pragma("unroll") for (int k = 0; k < 2; ++k) dst[n][k] = *(const PG8_LAS bf16x8*)(lds + PG8_SB(b, h) + boff + n * 2048 + k * 1024); } } while (0)
#define PG8_MMA(ai, bj, At, Bt) do { __builtin_amdgcn_s_setprio(1); if constexpr (FP8) { _Pragma("unroll") for (int m = 0; m < 4; ++m) _Pragma("unroll") for (int n = 0; n < 2; ++n) \
        mfma_f8_inplace(acc[ai][bj][m][n], Bt##8[n], At##8[m], 0x7f7f7f7f); } else { \
        _Pragma("unroll") for (int m = 0; m < 4; ++m) _Pragma("unroll") for (int n = 0; n < 2; ++n) _Pragma("unroll") for (int k = 0; k < 2; ++k) \
        acc[ai][bj][m][n] = __builtin_amdgcn_mfma_f32_16x16x32_bf16(Bt[n][k], At[m][k], acc[ai][bj][m][n], 0, 0, 0); } __builtin_amdgcn_s_setprio(0); } while (0)
#define PG8_WAIT_V(n) asm volatile("s_waitcnt vmcnt(" #n ")" ::: "memory")
#define PG8_WAIT_L(n) asm volatile("s_waitcnt lgkmcnt(" #n ")" ::: "memory")
#define PG8_BAR __builtin_amdgcn_s_barrier()
#define PG8_SCHED __builtin_amdgcn_sched_barrier(0)
    Unit cur, nxt; int ui = 0;
    if (!S.next(0, cur)) return;
    f32x4 acc[2][2][4][2];
#pragma unroll
    for (int a = 0; a < 2; ++a)
#pragma unroll
        for (int b = 0; b < 2; ++b)
#pragma unroll
            for (int m = 0; m < 4; ++m)
#pragma unroll
                for (int n = 0; n < 2; ++n) acc[a][b][m][n] = (f32x4){0.f, 0.f, 0.f, 0.f};
    bf16x8 At[4][2], B0[2][2], B1[2][2]; v8i32 At8[4], B08[2], B18[2];
    const char* cA; const char* cB; S.bases(cur, cA, cB);
    if constexpr (Sched::GATHER) {
#pragma unroll
        for (int i = 0; i < 2; ++i) { va0[i] = S.gather_off(cur, gR[i], gC[i]); va1[i] = S.gather_off(cur, gR[i] + HALF, gC[i]); } }
    S.a_ready(cur);
    if constexpr (SP2) {
        PG8_STAGE(PG8_SB(0, 0), cB, voffB); PG8_STAGE(PG8_SB(0, 1), cB + hstep, voffB); PG8_STAGE_A(PG8_SA(0, 0), cA, 0, false); PG8_STAGE_A(PG8_SA(0, 1), cA, 1, false);
        if (wr == 1) PG8_BAR;
        PG8_WAIT_V(2); PG8_BAR;
        PG8_STAGE(PG8_SB(1, 0), cB + kstep, voffB); PG8_STAGE_A(PG8_SA(1, 0), cA + kstep, 0, false); PG8_STAGE(PG8_SB(1, 1), cB + hstep + kstep, voffB);
        PG8_WAIT_V(6); PG8_BAR;
    } else {
        PG8_STAGE(PG8_SB(0, 0), cB, voffB); PG8_STAGE_A(PG8_SA(0, 0), cA, 0, false); PG8_STAGE(PG8_SB(0, 1), cB + hstep, voffB); PG8_STAGE_A(PG8_SA(0, 1), cA, 1, false);
        if (wr == 1) PG8_BAR;
        PG8_WAIT_V(4); PG8_BAR;
        PG8_STAGE(PG8_SB(1, 0), cB + kstep, voffB); PG8_STAGE_A(PG8_SA(1, 0), cA + kstep, 0, false); PG8_STAGE(PG8_SB(1, 1), cB + hstep + kstep, voffB);
        PG8_WAIT_V(6); PG8_BAR;
    }
    for (;;) {
        const bool has_next = S.next(ui + 1, nxt);
        const char* nA = cA; const char* nB = cB; if (has_next) S.bases(nxt, nA, nB);
        if constexpr (Sched::GATHER) { if (has_next) {
#pragma unroll
            for (int i = 0; i < 2; ++i) { vn0[i] = S.gather_off(nxt, gR[i], gC[i]); vn1[i] = S.gather_off(nxt, gR[i] + HALF, gC[i]); } }
            else {
#pragma unroll
            for (int i = 0; i < 2; ++i) { vn0[i] = va0[i]; vn1[i] = va1[i]; } } }
#pragma unroll 1
        for (int t = 0; t < nt; t += 2) {
            const bool last = (t == nt - 2);
            const char* a1 = cA + (size_t)(t + 1) * kstep;
            const char* a2 = last ? nA : cA + (size_t)(t + 2) * kstep; const char* b2 = last ? nB : cB + (size_t)(t + 2) * kstep;
            const char* a3 = a2 + kstep; const char* b3 = b2 + kstep;
            if (last && has_next) S.a_ready(nxt);
            if constexpr (SP2) {
            PG8_LDB(B0, 0, 0); PG8_LDB(B1, 0, 1); PG8_SCHED; PG8_LDA(At, 0, 0); PG8_STAGE_A(PG8_SA(1, 1), a1, 1, false);
            PG8_WAIT_V(8); PG8_WAIT_L(0); PG8_BAR; PG8_MMA(0, 0, At, B0); PG8_MMA(0, 1, At, B1); PG8_BAR; PG8_SCHED;
            PG8_LDA(At, 0, 1); PG8_STAGE(PG8_SB(0, 0), b2, voffB); PG8_STAGE(PG8_SB(0, 1), b2 + hstep, voffB); PG8_STAGE_A(PG8_SA(0, 0), a2, 0, last);
            PG8_WAIT_V(8); PG8_WAIT_L(0); PG8_BAR; PG8_MMA(1, 0, At, B0); PG8_MMA(1, 1, At, B1); PG8_BAR; PG8_SCHED;
            PG8_LDB(B0, 1, 0); PG8_LDB(B1, 1, 1); PG8_SCHED; PG8_LDA(At, 1, 0); PG8_STAGE_A(PG8_SA(0, 1), a2, 1, last);
            PG8_WAIT_V(8); PG8_WAIT_L(0); PG8_BAR; PG8_MMA(0, 0, At, B0); PG8_MMA(0, 1, At, B1); PG8_BAR; PG8_SCHED;
            PG8_LDA(At, 1, 1); PG8_STAGE(PG8_SB(1, 0), b3, voffB); PG8_STAGE(PG8_SB(1, 1), b3 + hstep, voffB); PG8_STAGE_A(PG8_SA(1, 0), a3, 0, last);
            PG8_WAIT_V(8); PG8_WAIT_L(0); PG8_BAR; PG8_MMA(1, 0, At, B0); PG8_MMA(1, 1, At, B1); PG8_BAR; PG8_SCHED;
            } else {
            PG8_LDB(B0, 0, 0); PG8_SCHED; PG8_LDA(At, 0, 0); PG8_STAGE_A(PG8_SA(1, 1), a1, 1, false);
            PG8_WAIT_L(8); PG8_BAR; PG8_WAIT_L(0); PG8_MMA(0, 0, At, B0); PG8_BAR; PG8_SCHED;
            PG8_LDB(B1, 0, 1); PG8_STAGE(PG8_SB(0, 0), b2, voffB);
            PG8_BAR; PG8_WAIT_L(0); PG8_MMA(0, 1, At, B1); PG8_BAR;
            PG8_LDA(At, 0, 1); PG8_STAGE_A(PG8_SA(0, 0), a2, 0, last);
            PG8_BAR; PG8_WAIT_L(0); PG8_MMA(1, 0, At, B0); PG8_BAR; PG8_SCHED;
            PG8_STAGE(PG8_SB(0, 1), b2 + hstep, voffB);
            PG8_WAIT_V(6); PG8_BAR; PG8_MMA(1, 1, At, B1); PG8_BAR;
            PG8_LDB(B0, 1, 0); PG8_SCHED; PG8_LDA(At, 1, 0); PG8_STAGE_A(PG8_SA(0, 1), a2, 1, last);
            PG8_WAIT_L(8); PG8_BAR; PG8_WAIT_L(0); PG8_MMA(0, 0, At, B0); PG8_BAR; PG8_SCHED;
            PG8_LDB(B1, 1, 1); PG8_STAGE(PG8_SB(1, 0), b3, voffB);
            PG8_BAR; PG8_WAIT_L(0); PG8_MMA(0, 1, At, B1); PG8_BAR;
            PG8_LDA(At, 1, 1); PG8_STAGE_A(PG8_SA(1, 0), a3, 0, last);
            PG8_BAR; PG8_WAIT_L(0); PG8_MMA(1, 0, At, B0); PG8_BAR; PG8_SCHED;
            PG8_STAGE(PG8_SB(1, 1), b3 + hstep, voffB);
            PG8_WAIT_V(6); PG8_BAR; PG8_MMA(1, 1, At, B1); PG8_BAR;
            }
        }
        if constexpr (FP8) asm volatile("s_nop 15\n\ts_nop 15" ::: "memory");
        if constexpr (ALIGN_EPI) { if (wr == 0) PG8_BAR; }
        if constexpr (!Epi::AFTER_DRAIN) { int le_; asm volatile("v_mbcnt_lo_u32_b32 %0, -1, 0\n\tv_mbcnt_hi_u32_b32 %0, -1, %0" : "=v"(le_));
            E(acc, cur, wr, wc, le_ & 15, le_ >> 4); S.done(cur); }
        if (!has_next) break;
        if (!S.keep_acc(nxt)) {
#pragma unroll
        for (int a = 0; a < 2; ++a)
#pragma unroll
            for (int b = 0; b < 2; ++b)
#pragma unroll
                for (int m = 0; m < 4; ++m)
#pragma unroll
                    for (int n = 0; n < 2; ++n) acc[a][b][m][n] = (f32x4){0.f, 0.f, 0.f, 0.f};
        }
        cur = nxt; cA = nA; cB = nB; ++ui;
        if constexpr (Sched::GATHER) {
#pragma unroll
            for (int i = 0; i < 2; ++i) { va0[i] = vn0[i]; va1[i] = vn1[i]; } }
        if constexpr (ALIGN_EPI) { if (wr == 1) PG8_BAR; }
    }
    PG8_WAIT_V(0);
    if constexpr (!ALIGN_EPI) { if (wr == 0) PG8_BAR; }
    PG8_BAR;
    if constexpr (Epi::AFTER_DRAIN) { E.fused(acc, cur, wr, wc, fr, fq, lds, wid, lane); S.done(cur); }
#undef PG8_SA
#undef PG8_SB
#undef PG8_STAGE
#undef PG8_STAGE_A
#undef PG8_LDA
#undef PG8_LDB
#undef PG8_MMA
#undef PG8_WAIT_V
#undef PG8_WAIT_L
#undef PG8_BAR
#undef PG8_SCHED
}
}


namespace attn {
using bf16 = __hip_bfloat16;
constexpr int   D = 128, NW = 8, QBLK = 32, KVBLK = 64;
constexpr float SCALE = 0.088388347648318440f;
constexpr float THR = 8.f;
constexpr int SDEPTH = 2;
constexpr int LDQ = 512, LDK = 256, LDO = 512;
constexpr size_t SHM_V = KVBLK * D * 2, SHM_K = KVBLK * D * 2, SHM_ATTN = 2 * SHM_V + 2 * SHM_K + NW * 64 * 4;
using bf16x8 = __attribute__((ext_vector_type(8))) short;
using s16x4  = __attribute__((ext_vector_type(4))) short;
using f32x16 = __attribute__((ext_vector_type(16))) float;
using f32x8  = __attribute__((ext_vector_type(8))) float;
using u32x4  = __attribute__((ext_vector_type(4))) unsigned;
#define KSWZ(row, colB) ((row) * 256 + ((colB) ^ (((row) & 7) << 4)))
#define SBAR() __builtin_amdgcn_sched_barrier(0)
__device__ __forceinline__ int crow(int r, int hi) { return (r & 3) + 8 * (r >> 2) + 4 * hi; }
typedef float f32x2_t __attribute__((ext_vector_type(2))); typedef __bf16 bf16x2_t __attribute__((ext_vector_type(2)));
__device__ __forceinline__ unsigned cvtpk(float lo, float hi) { f32x2_t v = {lo, hi}; bf16x2_t b = __builtin_convertvector(v, bf16x2_t); return __builtin_bit_cast(unsigned, b); }
template <typename TIn> struct Stage;
template <> struct Stage<bf16>  { using T = bf16x8;
  __device__ static __forceinline__ T ld8(const bf16* p) { return *reinterpret_cast<const bf16x8*>(p); }
  __device__ static __forceinline__ bf16x8 tobf(T x) { return x; } };
template <> struct Stage<float> { using T = f32x8;
  __device__ static __forceinline__ T ld8(const float* p) { return *reinterpret_cast<const f32x8*>(p); }
  __device__ static __forceinline__ bf16x8 tobf(T x) {
    u32x4 w = {cvtpk(x[0], x[1]), cvtpk(x[2], x[3]), cvtpk(x[4], x[5]), cvtpk(x[6], x[7])}; return *reinterpret_cast<bf16x8*>(&w); } };

__device__ __forceinline__ void partialSM(f32x16& p0, f32x16& p1, float& m_reg, float& mn, float& alpha) {
  constexpr float C = SCALE * 1.4426950408889634f;
  float pmax = p0[0]; for (int r = 1; r < 16; ++r) pmax = fmaxf(pmax, p0[r]); for (int r = 0; r < 16; ++r) pmax = fmaxf(pmax, p1[r]);
  { auto rr = __builtin_amdgcn_permlane32_swap(__float_as_uint(pmax), __float_as_uint(pmax), false, false);
    pmax = fmaxf(__uint_as_float(rr[0]), __uint_as_float(rr[1])); }
  if (__builtin_expect(__all(pmax - m_reg <= THR / SCALE), 1)) { mn = m_reg; alpha = 1.f; }
  else { mn = fmaxf(m_reg, pmax); alpha = __builtin_amdgcn_exp2f((m_reg - mn) * C); m_reg = mn; }
  float mnC = -mn * C;
  for (int r = 0; r < 16; ++r) p0[r] = fmaf(p0[r], C, mnC); for (int r = 0; r < 16; ++r) p1[r] = fmaf(p1[r], C, mnC);
  for (int r = 0; r < 16; ++r) p0[r] = __builtin_amdgcn_exp2f(p0[r]);
}
__device__ __forceinline__ void finishSM(f32x16& p0, f32x16& p1, float alpha, float& l_reg, bf16x8& pa0, bf16x8& pa1, bf16x8& pa2, bf16x8& pa3) {
  for (int r = 0; r < 16; ++r) p1[r] = __builtin_amdgcn_exp2f(p1[r]);
  float ps = 0; for (int r = 0; r < 16; ++r) ps += p0[r]; for (int r = 0; r < 16; ++r) ps += p1[r];
  { auto rr = __builtin_amdgcn_permlane32_swap(__float_as_uint(ps), __float_as_uint(ps), false, false);
    ps = __uint_as_float(rr[0]) + __uint_as_float(rr[1]); }
  l_reg = l_reg * alpha + ps;
#define PK4(P, BASE, OUT) do { unsigned a0 = cvtpk(P[BASE + 0], P[BASE + 1]), a1 = cvtpk(P[BASE + 2], P[BASE + 3]);   \
    unsigned b0 = cvtpk(P[BASE + 4], P[BASE + 5]), b1 = cvtpk(P[BASE + 6], P[BASE + 7]);                              \
    auto r0 = __builtin_amdgcn_permlane32_swap(a0, b0, false, false); auto r1 = __builtin_amdgcn_permlane32_swap(a1, b1, false, false); \
    u32x4 w = {r0[0], r1[0], r0[1], r1[1]}; OUT = *reinterpret_cast<bf16x8*>(&w); } while (0)
  PK4(p0, 0, pa0); PK4(p0, 8, pa1); PK4(p1, 0, pa2); PK4(p1, 8, pa3);
#undef PK4
}
__device__ __forceinline__ void qkt(f32x16& p0, f32x16& p1, const bf16* Ks, const bf16x8* qr, int r32, int hi) {
  p0 = f32x16{}; p1 = f32x16{};
  for (int d0 = 0; d0 < 8; ++d0) { int cb = (d0 * 16 + hi * 8) * 2;
    bf16x8 b0 = *reinterpret_cast<const bf16x8*>((const char*)Ks + KSWZ(r32, cb));
    bf16x8 b1 = *reinterpret_cast<const bf16x8*>((const char*)Ks + KSWZ(32 + r32, cb));
    p0 = __builtin_amdgcn_mfma_f32_32x32x16_bf16(b0, qr[d0], p0, 0, 0, 0);
    p1 = __builtin_amdgcn_mfma_f32_32x32x16_bf16(b1, qr[d0], p1, 0, 0, 0); }
}
__device__ __forceinline__ int v_st(int k, int c) { const int kk = (k & ~0xC) | ((k & 4) << 1) | ((k & 8) >> 1); return ((kk >> 3) * 4 + (c >> 5)) * 512 + ((kk & 7) * 32 + (c & 31)) * 2; }
__device__ __forceinline__ int v_rd_base(int lane) { return ((lane & 3) << 3) | (((lane >> 2) & 3) << 6) | (((lane >> 4) & 1) << 5) | (((lane >> 5) & 1) << 8); }
constexpr int v_rd_off(int d0, int ks, int half) { return d0 * 512 + ks * 4096 + half * 2048; }
template <int OFF> __device__ __forceinline__ s16x4 tr_read(int vb) {
  s16x4 r; asm volatile("ds_read_b64_tr_b16 %0, %1 offset:%2" : "=&v"(r) : "v"(vb), "i"(OFF) : "memory"); return r;
}
template <int D0> __device__ __forceinline__ void pv_one(f32x16& od, int vb, bf16x8 pa0, bf16x8 pa1, bf16x8 pa2, bf16x8 pa3) {
  const s16x4 l0 = tr_read<v_rd_off(D0, 0, 0)>(vb), h0 = tr_read<v_rd_off(D0, 0, 1)>(vb), l1 = tr_read<v_rd_off(D0, 1, 0)>(vb), h1 = tr_read<v_rd_off(D0, 1, 1)>(vb);
  const s16x4 l2 = tr_read<v_rd_off(D0, 2, 0)>(vb), h2 = tr_read<v_rd_off(D0, 2, 1)>(vb), l3 = tr_read<v_rd_off(D0, 3, 0)>(vb), h3 = tr_read<v_rd_off(D0, 3, 1)>(vb);
  asm volatile("s_waitcnt lgkmcnt(0)" ::: "memory"); SBAR();
#define PK(L, H) (bf16x8){L[0], L[1], L[2], L[3], H[0], H[1], H[2], H[3]}
  od = __builtin_amdgcn_mfma_f32_32x32x16_bf16(pa0, PK(l0, h0), od, 0, 0, 0);
  od = __builtin_amdgcn_mfma_f32_32x32x16_bf16(pa1, PK(l1, h1), od, 0, 0, 0);
  od = __builtin_amdgcn_mfma_f32_32x32x16_bf16(pa2, PK(l2, h2), od, 0, 0, 0);
  od = __builtin_amdgcn_mfma_f32_32x32x16_bf16(pa3, PK(l3, h3), od, 0, 0, 0);
#undef PK
}
__device__ __forceinline__ void pv_d0(f32x16* o, int vb, bf16x8 pa0, bf16x8 pa1, bf16x8 pa2, bf16x8 pa3) {
  pv_one<0>(o[0], vb, pa0, pa1, pa2, pa3); pv_one<1>(o[1], vb, pa0, pa1, pa2, pa3); pv_one<2>(o[2], vb, pa0, pa1, pa2, pa3); pv_one<3>(o[3], vb, pa0, pa1, pa2, pa3);
}

template <typename TQ>
__device__ __forceinline__ void attn_dense_body(const TQ* __restrict__ Qb, const bf16* __restrict__ Kh, const bf16* __restrict__ Vh,
                                                bf16* __restrict__ Ob, int seq, char* lds, const int tid) {
  using St = Stage<bf16>; using SQ = Stage<TQ>;
  const int wid = tid >> 6, lane = tid & 63, r32 = lane & 31, hi = lane >> 5;
  bf16* V_lds = (bf16*)lds; bf16* K_lds = (bf16*)(lds + 2 * SHM_V);
  float* ws = (float*)(lds + 2 * SHM_V + 2 * SHM_K) + wid * 64; float* li_l = ws; float* al_l = ws + 32;
  float m_reg = -1e30f, l_reg = 0; f32x16 o[4] = {}; bf16x8 qr[8];
  const TQ* Qw = Qb + (long)(wid * QBLK + r32) * LDQ + hi * 8;
#pragma unroll
  for (int d0 = 0; d0 < 8; ++d0) qr[d0] = SQ::tobf(SQ::ld8(Qw + d0 * 16));
  const int sr = tid >> 4, sc = (tid & 15) * 8, vst0 = v_st(sr, sc), vst1 = v_st(32 + sr, sc);
  const int vb0 = (int)(uintptr_t)V_lds + v_rd_base(lane);
  struct { typename St::T vs0, vs1, ks0, ks1; } sr_[SDEPTH];
#define SLOAD(i, k0) do { sr_[i].vs0 = St::ld8(&Vh[(long)((k0) + sr) * LDK + sc]); sr_[i].vs1 = St::ld8(&Vh[(long)((k0) + 32 + sr) * LDK + sc]); \
    sr_[i].ks0 = St::ld8(&Kh[(long)((k0) + sr) * LDK + sc]); sr_[i].ks1 = St::ld8(&Kh[(long)((k0) + 32 + sr) * LDK + sc]); } while (0)
#define SWRITE(b, i) do { *(bf16x8*)((char*)V_lds + (b) * SHM_V + vst0) = St::tobf(sr_[i].vs0);          \
    *(bf16x8*)((char*)V_lds + (b) * SHM_V + vst1) = St::tobf(sr_[i].vs1); int kc = sc * 2;               \
    *(bf16x8*)((char*)K_lds + (b) * SHM_K + KSWZ(sr, kc)) = St::tobf(sr_[i].ks0);                       \
    *(bf16x8*)((char*)K_lds + (b) * SHM_K + KSWZ(32 + sr, kc)) = St::tobf(sr_[i].ks1); } while (0)
#define SWAIT() do { if constexpr (SDEPTH == 2) asm volatile("s_waitcnt vmcnt(4)" ::: "memory"); else asm volatile("s_waitcnt vmcnt(0)" ::: "memory"); } while (0)
#define RESC(a) do { if (__any((a) < 1.f)) { if (hi == 0) al_l[r32] = (a); asm volatile("s_waitcnt lgkmcnt(0)" ::: "memory"); \
    for (int d = 0; d < 4; ++d) for (int r = 0; r < 16; ++r) o[d][r] *= al_l[crow(r, hi)]; } } while (0)
  f32x16 pA0, pA1, pB0, pB1; float mnA, mnB, alA, alB; bf16x8 pa0, pa1, pa2, pa3; const int NT = seq / KVBLK;
  constexpr int SE = 0, SO = SDEPTH - 1;
  SLOAD(SE, 0); asm volatile("s_waitcnt vmcnt(0)" ::: "memory"); SWRITE(0, SE); __syncthreads();
  qkt(pA0, pA1, K_lds, qr, r32, hi); partialSM(pA0, pA1, m_reg, mnA, alA);
  SLOAD(SO, KVBLK); if constexpr (SDEPTH == 2) { if (2 < NT) SLOAD(SE, 2 * KVBLK); }
  SWAIT(); SWRITE(1, SO); __syncthreads();
  for (int j = 1; j + 1 < NT; j += 2) {
    SBAR(); qkt(pB0, pB1, (bf16*)((char*)K_lds + SHM_K), qr, r32, hi);
    finishSM(pA0, pA1, alA, l_reg, pa0, pa1, pa2, pa3); SBAR();
    SLOAD(SO, (j + SDEPTH) * KVBLK); SBAR();
    pv_d0(o, vb0, pa0, pa1, pa2, pa3); partialSM(pB0, pB1, m_reg, mnB, alB);
    __syncthreads(); SWAIT(); SWRITE(0, SE);
    RESC(alB); __syncthreads();
    SBAR(); qkt(pA0, pA1, K_lds, qr, r32, hi);
    finishSM(pB0, pB1, alB, l_reg, pa0, pa1, pa2, pa3); SBAR();
    if (SDEPTH == 1 || j + 3 < NT) SLOAD(SE, (j + 1 + SDEPTH) * KVBLK); SBAR();
    pv_d0(o, vb0 + (int)SHM_V, pa0, pa1, pa2, pa3); partialSM(pA0, pA1, m_reg, mnA, alA);
    __syncthreads(); SWAIT(); SWRITE(1, SO);
    RESC(alA); __syncthreads();
  }
  SBAR(); qkt(pB0, pB1, (bf16*)((char*)K_lds + SHM_K), qr, r32, hi);
  finishSM(pA0, pA1, alA, l_reg, pa0, pa1, pa2, pa3); SBAR();
  pv_d0(o, vb0, pa0, pa1, pa2, pa3); partialSM(pB0, pB1, m_reg, mnB, alB);
  __syncthreads(); RESC(alB);
  finishSM(pB0, pB1, alB, l_reg, pa0, pa1, pa2, pa3); SBAR();
  pv_d0(o, vb0 + (int)SHM_V, pa0, pa1, pa2, pa3);
  if (hi == 0) li_l[r32] = l_reg; asm volatile("s_waitcnt lgkmcnt(0)" ::: "memory");
  float rli[16];
#pragma unroll
  for (int r = 0; r < 16; ++r) rli[r] = __builtin_amdgcn_rcpf(li_l[crow(r, hi)]);
  bf16* Ow = Ob + (long)(wid * QBLK) * LDO;
#pragma unroll
  for (int r = 0; r < 16; ++r) { int orow = crow(r, hi);
    for (int d0 = 0; d0 < 4; ++d0) Ow[(long)orow * LDO + d0 * 32 + r32] = __float2bfloat16(o[d0][r] * rli[r]); }
#undef SLOAD
#undef SWRITE
#undef SWAIT
#undef RESC
}

constexpr float THR8 = 4.f;
using v8i = __attribute__((ext_vector_type(8))) int;
using v4i = __attribute__((ext_vector_type(4))) int;
__device__ __forceinline__ v8i cat8i(const v4i lo, const v4i hi) { return __builtin_shufflevector(lo, hi, 0, 1, 2, 3, 4, 5, 6, 7); }
__device__ __forceinline__ int pk4f8(float a, float b, float c, float d) { int w = 0; w = __builtin_amdgcn_cvt_pk_fp8_f32(a, b, w, false); w = __builtin_amdgcn_cvt_pk_fp8_f32(c, d, w, true); return w; }
__device__ __forceinline__ void partialSM8(f32x16& p0, f32x16& p1, float& m_reg, float& mn, float& alpha) {
  constexpr float C = SCALE * 1.4426950408889634f;
  float pmax = p0[0]; for (int r = 1; r < 16; ++r) pmax = fmaxf(pmax, p0[r]); for (int r = 0; r < 16; ++r) pmax = fmaxf(pmax, p1[r]);
  { auto rr = __builtin_amdgcn_permlane32_swap(__float_as_uint(pmax), __float_as_uint(pmax), false, false);
    pmax = fmaxf(__uint_as_float(rr[0]), __uint_as_float(rr[1])); }
  if (__builtin_expect(__all(pmax - m_reg <= THR8 / SCALE), 1)) { mn = m_reg; alpha = 1.f; }
  else { mn = fmaxf(m_reg, pmax); alpha = __builtin_amdgcn_exp2f((m_reg - mn) * C); m_reg = mn; }
  float mnC = -mn * C;
  for (int r = 0; r < 16; ++r) p0[r] = fmaf(p0[r], C, mnC); for (int r = 0; r < 16; ++r) p1[r] = fmaf(p1[r], C, mnC);
  for (int r = 0; r < 16; ++r) p0[r] = __builtin_amdgcn_exp2f(p0[r]);
}
__device__ __forceinline__ void finishSM8(f32x16& p0, f32x16& p1, float alpha, float& l_reg, v8i& pa) {
  for (int r = 0; r < 16; ++r) p1[r] = __builtin_amdgcn_exp2f(p1[r]);
  float ps = 0; for (int r = 0; r < 16; ++r) ps += p0[r]; for (int r = 0; r < 16; ++r) ps += p1[r];
  { auto rr = __builtin_amdgcn_permlane32_swap(__float_as_uint(ps), __float_as_uint(ps), false, false);
    ps = __uint_as_float(rr[0]) + __uint_as_float(rr[1]); }
  l_reg = l_reg * alpha + ps;
  pa[0] = pk4f8(p0[0], p0[1], p0[2], p0[3]);   pa[1] = pk4f8(p0[4], p0[5], p0[6], p0[7]);   pa[2] = pk4f8(p0[8], p0[9], p0[10], p0[11]); pa[3] = pk4f8(p0[12], p0[13], p0[14], p0[15]);
  pa[4] = pk4f8(p1[0], p1[1], p1[2], p1[3]);   pa[5] = pk4f8(p1[4], p1[5], p1[6], p1[7]);   pa[6] = pk4f8(p1[8], p1[9], p1[10], p1[11]); pa[7] = pk4f8(p1[12], p1[13], p1[14], p1[15]);
}
__device__ __forceinline__ void qkt8(f32x16& p0, f32x16& p1, const char* Ks, const v8i* qr8, int r32, int hi) {
  const int sw = r32 & 7; const char* k0 = Ks + r32 * 128; const char* k1 = Ks + (32 + r32) * 128;
#pragma unroll
  for (int s = 0; s < 2; ++s) { const int c0 = 4 * s + 2 * hi;
    const v8i a0 = cat8i(*(const v4i*)(k0 + ((c0 ^ sw) << 4)), *(const v4i*)(k0 + (((c0 + 1) ^ sw) << 4)));
    const v8i a1 = cat8i(*(const v4i*)(k1 + ((c0 ^ sw) << 4)), *(const v4i*)(k1 + (((c0 + 1) ^ sw) << 4)));
    if (s == 0) { p0 = __builtin_amdgcn_mfma_scale_f32_32x32x64_f8f6f4(a0, qr8[0], f32x16{}, 0, 0, 0, 0x7f7f7f7f, 0, 0x7f7f7f7f); p1 = __builtin_amdgcn_mfma_scale_f32_32x32x64_f8f6f4(a1, qr8[0], f32x16{}, 0, 0, 0, 0x7f7f7f7f, 0, 0x7f7f7f7f); }
    else { p0 = __builtin_amdgcn_mfma_scale_f32_32x32x64_f8f6f4(a0, qr8[1], p0, 0, 0, 0, 0x7f7f7f7f, 0, 0x7f7f7f7f); p1 = __builtin_amdgcn_mfma_scale_f32_32x32x64_f8f6f4(a1, qr8[1], p1, 0, 0, 0, 0x7f7f7f7f, 0, 0x7f7f7f7f); } }
}
__device__ __forceinline__ void pv8(f32x16* o, const char* Vs, const v8i pa, int r32, int hi) {
#pragma unroll
  for (int d0 = 0; d0 < 4; ++d0) { const int d = 32 * d0 + r32, sw = (d >> 2) & 3, c0 = 2 * hi; const char* vr = Vs + d * 64;
    const v8i b = cat8i(*(const v4i*)(vr + ((c0 ^ sw) << 4)), *(const v4i*)(vr + (((c0 + 1) ^ sw) << 4)));
    asm volatile("s_nop 4\n\tv_mfma_scale_f32_32x32x64_f8f6f4 %0, %1, %2, %0, %3, %3 op_sel_hi:[0,0,0]" : "+v"(o[d0]) : "v"(pa), "v"(b), "v"(0x7f7f7f7f)); }
}
constexpr float CQ8 = SCALE * 1.4426950408889634f * 8.f;
constexpr float THRL = 6.f;
typedef short v2s16 __attribute__((ext_vector_type(2)));
__device__ __forceinline__ int pk4s(float a, float b, float c, float d, float sc) { v2s16 w; w = __builtin_amdgcn_cvt_scalef32_pk_fp8_f32(w, a, b, sc, false); w = __builtin_amdgcn_cvt_scalef32_pk_fp8_f32(w, c, d, sc, true); return __builtin_bit_cast(int, w); }
template <bool FIRST>
__device__ __forceinline__ void partialSM10(f32x16& p0, f32x16& p1, float& Mi, float& sc, float& alpha) {
  float pmax = p0[0]; for (int r = 1; r < 16; ++r) pmax = fmaxf(pmax, p0[r]); for (int r = 0; r < 16; ++r) pmax = fmaxf(pmax, p1[r]);
  { auto rr = __builtin_amdgcn_permlane32_swap(__float_as_uint(pmax), __float_as_uint(pmax), false, false);
    pmax = fmaxf(__uint_as_float(rr[0]), __uint_as_float(rr[1])); }
  if (FIRST) { Mi = __builtin_ceilf(pmax); sc = __builtin_ldexpf(1.f, (int)Mi); alpha = 1.f; }
  else if (__builtin_expect(__all(pmax <= Mi + THRL), 1)) { alpha = 1.f; }
  else { const float Mn = fmaxf(Mi, __builtin_ceilf(pmax)); alpha = __builtin_amdgcn_exp2f(Mi - Mn); Mi = Mn; sc = __builtin_amdgcn_exp2f(Mi); }
  for (int r = 0; r < 16; ++r) p0[r] = __builtin_amdgcn_exp2f(p0[r]);
}
__device__ __forceinline__ void finishSM10(f32x16& p0, f32x16& p1, const float sc, v8i& pa) {
  for (int r = 0; r < 16; ++r) p1[r] = __builtin_amdgcn_exp2f(p1[r]);
  pa[0] = pk4s(p0[0], p0[1], p0[2], p0[3], sc);   pa[1] = pk4s(p0[4], p0[5], p0[6], p0[7], sc);   pa[2] = pk4s(p0[8], p0[9], p0[10], p0[11], sc); pa[3] = pk4s(p0[12], p0[13], p0[14], p0[15], sc);
  pa[4] = pk4s(p1[0], p1[1], p1[2], p1[3], sc);   pa[5] = pk4s(p1[4], p1[5], p1[6], p1[7], sc);   pa[6] = pk4s(p1[8], p1[9], p1[10], p1[11], sc); pa[7] = pk4s(p1[12], p1[13], p1[14], p1[15], sc);
}
__device__ __forceinline__ void attn8_body(const bf16* __restrict__ Qb, const unsigned char* __restrict__ K8h, const unsigned char* __restrict__ V8h,
                                           bf16* __restrict__ Ob, int seq, char* lds, const int tid) {
  const int wid = __builtin_amdgcn_readfirstlane(tid >> 6), lane = tid & 63, r32 = lane & 31, hi = lane >> 5;
  float* al_l = (float*)(lds + 65536) + wid * 32;
  f32x16 o[4] = {}, ol = {}; v8i qr8[2]; float Mi, sc;
  { const bf16* Qw = Qb + (long)(wid * QBLK + r32) * LDQ + hi * 32;
#pragma unroll
    for (int s = 0; s < 2; ++s)
#pragma unroll
      for (int q = 0; q < 4; ++q) { const bf16x8 x = *reinterpret_cast<const bf16x8*>(Qw + s * 64 + q * 8); float f[8];
#pragma unroll
        for (int i = 0; i < 8; ++i) f[i] = __uint_as_float((unsigned)(unsigned short)x[i] << 16) * CQ8;
        qr8[s][2 * q] = pk4f8(f[0], f[1], f[2], f[3]); qr8[s][2 * q + 1] = pk4f8(f[4], f[5], f[6], f[7]); } }
  typedef __attribute__((address_space(3))) unsigned lds_u32;
  const unsigned char* kg = K8h + tid * 16; const unsigned char* vg = V8h + tid * 16;
#define DMA8(t, slot) do { __builtin_amdgcn_global_load_lds((const unsigned*)(kg + (size_t)(t) * 8192), (lds_u32*)(lds + (slot) * 16384 + wid * 1024), 16, 0, 0); \
    __builtin_amdgcn_global_load_lds((const unsigned*)(vg + (size_t)(t) * 8192), (lds_u32*)(lds + (slot) * 16384 + 8192 + wid * 1024), 16, 0, 0); } while (0)
  const int ksw = (r32 >> 1) & 7, vsw = (r32 >> 2) & 3;
  const int kc0 = r32 * 128 + (((2 * hi) ^ ksw) << 4), kc1 = r32 * 128 + (((2 * hi + 1) ^ ksw) << 4), kc2 = r32 * 128 + (((4 + 2 * hi) ^ ksw) << 4), kc3 = r32 * 128 + (((5 + 2 * hi) ^ ksw) << 4);
  const int vc0 = 8192 + r32 * 64 + (((2 * hi) ^ vsw) << 4), vc1 = 8192 + r32 * 64 + (((2 * hi + 1) ^ vsw) << 4);
  v8i ones8; for (int i = 0; i < 8; ++i) ones8[i] = 0x38383838;
  asm volatile("" : "+v"(ones8));
#define LDK(S) do { const char* kb_ = lds + (S) * 16384; ka0 = cat8i(*(const v4i*)(kb_ + kc0), *(const v4i*)(kb_ + kc1)); ka1 = cat8i(*(const v4i*)(kb_ + 4096 + kc0), *(const v4i*)(kb_ + 4096 + kc1)); \
    kb0 = cat8i(*(const v4i*)(kb_ + kc2), *(const v4i*)(kb_ + kc3)); kb1 = cat8i(*(const v4i*)(kb_ + 4096 + kc2), *(const v4i*)(kb_ + 4096 + kc3)); } while (0)
#define LDV(S) do { const char* vb_ = lds + (S) * 16384; vf0 = cat8i(*(const v4i*)(vb_ + vc0), *(const v4i*)(vb_ + vc1)); vf1 = cat8i(*(const v4i*)(vb_ + 2048 + vc0), *(const v4i*)(vb_ + 2048 + vc1)); \
    vf2 = cat8i(*(const v4i*)(vb_ + 4096 + vc0), *(const v4i*)(vb_ + 4096 + vc1)); vf3 = cat8i(*(const v4i*)(vb_ + 6144 + vc0), *(const v4i*)(vb_ + 6144 + vc1)); } while (0)
#define QKT(P0, P1) do { P0 = __builtin_amdgcn_mfma_scale_f32_32x32x64_f8f6f4(ka0, qr8[0], f32x16{}, 0, 0, 0, 0x7f7f7f7f, 0, 0x7c7c7c7c); P1 = __builtin_amdgcn_mfma_scale_f32_32x32x64_f8f6f4(ka1, qr8[0], f32x16{}, 0, 0, 0, 0x7f7f7f7f, 0, 0x7c7c7c7c); \
    P0 = __builtin_amdgcn_mfma_scale_f32_32x32x64_f8f6f4(kb0, qr8[1], P0, 0, 0, 0, 0x7f7f7f7f, 0, 0x7c7c7c7c); P1 = __builtin_amdgcn_mfma_scale_f32_32x32x64_f8f6f4(kb1, qr8[1], P1, 0, 0, 0, 0x7f7f7f7f, 0, 0x7c7c7c7c); } while (0)
#define PVM(OD, VF) asm volatile("s_nop 4\n\tv_mfma_scale_f32_32x32x64_f8f6f4 %0, %1, %2, %0, %3, %3 op_sel_hi:[0,0,0]" : "+v"(OD) : "v"(pa), "v"(VF), "v"(0x7f7f7f7f))
#define PV() do { PVM(o[0], vf0); PVM(o[1], vf1); PVM(o[2], vf2); PVM(o[3], vf3); PVM(ol, ones8); } while (0)
#define RESC(a) do { if (__any((a) < 1.f)) { if (hi == 0) al_l[r32] = (a); asm volatile("s_nop 15\n\ts_nop 15\n\ts_nop 15\n\ts_nop 15\n\ts_nop 15\n\ts_waitcnt lgkmcnt(0)" ::: "memory"); \
    for (int r = 0; r < 16; ++r) { const float al_ = al_l[crow(r, hi)]; for (int d = 0; d < 4; ++d) o[d][r] *= al_; ol[r] *= al_; } } } while (0)
#define DMAK(t, slot) __builtin_amdgcn_global_load_lds((const unsigned*)(kg + (size_t)(t) * 8192), (lds_u32*)(lds + (slot) * 16384 + wid * 1024), 16, 0, 0)
#define DMAV(t, slot) __builtin_amdgcn_global_load_lds((const unsigned*)(vg + (size_t)(t) * 8192), (lds_u32*)(lds + (slot) * 16384 + 8192 + wid * 1024), 16, 0, 0)
#define PIN(x) asm volatile("" : "+v"(x))
#define TILE(j, PC0, PC1, alC, PP0, PP1, LASTW, DODMA) do { float pmx; \
    if (LASTW) asm volatile("s_waitcnt vmcnt(0)" ::: "memory"); else asm volatile("s_waitcnt vmcnt(2)" ::: "memory"); \
    __builtin_amdgcn_s_barrier(); asm volatile("" ::: "memory"); \
    SBAR(); LDK((j) & 3); SBAR(); \
    QKT(PC0, PC1); finishSM10(PP0, PP1, sc, pa); SBAR(); LDV(((j) - 1) & 3); SBAR(); \
    PVM(o[0], vf0); if (DODMA) DMAK((j) + 2, ((j) + 2) & 3); \
      pmx = PC0[0]; for (int r = 1; r < 16; ++r) pmx = fmaxf(pmx, PC0[r]); PIN(pmx); \
    PVM(o[1], vf1); if (DODMA) DMAV((j) + 2, ((j) + 2) & 3); \
      for (int r = 0; r < 16; ++r) pmx = fmaxf(pmx, PC1[r]); \
      { auto rr = __builtin_amdgcn_permlane32_swap(__float_as_uint(pmx), __float_as_uint(pmx), false, false); pmx = fmaxf(__uint_as_float(rr[0]), __uint_as_float(rr[1])); } PIN(pmx); \
    PVM(o[2], vf2); \
      { const bool ok_ = __all(pmx <= Mi + THRL); const float Mn = ok_ ? Mi : fmaxf(Mi, __builtin_ceilf(pmx)); \
        alC = __builtin_ldexpf(1.f, (int)(Mi - Mn)); sc = __builtin_ldexpf(1.f, (int)Mn); Mi = Mn; } \
      for (int r = 0; r < 5; ++r) PC0[r] = __builtin_amdgcn_exp2f(PC0[r]); PIN(PC0); PIN(sc); \
    PVM(o[3], vf3); for (int r = 5; r < 11; ++r) PC0[r] = __builtin_amdgcn_exp2f(PC0[r]); PIN(PC0); \
    PVM(ol, ones8); for (int r = 11; r < 16; ++r) PC0[r] = __builtin_amdgcn_exp2f(PC0[r]); PIN(PC0); SBAR(); \
    RESC(alC); } while (0)
  f32x16 pA0, pA1, pB0, pB1; float alA, alB; v8i pa, ka0, ka1, kb0, kb1, vf0, vf1, vf2, vf3; const int NT = seq / KVBLK;
  DMA8(0, 0); DMA8(1, 1);
  asm volatile("s_waitcnt vmcnt(2)" ::: "memory"); __builtin_amdgcn_s_barrier(); asm volatile("" ::: "memory"); DMA8(2, 2);
  SBAR(); LDK(0); SBAR(); QKT(pA0, pA1); partialSM10<true>(pA0, pA1, Mi, sc, alA); SBAR();
  for (int j = 1; j + 1 < NT; j += 2) {
    TILE(j, pB0, pB1, alB, pA0, pA1, false, true);
    TILE(j + 1, pA0, pA1, alA, pB0, pB1, false, (j + 3 < NT));
  }
  TILE(NT - 1, pB0, pB1, alB, pA0, pA1, true, false);
  finishSM10(pB0, pB1, sc, pa); SBAR(); LDV((NT - 1) & 3); SBAR();
  PV();
  asm volatile("s_nop 15\n\ts_nop 15\n\ts_nop 15\n\ts_nop 15\n\ts_nop 15" : "+v"(o[0]), "+v"(o[1]), "+v"(o[2]), "+v"(o[3]), "+v"(ol));
  bf16* Ow = Ob + (long)(wid * QBLK) * LDO;
#pragma unroll
  for (int r = 0; r < 16; ++r) { const int orow = crow(r, hi); const float rli = __builtin_amdgcn_rcpf(ol[r]);
    for (int d0 = 0; d0 < 4; ++d0) Ow[(long)orow * LDO + d0 * 32 + r32] = __float2bfloat16(o[d0][r] * rli); }
#undef DMA8
#undef LDK
#undef LDV
#undef QKT
#undef PVM
#undef PV
#undef RESC
#undef TILE
#undef PIN
#undef DMAK
#undef DMAV
}

#undef KSWZ
#undef SBAR
}
#define GAS __attribute__((address_space(1)))
#define LAS __attribute__((address_space(3)))
typedef unsigned short bf16;
typedef unsigned v4u __attribute__((ext_vector_type(4)));
typedef float f32x4 __attribute__((ext_vector_type(4)));
typedef short bf16x8 __attribute__((ext_vector_type(8)));
typedef GAS unsigned gu32;
typedef GAS unsigned long long gu64;
#define RLX_AGENT __ATOMIC_RELAXED, __HIP_MEMORY_SCOPE_AGENT
#define LDS_WAIT() asm volatile("s_waitcnt lgkmcnt(0)" ::: "memory")
#define VM_WAIT() asm volatile("s_waitcnt vmcnt(0)" ::: "memory")
__device__ __forceinline__ unsigned long long rt() { return __builtin_amdgcn_s_memrealtime(); }
__device__ __forceinline__ unsigned f2bf(float f) { unsigned u = __builtin_bit_cast(unsigned, f); return (u + 0x7fffu + ((u >> 16) & 1u)) >> 16; }
__device__ __forceinline__ unsigned pk2(float lo, float hi) { return f2bf(lo) | (f2bf(hi) << 16); }

#define XB_TMO      128
#define XB_XCNT(j)  (256  + 64 * (j))
#define XB_XSUB(j)  (1280 + 64 * (j))
#define XB_XGEN(j)  (2304 + 64 * (j))
#define XB_TOP      3328
#define XB_TOPGEN   3392
#define XCD_BAR_WORDS 3456
#define XB_SPIN_CAP (1u << 18)

__device__ __forceinline__ unsigned xb_ld(unsigned* p)              { return __hip_atomic_load(p, __ATOMIC_RELAXED, __HIP_MEMORY_SCOPE_AGENT); }
__device__ __forceinline__ unsigned xb_add(unsigned* p, unsigned v) { return __hip_atomic_fetch_add(p, v, __ATOMIC_RELAXED, __HIP_MEMORY_SCOPE_AGENT); }
__device__ __forceinline__ unsigned xb_xcc_id() { return (unsigned)__builtin_amdgcn_s_getreg((3 << 11) | 20) & 0xFu; }
#define XB_SPIN(cond, bar) do { unsigned _sp = 0; while (cond) { __builtin_amdgcn_s_sleep(1); \
    if ((++_sp & 255u) == 0u) { if (xb_ld(&(bar)[XB_TMO])) break; if (_sp > XB_SPIN_CAP) { atomicAdd(&(bar)[XB_TMO], 1u); break; } } } } while (0)

struct XcdBarrier {
    unsigned* bar; unsigned x;
    volatile LAS unsigned* st;
};

__device__ __forceinline__ XcdBarrier xcd_barrier_post(unsigned* bar, volatile LAS unsigned* st) {
    XcdBarrier b; b.bar = bar; b.x = xb_xcc_id(); b.st = st;
    if (threadIdx.x == 0) (void)xb_add(&bar[XB_XCNT(b.x)], 1u);
    return b;
}
__device__ __forceinline__ void xcd_barrier_complete(unsigned* bar, unsigned x, unsigned& nloc, unsigned& nx) {
    const unsigned G = gridDim.x * gridDim.y * gridDim.z;
    unsigned sum, cnt, mine, sp = 0u;
    for (;;) {
        sum = 0u; cnt = 0u; mine = 0u;
#pragma unroll
        for (unsigned j = 0; j < 16; ++j) { const unsigned c = xb_ld(&bar[XB_XCNT(j)]); sum += c; cnt += (c > 0u) ? 1u : 0u; mine = (j == x) ? c : mine; }
        if (sum == G) break;
        __builtin_amdgcn_s_sleep(1);
        if ((++sp & 255u) == 0u) { if (xb_ld(&bar[XB_TMO])) break; if (sp > XB_SPIN_CAP) { atomicAdd(&bar[XB_TMO], 1u); break; } }
    }
    nloc = mine > 0u ? mine : 1u; nx = cnt > 0u ? cnt : 1u;
}

__device__ __forceinline__ void xcd_barrier(const XcdBarrier& b, const int tid_) {
    asm volatile("s_waitcnt vmcnt(0)" ::: "memory");
    __syncthreads();
    if (tid_ == 0) {
        unsigned* bar = b.bar;
        __builtin_amdgcn_s_waitcnt(0);
        unsigned nloc = b.st[0], nx = b.st[1];
        if (nloc == 0u) { xcd_barrier_complete(bar, b.x, nloc, nx); b.st[0] = nloc; b.st[1] = nx; }
        const unsigned old = xb_add(&bar[XB_XSUB(b.x)], 1u);
        const unsigned gen = old / nloc;
        if (old + 1u == (gen + 1u) * nloc) {
            __builtin_amdgcn_fence(__ATOMIC_RELEASE, "agent");
            asm volatile("s_waitcnt vmcnt(0)" ::: "memory");
            const unsigned og = xb_add(&bar[XB_TOP], 1u);
            const unsigned tg = og / nx;
            if (og + 1u == (tg + 1u) * nx) xb_add(&bar[XB_TOPGEN], 1u);
            else XB_SPIN(xb_ld(&bar[XB_TOPGEN]) == tg, bar);
            __builtin_amdgcn_fence(__ATOMIC_ACQUIRE, "agent");
            xb_add(&bar[XB_XGEN(b.x)], 1u);
            asm volatile("s_waitcnt vmcnt(0)" ::: "memory");
        } else {
            XB_SPIN(xb_ld(&bar[XB_XGEN(b.x)]) == gen, bar);
            __builtin_amdgcn_fence(__ATOMIC_ACQUIRE, "agent");
            asm volatile("s_waitcnt vmcnt(0)" ::: "memory");
        }
    }
    __syncthreads();
}


constexpr size_t MiB = 1u << 20;
constexpr size_t WS_CTL = 0, CTL_ZERO_BYTES = 64 * 1024;
constexpr size_t WS_AFF = 1 * MiB;
constexpr size_t WS_COS = 2 * MiB, WS_SIN = 4 * MiB;
constexpr size_t WS_IDX = 6 * MiB, WS_GATE = 6 * MiB + 256 * 1024, WS_SEL = 7 * MiB;
constexpr size_t WS_WIN = 8 * MiB;
constexpr size_t WS_WR = 18 * MiB, WS_WA = 19 * MiB, WS_WO = 20 * MiB;
constexpr size_t WS_W1C = 22 * MiB;
constexpr size_t WS_WD = 198 * MiB;
constexpr size_t WS_X1 = 286 * MiB;
constexpr size_t WS_H = 350 * MiB;
constexpr size_t WS_RQ = 382 * MiB, WS_RK = 398 * MiB, WS_RV = 414 * MiB, WS_RGS = 430 * MiB;
constexpr size_t WS_AQ = 446 * MiB, WS_AK = 462 * MiB, WS_AV = 470 * MiB;
constexpr size_t WS_GRS = 478 * MiB, WS_GAS = 510 * MiB;
constexpr size_t WS_KV = 542 * MiB;
constexpr size_t WS_S = 606 * MiB;
constexpr size_t WS_YRIN = 638 * MiB, WS_ATT = 654 * MiB;
constexpr size_t WS_MIXED = 670 * MiB;
constexpr size_t WS_XE = 382 * MiB, WS_ACT = 446 * MiB, WS_Y = 622 * MiB;
constexpr size_t WS_K8 = 244 * MiB, WS_VT8 = 248 * MiB;
constexpr size_t WS_END = 704 * MiB;
static_assert(EP_COS == WS_COS && EP_SIN == WS_SIN && EP_RQ == WS_RQ && EP_RK == WS_RK && EP_RV == WS_RV && EP_RGS == WS_RGS && EP_AQ == WS_AQ && EP_AK == WS_AK && EP_AV == WS_AV && EP_GRS == WS_GRS && EP_GAS == WS_GAS, "epilogue offsets vs d_ws map");
constexpr int CW_BAR = 4096;

constexpr int RING_OFF = 0, RING_BYTES = 131072;
constexpr int LDSCTL_OFF = RING_BYTES, MISC_OFF = LDSCTL_OFF + 320;
constexpr int XCH_OFF = RING_BYTES + 1024;
constexpr int LDS_BYTES = 147456;
constexpr int NWAVES = 8;

__device__ __forceinline__ float wave_sum(float v) {
#pragma unroll
    for (int o = 1; o < 64; o <<= 1) v += __shfl_xor(v, o);
    return v;
}
__device__ __forceinline__ float bf2f(bf16 v) { return __uint_as_float((unsigned)v << 16); }

template <class CM>
__device__ __forceinline__ void transpose_item(const float* W, int K, int N, bf16* WT, const CM cm, LAS float* scr, int kb, int nb, int lane) {
    const int k0 = 64 * kb, n0 = 32 * nb;
    const int srccol = cm(n0 + (lane & 31));
    float tv[32];
#pragma unroll
    for (int i = 0; i < 32; ++i) tv[i] = __builtin_nontemporal_load(W + (size_t)(k0 + 2 * i + (lane >> 5)) * N + srccol);
#pragma unroll
    for (int i = 0; i < 32; ++i) scr[(2 * i + (lane >> 5)) * 33 + (lane & 31)] = tv[i];
    LDS_WAIT(); asm volatile("" ::: "memory");
    const int c = lane & 7;
#pragma unroll
    for (int j = 0; j < 4; ++j) { const int n = (lane >> 3) + 8 * j; const LAS float* s = scr + (8 * c) * 33 + n;
        v4u o; o.x = pk2(s[0 * 33], s[1 * 33]); o.y = pk2(s[2 * 33], s[3 * 33]); o.z = pk2(s[4 * 33], s[5 * 33]); o.w = pk2(s[6 * 33], s[7 * 33]);
        __builtin_nontemporal_store(o, (GAS v4u*)(WT + (size_t)(n0 + n) * K + k0 + 8 * c)); }
    LDS_WAIT(); asm volatile("" ::: "memory");
}
__device__ __forceinline__ unsigned pk4_fp8(float a, float b, float c, float d) { int w = 0; w = __builtin_amdgcn_cvt_pk_fp8_f32(a, b, w, false); w = __builtin_amdgcn_cvt_pk_fp8_f32(c, d, w, true); return (unsigned)w; }
template <class CM>
__device__ __forceinline__ void transpose_item_f8(const float* W, int K, int N, unsigned char* WT, const CM cm, LAS float* scr, int kb, int nb, int lane, float scale) {
    const int k0 = 64 * kb, n0 = 32 * nb;
    const int srccol = cm(n0 + (lane & 31));
    float tv[32];
#pragma unroll
    for (int i = 0; i < 32; ++i) tv[i] = __builtin_nontemporal_load(W + (size_t)(k0 + 2 * i + (lane >> 5)) * N + srccol);
#pragma unroll
    for (int i = 0; i < 32; ++i) scr[(2 * i + (lane >> 5)) * 33 + (lane & 31)] = tv[i];
    LDS_WAIT(); asm volatile("" ::: "memory");
    const int c = lane & 7;
#pragma unroll
    for (int j = 0; j < 4; ++j) { const int n = (lane >> 3) + 8 * j; const LAS float* sp = scr + (8 * c) * 33 + n;
        const unsigned lo = pk4_fp8(sp[0 * 33] * scale, sp[1 * 33] * scale, sp[2 * 33] * scale, sp[3 * 33] * scale), hi = pk4_fp8(sp[4 * 33] * scale, sp[5 * 33] * scale, sp[6 * 33] * scale, sp[7 * 33] * scale);
        __builtin_nontemporal_store((unsigned long long)lo | ((unsigned long long)hi << 32), (GAS unsigned long long*)(WT + (size_t)(n0 + n) * K + k0 + 8 * c)); }
    LDS_WAIT(); asm volatile("" ::: "memory");
}
struct CmId { __device__ __forceinline__ int operator()(int n) const { return n; } };
struct CmWin {
    __device__ __forceinline__ int operator()(int n) const {
        const bool rope = (n < 1024) || (n >= 2048 && n < 2816);
        const int L = n & 127, g = L >> 3, i = L & 7, o = (i < 4) ? (4 * g + i) : (64 + 4 * g + (i - 4));
        return rope ? ((n & ~127) + o) : n; }
};
struct CmW1 { __device__ __forceinline__ int operator()(int n) const { return 128 * (n >> 8) + (n & 127); } };

__device__ __forceinline__ void rms_row_to_bf16(const float* xrow, const float* gain, bf16* orow, int lane) {
    const GAS f32x4* xr = (const GAS f32x4*)xrow + lane; const GAS f32x4* gr = (const GAS f32x4*)gain + lane;
    f32x4 v[4]; float s = 0.f;
#pragma unroll
    for (int j = 0; j < 4; ++j) { v[j] = xr[64 * j]; s += (v[j].x * v[j].x + v[j].y * v[j].y) + (v[j].z * v[j].z + v[j].w * v[j].w); }
    const float rstd = 1.f / sqrtf(wave_sum(s) * (1.f / D_MODEL) + EPS);
    GAS unsigned long long* o8 = (GAS unsigned long long*)orow + lane;
#pragma unroll
    for (int j = 0; j < 4; ++j) { const f32x4 g4 = gr[64 * j]; o8[64 * j] = (unsigned long long)pk2(v[j].x * rstd * g4.x, v[j].y * rstd * g4.y) | ((unsigned long long)pk2(v[j].z * rstd * g4.z, v[j].w * rstd * g4.w) << 32); }
}


namespace ret {
typedef short bf16x8 __attribute__((ext_vector_type(8)));
typedef short v4i16 __attribute__((ext_vector_type(4)));
constexpr int PITCH = 272;
constexpr int TILE_B = 128 * PITCH;
constexpr int STRIP_B = 16 * PITCH;
__device__ __forceinline__ float lg2_of(const float* p, int h) { return log1pf(-expf(p[h])) * 1.4426950408889634f; }
__device__ __forceinline__ unsigned cvt2(float lo, float hi) { typedef float f2 __attribute__((ext_vector_type(2))); typedef __bf16 b2 __attribute__((ext_vector_type(2))); f2 v = {lo, hi}; b2 b = __builtin_convertvector(v, b2); return __builtin_bit_cast(unsigned, b); }
__device__ __forceinline__ bf16x8 frag_tr(LAS const unsigned char* tile, int k0, int n0, int lane) {
    const int g = lane >> 4, q = (lane >> 2) & 3, p = lane & 3;
    LAS const unsigned char* a = tile + (k0 + 8 * g + q) * PITCH + (n0 + 4 * p) * 2;
    const v4i16 lo = __builtin_amdgcn_ds_read_tr16_b64_v4i16((LAS v4i16*)a);
    const v4i16 hi = __builtin_amdgcn_ds_read_tr16_b64_v4i16((LAS v4i16*)(a + 4 * PITCH));
    return (bf16x8){lo[0], lo[1], lo[2], lo[3], hi[0], hi[1], hi[2], hi[3]};
}
__device__ __forceinline__ bf16x8 frag_row(LAS const unsigned char* tile, int r0, int k0, int lane) { return *(LAS const bf16x8*)(tile + (r0 + (lane & 15)) * PITCH + (k0 + 8 * (lane >> 4)) * 2); }
__device__ __forceinline__ void stage_tile(LAS unsigned char* tile, const bf16* src, long tok0, int h, int tid) {
#pragma unroll
    for (int i = 0; i < 4; ++i) { const int q = tid + 512 * i, row = q >> 4, ch = q & 15;
        const v4u v = *(const GAS v4u*)(src + (tok0 + row) * 512 + h * HD + ch * 8); *(LAS v4u*)(tile + row * PITCH + ch * 16) = v; }
}
__device__ __forceinline__ void kv_item(int item, LAS unsigned char* lds, const bf16* rk, const bf16* rv, const float* pf, const float* pb, float* kv, int tid) {
    asm volatile("" : "+v"(tid));
    const int c = item & 63, bh = item >> 6, b = bh >> 2, h = bh & 3, lane = tid & 63, w = tid >> 6, g = lane >> 4;
    const long tok0 = (long)b * SEQ + (long)c * CHUNK;
    LAS unsigned char* Kl = lds; LAS unsigned char* Vl = lds + TILE_B;
    stage_tile(Kl, rk, tok0, h, tid); stage_tile(Vl, rv, tok0, h, tid);
    __syncthreads();
    const float lf = lg2_of(pf, h), lb = lg2_of(pb, h);
    f32x4 accf[8], accb[8];
#pragma unroll
    for (int n = 0; n < 8; ++n) { accf[n] = (f32x4){0.f, 0.f, 0.f, 0.f}; accb[n] = (f32x4){0.f, 0.f, 0.f, 0.f}; }
#pragma unroll
    for (int kk = 0; kk < 4; ++kk) {
        const bf16x8 a = frag_tr(Vl, 32 * kk, 16 * w, lane);
        bf16x8 af, ab;
        { unsigned pf_[4], pb_[4];
#pragma unroll
          for (int t = 0; t < 8; t += 2) { const int j = 32 * kk + 8 * g + t;
              const float v0 = __uint_as_float((unsigned)(unsigned short)a[t] << 16), v1 = __uint_as_float((unsigned)(unsigned short)a[t + 1] << 16);
              pf_[t >> 1] = cvt2(v0 * __builtin_amdgcn_exp2f(lf * (float)(127 - j)), v1 * __builtin_amdgcn_exp2f(lf * (float)(126 - j)));
              pb_[t >> 1] = cvt2(v0 * __builtin_amdgcn_exp2f(lb * (float)j), v1 * __builtin_amdgcn_exp2f(lb * (float)(j + 1))); }
          const v4u wf_ = {pf_[0], pf_[1], pf_[2], pf_[3]}, wb_ = {pb_[0], pb_[1], pb_[2], pb_[3]};
          af = __builtin_bit_cast(bf16x8, wf_); ab = __builtin_bit_cast(bf16x8, wb_); }
#pragma unroll
        for (int n = 0; n < 8; ++n) { const bf16x8 bk = frag_tr(Kl, 32 * kk, 16 * n, lane);
            accf[n] = __builtin_amdgcn_mfma_f32_16x16x32_bf16(af, bk, accf[n], 0, 0, 0); accb[n] = __builtin_amdgcn_mfma_f32_16x16x32_bf16(ab, bk, accb[n], 0, 0, 0); }
    }
    float* of = kv + (((long)0 * 8 + bh) * NCHUNK + c) * (HD * HD); float* ob = kv + (((long)1 * 8 + bh) * NCHUNK + c) * (HD * HD);
#pragma unroll
    for (int n = 0; n < 8; ++n)
#pragma unroll
        for (int r = 0; r < 4; ++r) { const int o = (16 * w + 4 * g + r) * HD + 16 * n + (lane & 15); of[o] = accf[n][r]; ob[o] = accb[n][r]; }
    __syncthreads();
}
__device__ __forceinline__ void scan_thread(long gid, const float* pf, const float* pb, const float* kv, bf16* S) {
    const int el = (int)(gid & 16383), bh = (int)((gid >> 14) & 7), dir = (int)(gid >> 17), h = bh & 3;
    const float gC = __builtin_amdgcn_exp2f(lg2_of(dir ? pb : pf, h) * (float)CHUNK);
    const float* p = kv + (((long)dir * 8 + bh) * NCHUNK) * (HD * HD) + el; bf16* o = S + (((long)dir * 8 + bh) * NCHUNK) * (HD * HD) + el;
    float st = 0.f;
    if (dir == 0) {
#pragma unroll 8
        for (int c = 0; c < NCHUNK; ++c) { const float v = p[(long)c * HD * HD]; o[(long)c * HD * HD] = (bf16)f2bf(st); st = st * gC + v; } }
    else {
#pragma unroll 8
        for (int c = NCHUNK - 1; c >= 0; --c) { const float v = p[(long)c * HD * HD]; o[(long)c * HD * HD] = (bf16)f2bf(st); st = st * gC + v; } }
}
__device__ __forceinline__ void out_item(int item, LAS unsigned char* lds, const bf16* rq, const bf16* rk, const bf16* rv, const bf16* rgs, const float* pf, const float* pb,
                                         const bf16* S, const float* gain, bf16* yrin, int tid) {
    asm volatile("" : "+v"(tid));
    const int c = item & 63, bh = item >> 6, b = bh >> 2, h = bh & 3, lane = tid & 63, w = tid >> 6, g = lane >> 4, lc = lane & 15;
    const long tok0 = (long)b * SEQ + (long)c * CHUNK;
    LAS unsigned char* Kl = lds; LAS unsigned char* Vl = lds + TILE_B; LAS unsigned char* strip = lds + 2 * TILE_B + w * STRIP_B;
    stage_tile(Kl, rk, tok0, h, tid); stage_tile(Vl, rv, tok0, h, tid);
    bf16x8 qa[4];
#pragma unroll
    for (int kk = 0; kk < 4; ++kk) qa[kk] = *(const GAS bf16x8*)(rq + (tok0 + 16 * w + lc) * 512 + h * HD + 32 * kk + 8 * g);
    __syncthreads();
    const float lf = lg2_of(pf, h), lb = lg2_of(pb, h);
    {
        f32x4 sc[8];
#pragma unroll
        for (int n = 0; n < 8; ++n) { sc[n] = (f32x4){0.f, 0.f, 0.f, 0.f};
#pragma unroll
            for (int kk = 0; kk < 4; ++kk) sc[n] = __builtin_amdgcn_mfma_f32_16x16x32_bf16(qa[kk], frag_row(Kl, 16 * n, 32 * kk, lane), sc[n], 0, 0, 0); }
#pragma unroll
        for (int n = 0; n < 8; ++n)
#pragma unroll
            for (int r = 0; r < 4; ++r) { const int i = 16 * w + 4 * g + r, j = 16 * n + lc; const int df = i - j;
                const float dec = __builtin_amdgcn_exp2f(df >= 0 ? lf * (float)df : lb * (float)(-df));
                *(LAS unsigned short*)(strip + (4 * g + r) * PITCH + j * 2) = (unsigned short)f2bf(sc[n][r] * dec); }
    }
    asm volatile("s_waitcnt lgkmcnt(0)" ::: "memory");
    bf16x8 qf[4], qb[4];
    { const int ia = 16 * w + lc; const float cf = __builtin_amdgcn_exp2f(lf * (float)(ia + 1)), cb = __builtin_amdgcn_exp2f(lb * (float)(CHUNK - ia));
#pragma unroll
      for (int kk = 0; kk < 4; ++kk) { unsigned pf_[4], pb_[4];
#pragma unroll
          for (int t = 0; t < 8; t += 2) { const float v0 = __uint_as_float((unsigned)(unsigned short)qa[kk][t] << 16), v1 = __uint_as_float((unsigned)(unsigned short)qa[kk][t + 1] << 16);
              pf_[t >> 1] = cvt2(v0 * cf, v1 * cf); pb_[t >> 1] = cvt2(v0 * cb, v1 * cb); }
          const v4u wf_ = {pf_[0], pf_[1], pf_[2], pf_[3]}, wb_ = {pb_[0], pb_[1], pb_[2], pb_[3]};
          qf[kk] = __builtin_bit_cast(bf16x8, wf_); qb[kk] = __builtin_bit_cast(bf16x8, wb_); } }
    f32x4 o[8];
#pragma unroll
    for (int n = 0; n < 8; ++n) o[n] = (f32x4){0.f, 0.f, 0.f, 0.f};
    const bf16* Sf = S + (((long)0 * 8 + bh) * NCHUNK + c) * (HD * HD); const bf16* Sb = S + (((long)1 * 8 + bh) * NCHUNK + c) * (HD * HD);
#pragma unroll
    for (int kh = 0; kh < 2; ++kh) {
        bf16x8 bfv[2][8], bbv[2][8];
#pragma unroll
        for (int k2 = 0; k2 < 2; ++k2)
#pragma unroll
            for (int n = 0; n < 8; ++n) { const int kk = 2 * kh + k2; bfv[k2][n] = *(const GAS bf16x8*)(Sf + (16 * n + lc) * HD + 32 * kk + 8 * g); bbv[k2][n] = *(const GAS bf16x8*)(Sb + (16 * n + lc) * HD + 32 * kk + 8 * g); }
#pragma unroll
        for (int k2 = 0; k2 < 2; ++k2) { const int kk = 2 * kh + k2;
            const bf16x8 sa = frag_row(strip, 0, 32 * kk, lane);
#pragma unroll
            for (int n = 0; n < 8; ++n) {
                o[n] = __builtin_amdgcn_mfma_f32_16x16x32_bf16(sa, frag_tr(Vl, 32 * kk, 16 * n, lane), o[n], 0, 0, 0);
                o[n] = __builtin_amdgcn_mfma_f32_16x16x32_bf16(qf[kk], bfv[k2][n], o[n], 0, 0, 0); o[n] = __builtin_amdgcn_mfma_f32_16x16x32_bf16(qb[kk], bbv[k2][n], o[n], 0, 0, 0); } }
        asm volatile("" ::: "memory");
    }
    asm volatile("s_waitcnt lgkmcnt(0)" ::: "memory");
#pragma unroll
    for (int r = 0; r < 4; ++r) {
        float y[8]; float s = 0.f;
#pragma unroll
        for (int n = 0; n < 8; ++n) { y[n] = o[n][r]; s += y[n]; }
        s += __shfl_xor(s, 1); s += __shfl_xor(s, 2); s += __shfl_xor(s, 4); s += __shfl_xor(s, 8);
        const float mu = s * (1.0f / HD); float s2 = 0.f;
#pragma unroll
        for (int n = 0; n < 8; ++n) { y[n] -= mu; s2 += y[n] * y[n]; }
        s2 += __shfl_xor(s2, 1); s2 += __shfl_xor(s2, 2); s2 += __shfl_xor(s2, 4); s2 += __shfl_xor(s2, 8);
        const float rstd = 1.0f / sqrtf(s2 * (1.0f / HD) + EPS);
#pragma unroll
        for (int n = 0; n < 8; ++n) *(LAS unsigned short*)(strip + (4 * g + r) * PITCH + (16 * n + lc) * 2) = (unsigned short)f2bf(y[n] * rstd); }
    asm volatile("s_waitcnt lgkmcnt(0)" ::: "memory");
    { const int row = lane >> 2, qc = lane & 3; const long ro = (tok0 + 16 * w + row) * 512 + h * HD;
#pragma unroll
      for (int t = 0; t < 4; ++t) { const int e0 = 32 * qc + 8 * t;
          const v4u yv = *(LAS const v4u*)(strip + row * PITCH + e0 * 2);
          const f32x4 y0 = {__uint_as_float(yv.x << 16), __uint_as_float(yv.x & 0xffff0000u), __uint_as_float(yv.y << 16), __uint_as_float(yv.y & 0xffff0000u)};
          const f32x4 y1 = {__uint_as_float(yv.z << 16), __uint_as_float(yv.z & 0xffff0000u), __uint_as_float(yv.w << 16), __uint_as_float(yv.w & 0xffff0000u)};
          const f32x4 g0 = *(const GAS f32x4*)(gain + h * HD + e0), g1 = *(const GAS f32x4*)(gain + h * HD + e0 + 4);
          const v4u rg = *(const GAS v4u*)(rgs + ro + e0);
          const f32x4 r0 = {__uint_as_float(rg.x << 16), __uint_as_float(rg.x & 0xffff0000u), __uint_as_float(rg.y << 16), __uint_as_float(rg.y & 0xffff0000u)};
          const f32x4 r1 = {__uint_as_float(rg.z << 16), __uint_as_float(rg.z & 0xffff0000u), __uint_as_float(rg.w << 16), __uint_as_float(rg.w & 0xffff0000u)};
          const f32x4 a0 = y0 * g0 * r0, a1 = y1 * g1 * r1;
          v4u ov; ov.x = cvt2(a0[0], a0[1]); ov.y = cvt2(a0[2], a0[3]); ov.z = cvt2(a1[0], a1[1]); ov.w = cvt2(a1[2], a1[3]);
          *(GAS v4u*)(yrin + ro + e0) = ov; } }
    __syncthreads();
}
}

constexpr int W1_ITEMS = 16 * (16 * 176), W1_EARLY = (W1_ITEMS * MK_W1_EARLY_PCT) / 100;
struct Args { const float* in[17]; float* out; unsigned char* ws; int ph_lo, ph_hi; };
constexpr int PH_PROLOGUE = 0, PH_PROJ = 1, PH_RETKV = 2, PH_ATTN = 3, PH_RETOUT = 4, PH_BRANCH = 5, PH_WO = 6, PH_ROUTER = 7, PH_TOPK = 8, PH_GATHER = 9, PH_MOE1 = 10, PH_MOE2 = 11, PH_FINAL = 12, PH_END = 13;
#ifndef MK_EXPERT_CVT
#define MK_EXPERT_CVT 1
#endif

__global__ void __launch_bounds__(NWAVES * 64, 2) mega(Args args) {
    extern __shared__ __attribute__((aligned(16))) unsigned char lds_raw[];
    LAS unsigned char* lds = (LAS unsigned char*)lds_raw;
    volatile LAS unsigned* MISC = (volatile LAS unsigned*)(lds + MISC_OFF);
    const int wave = __builtin_amdgcn_readfirstlane((int)threadIdx.x >> 6);
#define PHASE_IDS int lane; asm volatile("v_mbcnt_lo_u32_b32 %0, -1, 0\n\tv_mbcnt_hi_u32_b32 %0, -1, %0" : "=v"(lane)); const int tid = wave * 64 + lane; (void)tid;
    const int G = gridDim.x; const int bx = blockIdx.x; const int vcu = (G % 8 == 0) ? (bx % 8) * (G / 8) + bx / 8 : bx;
    unsigned char* ws = args.ws;
    gu32* ctl = (gu32*)(ws + WS_CTL);
    for (int u = threadIdx.x; u < (LDS_BYTES - LDSCTL_OFF) / 4; u += NWAVES * 64) ((LAS unsigned*)(lds + LDSCTL_OFF))[u] = 0u;
    __syncthreads();
    const bool one_launch = (args.ph_hi - args.ph_lo) > 1;
    XcdBarrier bar; bar.bar = (unsigned*)(ctl + CW_BAR); bar.x = 0; bar.st = nullptr;
    if (one_launch) bar = xcd_barrier_post((unsigned*)(ctl + CW_BAR), MISC + 8);
    const int lo = args.ph_lo, hi = args.ph_hi;
#define IN(k) (lo <= (k) && (k) < hi)
#define SEAM(k) do { if (IN(k) && IN((k) + 1)) { PHASE_IDS xcd_barrier(bar, tid); } } while (0)
    const int gw = vcu * NWAVES + wave, NGW = G * NWAVES;

    if (IN(PH_PROLOGUE)) { PHASE_IDS
        LAS float* scr = (LAS float*)(lds + RING_OFF + wave * 16384);
        const float* w_in = args.in[2]; const float* w_ret = args.in[6]; const float* w_att = args.in[9]; const float* w_o = args.in[10];
        const float* wg = args.in[13]; const float* wu = args.in[14];
        constexpr int I_IN = 16 * 160, I_R = 8 * 32, I_A = 8 * 32, I_O = 16 * 32, I_1 = 16 * 176;
        constexpr int NSMALL = I_IN + I_R + I_A + I_O;
        const int NITEMS = NSMALL + W1_EARLY;
        for (int it = gw; it < NITEMS; it += NGW) {
            int r = it;
            if (r < I_IN) { transpose_item(w_in, 1024, INW, (bf16*)(ws + WS_WIN), CmWin(), scr, r / 160, r % 160, lane); continue; } r -= I_IN;
            if (r < I_R) { transpose_item(w_ret, 512, D_MODEL, (bf16*)(ws + WS_WR), CmId(), scr, r / 32, r % 32, lane); continue; } r -= I_R;
            if (r < I_A) { transpose_item(w_att, 512, D_MODEL, (bf16*)(ws + WS_WA), CmId(), scr, r / 32, r % 32, lane); continue; } r -= I_A;
            if (r < I_O) { transpose_item(w_o, 1024, D_MODEL, (bf16*)(ws + WS_WO), CmId(), scr, r / 32, r % 32, lane); continue; } r -= I_O;
            { const int e = r / I_1, q = r % I_1, kb = q / 176, nb = q % 176; const bool up = (nb >> 2) & 1;
                transpose_item_f8((up ? wu : wg) + (size_t)e * D_MODEL * FF, 1024, FF, (unsigned char*)(ws + WS_W1C) + (size_t)e * 5632 * 1024, CmW1(), scr, kb, nb, lane, W1_SCALE); }
        }
        for (int m = gw; m < T; m += NGW) rms_row_to_bf16(args.in[0] + (size_t)m * D_MODEL, args.in[1], (bf16*)(ws + WS_H) + (size_t)m * D_MODEL, lane);
        { float* ct = (float*)(ws + WS_COS); float* st = (float*)(ws + WS_SIN);
          for (int e = (vcu * NWAVES * 64) + tid; e < SEQ * 64; e += G * NWAVES * 64) { const int pos = e >> 6, j = e & 63;
              const float freq = powf(10000.0f, -(float)(j & 31) / 32.0f); const float ang = (float)(j < 32 ? (pos >> 6) : (pos & 63)) * freq;
              ct[e] = cosf(ang); st[e] = sinf(ang); } }
    }
    SEAM(PH_PROLOGUE);

    if (IN(PH_PROJ)) { PHASE_IDS
        pg8::PlainSched S; S.init(T, INW, G, bx); S.A = (const char*)(ws + WS_H); S.Bt = (const char*)(ws + WS_WIN); S.tstep = (size_t)256 * 1024 * 2;
        pg8::EpiProj E; E.wsb = ws; E.qn = args.in[7]; E.kn = args.in[8]; E.xch = (LAS float*)(lds + XCH_OFF); E.epoch = 0u;
        pg8::gemm_phase<pg8::EpiProj, pg8::PlainSched, true, true>(lds + RING_OFF, 1024, S, E, tid);
    }
    SEAM(PH_PROJ);

    if (IN(PH_RETKV)) { PHASE_IDS
        { const bf16* ak = (const bf16*)(ws + WS_AK); const bf16* av = (const bf16*)(ws + WS_AV); unsigned char* K8 = ws + WS_K8; unsigned char* Vt8 = ws + WS_VT8;
          for (int i = vcu * 512 + tid; i < T * 2 * 16; i += G * 512) { const int dg = i & 15, kvh = (i >> 4) & 1, t = i >> 5, b = t >> 13, tt = t & 8191;
              const v4u kx = *(const GAS v4u*)(ak + (size_t)t * 256 + kvh * 128 + dg * 8), vx = *(const GAS v4u*)(av + (size_t)t * 256 + kvh * 128 + dg * 8);
              float kf[8], vf[8];
              kf[0] = __uint_as_float(kx.x << 16); kf[1] = __uint_as_float(kx.x & 0xffff0000u); kf[2] = __uint_as_float(kx.y << 16); kf[3] = __uint_as_float(kx.y & 0xffff0000u);
              kf[4] = __uint_as_float(kx.z << 16); kf[5] = __uint_as_float(kx.z & 0xffff0000u); kf[6] = __uint_as_float(kx.w << 16); kf[7] = __uint_as_float(kx.w & 0xffff0000u);
              vf[0] = __uint_as_float(vx.x << 16); vf[1] = __uint_as_float(vx.x & 0xffff0000u); vf[2] = __uint_as_float(vx.y << 16); vf[3] = __uint_as_float(vx.y & 0xffff0000u);
              vf[4] = __uint_as_float(vx.z << 16); vf[5] = __uint_as_float(vx.z & 0xffff0000u); vf[6] = __uint_as_float(vx.w << 16); vf[7] = __uint_as_float(vx.w & 0xffff0000u);
              const size_t hb = (size_t)(b * 2 + kvh);
              *(GAS unsigned long long*)(K8 + (hb * 8192 + tt) * 128 + ((((dg >> 1) ^ ((tt >> 1) & 7)) << 4) | ((dg & 1) << 3))) = (unsigned long long)pk4_fp8(kf[0], kf[1], kf[2], kf[3]) | ((unsigned long long)pk4_fp8(kf[4], kf[5], kf[6], kf[7]) << 32);
              const int key = tt & 63, jt = tt >> 6, kk = key & 31, khi = (kk >> 2) & 1, j = (kk & 3) + 4 * (kk >> 3) + 16 * (key >> 5);
              const unsigned v03 = pk4_fp8(vf[0], vf[1], vf[2], vf[3]), v47 = pk4_fp8(vf[4], vf[5], vf[6], vf[7]);
              unsigned char* vt = Vt8 + (hb * 128 + jt) * 8192 + (j & 15);
#pragma unroll
              for (int q = 0; q < 8; ++q) { const int d = dg * 8 + q; vt[d * 64 + (((2 * khi + (j >> 4)) ^ ((d >> 2) & 3)) << 4)] = (unsigned char)(((q < 4 ? v03 : v47) >> (8 * (q & 3))) & 0xffu); } } }
        for (int item = vcu; item < 8 * NCHUNK; item += G)
            ret::kv_item(item, lds + RING_OFF, (const bf16*)(ws + WS_RK), (const bf16*)(ws + WS_RV), args.in[3], args.in[4], (float*)(ws + WS_KV), tid);
    }
    SEAM(PH_RETKV);

    if (IN(PH_ATTN)) { PHASE_IDS
        for (long gid = (long)vcu * 512 + tid; gid < 2 * 8 * 16384; gid += (long)G * 512) ret::scan_thread(gid, args.in[3], args.in[4], (const float*)(ws + WS_KV), (bf16*)(ws + WS_S));
    }

    if (IN(PH_ATTN)) { PHASE_IDS
        for (int u = vcu; u < BATCH * 4 * (SEQ / 256); u += G) {
            const int bh = u >> 5, qb = u & 31, b = bh >> 2, h = bh & 3, kvh = h >> 1;
            const size_t q0 = ((size_t)b * SEQ + (size_t)qb * 256) * 512 + (size_t)h * 128, k0 = (size_t)b * SEQ * 256 + (size_t)kvh * 128;
            attn::attn8_body((const attn::bf16*)(ws + WS_AQ) + q0, ws + WS_K8 + (size_t)(b * 2 + kvh) * 8192 * 128, ws + WS_VT8 + (size_t)(b * 2 + kvh) * 128 * 8192,
                             (attn::bf16*)(ws + WS_ATT) + q0, SEQ, (char*)lds_raw, tid);
            __syncthreads();
        }
    }
    SEAM(PH_ATTN);

    if (IN(PH_RETOUT)) { PHASE_IDS
        for (int item = vcu; item < 8 * NCHUNK; item += G)
            ret::out_item(item, lds + RING_OFF, (const bf16*)(ws + WS_RQ), (const bf16*)(ws + WS_RK), (const bf16*)(ws + WS_RV), (const bf16*)(ws + WS_RGS), args.in[3], args.in[4],
                          (const bf16*)(ws + WS_S), args.in[5], (bf16*)(ws + WS_YRIN), tid);
    }
    SEAM(PH_RETOUT);

    if (IN(PH_BRANCH)) { PHASE_IDS
        pg8::BranchSched S; S.init(T, D_MODEL, G, bx); S.A0 = (const char*)(ws + WS_YRIN); S.A1 = (const char*)(ws + WS_ATT); S.B0 = (const char*)(ws + WS_WR); S.B1 = (const char*)(ws + WS_WA); S.tstep = (size_t)256 * 512 * 2;
        pg8::EpiBranch E; E.grs = (const bf16*)(ws + WS_GRS); E.gas = (const bf16*)(ws + WS_GAS); E.mixed = (bf16*)(ws + WS_MIXED);
        pg8::gemm_phase<pg8::EpiBranch, pg8::BranchSched, true, true>(lds + RING_OFF, 512, S, E, tid);
    }
    SEAM(PH_BRANCH);

    if (IN(PH_WO)) { PHASE_IDS
        pg8::PlainSched S; S.init(T, D_MODEL, G, bx); S.A = (const char*)(ws + WS_MIXED); S.Bt = (const char*)(ws + WS_WO); S.tstep = (size_t)256 * 1024 * 2;
        pg8::EpiResid E; E.x = args.in[0]; E.x1 = (float*)(ws + WS_X1);
        pg8::gemm_phase<pg8::EpiResid, pg8::PlainSched, true, true>(lds + RING_OFF, 1024, S, E, tid);
    }
    SEAM(PH_WO);

    if (IN(PH_ROUTER)) { PHASE_IDS
        LAS float* wl = (LAS float*)(lds + RING_OFF);
        { const GAS float* src = (const GAS float*)args.in[12]; for (int i = tid; i < 1024 * 16; i += NWAVES * 64) wl[(i & 15) * 1024 + (i >> 4)] = src[i]; }
        __syncthreads();
        const float* x1 = (const float*)(ws + WS_X1); const float* gain = args.in[11]; bf16* h2 = (bf16*)(ws + WS_H); float* aff = (float*)(ws + WS_AFF);
        if (wave >= 4) {
            LAS float* scr = (LAS float*)(lds + RING_OFF + 65536 + (wave - 4) * 16384); const float* wg = args.in[13]; const float* wu = args.in[14]; constexpr int I_1 = 16 * 176;
            for (int it = W1_EARLY + vcu * 4 + (wave - 4); it < W1_ITEMS; it += G * 4) { const int e = it / I_1, q = it % I_1, kb = q / 176, nb = q % 176; const bool up = (nb >> 2) & 1;
                transpose_item_f8((up ? wu : wg) + (size_t)e * D_MODEL * FF, 1024, FF, (unsigned char*)(ws + WS_W1C) + (size_t)e * 5632 * 1024, CmW1(), scr, kb, nb, lane, W1_SCALE); }
        } else {
        const int gw = vcu * 4 + wave, NGW = G * 4;
        const GAS f32x4* gr = (const GAS f32x4*)gain + lane;
        f32x4 v[4];
        if (gw < T) { const GAS f32x4* xr = (const GAS f32x4*)(x1 + (size_t)gw * D_MODEL) + lane;
#pragma unroll
            for (int j = 0; j < 4; ++j) v[j] = xr[64 * j]; }
        for (int m = gw; m < T; m += NGW) {
            f32x4 nv[4];
            { const int mn = (m + NGW < T) ? m + NGW : m; const GAS f32x4* xn = (const GAS f32x4*)(x1 + (size_t)mn * D_MODEL) + lane;
#pragma unroll
              for (int j = 0; j < 4; ++j) nv[j] = xn[64 * j]; }
            float s = 0.f;
#pragma unroll
            for (int j = 0; j < 4; ++j) s += (v[j].x * v[j].x + v[j].y * v[j].y) + (v[j].z * v[j].z + v[j].w * v[j].w);
            const float rstd = 1.f / sqrtf(wave_sum(s) * (1.f / D_MODEL) + EPS);
            float lg[NE];
#pragma unroll
            for (int e = 0; e < NE; ++e) lg[e] = 0.f;
            GAS unsigned* o4 = (GAS unsigned*)((unsigned char*)h2 + (size_t)m * D_MODEL) + lane;
#pragma unroll
            for (int j = 0; j < 4; ++j) { const f32x4 g4 = gr[64 * j]; const f32x4 hv = v[j] * g4 * rstd;
                o4[64 * j] = pk4_fp8(hv.x, hv.y, hv.z, hv.w);
#pragma unroll
                for (int e = 0; e < NE; ++e) { const f32x4 w = *(const LAS f32x4*)(wl + e * 1024 + 4 * lane + 256 * j); lg[e] += (hv.x * w.x + hv.y * w.y) + (hv.z * w.z + hv.w * w.w); if ((e & 3) == 3) asm volatile("" ::: "memory"); }
                asm volatile("" ::: "memory"); }
            float r8[8], r4[4], r2[2], r1;
            { const bool b = (lane & 32) != 0;
#pragma unroll
              for (int e = 0; e < 8; ++e) { const float keep = b ? lg[e + 8] : lg[e], send = b ? lg[e] : lg[e + 8]; r8[e] = keep + __shfl_xor(send, 32); } }
            { const bool b = (lane & 16) != 0;
#pragma unroll
              for (int e = 0; e < 4; ++e) { const float keep = b ? r8[e + 4] : r8[e], send = b ? r8[e] : r8[e + 4]; r4[e] = keep + __shfl_xor(send, 16); } }
            { const bool b = (lane & 8) != 0;
#pragma unroll
              for (int e = 0; e < 2; ++e) { const float keep = b ? r4[e + 2] : r4[e], send = b ? r4[e] : r4[e + 2]; r2[e] = keep + __shfl_xor(send, 8); } }
            { const bool b = (lane & 4) != 0; const float keep = b ? r2[1] : r2[0], send = b ? r2[0] : r2[1]; r1 = keep + __shfl_xor(send, 4); }
            r1 += __shfl_xor(r1, 2); r1 += __shfl_xor(r1, 1);
            float mx = r1; mx = fmaxf(mx, __shfl_xor(mx, 4)); mx = fmaxf(mx, __shfl_xor(mx, 8)); mx = fmaxf(mx, __shfl_xor(mx, 16)); mx = fmaxf(mx, __shfl_xor(mx, 32));
            const float pe = expf(r1 - mx); float den = pe; den += __shfl_xor(den, 4); den += __shfl_xor(den, 8); den += __shfl_xor(den, 16); den += __shfl_xor(den, 32);
            if ((lane & 3) == 0) aff[(size_t)m * NE + (((lane >> 5) & 1) * 8 + ((lane >> 4) & 1) * 4 + ((lane >> 3) & 1) * 2 + ((lane >> 2) & 1))] = pe / den;
#pragma unroll
            for (int j = 0; j < 4; ++j) v[j] = nv[j];
        }
        }
        __syncthreads();
    }
    SEAM(PH_ROUTER);

    if (IN(PH_TOPK)) { PHASE_IDS
        if (vcu >= NZ) {
            const int lane_c = lane;
            LAS float* scr = (LAS float*)(lds + RING_OFF + wave * 16384); const float* wd = args.in[15]; constexpr int I_D = 44 * 32;
            for (int it = (vcu - NZ) * NWAVES + wave; it < NE * I_D; it += (G - NZ) * NWAVES) { const int e = it / I_D, q = it % I_D;
                transpose_item_f8(wd + (size_t)e * FF * D_MODEL, FF, D_MODEL, (unsigned char*)(ws + WS_WD) + (size_t)e * 1024 * FF, CmId(), scr, q / 32, q % 32, lane_c, WD_SCALE); }
        }
        LAS unsigned* keys = (LAS unsigned*)(lds + RING_OFF); LAS int* hist = (LAS int*)(lds + RING_OFF + 32768); LAS int* sc = (LAS int*)(lds + RING_OFF + 34816); volatile LAS unsigned* sv = (volatile LAS unsigned*)(lds + RING_OFF + 36864);
        const float* aff = (const float*)(ws + WS_AFF); int* idx = (int*)(ws + WS_IDX); float* gate = (float*)(ws + WS_GATE); int* sel = (int*)(ws + WS_SEL);
        for (int z = vcu; z < NZ; z += G) {
            const int b = z / NE, e = z % NE;
            for (int i = tid; i < SEQ; i += 512) keys[i] = __float_as_uint(aff[((size_t)b * SEQ + i) * NE + e]);
            if (tid == 0) { sv[0] = 0u; sv[1] = (unsigned)CAP; }
            __syncthreads();
            unsigned mask = 0u;
            for (int pass = 3; pass >= 0; --pass) {
                const int shift = pass * 8;
                if (tid < 256) hist[tid] = 0;
                __syncthreads();
                const unsigned prefix = sv[0];
                for (int i = tid; i < SEQ; i += 512) { const unsigned k = keys[i]; if ((k & mask) == prefix) atomicAdd((int*)&hist[(k >> shift) & 255u], 1); }
                __syncthreads();
                if (tid < 64) {
                    const int krem = (int)sv[1]; const int h0 = hist[4 * tid], h1 = hist[4 * tid + 1], h2 = hist[4 * tid + 2], h3 = hist[4 * tid + 3];
                    int suf = h0 + h1 + h2 + h3;
#pragma unroll
                    for (int o = 1; o < 64; o <<= 1) { const int t = __shfl_down(suf, o); if (tid + o < 64) suf += t; }
                    int cum = suf - (h0 + h1 + h2 + h3);
                    int dsel = -1, cumsel = 0;
                    if (cum < krem && cum + h3 >= krem) { dsel = 3; cumsel = cum; } cum += h3;
                    if (dsel < 0 && cum < krem && cum + h2 >= krem) { dsel = 2; cumsel = cum; } cum += h2;
                    if (dsel < 0 && cum < krem && cum + h1 >= krem) { dsel = 1; cumsel = cum; } cum += h1;
                    if (dsel < 0 && cum < krem && cum + h0 >= krem) { dsel = 0; cumsel = cum; }
                    if (dsel >= 0) { sv[1] = (unsigned)(krem - cumsel); sv[0] = prefix | ((unsigned)(4 * tid + dsel) << shift); }
                }
                __syncthreads();
                mask |= 0xFFu << shift;
            }
            const unsigned Tk = sv[0]; const int krem = (int)sv[1];
            int cgt = 0, ceq = 0;
            for (int q = 0; q < 16; ++q) { const unsigned k = keys[tid * 16 + q]; cgt += (k > Tk); ceq += (k == Tk); }
            int eqbase, slot;
            { sc[tid] = ceq; __syncthreads(); for (int off = 1; off < 512; off <<= 1) { const int t = (tid >= off) ? sc[tid - off] : 0; __syncthreads(); sc[tid] += t; __syncthreads(); } eqbase = sc[tid] - ceq; __syncthreads(); }
            int take = krem - eqbase; take = take < 0 ? 0 : (take > ceq ? ceq : take);
            { const int v = cgt + take; sc[tid] = v; __syncthreads(); for (int off = 1; off < 512; off <<= 1) { const int t = (tid >= off) ? sc[tid - off] : 0; __syncthreads(); sc[tid] += t; __syncthreads(); } slot = sc[tid] - v; __syncthreads(); }
            int eqr = eqbase;
            for (int q = 0; q < 16; ++q) { const int i = tid * 16 + q; const unsigned k = keys[i]; bool tk = k > Tk; if (k == Tk) { tk = eqr < krem; ++eqr; }
                if (tk) { idx[z * CAP + slot] = i; gate[z * CAP + slot] = __uint_as_float(k); sel[((size_t)b * SEQ + i) * NE + e] = slot; ++slot; } else sel[((size_t)b * SEQ + i) * NE + e] = -1; }
            __syncthreads();
        }
    }
    SEAM(PH_TOPK);


    if (IN(PH_MOE1)) { PHASE_IDS
        pg8::MoeGatherSched S; S.init(NZ * CAP, 5632, G, bx); S.A = (const char*)(ws + WS_H); S.Bt = (const char*)(ws + WS_W1C); S.idx = (const int*)(ws + WS_IDX);
        pg8::EpiSwiglu E; E.act = (unsigned char*)(ws + WS_ACT); E.in_scale = 1.0f / W1_SCALE; E.act_scale = ACT_SCALE;
        pg8::gemm_phase<pg8::EpiSwiglu, pg8::MoeGatherSched, true, true, true>(lds + RING_OFF, 1024 / 2, S, E, tid);
    }
    SEAM(PH_MOE1);

    if (IN(PH_MOE2)) { PHASE_IDS
        pg8::MoeSched S; S.init(NZ * CAP, D_MODEL, G, bx); S.A = (const char*)(ws + WS_ACT); S.Bt = (const char*)(ws + WS_WD); S.kb = (size_t)FF; S.nper = 1024;
        pg8::EpiDown E; E.y = (bf16*)(ws + WS_Y); E.gate = (const float*)(ws + WS_GATE); E.out_scale = 1.0f / (WD_SCALE * ACT_SCALE);
        pg8::gemm_phase<pg8::EpiDown, pg8::MoeSched, true, true, true>(lds + RING_OFF, FF / 2, S, E, tid);
    }
    SEAM(PH_MOE2);

    if (IN(PH_FINAL)) { PHASE_IDS
        const float* x1 = (const float*)(ws + WS_X1); const int* sel = (const int*)(ws + WS_SEL); const bf16* y = (const bf16*)(ws + WS_Y); const float* gain = args.in[16];
        for (int m = gw; m < T; m += NGW) {
            const int b = m / SEQ;
            const GAS f32x4* xr = (const GAS f32x4*)(x1 + (size_t)m * D_MODEL) + lane; const GAS f32x4* gr = (const GAS f32x4*)gain + lane;
            f32x4 v[4];
#pragma unroll
            for (int j = 0; j < 4; ++j) v[j] = xr[64 * j];
            const int mysel = (lane < NE) ? sel[(size_t)m * NE + lane] : -1;
            for (int e = 0; e < NE; ++e) { const int sl = __builtin_amdgcn_readlane(mysel, e);
                if (sl >= 0) { const GAS unsigned long long* yr = (const GAS unsigned long long*)(y + ((size_t)(b * NE + e) * CAP + sl) * D_MODEL) + lane;
#pragma unroll
                    for (int j = 0; j < 4; ++j) { const unsigned long long w = yr[64 * j]; const unsigned lo = (unsigned)w, hi = (unsigned)(w >> 32);
                        v[j].x += __uint_as_float(lo << 16); v[j].y += __uint_as_float(lo & 0xffff0000u); v[j].z += __uint_as_float(hi << 16); v[j].w += __uint_as_float(hi & 0xffff0000u); } } }
            float s = 0.f;
#pragma unroll
            for (int j = 0; j < 4; ++j) s += (v[j].x * v[j].x + v[j].y * v[j].y) + (v[j].z * v[j].z + v[j].w * v[j].w);
            const float rstd = 1.f / sqrtf(wave_sum(s) * (1.f / D_MODEL) + EPS);
            GAS f32x4* o = (GAS f32x4*)(args.out + (size_t)m * D_MODEL) + lane;
#pragma unroll
            for (int j = 0; j < 4; ++j) { const f32x4 g4 = gr[64 * j]; o[64 * j] = v[j] * g4 * rstd; }
        }
    }
#undef IN
#undef SEAM
}

#ifndef MK_DUP
#define MK_DUP (-1)
#endif
#ifndef MK_ONE_LAUNCH
#define MK_ONE_LAUNCH 1
#endif
extern "C" void kernel_launch(void* const* d_in, const int* in_sizes, int n_in, void* d_out, int out_size, void* d_ws, size_t ws_size, hipStream_t stream) {
    static int grid = 0;
    if (grid == 0) {
        if (n_in != 17 || in_sizes[0] != T * D_MODEL || out_size != T * D_MODEL || ws_size < WS_END) { fprintf(stderr, "kernel_launch: shape/workspace mismatch (ws %zu need %zu)\n", ws_size, (size_t)WS_END); grid = -1; return; }
        int dev = 0, cus = 0, per_cu = 0;
        if (hipGetDevice(&dev) != hipSuccess || hipDeviceGetAttribute(&cus, hipDeviceAttributeMultiprocessorCount, dev) != hipSuccess) { grid = -1; return; }
        if (hipFuncSetAttribute((const void*)mega, hipFuncAttributeMaxDynamicSharedMemorySize, LDS_BYTES) != hipSuccess) { fprintf(stderr, "kernel_launch: hipFuncSetAttribute failed\n"); grid = -1; return; }
        if (hipOccupancyMaxActiveBlocksPerMultiprocessor(&per_cu, (const void*)mega, NWAVES * 64, LDS_BYTES) != hipSuccess || per_cu < 1) { fprintf(stderr, "kernel_launch: occupancy query says %d blocks per CU\n", per_cu); (void)hipGetLastError(); grid = -1; return; }
        grid = cus;
    }
    if (grid < 0) return;
    unsigned char* ws = (unsigned char*)d_ws;
    (void)hipMemsetAsync(ws + WS_CTL, 0, CTL_ZERO_BYTES, stream);
    Args a{};
    for (int i = 0; i < 17; ++i) a.in[i] = (const float*)d_in[i];
    a.out = (float*)d_out; a.ws = ws;
#if MK_ONE_LAUNCH
    a.ph_lo = 0; a.ph_hi = PH_END; hipLaunchKernelGGL(mega, dim3(grid), dim3(NWAVES * 64), LDS_BYTES, stream, a);
#if MK_DUP >= 0
    a.ph_lo = MK_DUP; a.ph_hi = MK_DUP + 1; hipLaunchKernelGGL(mega, dim3(grid), dim3(NWAVES * 64), LDS_BYTES, stream, a);
#endif
#else
    for (int ph = 0; ph < PH_END; ++ph) { a.ph_lo = ph; a.ph_hi = ph + 1; hipLaunchKernelGGL(mega, dim3(grid), dim3(NWAVES * 64), LDS_BYTES, stream, a); }
#endif
}
```
